# Optimizing an MI355X kernel written in HIP

```python
import math
import jax, jax.numpy as jnp
from jax import lax
import numpy as np

D_MODEL = 1024
BATCH = 32
SEQ = 2048
DEPTH = 4

MEM_LEN = 256
ROPE_THETA = 10000.0
EPS = 1e-6
Q_BLOCK = 128
MAX_POS_OFFSET = 4096

DIFF_HEADS = 8
DIFF_HEAD_DIM = 64
DIFF_V_DIM = 2 * DIFF_HEAD_DIM
DIFF_QK_W = DIFF_HEADS * 2 * DIFF_HEAD_DIM
DIFF_V_W = DIFF_HEADS * DIFF_V_DIM

MLA_HEADS = 8
MLA_Q_LORA = 384
MLA_KV_LORA = 256
MLA_NOPE_DIM = 64
MLA_ROPE_DIM = 32
MLA_V_DIM = 64
MLA_QK_DIM = MLA_NOPE_DIM + MLA_ROPE_DIM
MLA_V_W = MLA_HEADS * MLA_V_DIM

CROSS_HEADS = 4
CROSS_HEAD_DIM = 128
CROSS_W = CROSS_HEADS * CROSS_HEAD_DIM

N_BRANCHES = 3
D_FF = 4 * D_MODEL

IN_SIZES = (DIFF_QK_W, DIFF_QK_W, DIFF_V_W, MLA_Q_LORA, MLA_KV_LORA + MLA_ROPE_DIM, CROSS_W, N_BRANCHES * D_MODEL)
IN_WIDTH = sum(IN_SIZES)

kernel_name = "hybrid_diffattn_mla_memxattn_sqrelu"


def rmsnorm(x, gain):
    xf = x.astype(jnp.float32)
    y = xf * lax.rsqrt(jnp.mean(xf * xf, axis=-1, keepdims=True) + EPS)
    return (y * gain.astype(jnp.float32)).astype(x.dtype)


def rotary_tables(positions, dim):
    inv_freq = ROPE_THETA ** (-jnp.arange(0, dim, 2, dtype=jnp.float32) / dim)
    ang = positions.astype(jnp.float32)[..., None] * inv_freq
    return jnp.cos(ang), jnp.sin(ang)


def rotary(x, cos, sin):
    xf = x.astype(jnp.float32)
    x1, x2 = jnp.split(xf, 2, axis=-1)
    return jnp.concatenate([x1 * cos - x2 * sin, x2 * cos + x1 * sin], axis=-1).astype(x.dtype)


def causal_block_attention(q, k, v, scale):
    B, S, H, M, Dk = q.shape
    nb = S // Q_BLOCK
    qb = q.reshape(B, nb, Q_BLOCK, H, M, Dk).transpose(1, 0, 2, 3, 4, 5)
    key_pos = jnp.arange(S)

    def one_block(args):
        q_blk, blk = args
        s = jnp.einsum('bqhmd,bkhmd->bhmqk', q_blk, k).astype(jnp.float32) * scale
        q_pos = blk * Q_BLOCK + jnp.arange(Q_BLOCK)
        mask = key_pos[None, :] <= q_pos[:, None]
        s = jnp.where(mask, s, -jnp.inf)
        p = jax.nn.softmax(s, axis=-1).astype(v.dtype)
        return jnp.einsum('bhmqk,bkhd->bqhmd', p, v)

    out = lax.map(one_block, (qb, jnp.arange(nb)))
    return out.transpose(1, 0, 2, 3, 4, 5).reshape(B, S, H, M, v.shape[-1])


def diff_attention(q, k, v, q_gain, k_gain, lam_vecs, out_gain, cos, sin, layer_idx):
    B, S, _ = q.shape
    q = q.reshape(B, S, DIFF_HEADS, 2, DIFF_HEAD_DIM)
    k = k.reshape(B, S, DIFF_HEADS, 2, DIFF_HEAD_DIM)
    v = v.reshape(B, S, DIFF_HEADS, DIFF_V_DIM)
    c, s_ = cos[:, :, None, None, :], sin[:, :, None, None, :]
    q = rotary(rmsnorm(q, q_gain), c, s_)
    k = rotary(rmsnorm(k, k_gain), c, s_)
    o = causal_block_attention(q, k, v, DIFF_HEAD_DIM ** -0.5)
    lam_init = 0.8 - 0.6 * math.exp(-0.3 * layer_idx)
    lv = lam_vecs.astype(jnp.float32)
    lam = jnp.exp(jnp.sum(lv[0] * lv[1])) - jnp.exp(jnp.sum(lv[2] * lv[3])) + lam_init
    o = o[:, :, :, 0, :] - lam.astype(o.dtype) * o[:, :, :, 1, :]
    o = rmsnorm(o, out_gain) * (1.0 - lam_init)
    return o.reshape(B, S, DIFF_V_W)


def latent_attention(c_q, c_kv_kr, qa_gain, w_qb, kva_gain, w_kvb, q_gain, k_gain, cos, sin):
    B, S, _ = c_q.shape
    q = (rmsnorm(c_q, qa_gain) @ w_qb).reshape(B, S, MLA_HEADS, MLA_QK_DIM)
    q_nope, q_rope = jnp.split(q, [MLA_NOPE_DIM], axis=-1)
    q_rope = rotary(q_rope, cos[:, :, None, :], sin[:, :, None, :])
    c_kv, k_rope = jnp.split(c_kv_kr, [MLA_KV_LORA], axis=-1)
    kv = (rmsnorm(c_kv, kva_gain) @ w_kvb).reshape(B, S, MLA_HEADS, MLA_NOPE_DIM + MLA_V_DIM)
    k_nope, v = jnp.split(kv, [MLA_NOPE_DIM], axis=-1)
    k_rope = rotary(k_rope, cos, sin)
    k_rope = jnp.broadcast_to(k_rope[:, :, None, :], (B, S, MLA_HEADS, MLA_ROPE_DIM))
    q = rmsnorm(jnp.concatenate([q_nope, q_rope], axis=-1), q_gain)
    k = rmsnorm(jnp.concatenate([k_nope, k_rope], axis=-1), k_gain)
    o = causal_block_attention(q[:, :, :, None, :], k[:, :, :, None, :], v, MLA_QK_DIM ** -0.5)
    return o.reshape(B, S, MLA_V_W)


def memory_cross_attention(q, mem_n, w_mem_kv, q_gain, k_gain):
    B, S, _ = q.shape
    q = rmsnorm(q.reshape(B, S, CROSS_HEADS, CROSS_HEAD_DIM), q_gain)
    kv = (mem_n @ w_mem_kv).reshape(B, mem_n.shape[1], 2, CROSS_HEADS, CROSS_HEAD_DIM)
    k = rmsnorm(kv[:, :, 0], k_gain)
    v = kv[:, :, 1]
    s = jnp.einsum('bshd,bmhd->bhsm', q, k).astype(jnp.float32) * (CROSS_HEAD_DIM ** -0.5)
    p = jax.nn.softmax(s, axis=-1).astype(v.dtype)
    o = jnp.einsum('bhsm,bmhd->bshd', p, v)
    return o.reshape(B, S, CROSS_W)


def setup_inputs(seed: int = 0) -> dict:
    key = jax.random.key(seed)
    ks = iter(jax.random.split(key, 40))
    L = DEPTH

    def nrm(shape, fan_in, scale=1.0):
        return jax.random.normal(next(ks), shape, jnp.float32) * (scale * fan_in ** -0.5)

    def gain(shape):
        return 1.0 + 0.02 * jax.random.normal(next(ks), shape, jnp.float32)

    res_scale = (2 * DEPTH) ** -0.5
    x = jax.random.normal(next(ks), (BATCH, SEQ, D_MODEL), jnp.float32)
    mem = jax.random.normal(next(ks), (BATCH, MEM_LEN, D_MODEL), jnp.float32)
    offset = jax.random.randint(next(ks), (BATCH, 1), 0, MAX_POS_OFFSET, dtype=jnp.int32)
    positions = (offset + jnp.arange(SEQ, dtype=jnp.int32)[None, :]).astype(jnp.int32)
    return {
        "x": x,
        "mem": mem,
        "positions": positions,
        "g_mix": gain((L, D_MODEL)),
        "w_in": nrm((L, D_MODEL, IN_WIDTH), D_MODEL),
        "b_gate": 0.01 * jax.random.normal(next(ks), (L, N_BRANCHES * D_MODEL), jnp.float32),
        "diff_q_gain": gain((L, DIFF_HEAD_DIM)),
        "diff_k_gain": gain((L, DIFF_HEAD_DIM)),
        "diff_lambda": 0.1 * jax.random.normal(next(ks), (L, 4, DIFF_HEAD_DIM), jnp.float32),
        "diff_out_gain": gain((L, DIFF_V_DIM)),
        "w_diff_o": nrm((L, DIFF_V_W, D_MODEL), DIFF_V_W),
        "mla_qa_gain": gain((L, MLA_Q_LORA)),
        "w_mla_qb": nrm((L, MLA_Q_LORA, MLA_HEADS * MLA_QK_DIM), MLA_Q_LORA),
        "mla_kva_gain": gain((L, MLA_KV_LORA)),
        "w_mla_kvb": nrm((L, MLA_KV_LORA, MLA_HEADS * (MLA_NOPE_DIM + MLA_V_DIM)), MLA_KV_LORA),
        "mla_q_gain": gain((L, MLA_QK_DIM)),
        "mla_k_gain": gain((L, MLA_QK_DIM)),
        "w_mla_o": nrm((L, MLA_V_W, D_MODEL), MLA_V_W),
        "mem_gain": gain((L, D_MODEL)),
        "w_mem_kv": nrm((L, D_MODEL, 2 * CROSS_W), D_MODEL),
        "cross_q_gain": gain((L, CROSS_HEAD_DIM)),
        "cross_k_gain": gain((L, CROSS_HEAD_DIM)),
        "w_cross_o": nrm((L, CROSS_W, D_MODEL), CROSS_W),
        "w_out": nrm((L, D_MODEL, D_MODEL), D_MODEL, res_scale),
        "g_mlp": gain((L, D_MODEL)),
        "w_mlp1": nrm((L, D_MODEL, D_FF), D_MODEL),
        "w_mlp2": nrm((L, D_FF, D_MODEL), D_FF, res_scale),
    }


def reference(x, mem, positions, g_mix, w_in, b_gate, diff_q_gain, diff_k_gain, diff_lambda,
              diff_out_gain, w_diff_o, mla_qa_gain, w_mla_qb, mla_kva_gain, w_mla_kvb,
              mla_q_gain, mla_k_gain, w_mla_o, mem_gain, w_mem_kv, cross_q_gain, cross_k_gain,
              w_cross_o, w_out, g_mlp, w_mlp1, w_mlp2):
    B, S, D = x.shape
    cos_d, sin_d = rotary_tables(positions, DIFF_HEAD_DIM)
    cos_r, sin_r = rotary_tables(positions, MLA_ROPE_DIM)
    split_idx = np.cumsum(IN_SIZES)[:-1].tolist()

    for l in range(DEPTH):
        h = rmsnorm(x, g_mix[l])
        dq, dk, dv, c_q, c_kv_kr, xq, gate_logits = jnp.split(h @ w_in[l], split_idx, axis=-1)

        y_diff = diff_attention(dq, dk, dv, diff_q_gain[l], diff_k_gain[l], diff_lambda[l],
                                diff_out_gain[l], cos_d, sin_d, l) @ w_diff_o[l]
        y_mla = latent_attention(c_q, c_kv_kr, mla_qa_gain[l], w_mla_qb[l], mla_kva_gain[l],
                                 w_mla_kvb[l], mla_q_gain[l], mla_k_gain[l], cos_r, sin_r) @ w_mla_o[l]
        mem_n = rmsnorm(mem, mem_gain[l])
        y_mem = memory_cross_attention(xq, mem_n, w_mem_kv[l], cross_q_gain[l], cross_k_gain[l]) @ w_cross_o[l]

        gates = jax.nn.sigmoid((gate_logits + b_gate[l]).reshape(B, S, N_BRANCHES, D))
        merged = gates[:, :, 0] * y_diff + gates[:, :, 1] * y_mla + gates[:, :, 2] * y_mem
        x = x + merged @ w_out[l]

        u = rmsnorm(x, g_mlp[l]) @ w_mlp1[l]
        x = x + jnp.square(jax.nn.relu(u)) @ w_mlp2[l]
    return x
```

```cpp
#include <hip/hip_runtime.h>
#include <hip/hip_cooperative_groups.h>
#include <stdint.h>
#include <stdio.h>
namespace cg = cooperative_groups;

typedef unsigned short bf16_t;
using bf16x8 = __attribute__((ext_vector_type(8))) short;
using f32x16 = __attribute__((ext_vector_type(16))) float;
typedef unsigned u4 __attribute__((ext_vector_type(4)));
typedef unsigned u2 __attribute__((ext_vector_type(2)));
typedef float f4 __attribute__((ext_vector_type(4)));
#define DI __device__ __forceinline__
#define MFMA(a, b, c) __builtin_amdgcn_mfma_f32_32x32x16_bf16((a), (b), (c), 0, 0, 0)

constexpr int T = 65536, DM = 1024, NB = 32, SEQ = 2048, NL = 4, MEML = 256, MEMR = NB * MEML;
constexpr int NTHR = 512;
constexpr int DUP_K = -1;
constexpr float EPSV = 1e-6f;
constexpr int WIN_N = 7424;
constexpr int WIN_GATE0 = 4352;

constexpr size_t MiB = 1024ull * 1024ull;
constexpr size_t OFF_XB = 0;
constexpr size_t OFF_QD = OFF_XB + 128 * MiB;
constexpr size_t OFF_KD = OFF_QD + 128 * MiB;
constexpr size_t OFF_VDT = OFF_KD + 128 * MiB;
constexpr size_t OFF_CQ = OFF_VDT + 128 * MiB;
constexpr size_t OFF_CKV = OFF_CQ + 48 * MiB;
constexpr size_t OFF_KR = OFF_CKV + 32 * MiB;
constexpr size_t OFF_XQ = OFF_KR + 8 * MiB;
constexpr size_t OFF_QM = OFF_XQ + 64 * MiB;
constexpr size_t OFF_KM = OFF_QM + 96 * MiB;
constexpr size_t OFF_VMT = OFF_KM + 96 * MiB;
constexpr size_t OFF_MEMB = OFF_VMT + 64 * MiB;
constexpr size_t OFF_KC = OFF_MEMB + 16 * MiB;
constexpr size_t OFF_VCT = OFF_KC + 8 * MiB;
constexpr size_t OFF_SSQX = OFF_VCT + 8 * MiB;
constexpr size_t OFF_SSQCQ = OFF_SSQX + 2 * MiB;
constexpr size_t OFF_SSQCKV = OFF_SSQCQ + 1 * MiB;
constexpr size_t OFF_SSQMEM = OFF_SSQCKV + 1 * MiB;
constexpr size_t OFF_W = OFF_SSQMEM + 1 * MiB;
constexpr size_t OFF_U = OFF_QD;
constexpr size_t W_IN = 0;
constexpr size_t W_MEM = W_IN + (size_t)WIN_N * 1024;
constexpr size_t W_QB = W_MEM + 1024 * 1024;
constexpr size_t W_KVB = W_QB + 1024 * 384;
constexpr size_t W_DO = W_KVB + 1024 * 256;
constexpr size_t W_MO = W_DO + 1024 * 1024;
constexpr size_t W_CO = W_MO + 1024 * 768;
constexpr size_t W_OUT = W_CO + 1024 * 512;
constexpr size_t W_1 = W_OUT + 1024 * 1024;
constexpr size_t W_2 = W_1 + 4096 * 1024;
constexpr size_t W_END = W_2 + 4096 * 1024;
constexpr size_t WS_NEED = OFF_W + W_END * 2;

constexpr int LDS_ROW = 144;
constexpr int CS_LD = 132;
constexpr int CS_BYTES = 256 * CS_LD * 4;
constexpr int RS_OFF = 2 * 512 * LDS_ROW;
constexpr int LDS_BYTES = RS_OFF + 1024;

__constant__ float INVF64[32] = {1.000000000e+00f,7.498942614e-01f,5.623413324e-01f,4.216965139e-01f,3.162277639e-01f,2.371373773e-01f,1.778279394e-01f,1.333521307e-01f,1.000000015e-01f,7.498941571e-02f,5.623413250e-02f,4.216965288e-02f,3.162277490e-02f,2.371373773e-02f,1.778279431e-02f,1.333521493e-02f,9.999999776e-03f,7.498941850e-03f,5.623413250e-03f,4.216964822e-03f,3.162277630e-03f,2.371373586e-03f,1.778279431e-03f,1.333521446e-03f,1.000000047e-03f,7.498942432e-04f,5.623413017e-04f,4.216965172e-04f,3.162277571e-04f,2.371373703e-04f,1.778279402e-04f,1.333521504e-04f};
__constant__ float INVF32[16] = {1.000000000e+00f,5.623413324e-01f,3.162277639e-01f,1.778279394e-01f,1.000000015e-01f,5.623413250e-02f,3.162277490e-02f,1.778279431e-02f,9.999999776e-03f,5.623413250e-03f,3.162277630e-03f,1.778279431e-03f,1.000000047e-03f,5.623413017e-04f,3.162277571e-04f,1.778279402e-04f};

struct Params {
  const float* in[27];
  float* out;
  char* ws;
  int ph_lo, ph_hi;
  int dupk, per;
};

typedef __bf16 bf2_t __attribute__((ext_vector_type(2)));
typedef float fl2_t __attribute__((ext_vector_type(2)));
DI unsigned pack2(float a, float b) { fl2_t f = {a, b}; bf2_t r = __builtin_convertvector(f, bf2_t); return __builtin_bit_cast(unsigned, r); }
DI u4 pack8(const float* v) { u4 u; u.x = pack2(v[0], v[1]); u.y = pack2(v[2], v[3]); u.z = pack2(v[4], v[5]); u.w = pack2(v[6], v[7]); return u; }
DI int ltid() { int t = threadIdx.x; asm volatile("" : "+v"(t)); return t; }
DI int crow(int i, int h) { return (i & 3) + 8 * (i >> 2) + 4 * h; }
DI void rot_cs(int pos, float invf, float& c, float& s) {
  const float ang = (float)pos * invf;
  const float n = rintf(ang * 0.15915494309189535f);
  float r = fmaf(-n, 6.28318548202514648f, ang);
  r = fmaf(-n, -1.74845553146815e-07f, r);
  const float rf = r * 0.15915494309189535f;
  c = __builtin_amdgcn_cosf(rf);
  s = __builtin_amdgcn_sinf(rf);
}
DI void load8(const float* Cs, int r, int q, float* v) {
  const f4 a = *(const f4*)(Cs + r * CS_LD + q * 8);
  const f4 b = *(const f4*)(Cs + r * CS_LD + q * 8 + 4);
  v[0] = a.x; v[1] = a.y; v[2] = a.z; v[3] = a.w; v[4] = b.x; v[5] = b.y; v[6] = b.z; v[7] = b.w;
}

template <int MI, int NI, int WGN, bool FDB>
DI void gemm_mainloop(const bf16_t* __restrict__ A, int lda, const bf16_t* __restrict__ B, int ldb, int K, f32x16 (&acc)[MI][NI], char* smem) {
  constexpr int BM = (8 / WGN) * MI * 32, BN = WGN * NI * 32;
  constexpr int ASZ = BM * 64, STAGE = (BM + BN) * 64;
  constexpr int NGA = BM / 128, NGB = BN / 128, NLD = NGA + NGB;
  static_assert(4 * STAGE <= RS_OFF, "ring");
  const int tid = ltid(), lane = tid & 63, wave = tid >> 6, l31 = lane & 31, h = lane >> 5;
  const int wu = __builtin_amdgcn_readfirstlane(wave);
  const int wm = wave / WGN, wn = wave % WGN;
  const int lrow = lane >> 2, lchk = (lane & 3) ^ ((lane >> 4) & 3);
  const bf16_t* ga = A + (size_t)(wu * NGA * 16 + lrow) * lda + lchk * 8;
  const bf16_t* gb = B + (size_t)(wu * NGB * 16 + lrow) * ldb + lchk * 8;
#pragma unroll
  for (int mi = 0; mi < MI; ++mi)
#pragma unroll
    for (int ni = 0; ni < NI; ++ni)
#pragma unroll
      for (int i = 0; i < 16; ++i) acc[mi][ni][i] = 0.f;
  auto issue = [&](int j) {
    char* st = smem + (j & 3) * STAGE;
    const int k0 = j * 32;
#pragma unroll
    for (int i = 0; i < NGA; ++i)
      __builtin_amdgcn_global_load_lds((const unsigned*)(ga + (size_t)(i * 16) * lda + k0), (unsigned*)(st + (wu * NGA + i) * 1024), 16, 0, 0);
#pragma unroll
    for (int i = 0; i < NGB; ++i)
      __builtin_amdgcn_global_load_lds((const unsigned*)(gb + (size_t)(i * 16) * ldb + k0), (unsigned*)(st + ASZ + (wu * NGB + i) * 1024), 16, 0, 0);
  };
  asm volatile("s_waitcnt vmcnt(0)" ::: "memory");
  __syncthreads();
  const int nk = K >> 5;
  issue(0); issue(1);
  const int sw = (l31 >> 2) & 3;
  const int oa = (wm * MI * 32 + l31) * 64, ob = ASZ + (wn * NI * 32 + l31) * 64;
  const int c0 = ((0 + h) ^ sw) * 16, c1 = ((2 + h) ^ sw) * 16;
#pragma unroll 1
  for (int j = 0; j < nk; j += 2) {
    asm volatile("s_waitcnt vmcnt(0)" ::: "memory");
    asm volatile("s_waitcnt lgkmcnt(0)" ::: "memory");
    __builtin_amdgcn_s_barrier();
    const char* s0 = smem + (j & 3) * STAGE;
    const char* s1 = smem + ((j + 1) & 3) * STAGE;
    bf16x8 fa[2][MI], fb[2][NI];
#pragma unroll
    for (int mi = 0; mi < MI; ++mi) fa[0][mi] = *(const bf16x8*)(s0 + oa + mi * 2048 + c0);
#pragma unroll
    for (int ni = 0; ni < NI; ++ni) fb[0][ni] = *(const bf16x8*)(s0 + ob + ni * 2048 + c0);
#pragma unroll
    for (int g = 0; g < 4; ++g) {
      if (g < 3) {
        const char* sn = ((g + 1) >> 1) ? s1 : s0;
        const int cn = ((g + 1) & 1) ? c1 : c0;
#pragma unroll
        for (int mi = 0; mi < MI; ++mi) fa[(g + 1) & 1][mi] = *(const bf16x8*)(sn + oa + mi * 2048 + cn);
#pragma unroll
        for (int ni = 0; ni < NI; ++ni) fb[(g + 1) & 1][ni] = *(const bf16x8*)(sn + ob + ni * 2048 + cn);
      }
      __builtin_amdgcn_sched_barrier(0);
#pragma unroll
      for (int mi = 0; mi < MI; ++mi)
#pragma unroll
        for (int ni = 0; ni < NI; ++ni) acc[mi][ni] = MFMA(fa[g & 1][mi], fb[g & 1][ni], acc[mi][ni]);
      __builtin_amdgcn_sched_barrier(0);
      if (g == 0 && j + 2 < nk) issue(j + 2);
      if (g == 1 && j + 3 < nk) issue(j + 3);
    }
  }
  asm volatile("s_waitcnt lgkmcnt(0)" ::: "memory");
  __builtin_amdgcn_s_barrier();
}

DI void fill_rs(float* rs, const float* ssq, int nparts, int pstride, int row0, float invK) {
  const int t = ltid();
  if (t < 256) {
    float r = 1.f;
    if (ssq) {
      float s = 0.f;
      for (int p = 0; p < nparts; ++p) s += ssq[(size_t)p * pstride + row0 + t];
      r = rsqrtf(s * invK + EPSV);
    }
    rs[t] = r;
  }
}

enum { EP_HEADROT = 0, EP_VT, EP_PLAIN, EP_KROPE, EP_NORM128, EP_QB, EP_KVB, EP_RES, EP_MLP1 };

struct Tile {
  int epi, row0, cb;
  bf16_t* dst; int ldd;
  const float* gain;
  float* ssq_out;
  const float* xsrc;
};

DI void map_regular(int it, int bid, int NCB, int& rb, int& CB) {
  const int xcd = bid & 7, slot = bid >> 3;
  const int c = xcd * NCB + it;
  const int cgrp = c >> 5, rgrp = c & 31;
  rb = rgrp * 8 + (slot >> 2);
  CB = cgrp * 4 + (slot & 3);
}

template <int DK, int DV, int NM, bool CAUSAL>
DI void attn_block(const bf16_t* __restrict__ Q, int ldq, const bf16_t* __restrict__ Kg, int ldk, const bf16_t* __restrict__ Vt, int ldv,
                   int nkt, int q0, bf16_t* O, int ldo, float sc, float lam, const float* og, float omul, char* smem) {
  constexpr int KW = NM * DK, KS = (KW + 8) * 2, KCH = KW / 8;
  constexpr int KBYTES = 64 * KS, VBYTES = DV * LDS_ROW, STAGE = KBYTES + VBYTES;
  constexpr int NKC = 64 * KCH, NKL = (NKC + NTHR - 1) / NTHR;
  constexpr int NVC = DV * 8, NVL = NVC / NTHR;
  static_assert(NVC % NTHR == 0, "v chunks");
  static_assert(2 * STAGE <= CS_BYTES, "lds");
  constexpr int NKC16 = DK / 16, NDVB = DV / 32;
  const int tid = ltid(), lane = tid & 63, wave = tid >> 6, h = lane >> 5, l31 = lane & 31;
  const int wq = (NM == 2) ? (wave & 3) : wave;
  const int mymap = (NM == 2) ? (wave >> 2) : 0;
  const int q0w = q0 + wq * 32;

  bf16x8 qf[NKC16];
  {
    const bf16_t* qp = Q + (size_t)(wq * 32 + l31) * ldq + mymap * DK + h * 8;
#pragma unroll
    for (int kc = 0; kc < NKC16; ++kc) qf[kc] = *(const bf16x8*)(qp + kc * 16);
  }
  f32x16 o[NDVB];
#pragma unroll
  for (int d = 0; d < NDVB; ++d)
#pragma unroll
    for (int i = 0; i < 16; ++i) o[d][i] = 0.f;
  float m_run = -INFINITY, l_run = 0.f;

  u4 rk[NKL], rv[NVL];
  auto gload = [&](int kt) {
#pragma unroll
    for (int i = 0; i < NKL; ++i) {
      const int c = tid + i * NTHR;
      if (NKC % NTHR == 0 || c < NKC) {
        const int r = c / KCH, cc = c % KCH;
        rk[i] = *(const u4*)(Kg + (size_t)(kt * 64 + r) * ldk + cc * 8);
      }
    }
#pragma unroll
    for (int i = 0; i < NVL; ++i) {
      const int c = tid + i * NTHR;
      const int r = c >> 3, cc = c & 7;
      rv[i] = *(const u4*)(Vt + (size_t)r * ldv + kt * 64 + cc * 8);
    }
  };
  auto swrite = [&](int s) {
    char* base = smem + s * STAGE;
#pragma unroll
    for (int i = 0; i < NKL; ++i) {
      const int c = tid + i * NTHR;
      if (NKC % NTHR == 0 || c < NKC) {
        const int r = c / KCH, cc = c % KCH;
        *(u4*)(base + r * KS + cc * 16) = rk[i];
      }
    }
#pragma unroll
    for (int i = 0; i < NVL; ++i) {
      const int c = tid + i * NTHR;
      const int r = c >> 3, cc = c & 7;
      *(u4*)(base + KBYTES + r * LDS_ROW + cc * 16) = rv[i];
    }
  };

  __syncthreads();
  gload(0);
  swrite(0);
  __syncthreads();
  for (int kt = 0; kt < nkt; ++kt) {
    const bool more = (kt + 1 < nkt);
    if (more) gload(kt + 1);
    const bool skip = CAUSAL && (kt * 64 > q0w + 31);
    if (!skip) {
      const char* base = smem + (kt & 1) * STAGE;
      f32x16 s[2];
#pragma unroll
      for (int sb = 0; sb < 2; ++sb) {
#pragma unroll
        for (int i = 0; i < 16; ++i) s[sb][i] = 0.f;
        const char* pk = base + (sb * 32 + l31) * KS + (mymap * DK + h * 8) * 2;
#pragma unroll
        for (int kc = 0; kc < NKC16; ++kc) {
          const bf16x8 a = *(const bf16x8*)(pk + kc * 32);
          s[sb] = MFMA(a, qf[kc], s[sb]);
        }
      }
      const bool need_mask = CAUSAL && (kt * 64 + 63 > q0w);
      float mx = -INFINITY;
#pragma unroll
      for (int sb = 0; sb < 2; ++sb)
#pragma unroll
        for (int i = 0; i < 16; ++i) {
          float v = s[sb][i];
          if (need_mask) {
            const int key = kt * 64 + sb * 32 + crow(i, h);
            if (key > q0w + l31) v = -INFINITY;
            s[sb][i] = v;
          }
          mx = fmaxf(mx, v);
        }
      mx = fmaxf(mx, __shfl_xor(mx, 32));
      const float m_new = fmaxf(m_run, mx);
      if (__any(m_new > m_run)) {
        const float alpha = __builtin_amdgcn_exp2f((m_run - m_new) * sc);
        l_run *= alpha;
#pragma unroll
        for (int d = 0; d < NDVB; ++d)
#pragma unroll
          for (int i = 0; i < 16; ++i) o[d][i] *= alpha;
      }
      m_run = m_new;
      const float mb = -m_new * sc;
      float ls = 0.f;
#pragma unroll
      for (int sb = 0; sb < 2; ++sb)
#pragma unroll
        for (int i = 0; i < 16; ++i) {
          const float p = __builtin_amdgcn_exp2f(fmaf(s[sb][i], sc, mb));
          s[sb][i] = p;
          ls += p;
        }
      l_run += ls;
      const char* pv = base + KBYTES + l31 * LDS_ROW + h * 8;
#pragma unroll
      for (int ks = 0; ks < 4; ++ks) {
        u4 pu;
        pu.x = pack2(s[ks >> 1][(ks & 1) * 8 + 0], s[ks >> 1][(ks & 1) * 8 + 1]);
        pu.y = pack2(s[ks >> 1][(ks & 1) * 8 + 2], s[ks >> 1][(ks & 1) * 8 + 3]);
        pu.z = pack2(s[ks >> 1][(ks & 1) * 8 + 4], s[ks >> 1][(ks & 1) * 8 + 5]);
        pu.w = pack2(s[ks >> 1][(ks & 1) * 8 + 6], s[ks >> 1][(ks & 1) * 8 + 7]);
        const bf16x8 pf = __builtin_bit_cast(bf16x8, pu);
#pragma unroll
        for (int d = 0; d < NDVB; ++d) {
          const u2 lo = *(const u2*)(pv + d * 32 * LDS_ROW + ks * 32);
          const u2 hi = *(const u2*)(pv + d * 32 * LDS_ROW + ks * 32 + 16);
          u4 au; au.x = lo.x; au.y = lo.y; au.z = hi.x; au.w = hi.y;
          o[d] = MFMA(__builtin_bit_cast(bf16x8, au), pf, o[d]);
        }
      }
    }
    if (more) swrite((kt + 1) & 1);
    __syncthreads();
  }
  const float l_tot = l_run + __shfl_xor(l_run, 32);
  const float inv = 1.f / l_tot;
#pragma unroll
  for (int d = 0; d < NDVB; ++d)
#pragma unroll
    for (int i = 0; i < 16; ++i) o[d][i] *= inv;

  float rn_out = 1.f;
  if (NM == 2) {
    float* buf = (float*)smem;
    if (wave >= 4) {
#pragma unroll
      for (int d = 0; d < NDVB; ++d)
#pragma unroll
        for (int i = 0; i < 16; ++i) buf[(d * 16 + i) * 256 + (wave & 3) * 64 + lane] = o[d][i];
    }
    __syncthreads();
    if (wave < 4) {
      float ss = 0.f;
#pragma unroll
      for (int d = 0; d < NDVB; ++d) {
#pragma unroll
        for (int i = 0; i < 16; ++i) {
          const float v = o[d][i] - lam * buf[(d * 16 + i) * 256 + wave * 64 + lane];
          o[d][i] = v;
          ss += v * v;
        }
        __builtin_amdgcn_sched_barrier(0);
      }
      ss += __shfl_xor(ss, 32);
      rn_out = rsqrtf(ss * (1.f / DV) + EPSV) * omul;
    }
  }
  if (NM == 1 || wave < 4) {
    bf16_t* op = O + (size_t)(wq * 32 + l31) * ldo + 4 * h;
#pragma unroll
    for (int d = 0; d < NDVB; ++d)
#pragma unroll
      for (int g = 0; g < 4; ++g) {
        f4 gg = {1.f, 1.f, 1.f, 1.f};
        if (NM == 2) gg = *(const f4*)(og + d * 32 + 8 * g + 4 * h);
        u2 u;
        u.x = pack2(o[d][4 * g + 0] * rn_out * gg.x, o[d][4 * g + 1] * rn_out * gg.y);
        u.y = pack2(o[d][4 * g + 2] * rn_out * gg.z, o[d][4 * g + 3] * rn_out * gg.w);
        *(u2*)(op + d * 32 + 8 * g) = u;
      }
  }
}

DI void prep_tile(const float* __restrict__ src, int N, const float* __restrict__ gain, bf16_t* __restrict__ dst, int Kp, int nmode, int kmode, int kt, int nt, char* smem) {
  float* tile = (float*)smem;
  const int tid = ltid();
  __syncthreads();
  {
    const int n = tid & 63;
    const int np = nt * 64 + n;
    int ns = np; bool nv = true;
    if (nmode == 1) {
      if (np < 3712) ns = np;
      else if (np < 3840) { ns = np; nv = (np < 3744); }
      else if (np < 4352) ns = np - 96;
      else ns = np - 96;
    } else if (nmode == 2) {
      const int hh = np >> 7, j = np & 127;
      nv = j < 96; ns = hh * 96 + j;
    }
#pragma unroll
    for (int j = 0; j < 8; ++j) {
      const int kk = (tid >> 6) + 8 * j;
      const int kp = kt * 64 + kk;
      int ks = kp; bool kv = true;
      if (kmode == 1) { const int hh = kp / 96, jj = kp % 96; kv = jj < 64; ks = hh * 64 + jj; }
      float v = 0.f;
      if (nv && kv) { v = src[(size_t)ks * N + ns]; if (gain) v *= gain[ks]; }
      tile[n * 65 + kk] = v;
    }
  }
  __syncthreads();
  {
    const int n = tid >> 3, kc = tid & 7;
    float v[8];
#pragma unroll
    for (int e = 0; e < 8; ++e) v[e] = tile[n * 65 + kc * 8 + e];
    *(u4*)(dst + (size_t)(nt * 64 + n) * Kp + kt * 64 + kc * 8) = pack8(v);
  }
}

DI void prep_item(const Params& p, int l, int it, char* smem) {
  bf16_t* W = (bf16_t*)(p.ws + OFF_W);
  const float* src; const float* gain = nullptr; bf16_t* dst; int N, Kp, nmode = 0, kmode = 0, nkt, loc;
  if (it < 1856)      { loc = it;        src = p.in[4] + (size_t)l * 1024 * 7328; N = 7328; gain = p.in[3] + l * 1024; dst = W + W_IN; Kp = 1024; nmode = 1; nkt = 16; }
  else if (it < 2112) { loc = it - 1856; src = p.in[19] + (size_t)l * 1024 * 1024; N = 1024; gain = p.in[18] + l * 1024; dst = W + W_MEM; Kp = 1024; nkt = 16; }
  else if (it < 2208) { loc = it - 2112; src = p.in[12] + (size_t)l * 384 * 768; N = 768; gain = p.in[11] + l * 384; dst = W + W_QB; Kp = 384; nmode = 2; nkt = 6; }
  else if (it < 2272) { loc = it - 2208; src = p.in[14] + (size_t)l * 256 * 1024; N = 1024; gain = p.in[13] + l * 256; dst = W + W_KVB; Kp = 256; nkt = 4; }
  else if (it < 2528) { loc = it - 2272; src = p.in[10] + (size_t)l * 1024 * 1024; N = 1024; dst = W + W_DO; Kp = 1024; nkt = 16; }
  else if (it < 2720) { loc = it - 2528; src = p.in[17] + (size_t)l * 512 * 1024; N = 1024; dst = W + W_MO; Kp = 768; kmode = 1; nkt = 12; }
  else if (it < 2848) { loc = it - 2720; src = p.in[22] + (size_t)l * 512 * 1024; N = 1024; dst = W + W_CO; Kp = 512; nkt = 8; }
  else if (it < 3104) { loc = it - 2848; src = p.in[23] + (size_t)l * 1024 * 1024; N = 1024; dst = W + W_OUT; Kp = 1024; nkt = 16; }
  else if (it < 4128) { loc = it - 3104; src = p.in[25] + (size_t)l * 1024 * 4096; N = 4096; gain = p.in[24] + l * 1024; dst = W + W_1; Kp = 1024; nkt = 16; }
  else                { loc = it - 4128; src = p.in[26] + (size_t)l * 4096 * 1024; N = 1024; dst = W + W_2; Kp = 4096; nkt = 64; }
  prep_tile(src, N, gain, dst, Kp, nmode, kmode, loc % nkt, loc / nkt, smem);
}
DI void prep_range(const Params& p, int l, int lo, int hi, char* smem) {
  for (int it = lo + blockIdx.x; it < hi; it += gridDim.x) prep_item(p, l, it, smem);
}

DI void phase_init(const Params& p) {
  const int tid_ = ltid(); const int lane = tid_ & 63, gw = blockIdx.x * 8 + (tid_ >> 6), GW = gridDim.x * 8;
  bf16_t* XB = (bf16_t*)(p.ws + OFF_XB); bf16_t* MB = (bf16_t*)(p.ws + OFF_MEMB);
  float* SX = (float*)(p.ws + OFF_SSQX); float* SM = (float*)(p.ws + OFF_SSQMEM);
  for (int r = gw; r < T + MEMR; r += GW) {
    const bool isx = r < T;
    const float* src = isx ? p.in[0] + (size_t)r * 1024 : p.in[1] + (size_t)(r - T) * 1024;
    bf16_t* dst = isx ? XB + (size_t)r * 1024 : MB + (size_t)(r - T) * 1024;
    float ss = 0.f;
#pragma unroll
    for (int j = 0; j < 4; ++j) {
      const f4 v = *(const f4*)(src + j * 256 + lane * 4);
      ss += v.x * v.x + v.y * v.y + v.z * v.z + v.w * v.w;
      u2 u; u.x = pack2(v.x, v.y); u.y = pack2(v.z, v.w);
      *(u2*)(dst + j * 256 + lane * 4) = u;
    }
#pragma unroll
    for (int m = 32; m >= 1; m >>= 1) ss += __shfl_xor(ss, m);
    if (isx) { if (lane < 8) SX[(size_t)lane * T + r] = (lane == 0) ? ss : 0.f; }
    else if (lane == 0) SM[r - T] = ss;
  }
}

DI void run_epilogue(const Params& p, const Tile& t, char* smem) {
  float* Cs = (float*)smem;
  float* rs = (float*)(smem + RS_OFF);
  const int tid = ltid();
  const int q = tid & 15, rsub = tid >> 4;
  const int* pos = (const int*)p.in[2];
  if (t.epi == EP_VT) {
    const int c = tid >> 2, rq = tid & 3;
#pragma unroll
    for (int j = 0; j < 8; ++j) {
      float v[8];
#pragma unroll
      for (int e = 0; e < 8; ++e) { const int r = rq * 64 + j * 8 + e; v[e] = Cs[r * CS_LD + c] * rs[r]; }
      *(u4*)(t.dst + (size_t)c * t.ldd + rq * 64 + j * 8) = pack8(v);
    }
    return;
  }
  float g8[8];
#pragma unroll
  for (int e = 0; e < 8; ++e) g8[e] = 1.f;
  if (t.epi == EP_HEADROT || t.epi == EP_NORM128 || ((t.epi == EP_QB || t.epi == EP_KVB) && q < 12)) {
    const float* gp_ = t.gain + ((t.epi == EP_HEADROT) ? (q & 7) * 8 : q * 8);
    const f4 ga_ = *(const f4*)gp_, gb_ = *(const f4*)(gp_ + 4);
    g8[0] = ga_.x; g8[1] = ga_.y; g8[2] = ga_.z; g8[3] = ga_.w; g8[4] = gb_.x; g8[5] = gb_.y; g8[6] = gb_.z; g8[7] = gb_.w;
  }
  int pre_pos = 0;
  f4 pre_a = {0.f, 0.f, 0.f, 0.f}, pre_b = {0.f, 0.f, 0.f, 0.f};
  auto prefetch = [&](int pass_) {
    const int row_ = t.row0 + rsub + 32 * pass_;
    if (t.epi == EP_HEADROT || t.epi == EP_KROPE || t.epi == EP_QB) pre_pos = pos[row_];
    if (t.epi == EP_RES) {
      const float* xs = t.xsrc + (size_t)row_ * 1024 + t.cb * 128 + q * 8;
      pre_a = *(const f4*)xs; pre_b = *(const f4*)(xs + 4);
    }
    if (t.epi == EP_KVB && q >= 8 && q < 12) {
      const float* kr = (const float*)(p.ws + OFF_KR) + (size_t)row_ * 32 + (q - 8) * 8;
      pre_a = *(const f4*)kr; pre_b = *(const f4*)(kr + 4);
    }
  };
  prefetch(0);
#pragma unroll 2
  for (int pass = 0; pass < 8; ++pass) {
    const int r = rsub + 32 * pass;
    const int row = t.row0 + r;
    const int ps = pre_pos;
    const f4 ca = pre_a, cb4 = pre_b;
    if (pass < 7) prefetch(pass + 1);
    float v[8];
    load8(Cs, r, q, v);
    const float rsv = rs[r];
#pragma unroll
    for (int e = 0; e < 8; ++e) v[e] *= rsv;
    switch (t.epi) {
      case EP_HEADROT: {
        float ss = 0.f;
#pragma unroll
        for (int e = 0; e < 8; ++e) ss += v[e] * v[e];
        ss += __shfl_xor(ss, 1); ss += __shfl_xor(ss, 2); ss += __shfl_xor(ss, 4);
        const float rn = rsqrtf(ss * (1.f / 64) + EPSV);
        const int pp = q & 7; const bool first = pp < 4; const int i0 = (pp & 3) * 8;
        float ov[8];
#pragma unroll
        for (int e = 0; e < 8; ++e) {
          const float y = v[e] * rn * g8[e];
          const float yp = __shfl_xor(y, 4);
          float c, s; rot_cs(ps, INVF64[i0 + e], c, s);
          ov[e] = first ? (y * c - yp * s) : (y * c + yp * s);
        }
        *(u4*)(t.dst + (size_t)row * t.ldd + t.cb * 128 + q * 8) = pack8(ov);
      } break;
      case EP_PLAIN: {
        float ss = 0.f;
#pragma unroll
        for (int e = 0; e < 8; ++e) ss += v[e] * v[e];
        ss += __shfl_xor(ss, 1); ss += __shfl_xor(ss, 2); ss += __shfl_xor(ss, 4); ss += __shfl_xor(ss, 8);
        *(u4*)(t.dst + (size_t)row * t.ldd + t.cb * 128 + q * 8) = pack8(v);
        if (q == 0) t.ssq_out[row] = ss;
      } break;
      case EP_KROPE: {
        const bool first = (q & 2) == 0; const int i0 = (q & 1) * 8;
        float ov[8];
#pragma unroll
        for (int e = 0; e < 8; ++e) {
          const float yp = __shfl_xor(v[e], 2);
          float c, s; rot_cs(ps, INVF32[i0 + e], c, s);
          ov[e] = first ? (v[e] * c - yp * s) : (v[e] * c + yp * s);
        }
        if (q < 4) {
          float* kr = (float*)(p.ws + OFF_KR) + (size_t)row * 32 + q * 8;
          *(f4*)kr = f4{ov[0], ov[1], ov[2], ov[3]};
          *(f4*)(kr + 4) = f4{ov[4], ov[5], ov[6], ov[7]};
        }
      } break;
      case EP_NORM128: {
        float ss = 0.f;
#pragma unroll
        for (int e = 0; e < 8; ++e) ss += v[e] * v[e];
        ss += __shfl_xor(ss, 1); ss += __shfl_xor(ss, 2); ss += __shfl_xor(ss, 4); ss += __shfl_xor(ss, 8);
        const float rn = rsqrtf(ss * (1.f / 128) + EPSV);
#pragma unroll
        for (int e = 0; e < 8; ++e) v[e] *= rn * g8[e];
        *(u4*)(t.dst + (size_t)row * t.ldd + t.cb * 128 + q * 8) = pack8(v);
      } break;
      case EP_QB: {
        const bool isr = (q >= 8 && q < 12);
        const bool first = (q & 2) == 0; const int i0 = (q & 1) * 8;
        float ss = 0.f;
#pragma unroll
        for (int e = 0; e < 8; ++e) {
          const float yp = __shfl_xor(v[e], 2);
          float c, s; rot_cs(ps, INVF32[i0 + e], c, s);
          const float rv = first ? (v[e] * c - yp * s) : (v[e] * c + yp * s);
          v[e] = isr ? rv : v[e];
          ss += v[e] * v[e];
        }
        ss += __shfl_xor(ss, 1); ss += __shfl_xor(ss, 2); ss += __shfl_xor(ss, 4); ss += __shfl_xor(ss, 8);
        const float rn = rsqrtf(ss * (1.f / 96) + EPSV);
        if (q < 12) {
#pragma unroll
          for (int e = 0; e < 8; ++e) v[e] *= rn * g8[e];
          *(u4*)(t.dst + (size_t)row * 768 + t.cb * 96 + q * 8) = pack8(v);
        }
      } break;
      case EP_KVB: {
        if (q >= 8) {
          if (q < 12) {
            const f4 a = ca, b = cb4;
            v[0] = a.x; v[1] = a.y; v[2] = a.z; v[3] = a.w; v[4] = b.x; v[5] = b.y; v[6] = b.z; v[7] = b.w;
          } else {
#pragma unroll
            for (int e = 0; e < 8; ++e) v[e] = 0.f;
          }
        }
        float ss = 0.f;
#pragma unroll
        for (int e = 0; e < 8; ++e) ss += v[e] * v[e];
        ss += __shfl_xor(ss, 1); ss += __shfl_xor(ss, 2); ss += __shfl_xor(ss, 4); ss += __shfl_xor(ss, 8);
        const float rn = rsqrtf(ss * (1.f / 96) + EPSV);
        if (q < 12) {
#pragma unroll
          for (int e = 0; e < 8; ++e) v[e] *= rn * g8[e];
          *(u4*)(t.dst + (size_t)row * 768 + t.cb * 96 + q * 8) = pack8(v);
        }
      } break;
      case EP_RES: {
        const f4 a = ca, b = cb4;
        v[0] += a.x; v[1] += a.y; v[2] += a.z; v[3] += a.w; v[4] += b.x; v[5] += b.y; v[6] += b.z; v[7] += b.w;
        float ss = 0.f;
#pragma unroll
        for (int e = 0; e < 8; ++e) ss += v[e] * v[e];
        ss += __shfl_xor(ss, 1); ss += __shfl_xor(ss, 2); ss += __shfl_xor(ss, 4); ss += __shfl_xor(ss, 8);
        float* xo = p.out + (size_t)row * 1024 + t.cb * 128 + q * 8;
        *(f4*)xo = f4{v[0], v[1], v[2], v[3]};
        *(f4*)(xo + 4) = f4{v[4], v[5], v[6], v[7]};
        *(u4*)(t.dst + (size_t)row * 1024 + t.cb * 128 + q * 8) = pack8(v);
        if (q == 0) t.ssq_out[row] = ss;
      } break;
      case EP_MLP1: {
#pragma unroll
        for (int e = 0; e < 8; ++e) { const float u = fmaxf(v[e], 0.f); v[e] = u * u; }
        *(u4*)(t.dst + (size_t)row * t.ldd + t.cb * 128 + q * 8) = pack8(v);
      } break;
      default: break;
    }
  }
  if (t.epi == EP_KVB) {
    bf16_t* VMT = (bf16_t*)(p.ws + OFF_VMT);
    const int c = tid >> 3, r8 = tid & 7;
    const int b = t.row0 >> 11, s0 = t.row0 & 2047;
    bf16_t* d = VMT + ((size_t)(b * 512 + t.cb * 64 + c)) * SEQ + s0 + r8 * 32;
#pragma unroll
    for (int j = 0; j < 4; ++j) {
      float v[8];
#pragma unroll
      for (int e = 0; e < 8; ++e) { const int r = r8 * 32 + j * 8 + e; v[e] = Cs[r * CS_LD + 64 + c] * rs[r]; }
      *(u4*)(d + j * 8) = pack8(v);
    }
  }
}

__global__ void __launch_bounds__(NTHR) mega_fwd(Params p) {
  __shared__ __attribute__((aligned(16))) char smem[LDS_BYTES];
  cg::grid_group grid = cg::this_grid();
  const int G = gridDim.x, bid = blockIdx.x;
  for (int ph = p.ph_lo; ph < p.ph_hi; ++ph) {
      char* ws = p.ws; asm volatile("" : "+s"(ws));
    bf16_t* XB = (bf16_t*)(ws + OFF_XB);   bf16_t* QD = (bf16_t*)(ws + OFF_QD);   bf16_t* KD = (bf16_t*)(ws + OFF_KD);
    bf16_t* VDT = (bf16_t*)(ws + OFF_VDT); bf16_t* CQ = (bf16_t*)(ws + OFF_CQ);   bf16_t* CKV = (bf16_t*)(ws + OFF_CKV);
    bf16_t* XQ = (bf16_t*)(ws + OFF_XQ);   bf16_t* QM = (bf16_t*)(ws + OFF_QM);   bf16_t* KM = (bf16_t*)(ws + OFF_KM);
    bf16_t* VMT = (bf16_t*)(ws + OFF_VMT); bf16_t* MEMB = (bf16_t*)(ws + OFF_MEMB); bf16_t* KC = (bf16_t*)(ws + OFF_KC);
    bf16_t* VCT = (bf16_t*)(ws + OFF_VCT); bf16_t* W = (bf16_t*)(ws + OFF_W);     bf16_t* U = (bf16_t*)(ws + OFF_U);
    bf16_t* MERGED = KD;
    float* SSQX = (float*)(ws + OFF_SSQX); float* SSQCQ = (float*)(ws + OFF_SSQCQ); float* SSQCKV = (float*)(ws + OFF_SSQCKV);
    float* SSQMEM = (float*)(ws + OFF_SSQMEM);

    if (ph == 0) {
      phase_init(p);
      prep_range(p, 0, 0, 5152, smem);
    } else {
      const int l = (ph - 1) / p.per, kr = (ph - 1) % p.per;
      const int k = (kr > p.dupk) ? kr - (p.per - 7) : kr;
#ifndef NO_GEMM
      if (k == 0 || k == 1 || k == 4 || k == 5 || k == 6) {
        int nits = 0, total = 0;
        if (k == 0) { nits = 18; total = 4480; if (l > 0) prep_range(p, l, 4128, 5152, smem); }
        else if (k == 1) { nits = 8; total = 2048; }
        else if (k == 4) { nits = 4; total = 1024; }
        else if (k == 5) { nits = 16; total = 4096; if (l + 1 < NL) prep_range(p, l + 1, 0, 3104, smem); }
        else { nits = 4; total = 1024; if (l + 1 < NL) prep_range(p, l + 1, 3104, 4128, smem); }
        const bool xmap = (G == 256);
        if (!xmap) nits = (total + G - 1) / G;
#pragma unroll 1
        for (int it = 0; it < nits; ++it) {
          int list = 0, rb = -1, CB = 0;
          if (xmap) {
            if (k == 0) {
              if (it < 16) map_regular(it, bid, 16, rb, CB);
              else if (it == 16) { rb = bid; CB = 16; }
              else if (bid < 128) { list = 1; rb = bid >> 2; CB = bid & 3; }
            } else if (k == 1) { list = it >> 2; map_regular(it & 3, bid, 4, rb, CB); }
            else if (k == 5) map_regular(it, bid, 16, rb, CB);
            else map_regular(it, bid, 4, rb, CB);
          } else {
            const int li = it * G + bid;
            if (li < total) {
              if (k == 0) { if (li < 4352) { rb = li / 17; CB = li % 17; } else { list = 1; rb = (li - 4352) >> 2; CB = (li - 4352) & 3; } }
              else if (k == 1) { list = li >> 10; rb = (li & 1023) >> 2; CB = li & 3; }
              else if (k == 5) { rb = li >> 4; CB = li & 15; }
              else { rb = li >> 2; CB = li & 3; }
            }
          }
          if (rb < 0) continue;
          const int row0 = rb * 256;
          const bf16_t* Ap; const bf16_t* Bp; int lda, Kd;
          const float* ssq = nullptr; int nparts = 0, pstride = T; float invK = 0.f;
          if (k == 0) {
            if (list == 0) { Ap = XB + (size_t)row0 * 1024; lda = 1024; Bp = W + W_IN + (size_t)CB * 256 * 1024; Kd = 1024; ssq = SSQX; nparts = 8; invK = 1.f / 1024; }
            else           { Ap = MEMB + (size_t)row0 * 1024; lda = 1024; Bp = W + W_MEM + (size_t)CB * 256 * 1024; Kd = 1024; ssq = SSQMEM; nparts = 1; pstride = 0; invK = 1.f / 1024; }
          } else if (k == 1) {
            if (list == 0) { Ap = CQ + (size_t)row0 * 384; lda = 384; Bp = W + W_QB + (size_t)CB * 256 * 384; Kd = 384; ssq = SSQCQ; nparts = 3; invK = 1.f / 384; }
            else           { Ap = CKV + (size_t)row0 * 256; lda = 256; Bp = W + W_KVB + (size_t)CB * 256 * 256; Kd = 256; ssq = SSQCKV; nparts = 2; invK = 1.f / 256; }
          } else if (k == 4) { Ap = MERGED + (size_t)row0 * 1024; lda = 1024; Bp = W + W_OUT + (size_t)CB * 256 * 1024; Kd = 1024; }
          else if (k == 5)   { Ap = XB + (size_t)row0 * 1024; lda = 1024; Bp = W + W_1 + (size_t)CB * 256 * 1024; Kd = 1024; ssq = SSQX; nparts = 8; invK = 1.f / 1024; }
          else               { Ap = U + (size_t)row0 * 4096; lda = 4096; Bp = W + W_2 + (size_t)CB * 256 * 4096; Kd = 4096; }
          f32x16 acc[4][2];
          gemm_mainloop<4, 2, 4, true>(Ap, lda, Bp, Kd, Kd, acc, smem);
          float* Cs = (float*)smem;
#pragma unroll 1
          for (int half = 0; half < 2; ++half) {
            if (half) __syncthreads();
            {
              const int tq = ltid(); const int lane = tq & 63, wave = tq >> 6, wm = wave >> 2, wn = wave & 3, h = lane >> 5;
              if ((wn >> 1) == half) {
#pragma unroll
                for (int mi = 0; mi < 4; ++mi)
#pragma unroll
                  for (int ni = 0; ni < 2; ++ni)
#pragma unroll
                    for (int i = 0; i < 16; ++i)
                      Cs[(wm * 128 + mi * 32 + crow(i, h)) * CS_LD + (wn & 1) * 64 + ni * 32 + (lane & 31)] = acc[mi][ni][i];
              }
            }
            if (half == 0) fill_rs((float*)(smem + RS_OFF), ssq, nparts, pstride, row0, invK);
            __syncthreads();
            const int cb = CB * 2 + half;
            Tile t;
            t.row0 = row0; t.cb = cb; t.epi = EP_PLAIN;
            t.dst = nullptr; t.ldd = 0; t.gain = nullptr; t.ssq_out = nullptr; t.xsrc = nullptr;
            if (k == 0) {
              if (list == 0) {
                if (cb < 8)       { t.epi = EP_HEADROT; t.cb = cb; t.dst = QD; t.ldd = 1024; t.gain = p.in[6] + l * 64; }
                else if (cb < 16) { t.epi = EP_HEADROT; t.cb = cb - 8; t.dst = KD; t.ldd = 1024; t.gain = p.in[7] + l * 64; }
                else if (cb < 24) { t.epi = EP_VT; t.cb = cb - 16; const int b = row0 >> 11, s0 = row0 & 2047; t.dst = VDT + ((size_t)(b * 1024 + (cb - 16) * 128)) * SEQ + s0; t.ldd = SEQ; }
                else if (cb < 27) { t.epi = EP_PLAIN; t.cb = cb - 24; t.dst = CQ; t.ldd = 384; t.ssq_out = SSQCQ + (size_t)(cb - 24) * T; }
                else if (cb < 29) { t.epi = EP_PLAIN; t.cb = cb - 27; t.dst = CKV; t.ldd = 256; t.ssq_out = SSQCKV + (size_t)(cb - 27) * T; }
                else if (cb == 29) { t.epi = EP_KROPE; t.cb = 0; }
                else              { t.epi = EP_NORM128; t.cb = cb - 30; t.dst = XQ; t.ldd = 512; t.gain = p.in[20] + l * 128; }
              } else {
                if (cb < 4) { t.epi = EP_NORM128; t.cb = cb; t.dst = KC; t.ldd = 512; t.gain = p.in[21] + l * 128; }
                else        { t.epi = EP_VT; t.cb = cb - 4; t.dst = VCT + ((size_t)(rb * 512 + (cb - 4) * 128)) * MEML; t.ldd = MEML; }
              }
            } else if (k == 1) {
              if (list == 0) { t.epi = EP_QB; t.dst = QM; t.gain = p.in[15] + l * 96; }
              else           { t.epi = EP_KVB; t.dst = KM; t.gain = p.in[16] + l * 96; }
            } else if (k == 4) { t.epi = EP_RES; t.dst = XB; t.xsrc = (l == 0) ? p.in[0] : p.out; t.ssq_out = SSQX + (size_t)cb * T; }
            else if (k == 5)   { t.epi = EP_MLP1; t.dst = U; t.ldd = 4096; }
            else               { t.epi = EP_RES; t.dst = XB; t.xsrc = p.out; t.ssq_out = SSQX + (size_t)cb * T; }
            run_epilogue(p, t, smem);
          }
        }
      } else
#endif
#ifndef NO_ATT
      if (k == 2) {
        float lam;
        const float lam_init = 0.8f - 0.6f * expf(-0.3f * (float)l);
        {
          const int lane = ltid() & 63;
          const float* lv = p.in[8] + l * 256;
          float sa = lv[lane] * lv[64 + lane], sb = lv[128 + lane] * lv[192 + lane];
#pragma unroll
          for (int m = 32; m >= 1; m >>= 1) { sa += __shfl_xor(sa, m); sb += __shfl_xor(sb, m); }
          lam = expf(sa) - expf(sb) + lam_init;
        }
        const float L2E = 1.4426950408889634f;
#pragma unroll 1
        for (int it = 0; it < ((G == 256) ? 16 : (4096 + G - 1) / G); ++it) {
          int w;
          if (G == 256) {
            const int xcd = bid & 7, slot = bid >> 3;
            if (it < 8)       w = ((it * 32 + (slot >> 3) * 8 + xcd) << 3) + (slot & 7);
            else if (it < 12) w = 2048 + ((((it - 8) * 64 + (slot >> 2) * 8 + xcd) << 2) + (slot & 3));
            else              w = 3072 + ((((it - 12) * 32 + (slot >> 3) * 8 + xcd) << 3) + (slot & 7));
          } else { w = it * G + bid; if (w >= 4096) continue; }
#ifndef NO_A1
          if (w < 2048) {
            const int bh = w >> 3, j = w & 7, b = bh >> 3, hh = bh & 7;
#pragma unroll 1
            for (int half = 0; half < 2; ++half) {
              const int qb = half ? j : 15 - j;
              const int q0 = qb * 128;
              bf16_t* Qp = QD + ((size_t)(b * SEQ + q0)) * 1024 + hh * 128;
              attn_block<64, 128, 2, true>(Qp, 1024, KD + (size_t)b * SEQ * 1024 + hh * 128, 1024, VDT + ((size_t)(b * 1024 + hh * 128)) * SEQ, SEQ,
                                            (q0 + 128) >> 6, q0, Qp, 1024, 0.125f * L2E, lam, p.in[9] + l * 128, 1.f - lam_init, smem);
            }
          } else
#endif
#ifndef NO_A2
          if (w < 3072) {
            const int wj = w - 2048; const int bh = wj >> 2, j = wj & 3, b = bh >> 3, hh = bh & 7;
#pragma unroll 1
            for (int half = 0; half < 2; ++half) {
              const int qb = half ? j : 7 - j;
              const int q0 = qb * 256;
              bf16_t* Qp = QM + ((size_t)(b * SEQ + q0)) * 768 + hh * 96;
              attn_block<96, 64, 1, true>(Qp, 768, KM + (size_t)b * SEQ * 768 + hh * 96, 768, VMT + ((size_t)(b * 512 + hh * 64)) * SEQ, SEQ,
                                           (q0 + 256) >> 6, q0, Qp, 768, 0.10206207261596575f * L2E, 0.f, nullptr, 1.f, smem);
            }
          } else
#endif
#ifndef NO_A3
          {
            const int wj = w - 3072; const int bh = wj >> 3, qb = wj & 7, b = bh >> 2, hh = bh & 3;
            const int q0 = qb * 256;
            bf16_t* Qp = XQ + ((size_t)(b * SEQ + q0)) * 512 + hh * 128;
            attn_block<128, 128, 1, false>(Qp, 512, KC + (size_t)b * MEML * 512 + hh * 128, 512, VCT + ((size_t)(b * 512 + hh * 128)) * MEML, MEML,
                                            4, q0, Qp, 512, 0.08838834764831845f * L2E, 0.f, nullptr, 1.f, smem);
          }
#endif
          {}
        }
      } else
#endif
#ifndef NO_D
      if (k == 3) {
        float* Cs = (float*)smem;
        float* rs = (float*)(smem + RS_OFF);
#pragma unroll 1
        for (int it = 0; it < ((G == 256) ? 8 : (2048 + G - 1) / G); ++it) {
          int rb, cb;
          if (G == 256) map_regular(it, bid, 8, rb, cb);
          else { const int li = it * G + bid; if (li >= 2048) continue; rb = li >> 3; cb = li & 7; }
          const int tidd = ltid(); const int lane = tidd & 63, wave = tidd >> 6, wm = wave >> 1, wn = wave & 1, h = lane >> 5;
          const int row0 = rb * 256, col0 = cb * 128;
          __syncthreads();
          fill_rs(rs, SSQX, 8, T, row0, 1.f / 1024);
          f32x16 acc[2][2];
          unsigned gp[2][2][8], mp[2][2][8];
#pragma unroll
          for (int mi = 0; mi < 2; ++mi)
#pragma unroll
            for (int ni = 0; ni < 2; ++ni)
#pragma unroll
              for (int i = 0; i < 8; ++i) mp[mi][ni][i] = 0u;
#pragma unroll 1
          for (int st = 0; st < 6; ++st) {
            const int br = st >> 1, half = st & 1;
            const bf16_t* Ab; const bf16_t* Bb; int Kb;
            if (half == 0)    { Ab = XB + (size_t)row0 * 1024; Bb = W + W_IN + (size_t)(WIN_GATE0 + br * 1024 + col0) * 1024; Kb = 1024; }
            else if (br == 0) { Ab = QD + (size_t)row0 * 1024; Bb = W + W_DO + (size_t)col0 * 1024; Kb = 1024; }
            else if (br == 1) { Ab = QM + (size_t)row0 * 768;  Bb = W + W_MO + (size_t)col0 * 768;  Kb = 768; }
            else              { Ab = XQ + (size_t)row0 * 512;  Bb = W + W_CO + (size_t)col0 * 512;  Kb = 512; }
            gemm_mainloop<2, 2, 2, false>(Ab, Kb, Bb, Kb, Kb, acc, smem);
            if (half == 0) {
              const float* bg = p.in[5] + (size_t)l * 3072 + br * 1024 + col0 + wn * 64 + (lane & 31);
              const float bgv0 = bg[0], bgv1 = bg[32];
#pragma unroll
              for (int mi = 0; mi < 2; ++mi) {
                float rsv[16];
#pragma unroll
                for (int i = 0; i < 16; ++i) rsv[i] = rs[wm * 64 + mi * 32 + crow(i, h)];
#pragma unroll
                for (int ni = 0; ni < 2; ++ni) {
                  const float bgv = ni ? bgv1 : bgv0;
#pragma unroll
                  for (int i = 0; i < 16; i += 2) {
                    const float z0 = acc[mi][ni][i] * rsv[i] + bgv;
                    const float z1 = acc[mi][ni][i + 1] * rsv[i + 1] + bgv;
                    gp[mi][ni][i >> 1] = pack2(1.f / (1.f + __expf(-z0)), 1.f / (1.f + __expf(-z1)));
                  }
                }
                __builtin_amdgcn_sched_barrier(0);
              }
            } else {
#pragma unroll
              for (int mi = 0; mi < 2; ++mi)
#pragma unroll
                for (int ni = 0; ni < 2; ++ni)
#pragma unroll
                  for (int i = 0; i < 16; i += 2) {
                    const unsigned g2 = gp[mi][ni][i >> 1], m2 = mp[mi][ni][i >> 1];
                    const float m0 = __uint_as_float(m2 << 16) + __uint_as_float(g2 << 16) * acc[mi][ni][i];
                    const float m1 = __uint_as_float(m2 & 0xffff0000u) + __uint_as_float(g2 & 0xffff0000u) * acc[mi][ni][i + 1];
                    mp[mi][ni][i >> 1] = pack2(m0, m1);
                  }
            }
          }
#pragma unroll
          for (int mi = 0; mi < 2; ++mi)
#pragma unroll
            for (int ni = 0; ni < 2; ++ni)
#pragma unroll
              for (int i = 0; i < 16; ++i) {
                const unsigned m2 = mp[mi][ni][i >> 1];
                Cs[(wm * 64 + mi * 32 + crow(i, h)) * CS_LD + wn * 64 + ni * 32 + (lane & 31)] = __uint_as_float((i & 1) ? (m2 & 0xffff0000u) : (m2 << 16));
              }
          __syncthreads();
          const int q = tidd & 15, rsub = tidd >> 4;
#pragma unroll 1
          for (int pass = 0; pass < 8; ++pass) {
            const int r = rsub + 32 * pass;
            float v[8];
            load8(Cs, r, q, v);
            *(u4*)(MERGED + (size_t)(row0 + r) * 1024 + col0 + q * 8) = pack8(v);
          }
        }
      }
#endif
      {}
    }
    if (ph + 1 < p.ph_hi) grid.sync();
  }
}

extern "C" void kernel_launch(void* const* d_in, const int* in_sizes, int n_in, void* d_out, int out_size, void* d_ws, size_t ws_size, hipStream_t stream) {
  static int grid_blocks = 0;
  if (grid_blocks == 0) {
    if (n_in != 27 || ws_size < WS_NEED) { fprintf(stderr, "kernel_launch: unexpected inputs (n_in %d) or workspace (%zu < %zu)\n", n_in, ws_size, (size_t)WS_NEED); grid_blocks = -1; return; }
    int dev = 0, cus = 0, per_cu = 0;
    hipGetDevice(&dev);
    hipDeviceGetAttribute(&cus, hipDeviceAttributeMultiprocessorCount, dev);
    hipOccupancyMaxActiveBlocksPerMultiprocessor(&per_cu, mega_fwd, NTHR, 0);
    if (per_cu < 1) per_cu = 1;
    if (per_cu > 1) per_cu = 1;
    grid_blocks = cus * per_cu;
  }
  if (grid_blocks < 0) return;
  Params p{};
  for (int i = 0; i < 27; ++i) p.in[i] = (const float*)d_in[i];
  p.out = (float*)d_out;
  p.ws = (char*)d_ws;
  p.ph_lo = 0;
  p.dupk = (DUP_K >= 0) ? DUP_K : 100;
  p.per = (DUP_K >= 0) ? 8 : 7;
  p.ph_hi = 1 + NL * p.per;
  void* args[] = {&p};
  hipError_t e = hipLaunchCooperativeKernel((void*)mega_fwd, dim3(grid_blocks), dim3(NTHR), args, 0, stream);
  if (e != hipSuccess) fprintf(stderr, "cooperative launch failed: %s (grid %d)\n", hipGetErrorString(e), grid_blocks);
}
```

```cpp
#include <hip/hip_runtime.h>
#include <hip/hip_cooperative_groups.h>
#include <stdint.h>
#include <stdio.h>
namespace cg = cooperative_groups;

typedef unsigned short bf16_t;
using bf16x8 = __attribute__((ext_vector_type(8))) short;
using f32x16 = __attribute__((ext_vector_type(16))) float;
typedef unsigned u4 __attribute__((ext_vector_type(4)));
typedef unsigned u2 __attribute__((ext_vector_type(2)));
typedef float f4 __attribute__((ext_vector_type(4)));
#define DI __device__ __forceinline__
#define MFMA(a, b, c) __builtin_amdgcn_mfma_f32_32x32x16_bf16((a), (b), (c), 0, 0, 0)

constexpr int T = 65536, DM = 1024, NB = 32, SEQ = 2048, NL = 4, MEML = 256, MEMR = NB * MEML;
constexpr int NTHR = 512;
constexpr int DUP_K = -1;
constexpr float EPSV = 1e-6f;
constexpr int WIN_N = 7424;
constexpr int WIN_GATE0 = 4352;

constexpr size_t MiB = 1024ull * 1024ull;
constexpr size_t OFF_XB = 0;
constexpr size_t OFF_QD = OFF_XB + 128 * MiB;
constexpr size_t OFF_KD = OFF_QD + 128 * MiB;
constexpr size_t OFF_VDT = OFF_KD + 128 * MiB;
constexpr size_t OFF_CQ = OFF_VDT + 128 * MiB;
constexpr size_t OFF_CKV = OFF_CQ + 48 * MiB;
constexpr size_t OFF_KR = OFF_CKV + 32 * MiB;
constexpr size_t OFF_XQ = OFF_KR + 8 * MiB;
constexpr size_t OFF_QM = OFF_XQ + 64 * MiB;
constexpr size_t OFF_KM = OFF_QM + 96 * MiB;
constexpr size_t OFF_VMT = OFF_KM + 96 * MiB;
constexpr size_t OFF_MEMB = OFF_VMT + 64 * MiB;
constexpr size_t OFF_KC = OFF_MEMB + 16 * MiB;
constexpr size_t OFF_VCT = OFF_KC + 8 * MiB;
constexpr size_t OFF_SSQX = OFF_VCT + 8 * MiB;
constexpr size_t OFF_SSQCQ = OFF_SSQX + 2 * MiB;
constexpr size_t OFF_SSQCKV = OFF_SSQCQ + 1 * MiB;
constexpr size_t OFF_SSQMEM = OFF_SSQCKV + 1 * MiB;
constexpr size_t OFF_W = OFF_SSQMEM + 1 * MiB;
constexpr size_t OFF_U = OFF_QD;
constexpr size_t W_IN = 0;
constexpr size_t W_MEM = W_IN + (size_t)WIN_N * 1024;
constexpr size_t W_QB = W_MEM + 1024 * 1024;
constexpr size_t W_KVB = W_QB + 1024 * 384;
constexpr size_t W_DO = W_KVB + 1024 * 256;
constexpr size_t W_MO = W_DO + 1024 * 1024;
constexpr size_t W_CO = W_MO + 1024 * 768;
constexpr size_t W_OUT = W_CO + 1024 * 512;
constexpr size_t W_1 = W_OUT + 1024 * 1024;
constexpr size_t W_2 = W_1 + 4096 * 1024;
constexpr size_t W_END = W_2 + 4096 * 1024;
constexpr size_t OFF_BAR = ((OFF_W + W_END * 2 + 255) / 256) * 256;
constexpr size_t WS_NEED = OFF_BAR + 256;

constexpr int LDS_ROW = 144;
constexpr int CS_LD = 132;
constexpr int CS_BYTES = 256 * CS_LD * 4;
constexpr int RS_OFF = 2 * 512 * LDS_ROW;
constexpr int LDS_BYTES = RS_OFF + 1024;

__constant__ float INVF64[32] = {1.000000000e+00f,7.498942614e-01f,5.623413324e-01f,4.216965139e-01f,3.162277639e-01f,2.371373773e-01f,1.778279394e-01f,1.333521307e-01f,1.000000015e-01f,7.498941571e-02f,5.623413250e-02f,4.216965288e-02f,3.162277490e-02f,2.371373773e-02f,1.778279431e-02f,1.333521493e-02f,9.999999776e-03f,7.498941850e-03f,5.623413250e-03f,4.216964822e-03f,3.162277630e-03f,2.371373586e-03f,1.778279431e-03f,1.333521446e-03f,1.000000047e-03f,7.498942432e-04f,5.623413017e-04f,4.216965172e-04f,3.162277571e-04f,2.371373703e-04f,1.778279402e-04f,1.333521504e-04f};
__constant__ float INVF32[16] = {1.000000000e+00f,5.623413324e-01f,3.162277639e-01f,1.778279394e-01f,1.000000015e-01f,5.623413250e-02f,3.162277490e-02f,1.778279431e-02f,9.999999776e-03f,5.623413250e-03f,3.162277630e-03f,1.778279431e-03f,1.000000047e-03f,5.623413017e-04f,3.162277571e-04f,1.778279402e-04f};

struct Params {
  const float* in[27];
  float* out;
  char* ws;
  int ph_lo, ph_hi;
  int dupk, per;
};

typedef __bf16 bf2_t __attribute__((ext_vector_type(2)));
typedef float fl2_t __attribute__((ext_vector_type(2)));
DI unsigned pack2(float a, float b) { fl2_t f = {a, b}; bf2_t r = __builtin_convertvector(f, bf2_t); return __builtin_bit_cast(unsigned, r); }
DI u4 pack8(const float* v) { u4 u; u.x = pack2(v[0], v[1]); u.y = pack2(v[2], v[3]); u.z = pack2(v[4], v[5]); u.w = pack2(v[6], v[7]); return u; }
DI int ltid() { int t = threadIdx.x; asm volatile("" : "+v"(t)); return t; }
DI int crow(int i, int h) { return (i & 3) + 8 * (i >> 2) + 4 * h; }
DI void rot_cs(int pos, float invf, float& c, float& s) {
  const float ang = (float)pos * invf;
  const float n = rintf(ang * 0.15915494309189535f);
  float r = fmaf(-n, 6.28318548202514648f, ang);
  r = fmaf(-n, -1.74845553146815e-07f, r);
  const float rf = r * 0.15915494309189535f;
  c = __builtin_amdgcn_cosf(rf);
  s = __builtin_amdgcn_sinf(rf);
}
DI void load8(const float* Cs, int r, int q, float* v) {
  const f4 a = *(const f4*)(Cs + r * CS_LD + q * 8);
  const f4 b = *(const f4*)(Cs + r * CS_LD + q * 8 + 4);
  v[0] = a.x; v[1] = a.y; v[2] = a.z; v[3] = a.w; v[4] = b.x; v[5] = b.y; v[6] = b.z; v[7] = b.w;
}

template <int MI, int NI, int WGN, bool FDB>
DI void gemm_mainloop(const bf16_t* __restrict__ A, int lda, const bf16_t* __restrict__ B, int ldb, int K, f32x16 (&acc)[MI][NI], char* smem,
                      int& gj, bool first, const bf16_t* __restrict__ An, const bf16_t* __restrict__ Bn, int ldn) {
  constexpr int BM = (8 / WGN) * MI * 32, BN = WGN * NI * 32;
  constexpr int ASZ = BM * 64, STAGE = (BM + BN) * 64;
  constexpr int NGA = BM / 128, NGB = BN / 128, NLD = NGA + NGB;
  static_assert(4 * STAGE <= RS_OFF, "ring");
  const int tid = ltid(), lane = tid & 63, wave = tid >> 6, l31 = lane & 31, h = lane >> 5;
  const int wu = __builtin_amdgcn_readfirstlane(wave);
  const int wm = wave / WGN, wn = wave % WGN;
  const int lrow = lane >> 2, lchk = (lane & 3) ^ ((lane >> 4) & 3);
  const bf16_t* ga = A + (size_t)(wu * NGA * 16 + lrow) * lda + lchk * 8;
  const bf16_t* gb = B + (size_t)(wu * NGB * 16 + lrow) * ldb + lchk * 8;
  const bf16_t* gan = An + (size_t)(wu * NGA * 16 + lrow) * ldn + lchk * 8;
  const bf16_t* gbn = Bn + (size_t)(wu * NGB * 16 + lrow) * ldn + lchk * 8;
  const int gj0 = gj;
#pragma unroll
  for (int mi = 0; mi < MI; ++mi)
#pragma unroll
    for (int ni = 0; ni < NI; ++ni)
#pragma unroll
      for (int i = 0; i < 16; ++i) acc[mi][ni][i] = 0.f;
  auto issue = [&](int j) {
    char* st = smem + ((gj0 + j) & 3) * STAGE;
    const int k0 = j * 32;
#pragma unroll
    for (int i = 0; i < NGA; ++i)
      __builtin_amdgcn_global_load_lds((const unsigned*)(ga + (size_t)(i * 16) * lda + k0), (unsigned*)(st + (wu * NGA + i) * 1024), 16, 0, 0);
#pragma unroll
    for (int i = 0; i < NGB; ++i)
      __builtin_amdgcn_global_load_lds((const unsigned*)(gb + (size_t)(i * 16) * ldb + k0), (unsigned*)(st + ASZ + (wu * NGB + i) * 1024), 16, 0, 0);
  };
  const int nk = K >> 5;
  auto issue_next = [&](int u) {
    char* st = smem + ((gj0 + nk + u) & 3) * STAGE;
#pragma unroll
    for (int i = 0; i < NGA; ++i)
      __builtin_amdgcn_global_load_lds((const unsigned*)(gan + (size_t)(i * 16) * ldn + u * 32), (unsigned*)(st + (wu * NGA + i) * 1024), 16, 0, 0);
#pragma unroll
    for (int i = 0; i < NGB; ++i)
      __builtin_amdgcn_global_load_lds((const unsigned*)(gbn + (size_t)(i * 16) * ldn + u * 32), (unsigned*)(st + ASZ + (wu * NGB + i) * 1024), 16, 0, 0);
  };
  if (first) {
    asm volatile("s_waitcnt vmcnt(0)" ::: "memory");
    __syncthreads();
    issue(0); issue(1);
  }
  const int sw = (l31 >> 2) & 3;
  const int oa = (wm * MI * 32 + l31) * 64, ob = ASZ + (wn * NI * 32 + l31) * 64;
  const int c0 = ((0 + h) ^ sw) * 16, c1 = ((2 + h) ^ sw) * 16;
#pragma unroll 1
  for (int j = 0; j < nk; j += 2) {
    asm volatile("s_waitcnt vmcnt(0)" ::: "memory");
    asm volatile("s_waitcnt lgkmcnt(0)" ::: "memory");
    __builtin_amdgcn_s_barrier();
    const char* s0 = smem + ((gj0 + j) & 3) * STAGE;
    const char* s1 = smem + ((gj0 + j + 1) & 3) * STAGE;
    bf16x8 fa[2][MI], fb[2][NI];
#pragma unroll
    for (int mi = 0; mi < MI; ++mi) fa[0][mi] = *(const bf16x8*)(s0 + oa + mi * 2048 + c0);
#pragma unroll
    for (int ni = 0; ni < NI; ++ni) fb[0][ni] = *(const bf16x8*)(s0 + ob + ni * 2048 + c0);
#pragma unroll
    for (int g = 0; g < 4; ++g) {
      if (g < 3) {
        const char* sn = ((g + 1) >> 1) ? s1 : s0;
        const int cn = ((g + 1) & 1) ? c1 : c0;
#pragma unroll
        for (int mi = 0; mi < MI; ++mi) fa[(g + 1) & 1][mi] = *(const bf16x8*)(sn + oa + mi * 2048 + cn);
#pragma unroll
        for (int ni = 0; ni < NI; ++ni) fb[(g + 1) & 1][ni] = *(const bf16x8*)(sn + ob + ni * 2048 + cn);
      }
      __builtin_amdgcn_sched_barrier(0);
#pragma unroll
      for (int mi = 0; mi < MI; ++mi)
#pragma unroll
        for (int ni = 0; ni < NI; ++ni) acc[mi][ni] = MFMA(fa[g & 1][mi], fb[g & 1][ni], acc[mi][ni]);
      __builtin_amdgcn_sched_barrier(0);
      if (g == 0) { if (j + 2 < nk) issue(j + 2); else if (An) issue_next(0); }
      if (g == 1) { if (j + 3 < nk) issue(j + 3); else if (An) issue_next(1); }
    }
  }
  gj = gj0 + nk;
  if (!An) {
    asm volatile("s_waitcnt lgkmcnt(0)" ::: "memory");
    __builtin_amdgcn_s_barrier();
  }
}

DI void fill_rs(float* rs, const float* ssq, int nparts, int pstride, int row0, float invK) {
  const int t = ltid();
  if (t < 256) {
    float r = 1.f;
    if (ssq) {
      float s = 0.f;
      for (int p = 0; p < nparts; ++p) s += ssq[(size_t)p * pstride + row0 + t];
      r = rsqrtf(s * invK + EPSV);
    }
    rs[t] = r;
  }
}

enum { EP_HEADROT = 0, EP_VT, EP_PLAIN, EP_KROPE, EP_NORM128, EP_QB, EP_KVB, EP_RES, EP_MLP1 };

struct Tile {
  int epi, row0, cb;
  bf16_t* dst; int ldd;
  const float* gain;
  float* ssq_out;
  const float* xsrc;
};

DI void map_regular(int it, int bid, int NCB, int& rb, int& CB) {
  const int xcd = bid & 7, slot = bid >> 3;
  const int c = xcd * NCB + it;
  const int cgrp = c >> 5, rgrp = c & 31;
  rb = rgrp * 8 + (slot >> 2);
  CB = cgrp * 4 + (slot & 3);
}

template <int DK, int DV, int NM, bool CAUSAL>
DI void attn_block(const bf16_t* __restrict__ Q, int ldq, const bf16_t* __restrict__ Kg, int ldk, const bf16_t* __restrict__ Vt, int ldv,
                   int nkt, int q0, bf16_t* O, int ldo, float sc, float lam, const float* og, float omul, char* smem) {
  constexpr int KW = NM * DK, KS = (KW + 8) * 2, KCH = KW / 8;
  constexpr int KBYTES = 64 * KS, VBYTES = DV * LDS_ROW, STAGE = KBYTES + VBYTES;
  constexpr int NKC = 64 * KCH, NKL = (NKC + NTHR - 1) / NTHR;
  constexpr int NVC = DV * 8, NVL = NVC / NTHR;
  static_assert(NVC % NTHR == 0, "v chunks");
  static_assert(2 * STAGE <= CS_BYTES, "lds");
  constexpr int NKC16 = DK / 16, NDVB = DV / 32;
  const int tid = ltid(), lane = tid & 63, wave = tid >> 6, h = lane >> 5, l31 = lane & 31;
  const int wq = (NM == 2) ? (wave & 3) : wave;
  const int mymap = (NM == 2) ? (wave >> 2) : 0;
  const int q0w = q0 + wq * 32;

  bf16x8 qf[NKC16];
  {
    const bf16_t* qp = Q + (size_t)(wq * 32 + l31) * ldq + mymap * DK + h * 8;
#pragma unroll
    for (int kc = 0; kc < NKC16; ++kc) qf[kc] = *(const bf16x8*)(qp + kc * 16);
  }
  f32x16 o[NDVB];
#pragma unroll
  for (int d = 0; d < NDVB; ++d)
#pragma unroll
    for (int i = 0; i < 16; ++i) o[d][i] = 0.f;
  float m_run = -INFINITY, l_run = 0.f;

  u4 rk[NKL], rv[NVL];
  auto gload = [&](int kt) {
#pragma unroll
    for (int i = 0; i < NKL; ++i) {
      const int c = tid + i * NTHR;
      if (NKC % NTHR == 0 || c < NKC) {
        const int r = c / KCH, cc = c % KCH;
        rk[i] = *(const u4*)(Kg + (size_t)(kt * 64 + r) * ldk + cc * 8);
      }
    }
#pragma unroll
    for (int i = 0; i < NVL; ++i) {
      const int c = tid + i * NTHR;
      const int r = c >> 3, cc = c & 7;
      rv[i] = *(const u4*)(Vt + (size_t)r * ldv + kt * 64 + cc * 8);
    }
  };
  auto swrite = [&](int s) {
    char* base = smem + s * STAGE;
#pragma unroll
    for (int i = 0; i < NKL; ++i) {
      const int c = tid + i * NTHR;
      if (NKC % NTHR == 0 || c < NKC) {
        const int r = c / KCH, cc = c % KCH;
        *(u4*)(base + r * KS + cc * 16) = rk[i];
      }
    }
#pragma unroll
    for (int i = 0; i < NVL; ++i) {
      const int c = tid + i * NTHR;
      const int r = c >> 3, cc = c & 7;
      *(u4*)(base + KBYTES + r * LDS_ROW + cc * 16) = rv[i];
    }
  };

  __syncthreads();
  gload(0);
  swrite(0);
  __syncthreads();
  for (int kt = 0; kt < nkt; ++kt) {
    const bool more = (kt + 1 < nkt);
    if (more) gload(kt + 1);
    const bool skip = CAUSAL && (kt * 64 > q0w + 31);
    if (!skip) {
      const char* base = smem + (kt & 1) * STAGE;
      f32x16 s[2];
#pragma unroll
      for (int sb = 0; sb < 2; ++sb) {
#pragma unroll
        for (int i = 0; i < 16; ++i) s[sb][i] = 0.f;
        const char* pk = base + (sb * 32 + l31) * KS + (mymap * DK + h * 8) * 2;
#pragma unroll
        for (int kc = 0; kc < NKC16; ++kc) {
          const bf16x8 a = *(const bf16x8*)(pk + kc * 32);
          s[sb] = MFMA(a, qf[kc], s[sb]);
        }
      }
      const bool need_mask = CAUSAL && (kt * 64 + 63 > q0w);
      float mx = -INFINITY;
#pragma unroll
      for (int sb = 0; sb < 2; ++sb)
#pragma unroll
        for (int i = 0; i < 16; ++i) {
          float v = s[sb][i];
          if (need_mask) {
            const int key = kt * 64 + sb * 32 + crow(i, h);
            if (key > q0w + l31) v = -INFINITY;
            s[sb][i] = v;
          }
          mx = fmaxf(mx, v);
        }
      mx = fmaxf(mx, __shfl_xor(mx, 32));
      const float m_new = fmaxf(m_run, mx);
      if (__any(m_new > m_run)) {
        const float alpha = __builtin_amdgcn_exp2f((m_run - m_new) * sc);
        l_run *= alpha;
#pragma unroll
        for (int d = 0; d < NDVB; ++d)
#pragma unroll
          for (int i = 0; i < 16; ++i) o[d][i] *= alpha;
      }
      m_run = m_new;
      const float mb = -m_new * sc;
      float ls = 0.f;
#pragma unroll
      for (int sb = 0; sb < 2; ++sb)
#pragma unroll
        for (int i = 0; i < 16; ++i) {
          const float p = __builtin_amdgcn_exp2f(fmaf(s[sb][i], sc, mb));
          s[sb][i] = p;
          ls += p;
        }
      l_run += ls;
      const char* pv = base + KBYTES + l31 * LDS_ROW + h * 8;
#pragma unroll
      for (int ks = 0; ks < 4; ++ks) {
        u4 pu;
        pu.x = pack2(s[ks >> 1][(ks & 1) * 8 + 0], s[ks >> 1][(ks & 1) * 8 + 1]);
        pu.y = pack2(s[ks >> 1][(ks & 1) * 8 + 2], s[ks >> 1][(ks & 1) * 8 + 3]);
        pu.z = pack2(s[ks >> 1][(ks & 1) * 8 + 4], s[ks >> 1][(ks & 1) * 8 + 5]);
        pu.w = pack2(s[ks >> 1][(ks & 1) * 8 + 6], s[ks >> 1][(ks & 1) * 8 + 7]);
        const bf16x8 pf = __builtin_bit_cast(bf16x8, pu);
#pragma unroll
        for (int d = 0; d < NDVB; ++d) {
          const u2 lo = *(const u2*)(pv + d * 32 * LDS_ROW + ks * 32);
          const u2 hi = *(const u2*)(pv + d * 32 * LDS_ROW + ks * 32 + 16);
          u4 au; au.x = lo.x; au.y = lo.y; au.z = hi.x; au.w = hi.y;
          o[d] = MFMA(__builtin_bit_cast(bf16x8, au), pf, o[d]);
        }
      }
    }
    if (more) swrite((kt + 1) & 1);
    __syncthreads();
  }
  const float l_tot = l_run + __shfl_xor(l_run, 32);
  const float inv = 1.f / l_tot;
#pragma unroll
  for (int d = 0; d < NDVB; ++d)
#pragma unroll
    for (int i = 0; i < 16; ++i) o[d][i] *= inv;

  float rn_out = 1.f;
  if (NM == 2) {
    float* buf = (float*)smem;
    if (wave >= 4) {
#pragma unroll
      for (int d = 0; d < NDVB; ++d)
#pragma unroll
        for (int i = 0; i < 16; ++i) buf[(d * 16 + i) * 256 + (wave & 3) * 64 + lane] = o[d][i];
    }
    __syncthreads();
    if (wave < 4) {
      float ss = 0.f;
#pragma unroll
      for (int d = 0; d < NDVB; ++d) {
#pragma unroll
        for (int i = 0; i < 16; ++i) {
          const float v = o[d][i] - lam * buf[(d * 16 + i) * 256 + wave * 64 + lane];
          o[d][i] = v;
          ss += v * v;
        }
        __builtin_amdgcn_sched_barrier(0);
      }
      ss += __shfl_xor(ss, 32);
      rn_out = rsqrtf(ss * (1.f / DV) + EPSV) * omul;
    }
  }
  if (NM == 1 || wave < 4) {
    bf16_t* op = O + (size_t)(wq * 32 + l31) * ldo + 4 * h;
#pragma unroll
    for (int d = 0; d < NDVB; ++d)
#pragma unroll
      for (int g = 0; g < 4; ++g) {
        f4 gg = {1.f, 1.f, 1.f, 1.f};
        if (NM == 2) gg = *(const f4*)(og + d * 32 + 8 * g + 4 * h);
        u2 u;
        u.x = pack2(o[d][4 * g + 0] * rn_out * gg.x, o[d][4 * g + 1] * rn_out * gg.y);
        u.y = pack2(o[d][4 * g + 2] * rn_out * gg.z, o[d][4 * g + 3] * rn_out * gg.w);
        *(u2*)(op + d * 32 + 8 * g) = u;
      }
  }
}

DI void prep_tile(const float* __restrict__ src, int N, const float* __restrict__ gain, bf16_t* __restrict__ dst, int Kp, int nmode, int kmode, int kt, int nt, char* smem) {
  float* tile = (float*)smem;
  const int tid = ltid();
  __syncthreads();
  {
    const int n = tid & 63;
    const int np = nt * 64 + n;
    int ns = np; bool nv = true;
    if (nmode == 1) {
      if (np < 3712) ns = np;
      else if (np < 3840) { ns = np; nv = (np < 3744); }
      else if (np < 4352) ns = np - 96;
      else ns = np - 96;
    } else if (nmode == 2) {
      const int hh = np >> 7, j = np & 127;
      nv = j < 96; ns = hh * 96 + j;
    }
#pragma unroll
    for (int j = 0; j < 8; ++j) {
      const int kk = (tid >> 6) + 8 * j;
      const int kp = kt * 64 + kk;
      int ks = kp; bool kv = true;
      if (kmode == 1) { const int hh = kp / 96, jj = kp % 96; kv = jj < 64; ks = hh * 64 + jj; }
      float v = 0.f;
      if (nv && kv) { v = src[(size_t)ks * N + ns]; if (gain) v *= gain[ks]; }
      tile[n * 65 + kk] = v;
    }
  }
  __syncthreads();
  {
    const int n = tid >> 3, kc = tid & 7;
    float v[8];
#pragma unroll
    for (int e = 0; e < 8; ++e) v[e] = tile[n * 65 + kc * 8 + e];
    *(u4*)(dst + (size_t)(nt * 64 + n) * Kp + kt * 64 + kc * 8) = pack8(v);
  }
}

DI void prep_item(const Params& p, int l, int it, char* smem) {
  bf16_t* W = (bf16_t*)(p.ws + OFF_W);
  const float* src; const float* gain = nullptr; bf16_t* dst; int N, Kp, nmode = 0, kmode = 0, nkt, loc;
  if (it < 1856)      { loc = it;        src = p.in[4] + (size_t)l * 1024 * 7328; N = 7328; gain = p.in[3] + l * 1024; dst = W + W_IN; Kp = 1024; nmode = 1; nkt = 16; }
  else if (it < 2112) { loc = it - 1856; src = p.in[19] + (size_t)l * 1024 * 1024; N = 1024; gain = p.in[18] + l * 1024; dst = W + W_MEM; Kp = 1024; nkt = 16; }
  else if (it < 2208) { loc = it - 2112; src = p.in[12] + (size_t)l * 384 * 768; N = 768; gain = p.in[11] + l * 384; dst = W + W_QB; Kp = 384; nmode = 2; nkt = 6; }
  else if (it < 2272) { loc = it - 2208; src = p.in[14] + (size_t)l * 256 * 1024; N = 1024; gain = p.in[13] + l * 256; dst = W + W_KVB; Kp = 256; nkt = 4; }
  else if (it < 2528) { loc = it - 2272; src = p.in[10] + (size_t)l * 1024 * 1024; N = 1024; dst = W + W_DO; Kp = 1024; nkt = 16; }
  else if (it < 2720) { loc = it - 2528; src = p.in[17] + (size_t)l * 512 * 1024; N = 1024; dst = W + W_MO; Kp = 768; kmode = 1; nkt = 12; }
  else if (it < 2848) { loc = it - 2720; src = p.in[22] + (size_t)l * 512 * 1024; N = 1024; dst = W + W_CO; Kp = 512; nkt = 8; }
  else if (it < 3104) { loc = it - 2848; src = p.in[23] + (size_t)l * 1024 * 1024; N = 1024; dst = W + W_OUT; Kp = 1024; nkt = 16; }
  else if (it < 4128) { loc = it - 3104; src = p.in[25] + (size_t)l * 1024 * 4096; N = 4096; gain = p.in[24] + l * 1024; dst = W + W_1; Kp = 1024; nkt = 16; }
  else                { loc = it - 4128; src = p.in[26] + (size_t)l * 4096 * 1024; N = 1024; dst = W + W_2; Kp = 4096; nkt = 64; }
  prep_tile(src, N, gain, dst, Kp, nmode, kmode, loc % nkt, loc / nkt, smem);
}
DI void prep_range(const Params& p, int l, int lo, int hi, char* smem) {
  for (int it = lo + blockIdx.x; it < hi; it += gridDim.x) prep_item(p, l, it, smem);
}

DI void phase_init(const Params& p) {
  const int tid_ = ltid(); const int lane = tid_ & 63, gw = blockIdx.x * 8 + (tid_ >> 6), GW = gridDim.x * 8;
  bf16_t* XB = (bf16_t*)(p.ws + OFF_XB); bf16_t* MB = (bf16_t*)(p.ws + OFF_MEMB);
  float* SX = (float*)(p.ws + OFF_SSQX); float* SM = (float*)(p.ws + OFF_SSQMEM);
  for (int r = gw; r < T + MEMR; r += GW) {
    const bool isx = r < T;
    const float* src = isx ? p.in[0] + (size_t)r * 1024 : p.in[1] + (size_t)(r - T) * 1024;
    bf16_t* dst = isx ? XB + (size_t)r * 1024 : MB + (size_t)(r - T) * 1024;
    float ss = 0.f;
#pragma unroll
    for (int j = 0; j < 4; ++j) {
      const f4 v = *(const f4*)(src + j * 256 + lane * 4);
      ss += v.x * v.x + v.y * v.y + v.z * v.z + v.w * v.w;
      u2 u; u.x = pack2(v.x, v.y); u.y = pack2(v.z, v.w);
      *(u2*)(dst + j * 256 + lane * 4) = u;
    }
#pragma unroll
    for (int m = 32; m >= 1; m >>= 1) ss += __shfl_xor(ss, m);
    if (isx) { if (lane < 8) SX[(size_t)lane * T + r] = (lane == 0) ? ss : 0.f; }
    else if (lane == 0) SM[r - T] = ss;
  }
}

DI void run_epilogue(const Params& p, const Tile& t, char* smem) {
  float* Cs = (float*)smem;
  float* rs = (float*)(smem + RS_OFF);
  const int tid = ltid();
  const int q = tid & 15, rsub = tid >> 4;
  const int* pos = (const int*)p.in[2];
  if (t.epi == EP_VT) {
    const int c = tid >> 2, rq = tid & 3;
#pragma unroll
    for (int j = 0; j < 8; ++j) {
      float v[8];
#pragma unroll
      for (int e = 0; e < 8; ++e) { const int r = rq * 64 + j * 8 + e; v[e] = Cs[r * CS_LD + c] * rs[r]; }
      *(u4*)(t.dst + (size_t)c * t.ldd + rq * 64 + j * 8) = pack8(v);
    }
    return;
  }
  float g8[8];
#pragma unroll
  for (int e = 0; e < 8; ++e) g8[e] = 1.f;
  if (t.epi == EP_HEADROT || t.epi == EP_NORM128 || ((t.epi == EP_QB || t.epi == EP_KVB) && q < 12)) {
    const float* gp_ = t.gain + ((t.epi == EP_HEADROT) ? (q & 7) * 8 : q * 8);
    const f4 ga_ = *(const f4*)gp_, gb_ = *(const f4*)(gp_ + 4);
    g8[0] = ga_.x; g8[1] = ga_.y; g8[2] = ga_.z; g8[3] = ga_.w; g8[4] = gb_.x; g8[5] = gb_.y; g8[6] = gb_.z; g8[7] = gb_.w;
  }
  int pre_pos = 0;
  f4 pre_a = {0.f, 0.f, 0.f, 0.f}, pre_b = {0.f, 0.f, 0.f, 0.f};
  auto prefetch = [&](int pass_) {
    const int row_ = t.row0 + rsub + 32 * pass_;
    if (t.epi == EP_HEADROT || t.epi == EP_KROPE || t.epi == EP_QB) pre_pos = pos[row_];
    if (t.epi == EP_RES) {
      const float* xs = t.xsrc + (size_t)row_ * 1024 + t.cb * 128 + q * 8;
      pre_a = *(const f4*)xs; pre_b = *(const f4*)(xs + 4);
    }
    if (t.epi == EP_KVB && q >= 8 && q < 12) {
      const float* kr = (const float*)(p.ws + OFF_KR) + (size_t)row_ * 32 + (q - 8) * 8;
      pre_a = *(const f4*)kr; pre_b = *(const f4*)(kr + 4);
    }
  };
  prefetch(0);
#pragma unroll 2
  for (int pass = 0; pass < 8; ++pass) {
    const int r = rsub + 32 * pass;
    const int row = t.row0 + r;
    const int ps = pre_pos;
    const f4 ca = pre_a, cb4 = pre_b;
    if (pass < 7) prefetch(pass + 1);
    float v[8];
    load8(Cs, r, q, v);
    const float rsv = rs[r];
#pragma unroll
    for (int e = 0; e < 8; ++e) v[e] *= rsv;
    switch (t.epi) {
      case EP_HEADROT: {
        float ss = 0.f;
#pragma unroll
        for (int e = 0; e < 8; ++e) ss += v[e] * v[e];
        ss += __shfl_xor(ss, 1); ss += __shfl_xor(ss, 2); ss += __shfl_xor(ss, 4);
        const float rn = rsqrtf(ss * (1.f / 64) + EPSV);
        const int pp = q & 7; const bool first = pp < 4; const int i0 = (pp & 3) * 8;
        float ov[8];
#pragma unroll
        for (int e = 0; e < 8; ++e) {
          const float y = v[e] * rn * g8[e];
          const float yp = __shfl_xor(y, 4);
          float c, s; rot_cs(ps, INVF64[i0 + e], c, s);
          ov[e] = first ? (y * c - yp * s) : (y * c + yp * s);
        }
        *(u4*)(t.dst + (size_t)row * t.ldd + t.cb * 128 + q * 8) = pack8(ov);
      } break;
      case EP_PLAIN: {
        float ss = 0.f;
#pragma unroll
        for (int e = 0; e < 8; ++e) ss += v[e] * v[e];
        ss += __shfl_xor(ss, 1); ss += __shfl_xor(ss, 2); ss += __shfl_xor(ss, 4); ss += __shfl_xor(ss, 8);
        *(u4*)(t.dst + (size_t)row * t.ldd + t.cb * 128 + q * 8) = pack8(v);
        if (q == 0) t.ssq_out[row] = ss;
      } break;
      case EP_KROPE: {
        const bool first = (q & 2) == 0; const int i0 = (q & 1) * 8;
        float ov[8];
#pragma unroll
        for (int e = 0; e < 8; ++e) {
          const float yp = __shfl_xor(v[e], 2);
          float c, s; rot_cs(ps, INVF32[i0 + e], c, s);
          ov[e] = first ? (v[e] * c - yp * s) : (v[e] * c + yp * s);
        }
        if (q < 4) {
          float* kr = (float*)(p.ws + OFF_KR) + (size_t)row * 32 + q * 8;
          *(f4*)kr = f4{ov[0], ov[1], ov[2], ov[3]};
          *(f4*)(kr + 4) = f4{ov[4], ov[5], ov[6], ov[7]};
        }
      } break;
      case EP_NORM128: {
        float ss = 0.f;
#pragma unroll
        for (int e = 0; e < 8; ++e) ss += v[e] * v[e];
        ss += __shfl_xor(ss, 1); ss += __shfl_xor(ss, 2); ss += __shfl_xor(ss, 4); ss += __shfl_xor(ss, 8);
        const float rn = rsqrtf(ss * (1.f / 128) + EPSV);
#pragma unroll
        for (int e = 0; e < 8; ++e) v[e] *= rn * g8[e];
        *(u4*)(t.dst + (size_t)row * t.ldd + t.cb * 128 + q * 8) = pack8(v);
      } break;
      case EP_QB: {
        const bool isr = (q >= 8 && q < 12);
        const bool first = (q & 2) == 0; const int i0 = (q & 1) * 8;
        float ss = 0.f;
#pragma unroll
        for (int e = 0; e < 8; ++e) {
          const float yp = __shfl_xor(v[e], 2);
          float c, s; rot_cs(ps, INVF32[i0 + e], c, s);
          const float rv = first ? (v[e] * c - yp * s) : (v[e] * c + yp * s);
          v[e] = isr ? rv : v[e];
          ss += v[e] * v[e];
        }
        ss += __shfl_xor(ss, 1); ss += __shfl_xor(ss, 2); ss += __shfl_xor(ss, 4); ss += __shfl_xor(ss, 8);
        const float rn = rsqrtf(ss * (1.f / 96) + EPSV);
        if (q < 12) {
#pragma unroll
          for (int e = 0; e < 8; ++e) v[e] *= rn * g8[e];
          *(u4*)(t.dst + (size_t)row * 768 + t.cb * 96 + q * 8) = pack8(v);
        }
      } break;
      case EP_KVB: {
        if (q >= 8) {
          if (q < 12) {
            const f4 a = ca, b = cb4;
            v[0] = a.x; v[1] = a.y; v[2] = a.z; v[3] = a.w; v[4] = b.x; v[5] = b.y; v[6] = b.z; v[7] = b.w;
          } else {
#pragma unroll
            for (int e = 0; e < 8; ++e) v[e] = 0.f;
          }
        }
        float ss = 0.f;
#pragma unroll
        for (int e = 0; e < 8; ++e) ss += v[e] * v[e];
        ss += __shfl_xor(ss, 1); ss += __shfl_xor(ss, 2); ss += __shfl_xor(ss, 4); ss += __shfl_xor(ss, 8);
        const float rn = rsqrtf(ss * (1.f / 96) + EPSV);
        if (q < 12) {
#pragma unroll
          for (int e = 0; e < 8; ++e) v[e] *= rn * g8[e];
          *(u4*)(t.dst + (size_t)row * 768 + t.cb * 96 + q * 8) = pack8(v);
        }
      } break;
      case EP_RES: {
        const f4 a = ca, b = cb4;
        v[0] += a.x; v[1] += a.y; v[2] += a.z; v[3] += a.w; v[4] += b.x; v[5] += b.y; v[6] += b.z; v[7] += b.w;
        float ss = 0.f;
#pragma unroll
        for (int e = 0; e < 8; ++e) ss += v[e] * v[e];
        ss += __shfl_xor(ss, 1); ss += __shfl_xor(ss, 2); ss += __shfl_xor(ss, 4); ss += __shfl_xor(ss, 8);
        float* xo = p.out + (size_t)row * 1024 + t.cb * 128 + q * 8;
        *(f4*)xo = f4{v[0], v[1], v[2], v[3]};
        *(f4*)(xo + 4) = f4{v[4], v[5], v[6], v[7]};
        *(u4*)(t.dst + (size_t)row * 1024 + t.cb * 128 + q * 8) = pack8(v);
        if (q == 0) t.ssq_out[row] = ss;
      } break;
      case EP_MLP1: {
#pragma unroll
        for (int e = 0; e < 8; ++e) { const float u = fmaxf(v[e], 0.f); v[e] = u * u; }
        *(u4*)(t.dst + (size_t)row * t.ldd + t.cb * 128 + q * 8) = pack8(v);
      } break;
      default: break;
    }
  }
  if (t.epi == EP_KVB) {
    bf16_t* VMT = (bf16_t*)(p.ws + OFF_VMT);
    const int c = tid >> 3, r8 = tid & 7;
    const int b = t.row0 >> 11, s0 = t.row0 & 2047;
    bf16_t* d = VMT + ((size_t)(b * 512 + t.cb * 64 + c)) * SEQ + s0 + r8 * 32;
#pragma unroll
    for (int j = 0; j < 4; ++j) {
      float v[8];
#pragma unroll
      for (int e = 0; e < 8; ++e) { const int r = r8 * 32 + j * 8 + e; v[e] = Cs[r * CS_LD + 64 + c] * rs[r]; }
      *(u4*)(d + j * 8) = pack8(v);
    }
  }
}

DI void grid_barrier(unsigned* cnt, unsigned target) {
  __syncthreads();
  if (ltid() == 0) {
    __threadfence();
    __hip_atomic_fetch_add(cnt, 1u, __ATOMIC_RELAXED, __HIP_MEMORY_SCOPE_AGENT);
    int spins = 0;
    while (__hip_atomic_load(cnt, __ATOMIC_RELAXED, __HIP_MEMORY_SCOPE_AGENT) < target && spins < (1 << 24)) { __builtin_amdgcn_s_sleep(2); ++spins; }
    __threadfence();
  }
  __syncthreads();
}

__global__ void __launch_bounds__(NTHR) mega_fwd(Params p) {
  __shared__ __attribute__((aligned(16))) char smem[LDS_BYTES];
  cg::grid_group grid = cg::this_grid();
  const int G = gridDim.x, bid = blockIdx.x;
  unsigned nsync = 0;
  for (int ph = p.ph_lo; ph < p.ph_hi; ++ph) {
      char* ws = p.ws; asm volatile("" : "+s"(ws));
    bf16_t* XB = (bf16_t*)(ws + OFF_XB);   bf16_t* QD = (bf16_t*)(ws + OFF_QD);   bf16_t* KD = (bf16_t*)(ws + OFF_KD);
    bf16_t* VDT = (bf16_t*)(ws + OFF_VDT); bf16_t* CQ = (bf16_t*)(ws + OFF_CQ);   bf16_t* CKV = (bf16_t*)(ws + OFF_CKV);
    bf16_t* XQ = (bf16_t*)(ws + OFF_XQ);   bf16_t* QM = (bf16_t*)(ws + OFF_QM);   bf16_t* KM = (bf16_t*)(ws + OFF_KM);
    bf16_t* VMT = (bf16_t*)(ws + OFF_VMT); bf16_t* MEMB = (bf16_t*)(ws + OFF_MEMB); bf16_t* KC = (bf16_t*)(ws + OFF_KC);
    bf16_t* VCT = (bf16_t*)(ws + OFF_VCT); bf16_t* W = (bf16_t*)(ws + OFF_W);     bf16_t* U = (bf16_t*)(ws + OFF_U);
    bf16_t* MERGED = KD;
    float* SSQX = (float*)(ws + OFF_SSQX); float* SSQCQ = (float*)(ws + OFF_SSQCQ); float* SSQCKV = (float*)(ws + OFF_SSQCKV);
    float* SSQMEM = (float*)(ws + OFF_SSQMEM);

    if (ph == 0) {
      phase_init(p);
      prep_range(p, 0, 0, 5152, smem);
    } else {
      const int l = (ph - 1) / p.per, kr = (ph - 1) % p.per;
      const int k = (kr > p.dupk) ? kr - (p.per - 7) : kr;
#ifndef NO_GEMM
      if (k == 0 || k == 1 || k == 4 || k == 5 || k == 6) {
        int nits = 0, total = 0;
        if (k == 0) { nits = 18; total = 4480; if (l > 0) prep_range(p, l, 4128, 5152, smem); }
        else if (k == 1) { nits = 8; total = 2048; }
        else if (k == 4) { nits = 4; total = 1024; }
        else if (k == 5) { nits = 16; total = 4096; if (l + 1 < NL) prep_range(p, l + 1, 0, 3104, smem); }
        else { nits = 4; total = 1024; if (l + 1 < NL) prep_range(p, l + 1, 3104, 4128, smem); }
        const bool xmap = (G == 256);
        if (!xmap) nits = (total + G - 1) / G;
#pragma unroll 1
        for (int it = 0; it < nits; ++it) {
          int list = 0, rb = -1, CB = 0;
          if (xmap) {
            if (k == 0) {
              if (it < 16) map_regular(it, bid, 16, rb, CB);
              else if (it == 16) { rb = bid; CB = 16; }
              else if (bid < 128) { list = 1; rb = bid >> 2; CB = bid & 3; }
            } else if (k == 1) { list = it >> 2; map_regular(it & 3, bid, 4, rb, CB); }
            else if (k == 5) map_regular(it, bid, 16, rb, CB);
            else map_regular(it, bid, 4, rb, CB);
          } else {
            const int li = it * G + bid;
            if (li < total) {
              if (k == 0) { if (li < 4352) { rb = li / 17; CB = li % 17; } else { list = 1; rb = (li - 4352) >> 2; CB = (li - 4352) & 3; } }
              else if (k == 1) { list = li >> 10; rb = (li & 1023) >> 2; CB = li & 3; }
              else if (k == 5) { rb = li >> 4; CB = li & 15; }
              else { rb = li >> 2; CB = li & 3; }
            }
          }
          if (rb < 0) continue;
          const int row0 = rb * 256;
          const bf16_t* Ap; const bf16_t* Bp; int lda, Kd;
          const float* ssq = nullptr; int nparts = 0, pstride = T; float invK = 0.f;
          if (k == 0) {
            if (list == 0) { Ap = XB + (size_t)row0 * 1024; lda = 1024; Bp = W + W_IN + (size_t)CB * 256 * 1024; Kd = 1024; ssq = SSQX; nparts = 8; invK = 1.f / 1024; }
            else           { Ap = MEMB + (size_t)row0 * 1024; lda = 1024; Bp = W + W_MEM + (size_t)CB * 256 * 1024; Kd = 1024; ssq = SSQMEM; nparts = 1; pstride = 0; invK = 1.f / 1024; }
          } else if (k == 1) {
            if (list == 0) { Ap = CQ + (size_t)row0 * 384; lda = 384; Bp = W + W_QB + (size_t)CB * 256 * 384; Kd = 384; ssq = SSQCQ; nparts = 3; invK = 1.f / 384; }
            else           { Ap = CKV + (size_t)row0 * 256; lda = 256; Bp = W + W_KVB + (size_t)CB * 256 * 256; Kd = 256; ssq = SSQCKV; nparts = 2; invK = 1.f / 256; }
          } else if (k == 4) { Ap = MERGED + (size_t)row0 * 1024; lda = 1024; Bp = W + W_OUT + (size_t)CB * 256 * 1024; Kd = 1024; }
          else if (k == 5)   { Ap = XB + (size_t)row0 * 1024; lda = 1024; Bp = W + W_1 + (size_t)CB * 256 * 1024; Kd = 1024; ssq = SSQX; nparts = 8; invK = 1.f / 1024; }
          else               { Ap = U + (size_t)row0 * 4096; lda = 4096; Bp = W + W_2 + (size_t)CB * 256 * 4096; Kd = 4096; }
          f32x16 acc[4][2];
          int gj = 0;
          gemm_mainloop<4, 2, 4, true>(Ap, lda, Bp, Kd, Kd, acc, smem, gj, true, nullptr, nullptr, 0);
          float* Cs = (float*)smem;
#pragma unroll 1
          for (int half = 0; half < 2; ++half) {
            if (half) __syncthreads();
            {
              const int tq = ltid(); const int lane = tq & 63, wave = tq >> 6, wm = wave >> 2, wn = wave & 3, h = lane >> 5;
              if ((wn >> 1) == half) {
#pragma unroll
                for (int mi = 0; mi < 4; ++mi)
#pragma unroll
                  for (int ni = 0; ni < 2; ++ni)
#pragma unroll
                    for (int i = 0; i < 16; ++i)
                      Cs[(wm * 128 + mi * 32 + crow(i, h)) * CS_LD + (wn & 1) * 64 + ni * 32 + (lane & 31)] = acc[mi][ni][i];
              }
            }
            if (half == 0) fill_rs((float*)(smem + RS_OFF), ssq, nparts, pstride, row0, invK);
            __syncthreads();
            const int cb = CB * 2 + half;
            Tile t;
            t.row0 = row0; t.cb = cb; t.epi = EP_PLAIN;
            t.dst = nullptr; t.ldd = 0; t.gain = nullptr; t.ssq_out = nullptr; t.xsrc = nullptr;
            if (k == 0) {
              if (list == 0) {
                if (cb < 8)       { t.epi = EP_HEADROT; t.cb = cb; t.dst = QD; t.ldd = 1024; t.gain = p.in[6] + l * 64; }
                else if (cb < 16) { t.epi = EP_HEADROT; t.cb = cb - 8; t.dst = KD; t.ldd = 1024; t.gain = p.in[7] + l * 64; }
                else if (cb < 24) { t.epi = EP_VT; t.cb = cb - 16; const int b = row0 >> 11, s0 = row0 & 2047; t.dst = VDT + ((size_t)(b * 1024 + (cb - 16) * 128)) * SEQ + s0; t.ldd = SEQ; }
                else if (cb < 27) { t.epi = EP_PLAIN; t.cb = cb - 24; t.dst = CQ; t.ldd = 384; t.ssq_out = SSQCQ + (size_t)(cb - 24) * T; }
                else if (cb < 29) { t.epi = EP_PLAIN; t.cb = cb - 27; t.dst = CKV; t.ldd = 256; t.ssq_out = SSQCKV + (size_t)(cb - 27) * T; }
                else if (cb == 29) { t.epi = EP_KROPE; t.cb = 0; }
                else              { t.epi = EP_NORM128; t.cb = cb - 30; t.dst = XQ; t.ldd = 512; t.gain = p.in[20] + l * 128; }
              } else {
                if (cb < 4) { t.epi = EP_NORM128; t.cb = cb; t.dst = KC; t.ldd = 512; t.gain = p.in[21] + l * 128; }
                else        { t.epi = EP_VT; t.cb = cb - 4; t.dst = VCT + ((size_t)(rb * 512 + (cb - 4) * 128)) * MEML; t.ldd = MEML; }
              }
            } else if (k == 1) {
              if (list == 0) { t.epi = EP_QB; t.dst = QM; t.gain = p.in[15] + l * 96; }
              else           { t.epi = EP_KVB; t.dst = KM; t.gain = p.in[16] + l * 96; }
            } else if (k == 4) { t.epi = EP_RES; t.dst = XB; t.xsrc = (l == 0) ? p.in[0] : p.out; t.ssq_out = SSQX + (size_t)cb * T; }
            else if (k == 5)   { t.epi = EP_MLP1; t.dst = U; t.ldd = 4096; }
            else               { t.epi = EP_RES; t.dst = XB; t.xsrc = p.out; t.ssq_out = SSQX + (size_t)cb * T; }
            run_epilogue(p, t, smem);
          }
        }
      } else
#endif
#ifndef NO_ATT
      if (k == 2) {
        float lam;
        const float lam_init = 0.8f - 0.6f * expf(-0.3f * (float)l);
        {
          const int lane = ltid() & 63;
          const float* lv = p.in[8] + l * 256;
          float sa = lv[lane] * lv[64 + lane], sb = lv[128 + lane] * lv[192 + lane];
#pragma unroll
          for (int m = 32; m >= 1; m >>= 1) { sa += __shfl_xor(sa, m); sb += __shfl_xor(sb, m); }
          lam = expf(sa) - expf(sb) + lam_init;
        }
        const float L2E = 1.4426950408889634f;
#pragma unroll 1
        for (int it = 0; it < ((G == 256) ? 16 : (4096 + G - 1) / G); ++it) {
          int w;
          if (G == 256) {
            const int xcd = bid & 7, slot = bid >> 3;
            if (it < 8)       w = ((it * 32 + (slot >> 3) * 8 + xcd) << 3) + (slot & 7);
            else if (it < 12) w = 2048 + ((((it - 8) * 64 + (slot >> 2) * 8 + xcd) << 2) + (slot & 3));
            else              w = 3072 + ((((it - 12) * 32 + (slot >> 3) * 8 + xcd) << 3) + (slot & 7));
          } else { w = it * G + bid; if (w >= 4096) continue; }
#ifndef NO_A1
          if (w < 2048) {
            const int bh = w >> 3, j = w & 7, b = bh >> 3, hh = bh & 7;
#pragma unroll 1
            for (int half = 0; half < 2; ++half) {
              const int qb = half ? j : 15 - j;
              const int q0 = qb * 128;
              bf16_t* Qp = QD + ((size_t)(b * SEQ + q0)) * 1024 + hh * 128;
              attn_block<64, 128, 2, true>(Qp, 1024, KD + (size_t)b * SEQ * 1024 + hh * 128, 1024, VDT + ((size_t)(b * 1024 + hh * 128)) * SEQ, SEQ,
                                            (q0 + 128) >> 6, q0, Qp, 1024, 0.125f * L2E, lam, p.in[9] + l * 128, 1.f - lam_init, smem);
            }
          } else
#endif
#ifndef NO_A2
          if (w < 3072) {
            const int wj = w - 2048; const int bh = wj >> 2, j = wj & 3, b = bh >> 3, hh = bh & 7;
#pragma unroll 1
            for (int half = 0; half < 2; ++half) {
              const int qb = half ? j : 7 - j;
              const int q0 = qb * 256;
              bf16_t* Qp = QM + ((size_t)(b * SEQ + q0)) * 768 + hh * 96;
              attn_block<96, 64, 1, true>(Qp, 768, KM + (size_t)b * SEQ * 768 + hh * 96, 768, VMT + ((size_t)(b * 512 + hh * 64)) * SEQ, SEQ,
                                           (q0 + 256) >> 6, q0, Qp, 768, 0.10206207261596575f * L2E, 0.f, nullptr, 1.f, smem);
            }
          } else
#endif
#ifndef NO_A3
          {
            const int wj = w - 3072; const int bh = wj >> 3, qb = wj & 7, b = bh >> 2, hh = bh & 3;
            const int q0 = qb * 256;
            bf16_t* Qp = XQ + ((size_t)(b * SEQ + q0)) * 512 + hh * 128;
            attn_block<128, 128, 1, false>(Qp, 512, KC + (size_t)b * MEML * 512 + hh * 128, 512, VCT + ((size_t)(b * 512 + hh * 128)) * MEML, MEML,
                                            4, q0, Qp, 512, 0.08838834764831845f * L2E, 0.f, nullptr, 1.f, smem);
          }
#endif
          {}
        }
      } else
#endif
#ifndef NO_D
      if (k == 3) {
        float* Cs = (float*)smem;
        float* rs = (float*)(smem + RS_OFF);
#pragma unroll 1
        for (int it = 0; it < ((G == 256) ? 8 : (2048 + G - 1) / G); ++it) {
          int rb, cb;
          if (G == 256) map_regular(it, bid, 8, rb, cb);
          else { const int li = it * G + bid; if (li >= 2048) continue; rb = li >> 3; cb = li & 7; }
          const int tidd = ltid(); const int lane = tidd & 63, wave = tidd >> 6, wm = wave >> 1, wn = wave & 1, h = lane >> 5;
          const int row0 = rb * 256, col0 = cb * 128;
          __syncthreads();
          fill_rs(rs, SSQX, 8, T, row0, 1.f / 1024);
          f32x16 acc[2][2];
          unsigned gp[2][2][8], mp[2][2][8];
#pragma unroll
          for (int mi = 0; mi < 2; ++mi)
#pragma unroll
            for (int ni = 0; ni < 2; ++ni)
#pragma unroll
              for (int i = 0; i < 8; ++i) mp[mi][ni][i] = 0u;
          int gj = 0;
          auto seg = [&](int st_, const bf16_t*& Ab_, const bf16_t*& Bb_, int& Kb_) {
            const int br_ = st_ >> 1, half_ = st_ & 1;
            if (half_ == 0)    { Ab_ = XB + (size_t)row0 * 1024; Bb_ = W + W_IN + (size_t)(WIN_GATE0 + br_ * 1024 + col0) * 1024; Kb_ = 1024; }
            else if (br_ == 0) { Ab_ = QD + (size_t)row0 * 1024; Bb_ = W + W_DO + (size_t)col0 * 1024; Kb_ = 1024; }
            else if (br_ == 1) { Ab_ = QM + (size_t)row0 * 768;  Bb_ = W + W_MO + (size_t)col0 * 768;  Kb_ = 768; }
            else               { Ab_ = XQ + (size_t)row0 * 512;  Bb_ = W + W_CO + (size_t)col0 * 512;  Kb_ = 512; }
          };
#pragma unroll 1
          for (int st = 0; st < 6; ++st) {
            const int br = st >> 1, half = st & 1;
            const bf16_t* Ab; const bf16_t* Bb; int Kb;
            const bf16_t* An = nullptr; const bf16_t* Bn = nullptr; int Kn = 0;
            seg(st, Ab, Bb, Kb);
            if (st < 5) seg(st + 1, An, Bn, Kn);
            gemm_mainloop<2, 2, 2, false>(Ab, Kb, Bb, Kb, Kb, acc, smem, gj, st == 0, An, Bn, Kn);
            if (half == 0) {
              const float* bg = p.in[5] + (size_t)l * 3072 + br * 1024 + col0 + wn * 64 + (lane & 31);
              const float bgv0 = bg[0], bgv1 = bg[32];
#pragma unroll
              for (int mi = 0; mi < 2; ++mi) {
                float rsv[16];
#pragma unroll
                for (int i = 0; i < 16; ++i) rsv[i] = rs[wm * 64 + mi * 32 + crow(i, h)];
#pragma unroll
                for (int ni = 0; ni < 2; ++ni) {
                  const float bgv = ni ? bgv1 : bgv0;
#pragma unroll
                  for (int i = 0; i < 16; i += 2) {
                    const float z0 = acc[mi][ni][i] * rsv[i] + bgv;
                    const float z1 = acc[mi][ni][i + 1] * rsv[i + 1] + bgv;
                    gp[mi][ni][i >> 1] = pack2(1.f / (1.f + __expf(-z0)), 1.f / (1.f + __expf(-z1)));
                  }
                }
                __builtin_amdgcn_sched_barrier(0);
              }
            } else {
#pragma unroll
              for (int mi = 0; mi < 2; ++mi)
#pragma unroll
                for (int ni = 0; ni < 2; ++ni)
#pragma unroll
                  for (int i = 0; i < 16; i += 2) {
                    const unsigned g2 = gp[mi][ni][i >> 1], m2 = mp[mi][ni][i >> 1];
                    const float m0 = __uint_as_float(m2 << 16) + __uint_as_float(g2 << 16) * acc[mi][ni][i];
                    const float m1 = __uint_as_float(m2 & 0xffff0000u) + __uint_as_float(g2 & 0xffff0000u) * acc[mi][ni][i + 1];
                    mp[mi][ni][i >> 1] = pack2(m0, m1);
                  }
            }
          }
#pragma unroll
          for (int mi = 0; mi < 2; ++mi)
#pragma unroll
            for (int ni = 0; ni < 2; ++ni)
#pragma unroll
              for (int i = 0; i < 16; ++i) {
                const unsigned m2 = mp[mi][ni][i >> 1];
                Cs[(wm * 64 + mi * 32 + crow(i, h)) * CS_LD + wn * 64 + ni * 32 + (lane & 31)] = __uint_as_float((i & 1) ? (m2 & 0xffff0000u) : (m2 << 16));
              }
          __syncthreads();
          const int q = tidd & 15, rsub = tidd >> 4;
#pragma unroll 1
          for (int pass = 0; pass < 8; ++pass) {
            const int r = rsub + 32 * pass;
            float v[8];
            load8(Cs, r, q, v);
            *(u4*)(MERGED + (size_t)(row0 + r) * 1024 + col0 + q * 8) = pack8(v);
          }
        }
      }
#endif
      {}
    }
    if (ph + 1 < p.ph_hi) {
      if (ph == p.ph_lo) grid.sync();
      else { ++nsync; grid_barrier((unsigned*)(p.ws + OFF_BAR), nsync * (unsigned)G); }
    }
  }
}

extern "C" void kernel_launch(void* const* d_in, const int* in_sizes, int n_in, void* d_out, int out_size, void* d_ws, size_t ws_size, hipStream_t stream) {
  static int grid_blocks = 0;
  if (grid_blocks == 0) {
    if (n_in != 27 || ws_size < WS_NEED) { fprintf(stderr, "kernel_launch: unexpected inputs (n_in %d) or workspace (%zu < %zu)\n", n_in, ws_size, (size_t)WS_NEED); grid_blocks = -1; return; }
    int dev = 0, cus = 0, per_cu = 0;
    hipGetDevice(&dev);
    hipDeviceGetAttribute(&cus, hipDeviceAttributeMultiprocessorCount, dev);
    hipOccupancyMaxActiveBlocksPerMultiprocessor(&per_cu, mega_fwd, NTHR, 0);
    if (per_cu < 1) per_cu = 1;
    if (per_cu > 1) per_cu = 1;
    grid_blocks = cus * per_cu;
  }
  if (grid_blocks < 0) return;
  Params p{};
  for (int i = 0; i < 27; ++i) p.in[i] = (const float*)d_in[i];
  p.out = (float*)d_out;
  p.ws = (char*)d_ws;
  p.ph_lo = 0;
  p.dupk = (DUP_K >= 0) ? DUP_K : 100;
  p.per = (DUP_K >= 0) ? 8 : 7;
  p.ph_hi = 1 + NL * p.per;
  if (hipMemsetAsync((char*)d_ws + OFF_BAR, 0, 256, stream) != hipSuccess) { fprintf(stderr, "kernel_launch: memset of the barrier word failed\n"); return; }
  void* args[] = {&p};
  hipError_t e = hipLaunchCooperativeKernel((void*)mega_fwd, dim3(grid_blocks), dim3(NTHR), args, 0, stream);
  if (e != hipSuccess) fprintf(stderr, "cooperative launch failed: %s (grid %d)\n", hipGetErrorString(e), grid_blocks);
}
```

```cpp
#include <hip/hip_runtime.h>
#include <hip/hip_cooperative_groups.h>
#include <stdint.h>
#include <stdio.h>
namespace cg = cooperative_groups;

typedef unsigned short bf16_t;
using bf16x8 = __attribute__((ext_vector_type(8))) short;
using f32x16 = __attribute__((ext_vector_type(16))) float;
typedef unsigned u4 __attribute__((ext_vector_type(4)));
typedef unsigned u2 __attribute__((ext_vector_type(2)));
typedef float f4 __attribute__((ext_vector_type(4)));
#define DI __device__ __forceinline__
#define MFMA(a, b, c) __builtin_amdgcn_mfma_f32_32x32x16_bf16((a), (b), (c), 0, 0, 0)

constexpr int T = 65536, DM = 1024, NB = 32, SEQ = 2048, NL = 4, MEML = 256, MEMR = NB * MEML;
constexpr int NTHR = 512;
constexpr int DUP_K = -1;
constexpr float EPSV = 1e-6f;
constexpr int WIN_N = 7424;
constexpr int WIN_GATE0 = 4352;

constexpr size_t MiB = 1024ull * 1024ull;
constexpr size_t OFF_XB = 0;
constexpr size_t OFF_QD = OFF_XB + 128 * MiB;
constexpr size_t OFF_KD = OFF_QD + 128 * MiB;
constexpr size_t OFF_VDT = OFF_KD + 128 * MiB;
constexpr size_t OFF_CQ = OFF_VDT + 128 * MiB;
constexpr size_t OFF_CKV = OFF_CQ + 48 * MiB;
constexpr size_t OFF_KR = OFF_CKV + 32 * MiB;
constexpr size_t OFF_XQ = OFF_KR + 8 * MiB;
constexpr size_t OFF_QM = OFF_XQ + 64 * MiB;
constexpr size_t OFF_KM = OFF_QM + 96 * MiB;
constexpr size_t OFF_VMT = OFF_KM + 96 * MiB;
constexpr size_t OFF_MEMB = OFF_VMT + 64 * MiB;
constexpr size_t OFF_KC = OFF_MEMB + 16 * MiB;
constexpr size_t OFF_VCT = OFF_KC + 8 * MiB;
constexpr size_t OFF_SSQX = OFF_VCT + 8 * MiB;
constexpr size_t OFF_SSQCQ = OFF_SSQX + 2 * MiB;
constexpr size_t OFF_SSQCKV = OFF_SSQCQ + 1 * MiB;
constexpr size_t OFF_SSQMEM = OFF_SSQCKV + 1 * MiB;
constexpr size_t OFF_W = OFF_SSQMEM + 1 * MiB;
constexpr size_t OFF_U = OFF_QD;
constexpr size_t W_IN = 0;
constexpr size_t W_MEM = W_IN + (size_t)WIN_N * 1024;
constexpr size_t W_QB = W_MEM + 1024 * 1024;
constexpr size_t W_KVB = W_QB + 1024 * 384;
constexpr size_t W_DO = W_KVB + 1024 * 256;
constexpr size_t W_MO = W_DO + 1024 * 1024;
constexpr size_t W_CO = W_MO + 1024 * 768;
constexpr size_t W_OUT = W_CO + 1024 * 512;
constexpr size_t W_1 = W_OUT + 1024 * 1024;
constexpr size_t W_2 = W_1 + 4096 * 1024;
constexpr size_t W_END = W_2 + 4096 * 1024;
constexpr size_t WS_NEED = OFF_W + W_END * 2;

constexpr int LDS_ROW = 144;
constexpr int CS_LD = 132;
constexpr int CS_BYTES = 256 * CS_LD * 4;
constexpr int RS_OFF = 2 * 512 * LDS_ROW;
constexpr int LDS_BYTES = RS_OFF + 1024;

__constant__ float INVF64[32] = {1.000000000e+00f,7.498942614e-01f,5.623413324e-01f,4.216965139e-01f,3.162277639e-01f,2.371373773e-01f,1.778279394e-01f,1.333521307e-01f,1.000000015e-01f,7.498941571e-02f,5.623413250e-02f,4.216965288e-02f,3.162277490e-02f,2.371373773e-02f,1.778279431e-02f,1.333521493e-02f,9.999999776e-03f,7.498941850e-03f,5.623413250e-03f,4.216964822e-03f,3.162277630e-03f,2.371373586e-03f,1.778279431e-03f,1.333521446e-03f,1.000000047e-03f,7.498942432e-04f,5.623413017e-04f,4.216965172e-04f,3.162277571e-04f,2.371373703e-04f,1.778279402e-04f,1.333521504e-04f};
__constant__ float INVF32[16] = {1.000000000e+00f,5.623413324e-01f,3.162277639e-01f,1.778279394e-01f,1.000000015e-01f,5.623413250e-02f,3.162277490e-02f,1.778279431e-02f,9.999999776e-03f,5.623413250e-03f,3.162277630e-03f,1.778279431e-03f,1.000000047e-03f,5.623413017e-04f,3.162277571e-04f,1.778279402e-04f};

struct Params {
  const float* in[27];
  float* out;
  char* ws;
  int ph_lo, ph_hi;
  int dupk, per;
};

typedef __bf16 bf2_t __attribute__((ext_vector_type(2)));
typedef float fl2_t __attribute__((ext_vector_type(2)));
DI unsigned pack2(float a, float b) { fl2_t f = {a, b}; bf2_t r = __builtin_convertvector(f, bf2_t); return __builtin_bit_cast(unsigned, r); }
DI u4 pack8(const float* v) { u4 u; u.x = pack2(v[0], v[1]); u.y = pack2(v[2], v[3]); u.z = pack2(v[4], v[5]); u.w = pack2(v[6], v[7]); return u; }
DI int ltid() { int t = threadIdx.x; asm volatile("" : "+v"(t)); return t; }
DI int crow(int i, int h) { return (i & 3) + 8 * (i >> 2) + 4 * h; }
DI void rot_cs(int pos, float invf, float& c, float& s) {
  const float ang = (float)pos * invf;
  double rev = (double)ang * 0.15915494309189535;
  rev -= floor(rev);
  const float rf = (float)rev;
  c = __builtin_amdgcn_cosf(rf);
  s = __builtin_amdgcn_sinf(rf);
}
DI void load8(const float* Cs, int r, int q, float* v) {
  const f4 a = *(const f4*)(Cs + r * CS_LD + q * 8);
  const f4 b = *(const f4*)(Cs + r * CS_LD + q * 8 + 4);
  v[0] = a.x; v[1] = a.y; v[2] = a.z; v[3] = a.w; v[4] = b.x; v[5] = b.y; v[6] = b.z; v[7] = b.w;
}

template <int MI, int NI, int WGN, bool FDB>
DI void gemm_mainloop(const bf16_t* __restrict__ A, int lda, const bf16_t* __restrict__ B, int ldb, int K, f32x16 (&acc)[MI][NI], char* smem) {
  constexpr int BM = (8 / WGN) * MI * 32, BN = WGN * NI * 32;
  constexpr int ASZ = BM * 64, STAGE = (BM + BN) * 64;
  constexpr int NGA = BM / 128, NGB = BN / 128, NLD = NGA + NGB;
  static_assert(4 * STAGE <= RS_OFF, "ring");
  const int tid = ltid(), lane = tid & 63, wave = tid >> 6, l31 = lane & 31, h = lane >> 5;
  const int wu = __builtin_amdgcn_readfirstlane(wave);
  const int wm = wave / WGN, wn = wave % WGN;
  const int lrow = lane >> 2, lchk = (lane & 3) ^ ((lane >> 4) & 3);
  const bf16_t* ga = A + (size_t)(wu * NGA * 16 + lrow) * lda + lchk * 8;
  const bf16_t* gb = B + (size_t)(wu * NGB * 16 + lrow) * ldb + lchk * 8;
#pragma unroll
  for (int mi = 0; mi < MI; ++mi)
#pragma unroll
    for (int ni = 0; ni < NI; ++ni)
#pragma unroll
      for (int i = 0; i < 16; ++i) acc[mi][ni][i] = 0.f;
  auto issue = [&](int j) {
    char* st = smem + (j & 3) * STAGE;
    const int k0 = j * 32;
#pragma unroll
    for (int i = 0; i < NGA; ++i)
      __builtin_amdgcn_global_load_lds((const unsigned*)(ga + (size_t)(i * 16) * lda + k0), (unsigned*)(st + (wu * NGA + i) * 1024), 16, 0, 0);
#pragma unroll
    for (int i = 0; i < NGB; ++i)
      __builtin_amdgcn_global_load_lds((const unsigned*)(gb + (size_t)(i * 16) * ldb + k0), (unsigned*)(st + ASZ + (wu * NGB + i) * 1024), 16, 0, 0);
  };
  asm volatile("s_waitcnt vmcnt(0)" ::: "memory");
  __syncthreads();
  const int nk = K >> 5;
  issue(0); issue(1); issue(2);
  const int sw = (l31 >> 2) & 3;
  const int oa = (wm * MI * 32 + l31) * 64, ob = ASZ + (wn * NI * 32 + l31) * 64;
  const int c0 = ((0 + h) ^ sw) * 16, c1 = ((2 + h) ^ sw) * 16;
#pragma unroll 1
  for (int j = 0; j < nk; ++j) {
    if (j + 2 < nk) asm volatile("s_waitcnt vmcnt(%0)" ::"n"(2 * NLD) : "memory");
    else if (j + 1 < nk) asm volatile("s_waitcnt vmcnt(%0)" ::"n"(NLD) : "memory");
    else asm volatile("s_waitcnt vmcnt(0)" ::: "memory");
    asm volatile("s_waitcnt lgkmcnt(0)" ::: "memory");
    __builtin_amdgcn_s_barrier();
    if (j + 3 < nk) issue(j + 3);
    const char* st = smem + (j & 3) * STAGE;
    const char* pa = st + oa;
    const char* pb = st + ob;
    bf16x8 fa0[MI], fb0[NI], fa1[MI], fb1[NI];
#pragma unroll
    for (int mi = 0; mi < MI; ++mi) fa0[mi] = *(const bf16x8*)(pa + mi * 2048 + c0);
#pragma unroll
    for (int ni = 0; ni < NI; ++ni) fb0[ni] = *(const bf16x8*)(pb + ni * 2048 + c0);
    if (FDB) {
#pragma unroll
      for (int mi = 0; mi < MI; ++mi) fa1[mi] = *(const bf16x8*)(pa + mi * 2048 + c1);
#pragma unroll
      for (int ni = 0; ni < NI; ++ni) fb1[ni] = *(const bf16x8*)(pb + ni * 2048 + c1);
    }
#pragma unroll
    for (int mi = 0; mi < MI; ++mi)
#pragma unroll
      for (int ni = 0; ni < NI; ++ni) acc[mi][ni] = MFMA(fa0[mi], fb0[ni], acc[mi][ni]);
    __builtin_amdgcn_sched_barrier(0);
    if (!FDB) {
#pragma unroll
      for (int mi = 0; mi < MI; ++mi) fa1[mi] = *(const bf16x8*)(pa + mi * 2048 + c1);
#pragma unroll
      for (int ni = 0; ni < NI; ++ni) fb1[ni] = *(const bf16x8*)(pb + ni * 2048 + c1);
    }
#pragma unroll
    for (int mi = 0; mi < MI; ++mi)
#pragma unroll
      for (int ni = 0; ni < NI; ++ni) acc[mi][ni] = MFMA(fa1[mi], fb1[ni], acc[mi][ni]);
    __builtin_amdgcn_sched_barrier(0);
  }
  asm volatile("s_waitcnt lgkmcnt(0)" ::: "memory");
  __builtin_amdgcn_s_barrier();
}

DI void fill_rs(float* rs, const float* ssq, int nparts, int pstride, int row0, float invK) {
  const int t = ltid();
  if (t < 256) {
    float r = 1.f;
    if (ssq) {
      float s = 0.f;
      for (int p = 0; p < nparts; ++p) s += ssq[(size_t)p * pstride + row0 + t];
      r = rsqrtf(s * invK + EPSV);
    }
    rs[t] = r;
  }
}

enum { EP_HEADROT = 0, EP_VT, EP_PLAIN, EP_KROPE, EP_NORM128, EP_QB, EP_KVB, EP_RES, EP_MLP1 };

struct Tile {
  int epi, row0, cb;
  bf16_t* dst; int ldd;
  const float* gain;
  float* ssq_out;
  const float* xsrc;
};

DI void map_regular(int it, int bid, int NCB, int& rb, int& CB) {
  const int xcd = bid & 7, slot = bid >> 3;
  const int c = xcd * NCB + it;
  const int cgrp = c >> 5, rgrp = c & 31;
  rb = rgrp * 8 + (slot >> 2);
  CB = cgrp * 4 + (slot & 3);
}

template <int DK, int DV, int NM, bool CAUSAL>
DI void attn_block(const bf16_t* __restrict__ Q, int ldq, const bf16_t* __restrict__ Kg, int ldk, const bf16_t* __restrict__ Vt, int ldv,
                   int nkt, int q0, bf16_t* O, int ldo, float sc, float lam, const float* og, float omul, char* smem) {
  constexpr int KW = NM * DK, KS = (KW + 8) * 2, KCH = KW / 8;
  constexpr int KBYTES = 64 * KS, VBYTES = DV * LDS_ROW, STAGE = KBYTES + VBYTES;
  constexpr int NKC = 64 * KCH, NKL = (NKC + NTHR - 1) / NTHR;
  constexpr int NVC = DV * 8, NVL = NVC / NTHR;
  static_assert(NVC % NTHR == 0, "v chunks");
  static_assert(2 * STAGE <= CS_BYTES, "lds");
  constexpr int NKC16 = DK / 16, NDVB = DV / 32;
  const int tid = ltid(), lane = tid & 63, wave = tid >> 6, h = lane >> 5, l31 = lane & 31;
  const int wq = (NM == 2) ? (wave & 3) : wave;
  const int mymap = (NM == 2) ? (wave >> 2) : 0;
  const int q0w = q0 + wq * 32;

  bf16x8 qf[NKC16];
  {
    const bf16_t* qp = Q + (size_t)(wq * 32 + l31) * ldq + mymap * DK + h * 8;
#pragma unroll
    for (int kc = 0; kc < NKC16; ++kc) qf[kc] = *(const bf16x8*)(qp + kc * 16);
  }
  f32x16 o[NDVB];
#pragma unroll
  for (int d = 0; d < NDVB; ++d)
#pragma unroll
    for (int i = 0; i < 16; ++i) o[d][i] = 0.f;
  float l_run = 0.f;

  u4 rk[NKL], rv[NVL];
  auto gload = [&](int kt) {
#pragma unroll
    for (int i = 0; i < NKL; ++i) {
      const int c = tid + i * NTHR;
      if (NKC % NTHR == 0 || c < NKC) {
        const int r = c / KCH, cc = c % KCH;
        rk[i] = *(const u4*)(Kg + (size_t)(kt * 64 + r) * ldk + cc * 8);
      }
    }
#pragma unroll
    for (int i = 0; i < NVL; ++i) {
      const int c = tid + i * NTHR;
      const int r = c >> 3, cc = c & 7;
      rv[i] = *(const u4*)(Vt + (size_t)r * ldv + kt * 64 + cc * 8);
    }
  };
  auto swrite = [&](int s) {
    char* base = smem + s * STAGE;
#pragma unroll
    for (int i = 0; i < NKL; ++i) {
      const int c = tid + i * NTHR;
      if (NKC % NTHR == 0 || c < NKC) {
        const int r = c / KCH, cc = c % KCH;
        *(u4*)(base + r * KS + cc * 16) = rk[i];
      }
    }
#pragma unroll
    for (int i = 0; i < NVL; ++i) {
      const int c = tid + i * NTHR;
      const int r = c >> 3, cc = c & 7;
      *(u4*)(base + KBYTES + r * LDS_ROW + cc * 16) = rv[i];
    }
  };

  __syncthreads();
  gload(0);
  swrite(0);
  __syncthreads();
  for (int kt = 0; kt < nkt; ++kt) {
    const bool more = (kt + 1 < nkt);
    if (more) gload(kt + 1);
    const bool skip = CAUSAL && (kt * 64 > q0w + 31);
    if (!skip) {
      const char* base = smem + (kt & 1) * STAGE;
      f32x16 s[2];
#pragma unroll
      for (int sb = 0; sb < 2; ++sb) {
#pragma unroll
        for (int i = 0; i < 16; ++i) s[sb][i] = 0.f;
        const char* pk = base + (sb * 32 + l31) * KS + (mymap * DK + h * 8) * 2;
#pragma unroll
        for (int kc = 0; kc < NKC16; ++kc) {
          const bf16x8 a = *(const bf16x8*)(pk + kc * 32);
          s[sb] = MFMA(a, qf[kc], s[sb]);
        }
        __builtin_amdgcn_sched_barrier(0);
      }
      const bool need_mask = CAUSAL && (kt * 64 + 63 > q0w);
      float ls = 0.f;
#pragma unroll
      for (int sb = 0; sb < 2; ++sb)
#pragma unroll
        for (int i = 0; i < 16; ++i) {
          float pz = __builtin_amdgcn_exp2f(s[sb][i] * sc);
          if (need_mask) {
            const int key = kt * 64 + sb * 32 + crow(i, h);
            if (key > q0w + l31) pz = 0.f;
          }
          s[sb][i] = pz;
          ls += pz;
        }
      l_run += ls;
      const char* pv = base + KBYTES + l31 * LDS_ROW + h * 8;
#pragma unroll
      for (int ks = 0; ks < 4; ++ks) {
        u4 pu;
        pu.x = pack2(s[ks >> 1][(ks & 1) * 8 + 0], s[ks >> 1][(ks & 1) * 8 + 1]);
        pu.y = pack2(s[ks >> 1][(ks & 1) * 8 + 2], s[ks >> 1][(ks & 1) * 8 + 3]);
        pu.z = pack2(s[ks >> 1][(ks & 1) * 8 + 4], s[ks >> 1][(ks & 1) * 8 + 5]);
        pu.w = pack2(s[ks >> 1][(ks & 1) * 8 + 6], s[ks >> 1][(ks & 1) * 8 + 7]);
        const bf16x8 pf = __builtin_bit_cast(bf16x8, pu);
#pragma unroll
        for (int d = 0; d < NDVB; ++d) {
          const u2 lo = *(const u2*)(pv + d * 32 * LDS_ROW + ks * 32);
          const u2 hi = *(const u2*)(pv + d * 32 * LDS_ROW + ks * 32 + 16);
          u4 au; au.x = lo.x; au.y = lo.y; au.z = hi.x; au.w = hi.y;
          o[d] = MFMA(__builtin_bit_cast(bf16x8, au), pf, o[d]);
        }
        __builtin_amdgcn_sched_barrier(0);
      }
    }
    if (more) swrite((kt + 1) & 1);
    __syncthreads();
  }
  const float l_tot = l_run + __shfl_xor(l_run, 32);
  const float inv = 1.f / l_tot;
#pragma unroll
  for (int d = 0; d < NDVB; ++d)
#pragma unroll
    for (int i = 0; i < 16; ++i) o[d][i] *= inv;

  float rn_out = 1.f;
  if (NM == 2) {
    float* buf = (float*)smem;
    if (wave >= 4) {
#pragma unroll
      for (int d = 0; d < NDVB; ++d)
#pragma unroll
        for (int i = 0; i < 16; ++i) buf[(d * 16 + i) * 256 + (wave & 3) * 64 + lane] = o[d][i];
    }
    __syncthreads();
    if (wave < 4) {
      float ss = 0.f;
#pragma unroll
      for (int d = 0; d < NDVB; ++d) {
#pragma unroll
        for (int i = 0; i < 16; ++i) {
          const float v = o[d][i] - lam * buf[(d * 16 + i) * 256 + wave * 64 + lane];
          o[d][i] = v;
          ss += v * v;
        }
        __builtin_amdgcn_sched_barrier(0);
      }
      ss += __shfl_xor(ss, 32);
      rn_out = rsqrtf(ss * (1.f / DV) + EPSV) * omul;
    }
  }
  if (NM == 1 || wave < 4) {
    bf16_t* op = O + (size_t)(wq * 32 + l31) * ldo + 4 * h;
#pragma unroll
    for (int d = 0; d < NDVB; ++d)
#pragma unroll
      for (int g = 0; g < 4; ++g) {
        f4 gg = {1.f, 1.f, 1.f, 1.f};
        if (NM == 2) gg = *(const f4*)(og + d * 32 + 8 * g + 4 * h);
        u2 u;
        u.x = pack2(o[d][4 * g + 0] * rn_out * gg.x, o[d][4 * g + 1] * rn_out * gg.y);
        u.y = pack2(o[d][4 * g + 2] * rn_out * gg.z, o[d][4 * g + 3] * rn_out * gg.w);
        *(u2*)(op + d * 32 + 8 * g) = u;
      }
  }
}

DI void prep_tile(const float* __restrict__ src, int N, const float* __restrict__ gain, bf16_t* __restrict__ dst, int Kp, int nmode, int kmode, int kt, int nt, char* smem) {
  float* tile = (float*)smem;
  const int tid = ltid();
  __syncthreads();
  {
    const int n = tid & 63;
    const int np = nt * 64 + n;
    int ns = np; bool nv = true;
    if (nmode == 1) {
      if (np < 3712) ns = np;
      else if (np < 3840) { ns = np; nv = (np < 3744); }
      else if (np < 4352) ns = np - 96;
      else ns = np - 96;
    } else if (nmode == 2) {
      const int hh = np >> 7, j = np & 127;
      nv = j < 96; ns = hh * 96 + j;
    }
#pragma unroll
    for (int j = 0; j < 8; ++j) {
      const int kk = (tid >> 6) + 8 * j;
      const int kp = kt * 64 + kk;
      int ks = kp; bool kv = true;
      if (kmode == 1) { const int hh = kp / 96, jj = kp % 96; kv = jj < 64; ks = hh * 64 + jj; }
      float v = 0.f;
      if (nv && kv) { v = src[(size_t)ks * N + ns]; if (gain) v *= gain[ks]; }
      tile[n * 65 + kk] = v;
    }
  }
  __syncthreads();
  {
    const int n = tid >> 3, kc = tid & 7;
    float v[8];
#pragma unroll
    for (int e = 0; e < 8; ++e) v[e] = tile[n * 65 + kc * 8 + e];
    *(u4*)(dst + (size_t)(nt * 64 + n) * Kp + kt * 64 + kc * 8) = pack8(v);
  }
}

DI void prep_item(const Params& p, int l, int it, char* smem) {
  bf16_t* W = (bf16_t*)(p.ws + OFF_W);
  const float* src; const float* gain = nullptr; bf16_t* dst; int N, Kp, nmode = 0, kmode = 0, nkt, loc;
  if (it < 1856)      { loc = it;        src = p.in[4] + (size_t)l * 1024 * 7328; N = 7328; gain = p.in[3] + l * 1024; dst = W + W_IN; Kp = 1024; nmode = 1; nkt = 16; }
  else if (it < 2112) { loc = it - 1856; src = p.in[19] + (size_t)l * 1024 * 1024; N = 1024; gain = p.in[18] + l * 1024; dst = W + W_MEM; Kp = 1024; nkt = 16; }
  else if (it < 2208) { loc = it - 2112; src = p.in[12] + (size_t)l * 384 * 768; N = 768; gain = p.in[11] + l * 384; dst = W + W_QB; Kp = 384; nmode = 2; nkt = 6; }
  else if (it < 2272) { loc = it - 2208; src = p.in[14] + (size_t)l * 256 * 1024; N = 1024; gain = p.in[13] + l * 256; dst = W + W_KVB; Kp = 256; nkt = 4; }
  else if (it < 2528) { loc = it - 2272; src = p.in[10] + (size_t)l * 1024 * 1024; N = 1024; dst = W + W_DO; Kp = 1024; nkt = 16; }
  else if (it < 2720) { loc = it - 2528; src = p.in[17] + (size_t)l * 512 * 1024; N = 1024; dst = W + W_MO; Kp = 768; kmode = 1; nkt = 12; }
  else if (it < 2848) { loc = it - 2720; src = p.in[22] + (size_t)l * 512 * 1024; N = 1024; dst = W + W_CO; Kp = 512; nkt = 8; }
  else if (it < 3104) { loc = it - 2848; src = p.in[23] + (size_t)l * 1024 * 1024; N = 1024; dst = W + W_OUT; Kp = 1024; nkt = 16; }
  else if (it < 4128) { loc = it - 3104; src = p.in[25] + (size_t)l * 1024 * 4096; N = 4096; gain = p.in[24] + l * 1024; dst = W + W_1; Kp = 1024; nkt = 16; }
  else                { loc = it - 4128; src = p.in[26] + (size_t)l * 4096 * 1024; N = 1024; dst = W + W_2; Kp = 4096; nkt = 64; }
  prep_tile(src, N, gain, dst, Kp, nmode, kmode, loc % nkt, loc / nkt, smem);
}
DI void prep_range(const Params& p, int l, int lo, int hi, char* smem) {
  for (int it = lo + blockIdx.x; it < hi; it += gridDim.x) prep_item(p, l, it, smem);
}

DI void phase_init(const Params& p) {
  const int tid_ = ltid(); const int lane = tid_ & 63, gw = blockIdx.x * 8 + (tid_ >> 6), GW = gridDim.x * 8;
  bf16_t* XB = (bf16_t*)(p.ws + OFF_XB); bf16_t* MB = (bf16_t*)(p.ws + OFF_MEMB);
  float* SX = (float*)(p.ws + OFF_SSQX); float* SM = (float*)(p.ws + OFF_SSQMEM);
  for (int r = gw; r < T + MEMR; r += GW) {
    const bool isx = r < T;
    const float* src = isx ? p.in[0] + (size_t)r * 1024 : p.in[1] + (size_t)(r - T) * 1024;
    bf16_t* dst = isx ? XB + (size_t)r * 1024 : MB + (size_t)(r - T) * 1024;
    float ss = 0.f;
#pragma unroll
    for (int j = 0; j < 4; ++j) {
      const f4 v = *(const f4*)(src + j * 256 + lane * 4);
      ss += v.x * v.x + v.y * v.y + v.z * v.z + v.w * v.w;
      u2 u; u.x = pack2(v.x, v.y); u.y = pack2(v.z, v.w);
      *(u2*)(dst + j * 256 + lane * 4) = u;
    }
#pragma unroll
    for (int m = 32; m >= 1; m >>= 1) ss += __shfl_xor(ss, m);
    if (isx) { if (lane < 8) SX[(size_t)lane * T + r] = (lane == 0) ? ss : 0.f; }
    else if (lane == 0) SM[r - T] = ss;
  }
}

DI void run_epilogue(const Params& p, const Tile& t, char* smem) {
  float* Cs = (float*)smem;
  float* rs = (float*)(smem + RS_OFF);
  const int tid = ltid();
  const int q = tid & 15, rsub = tid >> 4;
  const int* pos = (const int*)p.in[2];
  if (t.epi == EP_VT) {
    const int c = tid >> 2, rq = tid & 3;
#pragma unroll
    for (int j = 0; j < 8; ++j) {
      float v[8];
#pragma unroll
      for (int e = 0; e < 8; ++e) { const int r = rq * 64 + j * 8 + e; v[e] = Cs[r * CS_LD + c] * rs[r]; }
      *(u4*)(t.dst + (size_t)c * t.ldd + rq * 64 + j * 8) = pack8(v);
    }
    return;
  }
#pragma unroll 1
  for (int pass = 0; pass < 8; ++pass) {
    const int r = rsub + 32 * pass;
    const int row = t.row0 + r;
    float v[8];
    load8(Cs, r, q, v);
    const float rsv = rs[r];
#pragma unroll
    for (int e = 0; e < 8; ++e) v[e] *= rsv;
    switch (t.epi) {
      case EP_HEADROT: {
        float ss = 0.f;
#pragma unroll
        for (int e = 0; e < 8; ++e) ss += v[e] * v[e];
        ss += __shfl_xor(ss, 1); ss += __shfl_xor(ss, 2); ss += __shfl_xor(ss, 4);
        const float rn = rsqrtf(ss * (1.f / 64) + EPSV);
        const int pp = q & 7; const bool first = pp < 4; const int i0 = (pp & 3) * 8;
        const int ps = pos[row];
        float ov[8];
#pragma unroll
        for (int e = 0; e < 8; ++e) {
          const float y = v[e] * rn * t.gain[pp * 8 + e];
          const float yp = __shfl_xor(y, 4);
          float c, s; rot_cs(ps, INVF64[i0 + e], c, s);
          ov[e] = first ? (y * c - yp * s) : (y * c + yp * s);
        }
        *(u4*)(t.dst + (size_t)row * t.ldd + t.cb * 128 + q * 8) = pack8(ov);
      } break;
      case EP_PLAIN: {
        float ss = 0.f;
#pragma unroll
        for (int e = 0; e < 8; ++e) ss += v[e] * v[e];
        ss += __shfl_xor(ss, 1); ss += __shfl_xor(ss, 2); ss += __shfl_xor(ss, 4); ss += __shfl_xor(ss, 8);
        *(u4*)(t.dst + (size_t)row * t.ldd + t.cb * 128 + q * 8) = pack8(v);
        if (q == 0) t.ssq_out[row] = ss;
      } break;
      case EP_KROPE: {
        const bool first = (q & 2) == 0; const int i0 = (q & 1) * 8;
        const int ps = pos[row];
        float ov[8];
#pragma unroll
        for (int e = 0; e < 8; ++e) {
          const float yp = __shfl_xor(v[e], 2);
          float c, s; rot_cs(ps, INVF32[i0 + e], c, s);
          ov[e] = first ? (v[e] * c - yp * s) : (v[e] * c + yp * s);
        }
        if (q < 4) {
          float* kr = (float*)(p.ws + OFF_KR) + (size_t)row * 32 + q * 8;
          *(f4*)kr = f4{ov[0], ov[1], ov[2], ov[3]};
          *(f4*)(kr + 4) = f4{ov[4], ov[5], ov[6], ov[7]};
        }
      } break;
      case EP_NORM128: {
        float ss = 0.f;
#pragma unroll
        for (int e = 0; e < 8; ++e) ss += v[e] * v[e];
        ss += __shfl_xor(ss, 1); ss += __shfl_xor(ss, 2); ss += __shfl_xor(ss, 4); ss += __shfl_xor(ss, 8);
        const float rn = rsqrtf(ss * (1.f / 128) + EPSV);
#pragma unroll
        for (int e = 0; e < 8; ++e) v[e] *= rn * t.gain[q * 8 + e];
        *(u4*)(t.dst + (size_t)row * t.ldd + t.cb * 128 + q * 8) = pack8(v);
      } break;
      case EP_QB: {
        const bool isr = (q >= 8 && q < 12);
        const bool first = (q & 2) == 0; const int i0 = (q & 1) * 8;
        const int ps = pos[row];
        float ss = 0.f;
#pragma unroll
        for (int e = 0; e < 8; ++e) {
          const float yp = __shfl_xor(v[e], 2);
          float c, s; rot_cs(ps, INVF32[i0 + e], c, s);
          const float rv = first ? (v[e] * c - yp * s) : (v[e] * c + yp * s);
          v[e] = isr ? rv : v[e];
          ss += v[e] * v[e];
        }
        ss += __shfl_xor(ss, 1); ss += __shfl_xor(ss, 2); ss += __shfl_xor(ss, 4); ss += __shfl_xor(ss, 8);
        const float rn = rsqrtf(ss * (1.f / 96) + EPSV);
        if (q < 12) {
#pragma unroll
          for (int e = 0; e < 8; ++e) v[e] *= rn * t.gain[q * 8 + e];
          *(u4*)(t.dst + (size_t)row * 768 + t.cb * 96 + q * 8) = pack8(v);
        }
      } break;
      case EP_KVB: {
        if (q >= 8) {
          if (q < 12) {
            const float* kr = (const float*)(p.ws + OFF_KR) + (size_t)row * 32 + (q - 8) * 8;
            const f4 a = *(const f4*)kr, b = *(const f4*)(kr + 4);
            v[0] = a.x; v[1] = a.y; v[2] = a.z; v[3] = a.w; v[4] = b.x; v[5] = b.y; v[6] = b.z; v[7] = b.w;
          } else {
#pragma unroll
            for (int e = 0; e < 8; ++e) v[e] = 0.f;
          }
        }
        float ss = 0.f;
#pragma unroll
        for (int e = 0; e < 8; ++e) ss += v[e] * v[e];
        ss += __shfl_xor(ss, 1); ss += __shfl_xor(ss, 2); ss += __shfl_xor(ss, 4); ss += __shfl_xor(ss, 8);
        const float rn = rsqrtf(ss * (1.f / 96) + EPSV);
        if (q < 12) {
#pragma unroll
          for (int e = 0; e < 8; ++e) v[e] *= rn * t.gain[q * 8 + e];
          *(u4*)(t.dst + (size_t)row * 768 + t.cb * 96 + q * 8) = pack8(v);
        }
      } break;
      case EP_RES: {
        const float* xs = t.xsrc + (size_t)row * 1024 + t.cb * 128 + q * 8;
        const f4 a = *(const f4*)xs, b = *(const f4*)(xs + 4);
        v[0] += a.x; v[1] += a.y; v[2] += a.z; v[3] += a.w; v[4] += b.x; v[5] += b.y; v[6] += b.z; v[7] += b.w;
        float ss = 0.f;
#pragma unroll
        for (int e = 0; e < 8; ++e) ss += v[e] * v[e];
        ss += __shfl_xor(ss, 1); ss += __shfl_xor(ss, 2); ss += __shfl_xor(ss, 4); ss += __shfl_xor(ss, 8);
        float* xo = p.out + (size_t)row * 1024 + t.cb * 128 + q * 8;
        *(f4*)xo = f4{v[0], v[1], v[2], v[3]};
        *(f4*)(xo + 4) = f4{v[4], v[5], v[6], v[7]};
        *(u4*)(t.dst + (size_t)row * 1024 + t.cb * 128 + q * 8) = pack8(v);
        if (q == 0) t.ssq_out[row] = ss;
      } break;
      case EP_MLP1: {
#pragma unroll
        for (int e = 0; e < 8; ++e) { const float u = fmaxf(v[e], 0.f); v[e] = u * u; }
        *(u4*)(t.dst + (size_t)row * t.ldd + t.cb * 128 + q * 8) = pack8(v);
      } break;
      default: break;
    }
  }
  if (t.epi == EP_KVB) {
    bf16_t* VMT = (bf16_t*)(p.ws + OFF_VMT);
    const int c = tid >> 3, r8 = tid & 7;
    const int b = t.row0 >> 11, s0 = t.row0 & 2047;
    bf16_t* d = VMT + ((size_t)(b * 512 + t.cb * 64 + c)) * SEQ + s0 + r8 * 32;
#pragma unroll
    for (int j = 0; j < 4; ++j) {
      float v[8];
#pragma unroll
      for (int e = 0; e < 8; ++e) { const int r = r8 * 32 + j * 8 + e; v[e] = Cs[r * CS_LD + 64 + c] * rs[r]; }
      *(u4*)(d + j * 8) = pack8(v);
    }
  }
}

__global__ void __launch_bounds__(NTHR) mega_fwd(Params p) {
  __shared__ __attribute__((aligned(16))) char smem[LDS_BYTES];
  cg::grid_group grid = cg::this_grid();
  const int G = gridDim.x, bid = blockIdx.x;
  for (int ph = p.ph_lo; ph < p.ph_hi; ++ph) {
      char* ws = p.ws; asm volatile("" : "+s"(ws));
    bf16_t* XB = (bf16_t*)(ws + OFF_XB);   bf16_t* QD = (bf16_t*)(ws + OFF_QD);   bf16_t* KD = (bf16_t*)(ws + OFF_KD);
    bf16_t* VDT = (bf16_t*)(ws + OFF_VDT); bf16_t* CQ = (bf16_t*)(ws + OFF_CQ);   bf16_t* CKV = (bf16_t*)(ws + OFF_CKV);
    bf16_t* XQ = (bf16_t*)(ws + OFF_XQ);   bf16_t* QM = (bf16_t*)(ws + OFF_QM);   bf16_t* KM = (bf16_t*)(ws + OFF_KM);
    bf16_t* VMT = (bf16_t*)(ws + OFF_VMT); bf16_t* MEMB = (bf16_t*)(ws + OFF_MEMB); bf16_t* KC = (bf16_t*)(ws + OFF_KC);
    bf16_t* VCT = (bf16_t*)(ws + OFF_VCT); bf16_t* W = (bf16_t*)(ws + OFF_W);     bf16_t* U = (bf16_t*)(ws + OFF_U);
    bf16_t* MERGED = KD;
    float* SSQX = (float*)(ws + OFF_SSQX); float* SSQCQ = (float*)(ws + OFF_SSQCQ); float* SSQCKV = (float*)(ws + OFF_SSQCKV);
    float* SSQMEM = (float*)(ws + OFF_SSQMEM);

    if (ph == 0) {
      phase_init(p);
      prep_range(p, 0, 0, 5152, smem);
    } else {
      const int l = (ph - 1) / p.per, kr = (ph - 1) % p.per;
      const int k = (kr > p.dupk) ? kr - (p.per - 7) : kr;
#ifndef NO_GEMM
      if (k == 0 || k == 1 || k == 4 || k == 5 || k == 6) {
        int nits = 0, total = 0;
        if (k == 0) { nits = 18; total = 4480; if (l > 0) prep_range(p, l, 4128, 5152, smem); }
        else if (k == 1) { nits = 8; total = 2048; }
        else if (k == 4) { nits = 4; total = 1024; }
        else if (k == 5) { nits = 16; total = 4096; if (l + 1 < NL) prep_range(p, l + 1, 0, 3104, smem); }
        else { nits = 4; total = 1024; if (l + 1 < NL) prep_range(p, l + 1, 3104, 4128, smem); }
        const bool xmap = (G == 256);
        if (!xmap) nits = (total + G - 1) / G;
#pragma unroll 1
        for (int it = 0; it < nits; ++it) {
          int list = 0, rb = -1, CB = 0;
          if (xmap) {
            if (k == 0) {
              if (it < 16) map_regular(it, bid, 16, rb, CB);
              else if (it == 16) { rb = bid; CB = 16; }
              else if (bid < 128) { list = 1; rb = bid >> 2; CB = bid & 3; }
            } else if (k == 1) { list = it >> 2; map_regular(it & 3, bid, 4, rb, CB); }
            else if (k == 5) map_regular(it, bid, 16, rb, CB);
            else map_regular(it, bid, 4, rb, CB);
          } else {
            const int li = it * G + bid;
            if (li < total) {
              if (k == 0) { if (li < 4352) { rb = li / 17; CB = li % 17; } else { list = 1; rb = (li - 4352) >> 2; CB = (li - 4352) & 3; } }
              else if (k == 1) { list = li >> 10; rb = (li & 1023) >> 2; CB = li & 3; }
              else if (k == 5) { rb = li >> 4; CB = li & 15; }
              else { rb = li >> 2; CB = li & 3; }
            }
          }
          if (rb < 0) continue;
          const int row0 = rb * 256;
          const bf16_t* Ap; const bf16_t* Bp; int lda, Kd;
          const float* ssq = nullptr; int nparts = 0, pstride = T; float invK = 0.f;
          if (k == 0) {
            if (list == 0) { Ap = XB + (size_t)row0 * 1024; lda = 1024; Bp = W + W_IN + (size_t)CB * 256 * 1024; Kd = 1024; ssq = SSQX; nparts = 8; invK = 1.f / 1024; }
            else           { Ap = MEMB + (size_t)row0 * 1024; lda = 1024; Bp = W + W_MEM + (size_t)CB * 256 * 1024; Kd = 1024; ssq = SSQMEM; nparts = 1; pstride = 0; invK = 1.f / 1024; }
          } else if (k == 1) {
            if (list == 0) { Ap = CQ + (size_t)row0 * 384; lda = 384; Bp = W + W_QB + (size_t)CB * 256 * 384; Kd = 384; ssq = SSQCQ; nparts = 3; invK = 1.f / 384; }
            else           { Ap = CKV + (size_t)row0 * 256; lda = 256; Bp = W + W_KVB + (size_t)CB * 256 * 256; Kd = 256; ssq = SSQCKV; nparts = 2; invK = 1.f / 256; }
          } else if (k == 4) { Ap = MERGED + (size_t)row0 * 1024; lda = 1024; Bp = W + W_OUT + (size_t)CB * 256 * 1024; Kd = 1024; }
          else if (k == 5)   { Ap = XB + (size_t)row0 * 1024; lda = 1024; Bp = W + W_1 + (size_t)CB * 256 * 1024; Kd = 1024; ssq = SSQX; nparts = 8; invK = 1.f / 1024; }
          else               { Ap = U + (size_t)row0 * 4096; lda = 4096; Bp = W + W_2 + (size_t)CB * 256 * 4096; Kd = 4096; }
          f32x16 acc[4][2];
          gemm_mainloop<4, 2, 4, true>(Ap, lda, Bp, Kd, Kd, acc, smem);
          float* Cs = (float*)smem;
#pragma unroll 1
          for (int half = 0; half < 2; ++half) {
            if (half) __syncthreads();
            {
              const int tq = ltid(); const int lane = tq & 63, wave = tq >> 6, wm = wave >> 2, wn = wave & 3, h = lane >> 5;
              if ((wn >> 1) == half) {
#pragma unroll
                for (int mi = 0; mi < 4; ++mi)
#pragma unroll
                  for (int ni = 0; ni < 2; ++ni)
#pragma unroll
                    for (int i = 0; i < 16; ++i)
                      Cs[(wm * 128 + mi * 32 + crow(i, h)) * CS_LD + (wn & 1) * 64 + ni * 32 + (lane & 31)] = acc[mi][ni][i];
              }
            }
            if (half == 0) fill_rs((float*)(smem + RS_OFF), ssq, nparts, pstride, row0, invK);
            __syncthreads();
            const int cb = CB * 2 + half;
            Tile t;
            t.row0 = row0; t.cb = cb; t.epi = EP_PLAIN;
            t.dst = nullptr; t.ldd = 0; t.gain = nullptr; t.ssq_out = nullptr; t.xsrc = nullptr;
            if (k == 0) {
              if (list == 0) {
                if (cb < 8)       { t.epi = EP_HEADROT; t.cb = cb; t.dst = QD; t.ldd = 1024; t.gain = p.in[6] + l * 64; }
                else if (cb < 16) { t.epi = EP_HEADROT; t.cb = cb - 8; t.dst = KD; t.ldd = 1024; t.gain = p.in[7] + l * 64; }
                else if (cb < 24) { t.epi = EP_VT; t.cb = cb - 16; const int b = row0 >> 11, s0 = row0 & 2047; t.dst = VDT + ((size_t)(b * 1024 + (cb - 16) * 128)) * SEQ + s0; t.ldd = SEQ; }
                else if (cb < 27) { t.epi = EP_PLAIN; t.cb = cb - 24; t.dst = CQ; t.ldd = 384; t.ssq_out = SSQCQ + (size_t)(cb - 24) * T; }
                else if (cb < 29) { t.epi = EP_PLAIN; t.cb = cb - 27; t.dst = CKV; t.ldd = 256; t.ssq_out = SSQCKV + (size_t)(cb - 27) * T; }
                else if (cb == 29) { t.epi = EP_KROPE; t.cb = 0; }
                else              { t.epi = EP_NORM128; t.cb = cb - 30; t.dst = XQ; t.ldd = 512; t.gain = p.in[20] + l * 128; }
              } else {
                if (cb < 4) { t.epi = EP_NORM128; t.cb = cb; t.dst = KC; t.ldd = 512; t.gain = p.in[21] + l * 128; }
                else        { t.epi = EP_VT; t.cb = cb - 4; t.dst = VCT + ((size_t)(rb * 512 + (cb - 4) * 128)) * MEML; t.ldd = MEML; }
              }
            } else if (k == 1) {
              if (list == 0) { t.epi = EP_QB; t.dst = QM; t.gain = p.in[15] + l * 96; }
              else           { t.epi = EP_KVB; t.dst = KM; t.gain = p.in[16] + l * 96; }
            } else if (k == 4) { t.epi = EP_RES; t.dst = XB; t.xsrc = (l == 0) ? p.in[0] : p.out; t.ssq_out = SSQX + (size_t)cb * T; }
            else if (k == 5)   { t.epi = EP_MLP1; t.dst = U; t.ldd = 4096; }
            else               { t.epi = EP_RES; t.dst = XB; t.xsrc = p.out; t.ssq_out = SSQX + (size_t)cb * T; }
            run_epilogue(p, t, smem);
          }
        }
      } else
#endif
#ifndef NO_ATT
      if (k == 2) {
        float lam;
        const float lam_init = 0.8f - 0.6f * expf(-0.3f * (float)l);
        {
          const int lane = ltid() & 63;
          const float* lv = p.in[8] + l * 256;
          float sa = lv[lane] * lv[64 + lane], sb = lv[128 + lane] * lv[192 + lane];
#pragma unroll
          for (int m = 32; m >= 1; m >>= 1) { sa += __shfl_xor(sa, m); sb += __shfl_xor(sb, m); }
          lam = expf(sa) - expf(sb) + lam_init;
        }
        const float L2E = 1.4426950408889634f;
#pragma unroll 1
        for (int it = 0; it < ((G == 256) ? 16 : (4096 + G - 1) / G); ++it) {
          int w;
          if (G == 256) {
            const int xcd = bid & 7, slot = bid >> 3;
            if (it < 8)       w = ((it * 32 + (slot >> 3) * 8 + xcd) << 3) + (slot & 7);
            else if (it < 12) w = 2048 + ((((it - 8) * 64 + (slot >> 2) * 8 + xcd) << 2) + (slot & 3));
            else              w = 3072 + ((((it - 12) * 32 + (slot >> 3) * 8 + xcd) << 3) + (slot & 7));
          } else { w = it * G + bid; if (w >= 4096) continue; }
#ifndef NO_A1
          if (w < 2048) {
            const int bh = w >> 3, j = w & 7, b = bh >> 3, hh = bh & 7;
#pragma unroll 1
            for (int half = 0; half < 2; ++half) {
              const int qb = half ? j : 15 - j;
              const int q0 = qb * 128;
              bf16_t* Qp = QD + ((size_t)(b * SEQ + q0)) * 1024 + hh * 128;
              attn_block<64, 128, 2, true>(Qp, 1024, KD + (size_t)b * SEQ * 1024 + hh * 128, 1024, VDT + ((size_t)(b * 1024 + hh * 128)) * SEQ, SEQ,
                                            (q0 + 128) >> 6, q0, Qp, 1024, 0.125f * L2E, lam, p.in[9] + l * 128, 1.f - lam_init, smem);
            }
          } else
#endif
#ifndef NO_A2
          if (w < 3072) {
            const int wj = w - 2048; const int bh = wj >> 2, j = wj & 3, b = bh >> 3, hh = bh & 7;
#pragma unroll 1
            for (int half = 0; half < 2; ++half) {
              const int qb = half ? j : 7 - j;
              const int q0 = qb * 256;
              bf16_t* Qp = QM + ((size_t)(b * SEQ + q0)) * 768 + hh * 96;
              attn_block<96, 64, 1, true>(Qp, 768, KM + (size_t)b * SEQ * 768 + hh * 96, 768, VMT + ((size_t)(b * 512 + hh * 64)) * SEQ, SEQ,
                                           (q0 + 256) >> 6, q0, Qp, 768, 0.10206207261596575f * L2E, 0.f, nullptr, 1.f, smem);
            }
          } else
#endif
#ifndef NO_A3
          {
            const int wj = w - 3072; const int bh = wj >> 3, qb = wj & 7, b = bh >> 2, hh = bh & 3;
            const int q0 = qb * 256;
            bf16_t* Qp = XQ + ((size_t)(b * SEQ + q0)) * 512 + hh * 128;
            attn_block<128, 128, 1, false>(Qp, 512, KC + (size_t)b * MEML * 512 + hh * 128, 512, VCT + ((size_t)(b * 512 + hh * 128)) * MEML, MEML,
                                            4, q0, Qp, 512, 0.08838834764831845f * L2E, 0.f, nullptr, 1.f, smem);
          }
#endif
          {}
        }
      } else
#endif
#ifndef NO_D
      if (k == 3) {
        float* Cs = (float*)smem;
        float* rs = (float*)(smem + RS_OFF);
#pragma unroll 1
        for (int it = 0; it < ((G == 256) ? 8 : (2048 + G - 1) / G); ++it) {
          int rb, cb;
          if (G == 256) map_regular(it, bid, 8, rb, cb);
          else { const int li = it * G + bid; if (li >= 2048) continue; rb = li >> 3; cb = li & 7; }
          const int tidd = ltid(); const int lane = tidd & 63, wave = tidd >> 6, wm = wave >> 1, wn = wave & 1, h = lane >> 5;
          const int row0 = rb * 256, col0 = cb * 128;
          __syncthreads();
          fill_rs(rs, SSQX, 8, T, row0, 1.f / 1024);
          f32x16 acc[2][2];
          unsigned gp[2][2][8], mp[2][2][8];
#pragma unroll
          for (int mi = 0; mi < 2; ++mi)
#pragma unroll
            for (int ni = 0; ni < 2; ++ni)
#pragma unroll
              for (int i = 0; i < 8; ++i) mp[mi][ni][i] = 0u;
#pragma unroll 1
          for (int st = 0; st < 6; ++st) {
            const int br = st >> 1, half = st & 1;
            const bf16_t* Ab; const bf16_t* Bb; int Kb;
            if (half == 0)    { Ab = XB + (size_t)row0 * 1024; Bb = W + W_IN + (size_t)(WIN_GATE0 + br * 1024 + col0) * 1024; Kb = 1024; }
            else if (br == 0) { Ab = QD + (size_t)row0 * 1024; Bb = W + W_DO + (size_t)col0 * 1024; Kb = 1024; }
            else if (br == 1) { Ab = QM + (size_t)row0 * 768;  Bb = W + W_MO + (size_t)col0 * 768;  Kb = 768; }
            else              { Ab = XQ + (size_t)row0 * 512;  Bb = W + W_CO + (size_t)col0 * 512;  Kb = 512; }
            gemm_mainloop<2, 2, 2, false>(Ab, Kb, Bb, Kb, Kb, acc, smem);
            if (half == 0) {
              const float* bg = p.in[5] + (size_t)l * 3072 + br * 1024 + col0 + wn * 64 + (lane & 31);
              const float bgv0 = bg[0], bgv1 = bg[32];
#pragma unroll
              for (int mi = 0; mi < 2; ++mi) {
                float rsv[16];
#pragma unroll
                for (int i = 0; i < 16; ++i) rsv[i] = rs[wm * 64 + mi * 32 + crow(i, h)];
#pragma unroll
                for (int ni = 0; ni < 2; ++ni) {
                  const float bgv = ni ? bgv1 : bgv0;
#pragma unroll
                  for (int i = 0; i < 16; i += 2) {
                    const float z0 = acc[mi][ni][i] * rsv[i] + bgv;
                    const float z1 = acc[mi][ni][i + 1] * rsv[i + 1] + bgv;
                    gp[mi][ni][i >> 1] = pack2(1.f / (1.f + __expf(-z0)), 1.f / (1.f + __expf(-z1)));
                  }
                }
                __builtin_amdgcn_sched_barrier(0);
              }
            } else {
#pragma unroll
              for (int mi = 0; mi < 2; ++mi)
#pragma unroll
                for (int ni = 0; ni < 2; ++ni)
#pragma unroll
                  for (int i = 0; i < 16; i += 2) {
                    const unsigned g2 = gp[mi][ni][i >> 1], m2 = mp[mi][ni][i >> 1];
                    const float m0 = __uint_as_float(m2 << 16) + __uint_as_float(g2 << 16) * acc[mi][ni][i];
                    const float m1 = __uint_as_float(m2 & 0xffff0000u) + __uint_as_float(g2 & 0xffff0000u) * acc[mi][ni][i + 1];
                    mp[mi][ni][i >> 1] = pack2(m0, m1);
                  }
            }
          }
#pragma unroll
          for (int mi = 0; mi < 2; ++mi)
#pragma unroll
            for (int ni = 0; ni < 2; ++ni)
#pragma unroll
              for (int i = 0; i < 16; ++i) {
                const unsigned m2 = mp[mi][ni][i >> 1];
                Cs[(wm * 64 + mi * 32 + crow(i, h)) * CS_LD + wn * 64 + ni * 32 + (lane & 31)] = __uint_as_float((i & 1) ? (m2 & 0xffff0000u) : (m2 << 16));
              }
          __syncthreads();
          const int q = tidd & 15, rsub = tidd >> 4;
#pragma unroll 1
          for (int pass = 0; pass < 8; ++pass) {
            const int r = rsub + 32 * pass;
            float v[8];
            load8(Cs, r, q, v);
            *(u4*)(MERGED + (size_t)(row0 + r) * 1024 + col0 + q * 8) = pack8(v);
          }
        }
      }
#endif
      {}
    }
    if (ph + 1 < p.ph_hi) grid.sync();
  }
}

extern "C" void kernel_launch(void* const* d_in, const int* in_sizes, int n_in, void* d_out, int out_size, void* d_ws, size_t ws_size, hipStream_t stream) {
  static int grid_blocks = 0;
  if (grid_blocks == 0) {
    if (n_in != 27 || ws_size < WS_NEED) { fprintf(stderr, "kernel_launch: unexpected inputs (n_in %d) or workspace (%zu < %zu)\n", n_in, ws_size, (size_t)WS_NEED); grid_blocks = -1; return; }
    int dev = 0, cus = 0, per_cu = 0;
    hipGetDevice(&dev);
    hipDeviceGetAttribute(&cus, hipDeviceAttributeMultiprocessorCount, dev);
    hipOccupancyMaxActiveBlocksPerMultiprocessor(&per_cu, mega_fwd, NTHR, 0);
    if (per_cu < 1) per_cu = 1;
    if (per_cu > 1) per_cu = 1;
    grid_blocks = cus * per_cu;
  }
  if (grid_blocks < 0) return;
  Params p{};
  for (int i = 0; i < 27; ++i) p.in[i] = (const float*)d_in[i];
  p.out = (float*)d_out;
  p.ws = (char*)d_ws;
  p.ph_lo = 0;
  p.dupk = (DUP_K >= 0) ? DUP_K : 100;
  p.per = (DUP_K >= 0) ? 8 : 7;
  p.ph_hi = 1 + NL * p.per;
  void* args[] = {&p};
  hipError_t e = hipLaunchCooperativeKernel((void*)mega_fwd, dim3(grid_blocks), dim3(NTHR), args, 0, stream);
  if (e != hipSuccess) fprintf(stderr, "cooperative launch failed: %s (grid %d)\n", hipGetErrorString(e), grid_blocks);
}
```

```cpp
#include <hip/hip_runtime.h>
#include <hip/hip_cooperative_groups.h>
#include <stdint.h>
#include <stdio.h>
namespace cg = cooperative_groups;

typedef unsigned short bf16_t;
using bf16x8 = __attribute__((ext_vector_type(8))) short;
using f32x16 = __attribute__((ext_vector_type(16))) float;
typedef unsigned u4 __attribute__((ext_vector_type(4)));
typedef unsigned u2 __attribute__((ext_vector_type(2)));
typedef float f4 __attribute__((ext_vector_type(4)));
#define DI __device__ __forceinline__
#define MFMA(a, b, c) __builtin_amdgcn_mfma_f32_32x32x16_bf16((a), (b), (c), 0, 0, 0)

constexpr int T = 65536, DM = 1024, NB = 32, SEQ = 2048, NL = 4, MEML = 256, MEMR = NB * MEML;
constexpr int NTHR = 512;
constexpr int DUP_K = -1;
constexpr float EPSV = 1e-6f;
constexpr int WIN_N = 7424;
constexpr int WIN_GATE0 = 4352;

constexpr size_t MiB = 1024ull * 1024ull;
constexpr size_t OFF_XB = 0;
constexpr size_t OFF_QD = OFF_XB + 128 * MiB;
constexpr size_t OFF_KD = OFF_QD + 128 * MiB;
constexpr size_t OFF_VDT = OFF_KD + 128 * MiB;
constexpr size_t OFF_CQ = OFF_VDT + 128 * MiB;
constexpr size_t OFF_CKV = OFF_CQ + 48 * MiB;
constexpr size_t OFF_KR = OFF_CKV + 32 * MiB;
constexpr size_t OFF_XQ = OFF_KR + 8 * MiB;
constexpr size_t OFF_QM = OFF_XQ + 64 * MiB;
constexpr size_t OFF_KM = OFF_QM + 96 * MiB;
constexpr size_t OFF_VMT = OFF_KM + 96 * MiB;
constexpr size_t OFF_MEMB = OFF_VMT + 64 * MiB;
constexpr size_t OFF_KC = OFF_MEMB + 16 * MiB;
constexpr size_t OFF_VCT = OFF_KC + 8 * MiB;
constexpr size_t OFF_SSQX = OFF_VCT + 8 * MiB;
constexpr size_t OFF_SSQCQ = OFF_SSQX + 2 * MiB;
constexpr size_t OFF_SSQCKV = OFF_SSQCQ + 1 * MiB;
constexpr size_t OFF_SSQMEM = OFF_SSQCKV + 1 * MiB;
constexpr size_t OFF_W = OFF_SSQMEM + 1 * MiB;
constexpr size_t OFF_U = OFF_QD;
constexpr size_t W_IN = 0;
constexpr size_t W_MEM = W_IN + (size_t)WIN_N * 1024;
constexpr size_t W_QB = W_MEM + 1024 * 1024;
constexpr size_t W_KVB = W_QB + 1024 * 384;
constexpr size_t W_DO = W_KVB + 1024 * 256;
constexpr size_t W_MO = W_DO + 1024 * 1024;
constexpr size_t W_CO = W_MO + 1024 * 768;
constexpr size_t W_OUT = W_CO + 1024 * 512;
constexpr size_t W_1 = W_OUT + 1024 * 1024;
constexpr size_t W_2 = W_1 + 4096 * 1024;
constexpr size_t W_END = W_2 + 4096 * 1024;
constexpr size_t WS_NEED = OFF_W + W_END * 2;

constexpr int LDS_ROW = 144;
constexpr int CS_LD = 132;
constexpr int CS_BYTES = 256 * CS_LD * 4;
constexpr int RS_OFF = 2 * 512 * LDS_ROW;
constexpr int LDS_BYTES = RS_OFF + 1024;

__constant__ float INVF64[32] = {1.000000000e+00f,7.498942614e-01f,5.623413324e-01f,4.216965139e-01f,3.162277639e-01f,2.371373773e-01f,1.778279394e-01f,1.333521307e-01f,1.000000015e-01f,7.498941571e-02f,5.623413250e-02f,4.216965288e-02f,3.162277490e-02f,2.371373773e-02f,1.778279431e-02f,1.333521493e-02f,9.999999776e-03f,7.498941850e-03f,5.623413250e-03f,4.216964822e-03f,3.162277630e-03f,2.371373586e-03f,1.778279431e-03f,1.333521446e-03f,1.000000047e-03f,7.498942432e-04f,5.623413017e-04f,4.216965172e-04f,3.162277571e-04f,2.371373703e-04f,1.778279402e-04f,1.333521504e-04f};
__constant__ float INVF32[16] = {1.000000000e+00f,5.623413324e-01f,3.162277639e-01f,1.778279394e-01f,1.000000015e-01f,5.623413250e-02f,3.162277490e-02f,1.778279431e-02f,9.999999776e-03f,5.623413250e-03f,3.162277630e-03f,1.778279431e-03f,1.000000047e-03f,5.623413017e-04f,3.162277571e-04f,1.778279402e-04f};

struct Params {
  const float* in[27];
  float* out;
  char* ws;
  int ph_lo, ph_hi;
  int dupk, per;
};

typedef __bf16 bf2_t __attribute__((ext_vector_type(2)));
typedef float fl2_t __attribute__((ext_vector_type(2)));
DI unsigned pack2(float a, float b) { fl2_t f = {a, b}; bf2_t r = __builtin_convertvector(f, bf2_t); return __builtin_bit_cast(unsigned, r); }
DI u4 pack8(const float* v) { u4 u; u.x = pack2(v[0], v[1]); u.y = pack2(v[2], v[3]); u.z = pack2(v[4], v[5]); u.w = pack2(v[6], v[7]); return u; }
DI int ltid() { int t = threadIdx.x; asm volatile("" : "+v"(t)); return t; }
DI int crow(int i, int h) { return (i & 3) + 8 * (i >> 2) + 4 * h; }
DI void rot_cs(int pos, float invf, float& c, float& s) {
  const float ang = (float)pos * invf;
  double rev = (double)ang * 0.15915494309189535;
  rev -= floor(rev);
  const float rf = (float)rev;
  c = __builtin_amdgcn_cosf(rf);
  s = __builtin_amdgcn_sinf(rf);
}
DI void load8(const float* Cs, int r, int q, float* v) {
  const f4 a = *(const f4*)(Cs + r * CS_LD + q * 8);
  const f4 b = *(const f4*)(Cs + r * CS_LD + q * 8 + 4);
  v[0] = a.x; v[1] = a.y; v[2] = a.z; v[3] = a.w; v[4] = b.x; v[5] = b.y; v[6] = b.z; v[7] = b.w;
}

template <int MI, int NI, int WGN, bool FDB>
DI void gemm_mainloop(const bf16_t* __restrict__ A, int lda, const bf16_t* __restrict__ B, int ldb, int K, f32x16 (&acc)[MI][NI], char* smem) {
  constexpr int BM = (8 / WGN) * MI * 32, BN = WGN * NI * 32;
  constexpr int ASZ = BM * 64, STAGE = (BM + BN) * 64;
  constexpr int NGA = BM / 128, NGB = BN / 128, NLD = NGA + NGB;
  static_assert(4 * STAGE <= RS_OFF, "ring");
  const int tid = ltid(), lane = tid & 63, wave = tid >> 6, l31 = lane & 31, h = lane >> 5;
  const int wu = __builtin_amdgcn_readfirstlane(wave);
  const int wm = wave / WGN, wn = wave % WGN;
  const int lrow = lane >> 2, lchk = (lane & 3) ^ ((lane >> 4) & 3);
  const bf16_t* ga = A + (size_t)(wu * NGA * 16 + lrow) * lda + lchk * 8;
  const bf16_t* gb = B + (size_t)(wu * NGB * 16 + lrow) * ldb + lchk * 8;
#pragma unroll
  for (int mi = 0; mi < MI; ++mi)
#pragma unroll
    for (int ni = 0; ni < NI; ++ni)
#pragma unroll
      for (int i = 0; i < 16; ++i) acc[mi][ni][i] = 0.f;
  auto issue = [&](int j) {
    char* st = smem + (j & 3) * STAGE;
    const int k0 = j * 32;
#pragma unroll
    for (int i = 0; i < NGA; ++i)
      __builtin_amdgcn_global_load_lds((const unsigned*)(ga + (size_t)(i * 16) * lda + k0), (unsigned*)(st + (wu * NGA + i) * 1024), 16, 0, 0);
#pragma unroll
    for (int i = 0; i < NGB; ++i)
      __builtin_amdgcn_global_load_lds((const unsigned*)(gb + (size_t)(i * 16) * ldb + k0), (unsigned*)(st + ASZ + (wu * NGB + i) * 1024), 16, 0, 0);
  };
  asm volatile("s_waitcnt vmcnt(0)" ::: "memory");
  __syncthreads();
  const int nk = K >> 5;
  issue(0); issue(1); issue(2);
  const int sw = (l31 >> 2) & 3;
  const int oa = (wm * MI * 32 + l31) * 64, ob = ASZ + (wn * NI * 32 + l31) * 64;
  const int c0 = ((0 + h) ^ sw) * 16, c1 = ((2 + h) ^ sw) * 16;
#pragma unroll 1
  for (int j = 0; j < nk; ++j) {
    if (j + 2 < nk) asm volatile("s_waitcnt vmcnt(%0)" ::"n"(2 * NLD) : "memory");
    else if (j + 1 < nk) asm volatile("s_waitcnt vmcnt(%0)" ::"n"(NLD) : "memory");
    else asm volatile("s_waitcnt vmcnt(0)" ::: "memory");
    asm volatile("s_waitcnt lgkmcnt(0)" ::: "memory");
    __builtin_amdgcn_s_barrier();
    if (j + 3 < nk) issue(j + 3);
    const char* st = smem + (j & 3) * STAGE;
    const char* pa = st + oa;
    const char* pb = st + ob;
    bf16x8 fa0[MI], fb0[NI], fa1[MI], fb1[NI];
#pragma unroll
    for (int mi = 0; mi < MI; ++mi) fa0[mi] = *(const bf16x8*)(pa + mi * 2048 + c0);
#pragma unroll
    for (int ni = 0; ni < NI; ++ni) fb0[ni] = *(const bf16x8*)(pb + ni * 2048 + c0);
    if (FDB) {
#pragma unroll
      for (int mi = 0; mi < MI; ++mi) fa1[mi] = *(const bf16x8*)(pa + mi * 2048 + c1);
#pragma unroll
      for (int ni = 0; ni < NI; ++ni) fb1[ni] = *(const bf16x8*)(pb + ni * 2048 + c1);
    }
#pragma unroll
    for (int mi = 0; mi < MI; ++mi)
#pragma unroll
      for (int ni = 0; ni < NI; ++ni) acc[mi][ni] = MFMA(fa0[mi], fb0[ni], acc[mi][ni]);
    __builtin_amdgcn_sched_barrier(0);
    if (!FDB) {
#pragma unroll
      for (int mi = 0; mi < MI; ++mi) fa1[mi] = *(const bf16x8*)(pa + mi * 2048 + c1);
#pragma unroll
      for (int ni = 0; ni < NI; ++ni) fb1[ni] = *(const bf16x8*)(pb + ni * 2048 + c1);
    }
#pragma unroll
    for (int mi = 0; mi < MI; ++mi)
#pragma unroll
      for (int ni = 0; ni < NI; ++ni) acc[mi][ni] = MFMA(fa1[mi], fb1[ni], acc[mi][ni]);
    __builtin_amdgcn_sched_barrier(0);
  }
  asm volatile("s_waitcnt lgkmcnt(0)" ::: "memory");
  __builtin_amdgcn_s_barrier();
}

DI void fill_rs(float* rs, const float* ssq, int nparts, int pstride, int row0, float invK) {
  const int t = ltid();
  if (t < 256) {
    float r = 1.f;
    if (ssq) {
      float s = 0.f;
      for (int p = 0; p < nparts; ++p) s += ssq[(size_t)p * pstride + row0 + t];
      r = rsqrtf(s * invK + EPSV);
    }
    rs[t] = r;
  }
}

enum { EP_HEADROT = 0, EP_VT, EP_PLAIN, EP_KROPE, EP_NORM128, EP_QB, EP_KVB, EP_RES, EP_MLP1 };

struct Tile {
  int epi, row0, cb;
  bf16_t* dst; int ldd;
  const float* gain;
  float* ssq_out;
  const float* xsrc;
  float oscale;
};

DI void map_regular(int it, int bid, int NCB, int& rb, int& CB) {
  const int xcd = bid & 7, slot = bid >> 3;
  const int c = xcd * NCB + it;
  const int cgrp = c >> 5, rgrp = c & 31;
  rb = rgrp * 8 + (slot >> 2);
  CB = cgrp * 4 + (slot & 3);
}

template <int DK, int DV, int NM, bool CAUSAL>
DI void attn_block(const bf16_t* __restrict__ Q, int ldq, const bf16_t* __restrict__ Kg, int ldk, const bf16_t* __restrict__ Vt, int ldv,
                   int nkt, int q0, bf16_t* O, int ldo, float sc, float lam, const float* og, float omul, char* smem) {
  constexpr int KW = NM * DK, KS = (KW + 8) * 2, KCH = KW / 8;
  constexpr int KBYTES = 64 * KS, VBYTES = DV * LDS_ROW, STAGE = KBYTES + VBYTES;
  constexpr int NKC = 64 * KCH, NKL = (NKC + NTHR - 1) / NTHR;
  constexpr int NVC = DV * 8, NVL = NVC / NTHR;
  static_assert(NVC % NTHR == 0, "v chunks");
  static_assert(2 * STAGE <= CS_BYTES, "lds");
  constexpr int NKC16 = DK / 16, NDVB = DV / 32;
  const int tid = ltid(), lane = tid & 63, wave = tid >> 6, h = lane >> 5, l31 = lane & 31;
  const int wq = (NM == 2) ? (wave & 3) : wave;
  const int mymap = (NM == 2) ? (wave >> 2) : 0;
  const int q0w = q0 + wq * 32;

  bf16x8 qf[NKC16];
  {
    const bf16_t* qp = Q + (size_t)(wq * 32 + l31) * ldq + mymap * DK + h * 8;
#pragma unroll
    for (int kc = 0; kc < NKC16; ++kc) qf[kc] = *(const bf16x8*)(qp + kc * 16);
  }
  f32x16 o[NDVB];
#pragma unroll
  for (int d = 0; d < NDVB; ++d)
#pragma unroll
    for (int i = 0; i < 16; ++i) o[d][i] = 0.f;
  f32x16 lacc;
#pragma unroll
  for (int i = 0; i < 16; ++i) lacc[i] = 0.f;
  u4 onesu; onesu.x = onesu.y = onesu.z = onesu.w = 0x3F803F80u;
  const bf16x8 ones = __builtin_bit_cast(bf16x8, onesu);

  u4 rk[NKL], rv[NVL];
  auto gload = [&](int kt) {
#pragma unroll
    for (int i = 0; i < NKL; ++i) {
      const int c = tid + i * NTHR;
      if (NKC % NTHR == 0 || c < NKC) {
        const int r = c / KCH, cc = c % KCH;
        rk[i] = *(const u4*)(Kg + (size_t)(kt * 64 + r) * ldk + cc * 8);
      }
    }
#pragma unroll
    for (int i = 0; i < NVL; ++i) {
      const int c = tid + i * NTHR;
      const int r = c >> 3, cc = c & 7;
      rv[i] = *(const u4*)(Vt + (size_t)r * ldv + kt * 64 + cc * 8);
    }
  };
  auto swrite = [&](int s) {
    char* base = smem + s * STAGE;
#pragma unroll
    for (int i = 0; i < NKL; ++i) {
      const int c = tid + i * NTHR;
      if (NKC % NTHR == 0 || c < NKC) {
        const int r = c / KCH, cc = c % KCH;
        *(u4*)(base + r * KS + cc * 16) = rk[i];
      }
    }
#pragma unroll
    for (int i = 0; i < NVL; ++i) {
      const int c = tid + i * NTHR;
      const int r = c >> 3, cc = c & 7;
      *(u4*)(base + KBYTES + r * LDS_ROW + cc * 16) = rv[i];
    }
  };

  __syncthreads();
  gload(0);
  swrite(0);
  __syncthreads();
  for (int kt = 0; kt < nkt; ++kt) {
    const bool more = (kt + 1 < nkt);
    if (more) gload(kt + 1);
    const bool skip = CAUSAL && (kt * 64 > q0w + 31);
    if (!skip) {
      const char* base = smem + (kt & 1) * STAGE;
      f32x16 s[2];
#pragma unroll
      for (int sb = 0; sb < 2; ++sb) {
#pragma unroll
        for (int i = 0; i < 16; ++i) s[sb][i] = 0.f;
        const char* pk = base + (sb * 32 + l31) * KS + (mymap * DK + h * 8) * 2;
#pragma unroll
        for (int kc = 0; kc < NKC16; ++kc) {
          const bf16x8 a = *(const bf16x8*)(pk + kc * 32);
          s[sb] = MFMA(a, qf[kc], s[sb]);
        }
        __builtin_amdgcn_sched_barrier(0);
      }
      const bool need_mask = CAUSAL && (kt * 64 + 63 > q0w);
#pragma unroll
      for (int sb = 0; sb < 2; ++sb)
#pragma unroll
        for (int i = 0; i < 16; ++i) {
          float pz = __builtin_amdgcn_exp2f(s[sb][i]);
          if (need_mask) {
            const int key = kt * 64 + sb * 32 + crow(i, h);
            if (key > q0w + l31) pz = 0.f;
          }
          s[sb][i] = pz;
        }
      const char* pv = base + KBYTES + l31 * LDS_ROW + h * 8;
#pragma unroll
      for (int ks = 0; ks < 4; ++ks) {
        u4 pu;
        pu.x = pack2(s[ks >> 1][(ks & 1) * 8 + 0], s[ks >> 1][(ks & 1) * 8 + 1]);
        pu.y = pack2(s[ks >> 1][(ks & 1) * 8 + 2], s[ks >> 1][(ks & 1) * 8 + 3]);
        pu.z = pack2(s[ks >> 1][(ks & 1) * 8 + 4], s[ks >> 1][(ks & 1) * 8 + 5]);
        pu.w = pack2(s[ks >> 1][(ks & 1) * 8 + 6], s[ks >> 1][(ks & 1) * 8 + 7]);
        const bf16x8 pf = __builtin_bit_cast(bf16x8, pu);
        lacc = MFMA(ones, pf, lacc);
#pragma unroll
        for (int d = 0; d < NDVB; ++d) {
          const u2 lo = *(const u2*)(pv + d * 32 * LDS_ROW + ks * 32);
          const u2 hi = *(const u2*)(pv + d * 32 * LDS_ROW + ks * 32 + 16);
          u4 au; au.x = lo.x; au.y = lo.y; au.z = hi.x; au.w = hi.y;
          o[d] = MFMA(__builtin_bit_cast(bf16x8, au), pf, o[d]);
        }
        __builtin_amdgcn_sched_barrier(0);
      }
    }
    if (more) swrite((kt + 1) & 1);
    __syncthreads();
  }
  const float l_tot = lacc[0];
  const float inv = 1.f / l_tot;
#pragma unroll
  for (int d = 0; d < NDVB; ++d)
#pragma unroll
    for (int i = 0; i < 16; ++i) o[d][i] *= inv;

  float rn_out = 1.f;
  if (NM == 2) {
    float* buf = (float*)smem;
    if (wave >= 4) {
#pragma unroll
      for (int d = 0; d < NDVB; ++d)
#pragma unroll
        for (int i = 0; i < 16; ++i) buf[(d * 16 + i) * 256 + (wave & 3) * 64 + lane] = o[d][i];
    }
    __syncthreads();
    if (wave < 4) {
      float ss = 0.f;
#pragma unroll
      for (int d = 0; d < NDVB; ++d) {
#pragma unroll
        for (int i = 0; i < 16; ++i) {
          const float v = o[d][i] - lam * buf[(d * 16 + i) * 256 + wave * 64 + lane];
          o[d][i] = v;
          ss += v * v;
        }
        __builtin_amdgcn_sched_barrier(0);
      }
      ss += __shfl_xor(ss, 32);
      rn_out = rsqrtf(ss * (1.f / DV) + EPSV) * omul;
    }
  }
  if (NM == 1 || wave < 4) {
    bf16_t* op = O + (size_t)(wq * 32 + l31) * ldo + 4 * h;
#pragma unroll
    for (int d = 0; d < NDVB; ++d)
#pragma unroll
      for (int g = 0; g < 4; ++g) {
        f4 gg = {1.f, 1.f, 1.f, 1.f};
        if (NM == 2) gg = *(const f4*)(og + d * 32 + 8 * g + 4 * h);
        u2 u;
        u.x = pack2(o[d][4 * g + 0] * rn_out * gg.x, o[d][4 * g + 1] * rn_out * gg.y);
        u.y = pack2(o[d][4 * g + 2] * rn_out * gg.z, o[d][4 * g + 3] * rn_out * gg.w);
        *(u2*)(op + d * 32 + 8 * g) = u;
      }
  }
}

DI void prep_tile(const float* __restrict__ src, int N, const float* __restrict__ gain, bf16_t* __restrict__ dst, int Kp, int nmode, int kmode, int kt, int nt, char* smem) {
  float* tile = (float*)smem;
  const int tid = ltid();
  __syncthreads();
  {
    const int n = tid & 63;
    const int np = nt * 64 + n;
    int ns = np; bool nv = true;
    if (nmode == 1) {
      if (np < 3712) ns = np;
      else if (np < 3840) { ns = np; nv = (np < 3744); }
      else if (np < 4352) ns = np - 96;
      else ns = np - 96;
    } else if (nmode == 2) {
      const int hh = np >> 7, j = np & 127;
      nv = j < 96; ns = hh * 96 + j;
    }
#pragma unroll
    for (int j = 0; j < 8; ++j) {
      const int kk = (tid >> 6) + 8 * j;
      const int kp = kt * 64 + kk;
      int ks = kp; bool kv = true;
      if (kmode == 1) { const int hh = kp / 96, jj = kp % 96; kv = jj < 64; ks = hh * 64 + jj; }
      float v = 0.f;
      if (nv && kv) { v = src[(size_t)ks * N + ns]; if (gain) v *= gain[ks]; }
      tile[n * 65 + kk] = v;
    }
  }
  __syncthreads();
  {
    const int n = tid >> 3, kc = tid & 7;
    float v[8];
#pragma unroll
    for (int e = 0; e < 8; ++e) v[e] = tile[n * 65 + kc * 8 + e];
    *(u4*)(dst + (size_t)(nt * 64 + n) * Kp + kt * 64 + kc * 8) = pack8(v);
  }
}

DI void prep_item(const Params& p, int l, int it, char* smem) {
  bf16_t* W = (bf16_t*)(p.ws + OFF_W);
  const float* src; const float* gain = nullptr; bf16_t* dst; int N, Kp, nmode = 0, kmode = 0, nkt, loc;
  if (it < 1856)      { loc = it;        src = p.in[4] + (size_t)l * 1024 * 7328; N = 7328; gain = p.in[3] + l * 1024; dst = W + W_IN; Kp = 1024; nmode = 1; nkt = 16; }
  else if (it < 2112) { loc = it - 1856; src = p.in[19] + (size_t)l * 1024 * 1024; N = 1024; gain = p.in[18] + l * 1024; dst = W + W_MEM; Kp = 1024; nkt = 16; }
  else if (it < 2208) { loc = it - 2112; src = p.in[12] + (size_t)l * 384 * 768; N = 768; gain = p.in[11] + l * 384; dst = W + W_QB; Kp = 384; nmode = 2; nkt = 6; }
  else if (it < 2272) { loc = it - 2208; src = p.in[14] + (size_t)l * 256 * 1024; N = 1024; gain = p.in[13] + l * 256; dst = W + W_KVB; Kp = 256; nkt = 4; }
  else if (it < 2528) { loc = it - 2272; src = p.in[10] + (size_t)l * 1024 * 1024; N = 1024; dst = W + W_DO; Kp = 1024; nkt = 16; }
  else if (it < 2720) { loc = it - 2528; src = p.in[17] + (size_t)l * 512 * 1024; N = 1024; dst = W + W_MO; Kp = 768; kmode = 1; nkt = 12; }
  else if (it < 2848) { loc = it - 2720; src = p.in[22] + (size_t)l * 512 * 1024; N = 1024; dst = W + W_CO; Kp = 512; nkt = 8; }
  else if (it < 3104) { loc = it - 2848; src = p.in[23] + (size_t)l * 1024 * 1024; N = 1024; dst = W + W_OUT; Kp = 1024; nkt = 16; }
  else if (it < 4128) { loc = it - 3104; src = p.in[25] + (size_t)l * 1024 * 4096; N = 4096; gain = p.in[24] + l * 1024; dst = W + W_1; Kp = 1024; nkt = 16; }
  else                { loc = it - 4128; src = p.in[26] + (size_t)l * 4096 * 1024; N = 1024; dst = W + W_2; Kp = 4096; nkt = 64; }
  prep_tile(src, N, gain, dst, Kp, nmode, kmode, loc % nkt, loc / nkt, smem);
}
DI void prep_range(const Params& p, int l, int lo, int hi, char* smem) {
  for (int it = lo + blockIdx.x; it < hi; it += gridDim.x) prep_item(p, l, it, smem);
}

DI void phase_init(const Params& p) {
  const int tid_ = ltid(); const int lane = tid_ & 63, gw = blockIdx.x * 8 + (tid_ >> 6), GW = gridDim.x * 8;
  bf16_t* XB = (bf16_t*)(p.ws + OFF_XB); bf16_t* MB = (bf16_t*)(p.ws + OFF_MEMB);
  float* SX = (float*)(p.ws + OFF_SSQX); float* SM = (float*)(p.ws + OFF_SSQMEM);
  for (int r = gw; r < T + MEMR; r += GW) {
    const bool isx = r < T;
    const float* src = isx ? p.in[0] + (size_t)r * 1024 : p.in[1] + (size_t)(r - T) * 1024;
    bf16_t* dst = isx ? XB + (size_t)r * 1024 : MB + (size_t)(r - T) * 1024;
    float ss = 0.f;
#pragma unroll
    for (int j = 0; j < 4; ++j) {
      const f4 v = *(const f4*)(src + j * 256 + lane * 4);
      ss += v.x * v.x + v.y * v.y + v.z * v.z + v.w * v.w;
      u2 u; u.x = pack2(v.x, v.y); u.y = pack2(v.z, v.w);
      *(u2*)(dst + j * 256 + lane * 4) = u;
    }
#pragma unroll
    for (int m = 32; m >= 1; m >>= 1) ss += __shfl_xor(ss, m);
    if (isx) { if (lane < 8) SX[(size_t)lane * T + r] = (lane == 0) ? ss : 0.f; }
    else if (lane == 0) SM[r - T] = ss;
  }
}

DI void run_epilogue(const Params& p, const Tile& t, char* smem) {
  float* Cs = (float*)smem;
  float* rs = (float*)(smem + RS_OFF);
  const int tid = ltid();
  const int q = tid & 15, rsub = tid >> 4;
  const int* pos = (const int*)p.in[2];
  if (t.epi == EP_VT) {
    const int c = tid >> 2, rq = tid & 3;
#pragma unroll
    for (int j = 0; j < 8; ++j) {
      float v[8];
#pragma unroll
      for (int e = 0; e < 8; ++e) { const int r = rq * 64 + j * 8 + e; v[e] = Cs[r * CS_LD + c] * rs[r]; }
      *(u4*)(t.dst + (size_t)c * t.ldd + rq * 64 + j * 8) = pack8(v);
    }
    return;
  }
#pragma unroll 1
  for (int pass = 0; pass < 8; ++pass) {
    const int r = rsub + 32 * pass;
    const int row = t.row0 + r;
    float v[8];
    load8(Cs, r, q, v);
    const float rsv = rs[r];
#pragma unroll
    for (int e = 0; e < 8; ++e) v[e] *= rsv;
    switch (t.epi) {
      case EP_HEADROT: {
        float ss = 0.f;
#pragma unroll
        for (int e = 0; e < 8; ++e) ss += v[e] * v[e];
        ss += __shfl_xor(ss, 1); ss += __shfl_xor(ss, 2); ss += __shfl_xor(ss, 4);
        const float rn = rsqrtf(ss * (1.f / 64) + EPSV);
        const int pp = q & 7; const bool first = pp < 4; const int i0 = (pp & 3) * 8;
        const int ps = pos[row];
        float ov[8];
#pragma unroll
        for (int e = 0; e < 8; ++e) {
          const float y = v[e] * rn * t.gain[pp * 8 + e];
          const float yp = __shfl_xor(y, 4);
          float c, s; rot_cs(ps, INVF64[i0 + e], c, s);
          ov[e] = (first ? (y * c - yp * s) : (y * c + yp * s)) * t.oscale;
        }
        *(u4*)(t.dst + (size_t)row * t.ldd + t.cb * 128 + q * 8) = pack8(ov);
      } break;
      case EP_PLAIN: {
        float ss = 0.f;
#pragma unroll
        for (int e = 0; e < 8; ++e) ss += v[e] * v[e];
        ss += __shfl_xor(ss, 1); ss += __shfl_xor(ss, 2); ss += __shfl_xor(ss, 4); ss += __shfl_xor(ss, 8);
        *(u4*)(t.dst + (size_t)row * t.ldd + t.cb * 128 + q * 8) = pack8(v);
        if (q == 0) t.ssq_out[row] = ss;
      } break;
      case EP_KROPE: {
        const bool first = (q & 2) == 0; const int i0 = (q & 1) * 8;
        const int ps = pos[row];
        float ov[8];
#pragma unroll
        for (int e = 0; e < 8; ++e) {
          const float yp = __shfl_xor(v[e], 2);
          float c, s; rot_cs(ps, INVF32[i0 + e], c, s);
          ov[e] = first ? (v[e] * c - yp * s) : (v[e] * c + yp * s);
        }
        if (q < 4) {
          float* kr = (float*)(p.ws + OFF_KR) + (size_t)row * 32 + q * 8;
          *(f4*)kr = f4{ov[0], ov[1], ov[2], ov[3]};
          *(f4*)(kr + 4) = f4{ov[4], ov[5], ov[6], ov[7]};
        }
      } break;
      case EP_NORM128: {
        float ss = 0.f;
#pragma unroll
        for (int e = 0; e < 8; ++e) ss += v[e] * v[e];
        ss += __shfl_xor(ss, 1); ss += __shfl_xor(ss, 2); ss += __shfl_xor(ss, 4); ss += __shfl_xor(ss, 8);
        const float rn = rsqrtf(ss * (1.f / 128) + EPSV);
#pragma unroll
        for (int e = 0; e < 8; ++e) v[e] *= rn * t.oscale * t.gain[q * 8 + e];
        *(u4*)(t.dst + (size_t)row * t.ldd + t.cb * 128 + q * 8) = pack8(v);
      } break;
      case EP_QB: {
        const bool isr = (q >= 8 && q < 12);
        const bool first = (q & 2) == 0; const int i0 = (q & 1) * 8;
        const int ps = pos[row];
        float ss = 0.f;
#pragma unroll
        for (int e = 0; e < 8; ++e) {
          const float yp = __shfl_xor(v[e], 2);
          float c, s; rot_cs(ps, INVF32[i0 + e], c, s);
          const float rv = first ? (v[e] * c - yp * s) : (v[e] * c + yp * s);
          v[e] = isr ? rv : v[e];
          ss += v[e] * v[e];
        }
        ss += __shfl_xor(ss, 1); ss += __shfl_xor(ss, 2); ss += __shfl_xor(ss, 4); ss += __shfl_xor(ss, 8);
        const float rn = rsqrtf(ss * (1.f / 96) + EPSV);
        if (q < 12) {
#pragma unroll
          for (int e = 0; e < 8; ++e) v[e] *= rn * t.oscale * t.gain[q * 8 + e];
          *(u4*)(t.dst + (size_t)row * 768 + t.cb * 96 + q * 8) = pack8(v);
        }
      } break;
      case EP_KVB: {
        if (q >= 8) {
          if (q < 12) {
            const float* kr = (const float*)(p.ws + OFF_KR) + (size_t)row * 32 + (q - 8) * 8;
            const f4 a = *(const f4*)kr, b = *(const f4*)(kr + 4);
            v[0] = a.x; v[1] = a.y; v[2] = a.z; v[3] = a.w; v[4] = b.x; v[5] = b.y; v[6] = b.z; v[7] = b.w;
          } else {
#pragma unroll
            for (int e = 0; e < 8; ++e) v[e] = 0.f;
          }
        }
        float ss = 0.f;
#pragma unroll
        for (int e = 0; e < 8; ++e) ss += v[e] * v[e];
        ss += __shfl_xor(ss, 1); ss += __shfl_xor(ss, 2); ss += __shfl_xor(ss, 4); ss += __shfl_xor(ss, 8);
        const float rn = rsqrtf(ss * (1.f / 96) + EPSV);
        if (q < 12) {
#pragma unroll
          for (int e = 0; e < 8; ++e) v[e] *= rn * t.oscale * t.gain[q * 8 + e];
          *(u4*)(t.dst + (size_t)row * 768 + t.cb * 96 + q * 8) = pack8(v);
        }
      } break;
      case EP_RES: {
        const float* xs = t.xsrc + (size_t)row * 1024 + t.cb * 128 + q * 8;
        const f4 a = *(const f4*)xs, b = *(const f4*)(xs + 4);
        v[0] += a.x; v[1] += a.y; v[2] += a.z; v[3] += a.w; v[4] += b.x; v[5] += b.y; v[6] += b.z; v[7] += b.w;
        float ss = 0.f;
#pragma unroll
        for (int e = 0; e < 8; ++e) ss += v[e] * v[e];
        ss += __shfl_xor(ss, 1); ss += __shfl_xor(ss, 2); ss += __shfl_xor(ss, 4); ss += __shfl_xor(ss, 8);
        float* xo = p.out + (size_t)row * 1024 + t.cb * 128 + q * 8;
        *(f4*)xo = f4{v[0], v[1], v[2], v[3]};
        *(f4*)(xo + 4) = f4{v[4], v[5], v[6], v[7]};
        *(u4*)(t.dst + (size_t)row * 1024 + t.cb * 128 + q * 8) = pack8(v);
        if (q == 0) t.ssq_out[row] = ss;
      } break;
      case EP_MLP1: {
#pragma unroll
        for (int e = 0; e < 8; ++e) { const float u = fmaxf(v[e], 0.f); v[e] = u * u; }
        *(u4*)(t.dst + (size_t)row * t.ldd + t.cb * 128 + q * 8) = pack8(v);
      } break;
      default: break;
    }
  }
  if (t.epi == EP_KVB) {
    bf16_t* VMT = (bf16_t*)(p.ws + OFF_VMT);
    const int c = tid >> 3, r8 = tid & 7;
    const int b = t.row0 >> 11, s0 = t.row0 & 2047;
    bf16_t* d = VMT + ((size_t)(b * 512 + t.cb * 64 + c)) * SEQ + s0 + r8 * 32;
#pragma unroll
    for (int j = 0; j < 4; ++j) {
      float v[8];
#pragma unroll
      for (int e = 0; e < 8; ++e) { const int r = r8 * 32 + j * 8 + e; v[e] = Cs[r * CS_LD + 64 + c] * rs[r]; }
      *(u4*)(d + j * 8) = pack8(v);
    }
  }
}

__global__ void __launch_bounds__(NTHR) mega_fwd(Params p) {
  __shared__ __attribute__((aligned(16))) char smem[LDS_BYTES];
  cg::grid_group grid = cg::this_grid();
  const int G = gridDim.x, bid = blockIdx.x;
  for (int ph = p.ph_lo; ph < p.ph_hi; ++ph) {
      char* ws = p.ws; asm volatile("" : "+s"(ws));
    bf16_t* XB = (bf16_t*)(ws + OFF_XB);   bf16_t* QD = (bf16_t*)(ws + OFF_QD);   bf16_t* KD = (bf16_t*)(ws + OFF_KD);
    bf16_t* VDT = (bf16_t*)(ws + OFF_VDT); bf16_t* CQ = (bf16_t*)(ws + OFF_CQ);   bf16_t* CKV = (bf16_t*)(ws + OFF_CKV);
    bf16_t* XQ = (bf16_t*)(ws + OFF_XQ);   bf16_t* QM = (bf16_t*)(ws + OFF_QM);   bf16_t* KM = (bf16_t*)(ws + OFF_KM);
    bf16_t* VMT = (bf16_t*)(ws + OFF_VMT); bf16_t* MEMB = (bf16_t*)(ws + OFF_MEMB); bf16_t* KC = (bf16_t*)(ws + OFF_KC);
    bf16_t* VCT = (bf16_t*)(ws + OFF_VCT); bf16_t* W = (bf16_t*)(ws + OFF_W);     bf16_t* U = (bf16_t*)(ws + OFF_U);
    bf16_t* MERGED = KD;
    float* SSQX = (float*)(ws + OFF_SSQX); float* SSQCQ = (float*)(ws + OFF_SSQCQ); float* SSQCKV = (float*)(ws + OFF_SSQCKV);
    float* SSQMEM = (float*)(ws + OFF_SSQMEM);

    if (ph == 0) {
      phase_init(p);
      prep_range(p, 0, 0, 5152, smem);
    } else {
      const int l = (ph - 1) / p.per, kr = (ph - 1) % p.per;
      const int k = (kr > p.dupk) ? kr - (p.per - 7) : kr;
#ifndef NO_GEMM
      if (k == 0 || k == 1 || k == 4 || k == 5 || k == 6) {
        int nits = 0, total = 0;
        if (k == 0) { nits = 18; total = 4480; if (l > 0) prep_range(p, l, 4128, 5152, smem); }
        else if (k == 1) { nits = 8; total = 2048; }
        else if (k == 4) { nits = 4; total = 1024; }
        else if (k == 5) { nits = 16; total = 4096; if (l + 1 < NL) prep_range(p, l + 1, 0, 3104, smem); }
        else { nits = 4; total = 1024; if (l + 1 < NL) prep_range(p, l + 1, 3104, 4128, smem); }
        const bool xmap = (G == 256);
        if (!xmap) nits = (total + G - 1) / G;
#pragma unroll 1
        for (int it = 0; it < nits; ++it) {
          int list = 0, rb = -1, CB = 0;
          if (xmap) {
            if (k == 0) {
              if (it < 16) map_regular(it, bid, 16, rb, CB);
              else if (it == 16) { rb = bid; CB = 16; }
              else if (bid < 128) { list = 1; rb = bid >> 2; CB = bid & 3; }
            } else if (k == 1) { list = it >> 2; map_regular(it & 3, bid, 4, rb, CB); }
            else if (k == 5) map_regular(it, bid, 16, rb, CB);
            else map_regular(it, bid, 4, rb, CB);
          } else {
            const int li = it * G + bid;
            if (li < total) {
              if (k == 0) { if (li < 4352) { rb = li / 17; CB = li % 17; } else { list = 1; rb = (li - 4352) >> 2; CB = (li - 4352) & 3; } }
              else if (k == 1) { list = li >> 10; rb = (li & 1023) >> 2; CB = li & 3; }
              else if (k == 5) { rb = li >> 4; CB = li & 15; }
              else { rb = li >> 2; CB = li & 3; }
            }
          }
          if (rb < 0) continue;
          const int row0 = rb * 256;
          const bf16_t* Ap; const bf16_t* Bp; int lda, Kd;
          const float* ssq = nullptr; int nparts = 0, pstride = T; float invK = 0.f;
          if (k == 0) {
            if (list == 0) { Ap = XB + (size_t)row0 * 1024; lda = 1024; Bp = W + W_IN + (size_t)CB * 256 * 1024; Kd = 1024; ssq = SSQX; nparts = 8; invK = 1.f / 1024; }
            else           { Ap = MEMB + (size_t)row0 * 1024; lda = 1024; Bp = W + W_MEM + (size_t)CB * 256 * 1024; Kd = 1024; ssq = SSQMEM; nparts = 1; pstride = 0; invK = 1.f / 1024; }
          } else if (k == 1) {
            if (list == 0) { Ap = CQ + (size_t)row0 * 384; lda = 384; Bp = W + W_QB + (size_t)CB * 256 * 384; Kd = 384; ssq = SSQCQ; nparts = 3; invK = 1.f / 384; }
            else           { Ap = CKV + (size_t)row0 * 256; lda = 256; Bp = W + W_KVB + (size_t)CB * 256 * 256; Kd = 256; ssq = SSQCKV; nparts = 2; invK = 1.f / 256; }
          } else if (k == 4) { Ap = MERGED + (size_t)row0 * 1024; lda = 1024; Bp = W + W_OUT + (size_t)CB * 256 * 1024; Kd = 1024; }
          else if (k == 5)   { Ap = XB + (size_t)row0 * 1024; lda = 1024; Bp = W + W_1 + (size_t)CB * 256 * 1024; Kd = 1024; ssq = SSQX; nparts = 8; invK = 1.f / 1024; }
          else               { Ap = U + (size_t)row0 * 4096; lda = 4096; Bp = W + W_2 + (size_t)CB * 256 * 4096; Kd = 4096; }
          f32x16 acc[4][2];
          gemm_mainloop<4, 2, 4, true>(Ap, lda, Bp, Kd, Kd, acc, smem);
          float* Cs = (float*)smem;
#pragma unroll 1
          for (int half = 0; half < 2; ++half) {
            if (half) __syncthreads();
            {
              const int tq = ltid(); const int lane = tq & 63, wave = tq >> 6, wm = wave >> 2, wn = wave & 3, h = lane >> 5;
              if ((wn >> 1) == half) {
#pragma unroll
                for (int mi = 0; mi < 4; ++mi)
#pragma unroll
                  for (int ni = 0; ni < 2; ++ni)
#pragma unroll
                    for (int i = 0; i < 16; ++i)
                      Cs[(wm * 128 + mi * 32 + crow(i, h)) * CS_LD + (wn & 1) * 64 + ni * 32 + (lane & 31)] = acc[mi][ni][i];
              }
            }
            if (half == 0) fill_rs((float*)(smem + RS_OFF), ssq, nparts, pstride, row0, invK);
            __syncthreads();
            const int cb = CB * 2 + half;
            Tile t;
            t.row0 = row0; t.cb = cb; t.epi = EP_PLAIN;
            t.dst = nullptr; t.ldd = 0; t.gain = nullptr; t.ssq_out = nullptr; t.xsrc = nullptr; t.oscale = 1.f;
            if (k == 0) {
              if (list == 0) {
                if (cb < 8)       { t.epi = EP_HEADROT; t.cb = cb; t.dst = QD; t.ldd = 1024; t.gain = p.in[6] + l * 64; t.oscale = 0.125f * 1.4426950408889634f; }
                else if (cb < 16) { t.epi = EP_HEADROT; t.cb = cb - 8; t.dst = KD; t.ldd = 1024; t.gain = p.in[7] + l * 64; }
                else if (cb < 24) { t.epi = EP_VT; t.cb = cb - 16; const int b = row0 >> 11, s0 = row0 & 2047; t.dst = VDT + ((size_t)(b * 1024 + (cb - 16) * 128)) * SEQ + s0; t.ldd = SEQ; }
                else if (cb < 27) { t.epi = EP_PLAIN; t.cb = cb - 24; t.dst = CQ; t.ldd = 384; t.ssq_out = SSQCQ + (size_t)(cb - 24) * T; }
                else if (cb < 29) { t.epi = EP_PLAIN; t.cb = cb - 27; t.dst = CKV; t.ldd = 256; t.ssq_out = SSQCKV + (size_t)(cb - 27) * T; }
                else if (cb == 29) { t.epi = EP_KROPE; t.cb = 0; }
                else              { t.epi = EP_NORM128; t.cb = cb - 30; t.dst = XQ; t.ldd = 512; t.gain = p.in[20] + l * 128; t.oscale = 0.08838834764831845f * 1.4426950408889634f; }
              } else {
                if (cb < 4) { t.epi = EP_NORM128; t.cb = cb; t.dst = KC; t.ldd = 512; t.gain = p.in[21] + l * 128; }
                else        { t.epi = EP_VT; t.cb = cb - 4; t.dst = VCT + ((size_t)(rb * 512 + (cb - 4) * 128)) * MEML; t.ldd = MEML; }
              }
            } else if (k == 1) {
              if (list == 0) { t.epi = EP_QB; t.dst = QM; t.gain = p.in[15] + l * 96; t.oscale = 0.10206207261596575f * 1.4426950408889634f; }
              else           { t.epi = EP_KVB; t.dst = KM; t.gain = p.in[16] + l * 96; }
            } else if (k == 4) { t.epi = EP_RES; t.dst = XB; t.xsrc = (l == 0) ? p.in[0] : p.out; t.ssq_out = SSQX + (size_t)cb * T; }
            else if (k == 5)   { t.epi = EP_MLP1; t.dst = U; t.ldd = 4096; }
            else               { t.epi = EP_RES; t.dst = XB; t.xsrc = p.out; t.ssq_out = SSQX + (size_t)cb * T; }
            run_epilogue(p, t, smem);
          }
        }
      } else
#endif
#ifndef NO_ATT
      if (k == 2) {
        float lam;
        const float lam_init = 0.8f - 0.6f * expf(-0.3f * (float)l);
        {
          const int lane = ltid() & 63;
          const float* lv = p.in[8] + l * 256;
          float sa = lv[lane] * lv[64 + lane], sb = lv[128 + lane] * lv[192 + lane];
#pragma unroll
          for (int m = 32; m >= 1; m >>= 1) { sa += __shfl_xor(sa, m); sb += __shfl_xor(sb, m); }
          lam = expf(sa) - expf(sb) + lam_init;
        }
        const float L2E = 1.4426950408889634f;
#pragma unroll 1
        for (int it = 0; it < ((G == 256) ? 16 : (4096 + G - 1) / G); ++it) {
          int w;
          if (G == 256) {
            const int xcd = bid & 7, slot = bid >> 3;
            if (it < 8)       w = ((it * 32 + (slot >> 3) * 8 + xcd) << 3) + (slot & 7);
            else if (it < 12) w = 2048 + ((((it - 8) * 64 + (slot >> 2) * 8 + xcd) << 2) + (slot & 3));
            else              w = 3072 + ((((it - 12) * 32 + (slot >> 3) * 8 + xcd) << 3) + (slot & 7));
          } else { w = it * G + bid; if (w >= 4096) continue; }
#ifndef NO_A1
          if (w < 2048) {
            const int bh = w >> 3, j = w & 7, b = bh >> 3, hh = bh & 7;
#pragma unroll 1
            for (int half = 0; half < 2; ++half) {
              const int qb = half ? j : 15 - j;
              const int q0 = qb * 128;
              bf16_t* Qp = QD + ((size_t)(b * SEQ + q0)) * 1024 + hh * 128;
              attn_block<64, 128, 2, true>(Qp, 1024, KD + (size_t)b * SEQ * 1024 + hh * 128, 1024, VDT + ((size_t)(b * 1024 + hh * 128)) * SEQ, SEQ,
                                            (q0 + 128) >> 6, q0, Qp, 1024, 0.125f * L2E, lam, p.in[9] + l * 128, 1.f - lam_init, smem);
            }
          } else
#endif
#ifndef NO_A2
          if (w < 3072) {
            const int wj = w - 2048; const int bh = wj >> 2, j = wj & 3, b = bh >> 3, hh = bh & 7;
#pragma unroll 1
            for (int half = 0; half < 2; ++half) {
              const int qb = half ? j : 7 - j;
              const int q0 = qb * 256;
              bf16_t* Qp = QM + ((size_t)(b * SEQ + q0)) * 768 + hh * 96;
              attn_block<96, 64, 1, true>(Qp, 768, KM + (size_t)b * SEQ * 768 + hh * 96, 768, VMT + ((size_t)(b * 512 + hh * 64)) * SEQ, SEQ,
                                           (q0 + 256) >> 6, q0, Qp, 768, 0.10206207261596575f * L2E, 0.f, nullptr, 1.f, smem);
            }
          } else
#endif
#ifndef NO_A3
          {
            const int wj = w - 3072; const int bh = wj >> 3, qb = wj & 7, b = bh >> 2, hh = bh & 3;
            const int q0 = qb * 256;
            bf16_t* Qp = XQ + ((size_t)(b * SEQ + q0)) * 512 + hh * 128;
            attn_block<128, 128, 1, false>(Qp, 512, KC + (size_t)b * MEML * 512 + hh * 128, 512, VCT + ((size_t)(b * 512 + hh * 128)) * MEML, MEML,
                                            4, q0, Qp, 512, 0.08838834764831845f * L2E, 0.f, nullptr, 1.f, smem);
          }
#endif
          {}
        }
      } else
#endif
#ifndef NO_D
      if (k == 3) {
        float* Cs = (float*)smem;
        float* rs = (float*)(smem + RS_OFF);
#pragma unroll 1
        for (int it = 0; it < ((G == 256) ? 8 : (2048 + G - 1) / G); ++it) {
          int rb, cb;
          if (G == 256) map_regular(it, bid, 8, rb, cb);
          else { const int li = it * G + bid; if (li >= 2048) continue; rb = li >> 3; cb = li & 7; }
          const int tidd = ltid(); const int lane = tidd & 63, wave = tidd >> 6, wm = wave >> 1, wn = wave & 1, h = lane >> 5;
          const int row0 = rb * 256, col0 = cb * 128;
          __syncthreads();
          fill_rs(rs, SSQX, 8, T, row0, 1.f / 1024);
          f32x16 acc[2][2];
          unsigned gp[2][2][8], mp[2][2][8];
#pragma unroll
          for (int mi = 0; mi < 2; ++mi)
#pragma unroll
            for (int ni = 0; ni < 2; ++ni)
#pragma unroll
              for (int i = 0; i < 8; ++i) mp[mi][ni][i] = 0u;
#pragma unroll 1
          for (int st = 0; st < 6; ++st) {
            const int br = st >> 1, half = st & 1;
            const bf16_t* Ab; const bf16_t* Bb; int Kb;
            if (half == 0)    { Ab = XB + (size_t)row0 * 1024; Bb = W + W_IN + (size_t)(WIN_GATE0 + br * 1024 + col0) * 1024; Kb = 1024; }
            else if (br == 0) { Ab = QD + (size_t)row0 * 1024; Bb = W + W_DO + (size_t)col0 * 1024; Kb = 1024; }
            else if (br == 1) { Ab = QM + (size_t)row0 * 768;  Bb = W + W_MO + (size_t)col0 * 768;  Kb = 768; }
            else              { Ab = XQ + (size_t)row0 * 512;  Bb = W + W_CO + (size_t)col0 * 512;  Kb = 512; }
            gemm_mainloop<2, 2, 2, false>(Ab, Kb, Bb, Kb, Kb, acc, smem);
            if (half == 0) {
              const float* bg = p.in[5] + (size_t)l * 3072 + br * 1024 + col0 + wn * 64 + (lane & 31);
              const float bgv0 = bg[0], bgv1 = bg[32];
#pragma unroll
              for (int mi = 0; mi < 2; ++mi) {
                float rsv[16];
#pragma unroll
                for (int i = 0; i < 16; ++i) rsv[i] = rs[wm * 64 + mi * 32 + crow(i, h)];
#pragma unroll
                for (int ni = 0; ni < 2; ++ni) {
                  const float bgv = ni ? bgv1 : bgv0;
#pragma unroll
                  for (int i = 0; i < 16; i += 2) {
                    const float z0 = acc[mi][ni][i] * rsv[i] + bgv;
                    const float z1 = acc[mi][ni][i + 1] * rsv[i + 1] + bgv;
                    gp[mi][ni][i >> 1] = pack2(1.f / (1.f + __expf(-z0)), 1.f / (1.f + __expf(-z1)));
                  }
                }
                __builtin_amdgcn_sched_barrier(0);
              }
            } else {
#pragma unroll
              for (int mi = 0; mi < 2; ++mi)
#pragma unroll
                for (int ni = 0; ni < 2; ++ni)
#pragma unroll
                  for (int i = 0; i < 16; i += 2) {
                    const unsigned g2 = gp[mi][ni][i >> 1], m2 = mp[mi][ni][i >> 1];
                    const float m0 = __uint_as_float(m2 << 16) + __uint_as_float(g2 << 16) * acc[mi][ni][i];
                    const float m1 = __uint_as_float(m2 & 0xffff0000u) + __uint_as_float(g2 & 0xffff0000u) * acc[mi][ni][i + 1];
                    mp[mi][ni][i >> 1] = pack2(m0, m1);
                  }
            }
          }
#pragma unroll
          for (int mi = 0; mi < 2; ++mi)
#pragma unroll
            for (int ni = 0; ni < 2; ++ni)
#pragma unroll
              for (int i = 0; i < 16; ++i) {
                const unsigned m2 = mp[mi][ni][i >> 1];
                Cs[(wm * 64 + mi * 32 + crow(i, h)) * CS_LD + wn * 64 + ni * 32 + (lane & 31)] = __uint_as_float((i & 1) ? (m2 & 0xffff0000u) : (m2 << 16));
              }
          __syncthreads();
          const int q = tidd & 15, rsub = tidd >> 4;
#pragma unroll 1
          for (int pass = 0; pass < 8; ++pass) {
            const int r = rsub + 32 * pass;
            float v[8];
            load8(Cs, r, q, v);
            *(u4*)(MERGED + (size_t)(row0 + r) * 1024 + col0 + q * 8) = pack8(v);
          }
        }
      }
#endif
      {}
    }
    if (ph + 1 < p.ph_hi) grid.sync();
  }
}

extern "C" void kernel_launch(void* const* d_in, const int* in_sizes, int n_in, void* d_out, int out_size, void* d_ws, size_t ws_size, hipStream_t stream) {
  static int grid_blocks = 0;
  if (grid_blocks == 0) {
    if (n_in != 27 || ws_size < WS_NEED) { fprintf(stderr, "kernel_launch: unexpected inputs (n_in %d) or workspace (%zu < %zu)\n", n_in, ws_size, (size_t)WS_NEED); grid_blocks = -1; return; }
    int dev = 0, cus = 0, per_cu = 0;
    hipGetDevice(&dev);
    hipDeviceGetAttribute(&cus, hipDeviceAttributeMultiprocessorCount, dev);
    hipOccupancyMaxActiveBlocksPerMultiprocessor(&per_cu, mega_fwd, NTHR, 0);
    if (per_cu < 1) per_cu = 1;
    if (per_cu > 1) per_cu = 1;
    grid_blocks = cus * per_cu;
  }
  if (grid_blocks < 0) return;
  Params p{};
  for (int i = 0; i < 27; ++i) p.in[i] = (const float*)d_in[i];
  p.out = (float*)d_out;
  p.ws = (char*)d_ws;
  p.ph_lo = 0;
  p.dupk = (DUP_K >= 0) ? DUP_K : 100;
  p.per = (DUP_K >= 0) ? 8 : 7;
  p.ph_hi = 1 + NL * p.per;
  void* args[] = {&p};
  hipError_t e = hipLaunchCooperativeKernel((void*)mega_fwd, dim3(grid_blocks), dim3(NTHR), args, 0, stream);
  if (e != hipSuccess) fprintf(stderr, "cooperative launch failed: %s (grid %d)\n", hipGetErrorString(e), grid_blocks);
}
```

```cpp
#include <hip/hip_runtime.h>
#include <hip/hip_cooperative_groups.h>
#include <stdint.h>
#include <stdio.h>
namespace cg = cooperative_groups;

typedef unsigned short bf16_t;
using bf16x8 = __attribute__((ext_vector_type(8))) short;
using f32x16 = __attribute__((ext_vector_type(16))) float;
typedef unsigned u4 __attribute__((ext_vector_type(4)));
typedef unsigned u2 __attribute__((ext_vector_type(2)));
typedef float f4 __attribute__((ext_vector_type(4)));
#define DI __device__ __forceinline__
#define MFMA(a, b, c) __builtin_amdgcn_mfma_f32_32x32x16_bf16((a), (b), (c), 0, 0, 0)

constexpr int T = 65536, DM = 1024, NB = 32, SEQ = 2048, NL = 4, MEML = 256, MEMR = NB * MEML;
constexpr int NTHR = 512;
constexpr int DUP_K = -1;
constexpr float EPSV = 1e-6f;
constexpr int WIN_N = 7424;
constexpr int WIN_GATE0 = 4352;

constexpr size_t MiB = 1024ull * 1024ull;
constexpr size_t OFF_XB = 0;
constexpr size_t OFF_QD = OFF_XB + 128 * MiB;
constexpr size_t OFF_KD = OFF_QD + 128 * MiB;
constexpr size_t OFF_VDT = OFF_KD + 128 * MiB;
constexpr size_t OFF_CQ = OFF_VDT + 128 * MiB;
constexpr size_t OFF_CKV = OFF_CQ + 48 * MiB;
constexpr size_t OFF_KR = OFF_CKV + 32 * MiB;
constexpr size_t OFF_XQ = OFF_KR + 8 * MiB;
constexpr size_t OFF_QM = OFF_XQ + 64 * MiB;
constexpr size_t OFF_KM = OFF_QM + 96 * MiB;
constexpr size_t OFF_VMT = OFF_KM + 96 * MiB;
constexpr size_t OFF_MEMB = OFF_VMT + 64 * MiB;
constexpr size_t OFF_KC = OFF_MEMB + 16 * MiB;
constexpr size_t OFF_VCT = OFF_KC + 8 * MiB;
constexpr size_t OFF_SSQX = OFF_VCT + 8 * MiB;
constexpr size_t OFF_SSQCQ = OFF_SSQX + 2 * MiB;
constexpr size_t OFF_SSQCKV = OFF_SSQCQ + 1 * MiB;
constexpr size_t OFF_SSQMEM = OFF_SSQCKV + 1 * MiB;
constexpr size_t OFF_W = OFF_SSQMEM + 1 * MiB;
constexpr size_t OFF_U = OFF_QD;
constexpr size_t W_IN = 0;
constexpr size_t W_MEM = W_IN + (size_t)WIN_N * 1024;
constexpr size_t W_QB = W_MEM + 1024 * 1024;
constexpr size_t W_KVB = W_QB + 1024 * 384;
constexpr size_t W_DO = W_KVB + 1024 * 256;
constexpr size_t W_MO = W_DO + 1024 * 1024;
constexpr size_t W_CO = W_MO + 1024 * 768;
constexpr size_t W_OUT = W_CO + 1024 * 512;
constexpr size_t W_1 = W_OUT + 1024 * 1024;
constexpr size_t W_2 = W_1 + 4096 * 1024;
constexpr size_t W_END = W_2 + 4096 * 1024;
constexpr size_t WS_NEED = OFF_W + W_END * 2;

constexpr int LDS_ROW = 144;
constexpr int CS_LD = 132;
constexpr int CS_BYTES = 256 * CS_LD * 4;
constexpr int RS_OFF = 2 * 512 * LDS_ROW;
constexpr int LDS_BYTES = RS_OFF + 1024;

__constant__ float INVF64[32] = {1.000000000e+00f,7.498942614e-01f,5.623413324e-01f,4.216965139e-01f,3.162277639e-01f,2.371373773e-01f,1.778279394e-01f,1.333521307e-01f,1.000000015e-01f,7.498941571e-02f,5.623413250e-02f,4.216965288e-02f,3.162277490e-02f,2.371373773e-02f,1.778279431e-02f,1.333521493e-02f,9.999999776e-03f,7.498941850e-03f,5.623413250e-03f,4.216964822e-03f,3.162277630e-03f,2.371373586e-03f,1.778279431e-03f,1.333521446e-03f,1.000000047e-03f,7.498942432e-04f,5.623413017e-04f,4.216965172e-04f,3.162277571e-04f,2.371373703e-04f,1.778279402e-04f,1.333521504e-04f};
__constant__ float INVF32[16] = {1.000000000e+00f,5.623413324e-01f,3.162277639e-01f,1.778279394e-01f,1.000000015e-01f,5.623413250e-02f,3.162277490e-02f,1.778279431e-02f,9.999999776e-03f,5.623413250e-03f,3.162277630e-03f,1.778279431e-03f,1.000000047e-03f,5.623413017e-04f,3.162277571e-04f,1.778279402e-04f};

struct Params {
  const float* in[27];
  float* out;
  char* ws;
  int ph_lo, ph_hi;
  int dupk, per;
};

typedef __bf16 bf2_t __attribute__((ext_vector_type(2)));
typedef float fl2_t __attribute__((ext_vector_type(2)));
DI unsigned pack2(float a, float b) { fl2_t f = {a, b}; bf2_t r = __builtin_convertvector(f, bf2_t); return __builtin_bit_cast(unsigned, r); }
DI u4 pack8(const float* v) { u4 u; u.x = pack2(v[0], v[1]); u.y = pack2(v[2], v[3]); u.z = pack2(v[4], v[5]); u.w = pack2(v[6], v[7]); return u; }
DI int ltid() { int t = threadIdx.x; asm volatile("" : "+v"(t)); return t; }
DI int crow(int i, int h) { return (i & 3) + 8 * (i >> 2) + 4 * h; }
DI void rot_cs(int pos, float invf, float& c, float& s) {
  const float ang = (float)pos * invf;
  double rev = (double)ang * 0.15915494309189535;
  rev -= floor(rev);
  const float rf = (float)rev;
  c = __builtin_amdgcn_cosf(rf);
  s = __builtin_amdgcn_sinf(rf);
}
DI void load8(const float* Cs, int r, int q, float* v) {
  const f4 a = *(const f4*)(Cs + r * CS_LD + q * 8);
  const f4 b = *(const f4*)(Cs + r * CS_LD + q * 8 + 4);
  v[0] = a.x; v[1] = a.y; v[2] = a.z; v[3] = a.w; v[4] = b.x; v[5] = b.y; v[6] = b.z; v[7] = b.w;
}

template <int MI, int NI, int WGN, bool FDB>
DI void gemm_mainloop(const bf16_t* __restrict__ A, int lda, const bf16_t* __restrict__ B, int ldb, int K, f32x16 (&acc)[MI][NI], char* smem) {
  constexpr int BM = (8 / WGN) * MI * 32, BN = WGN * NI * 32;
  constexpr int ASZ = BM * 64, STAGE = (BM + BN) * 64;
  constexpr int NGA = BM / 128, NGB = BN / 128, NLD = NGA + NGB;
  static_assert(4 * STAGE <= RS_OFF, "ring");
  const int tid = ltid(), lane = tid & 63, wave = tid >> 6, l31 = lane & 31, h = lane >> 5;
  const int wu = __builtin_amdgcn_readfirstlane(wave);
  const int wm = wave / WGN, wn = wave % WGN;
  const int lrow = lane >> 2, lchk = (lane & 3) ^ ((lane >> 4) & 3);
  const bf16_t* ga = A + (size_t)(wu * NGA * 16 + lrow) * lda + lchk * 8;
  const bf16_t* gb = B + (size_t)(wu * NGB * 16 + lrow) * ldb + lchk * 8;
#pragma unroll
  for (int mi = 0; mi < MI; ++mi)
#pragma unroll
    for (int ni = 0; ni < NI; ++ni)
#pragma unroll
      for (int i = 0; i < 16; ++i) acc[mi][ni][i] = 0.f;
  auto issue = [&](int j) {
    char* st = smem + (j & 3) * STAGE;
    const int k0 = j * 32;
#pragma unroll
    for (int i = 0; i < NGA; ++i)
      __builtin_amdgcn_global_load_lds((const unsigned*)(ga + (size_t)(i * 16) * lda + k0), (unsigned*)(st + (wu * NGA + i) * 1024), 16, 0, 0);
#pragma unroll
    for (int i = 0; i < NGB; ++i)
      __builtin_amdgcn_global_load_lds((const unsigned*)(gb + (size_t)(i * 16) * ldb + k0), (unsigned*)(st + ASZ + (wu * NGB + i) * 1024), 16, 0, 0);
  };
  asm volatile("s_waitcnt vmcnt(0)" ::: "memory");
  __syncthreads();
  const int nk = K >> 5;
  issue(0); issue(1); issue(2);
  const int sw = (l31 >> 2) & 3;
  const int oa = (wm * MI * 32 + l31) * 64, ob = ASZ + (wn * NI * 32 + l31) * 64;
  const int c0 = ((0 + h) ^ sw) * 16, c1 = ((2 + h) ^ sw) * 16;
#pragma unroll 1
  for (int j = 0; j < nk; ++j) {
    if (j + 2 < nk) asm volatile("s_waitcnt vmcnt(%0)" ::"n"(2 * NLD) : "memory");
    else if (j + 1 < nk) asm volatile("s_waitcnt vmcnt(%0)" ::"n"(NLD) : "memory");
    else asm volatile("s_waitcnt vmcnt(0)" ::: "memory");
    asm volatile("s_waitcnt lgkmcnt(0)" ::: "memory");
    __builtin_amdgcn_s_barrier();
    if (j + 3 < nk) issue(j + 3);
    const char* st = smem + (j & 3) * STAGE;
    const char* pa = st + oa;
    const char* pb = st + ob;
    bf16x8 fa0[MI], fb0[NI], fa1[MI], fb1[NI];
#pragma unroll
    for (int mi = 0; mi < MI; ++mi) fa0[mi] = *(const bf16x8*)(pa + mi * 2048 + c0);
#pragma unroll
    for (int ni = 0; ni < NI; ++ni) fb0[ni] = *(const bf16x8*)(pb + ni * 2048 + c0);
    if (FDB) {
#pragma unroll
      for (int mi = 0; mi < MI; ++mi) fa1[mi] = *(const bf16x8*)(pa + mi * 2048 + c1);
#pragma unroll
      for (int ni = 0; ni < NI; ++ni) fb1[ni] = *(const bf16x8*)(pb + ni * 2048 + c1);
    }
#pragma unroll
    for (int mi = 0; mi < MI; ++mi)
#pragma unroll
      for (int ni = 0; ni < NI; ++ni) acc[mi][ni] = MFMA(fa0[mi], fb0[ni], acc[mi][ni]);
    __builtin_amdgcn_sched_barrier(0);
    if (!FDB) {
#pragma unroll
      for (int mi = 0; mi < MI; ++mi) fa1[mi] = *(const bf16x8*)(pa + mi * 2048 + c1);
#pragma unroll
      for (int ni = 0; ni < NI; ++ni) fb1[ni] = *(const bf16x8*)(pb + ni * 2048 + c1);
    }
#pragma unroll
    for (int mi = 0; mi < MI; ++mi)
#pragma unroll
      for (int ni = 0; ni < NI; ++ni) acc[mi][ni] = MFMA(fa1[mi], fb1[ni], acc[mi][ni]);
    __builtin_amdgcn_sched_barrier(0);
  }
  asm volatile("s_waitcnt lgkmcnt(0)" ::: "memory");
  __builtin_amdgcn_s_barrier();
}

DI void fill_rs(float* rs, const float* ssq, int nparts, int pstride, int row0, float invK) {
  const int t = ltid();
  if (t < 256) {
    float r = 1.f;
    if (ssq) {
      float s = 0.f;
      for (int p = 0; p < nparts; ++p) s += ssq[(size_t)p * pstride + row0 + t];
      r = rsqrtf(s * invK + EPSV);
    }
    rs[t] = r;
  }
}

enum { EP_HEADROT = 0, EP_VT, EP_PLAIN, EP_KROPE, EP_NORM128, EP_QB, EP_KVB, EP_RES, EP_MLP1 };

struct Tile {
  int epi, row0, cb;
  bf16_t* dst; int ldd;
  const float* gain;
  float* ssq_out;
  const float* xsrc;
  float oscale;
};

DI void map_regular(int it, int bid, int NCB, int& rb, int& CB) {
  const int xcd = bid & 7, slot = bid >> 3;
  const int c = xcd * NCB + it;
  const int cgrp = c >> 5, rgrp = c & 31;
  rb = rgrp * 8 + (slot >> 2);
  CB = cgrp * 4 + (slot & 3);
}

template <int DK, int DV, int NM, bool CAUSAL>
DI void attn_block(const bf16_t* __restrict__ Q, int ldq, const bf16_t* __restrict__ Kg, int ldk, const bf16_t* __restrict__ Vt, int ldv,
                   int nkt, int q0, bf16_t* O, int ldo, float sc, float lam, const float* og, float omul, char* smem) {
  constexpr int KW = NM * DK, KS = (KW + 8) * 2, KCH = KW / 8;
  constexpr int KBYTES = 64 * KS, VBYTES = DV * LDS_ROW, STAGE = KBYTES + VBYTES;
  constexpr int NKC = 64 * KCH, NKL = (NKC + NTHR - 1) / NTHR;
  constexpr int NVC = DV * 8, NVL = NVC / NTHR;
  static_assert(NVC % NTHR == 0, "v chunks");
  static_assert(2 * STAGE <= CS_BYTES, "lds");
  constexpr int NKC16 = DK / 16, NDVB = DV / 32;
  const int tid = ltid(), lane = tid & 63, wave = tid >> 6, h = lane >> 5, l31 = lane & 31;
  const int wq = (NM == 2) ? (wave & 3) : wave;
  const int mymap = (NM == 2) ? (wave >> 2) : 0;
  const int q0w = q0 + wq * 32;

  bf16x8 qf[NKC16];
  {
    const bf16_t* qp = Q + (size_t)(wq * 32 + l31) * ldq + mymap * DK + h * 8;
#pragma unroll
    for (int kc = 0; kc < NKC16; ++kc) qf[kc] = *(const bf16x8*)(qp + kc * 16);
  }
  f32x16 o[NDVB];
#pragma unroll
  for (int d = 0; d < NDVB; ++d)
#pragma unroll
    for (int i = 0; i < 16; ++i) o[d][i] = 0.f;
  f32x16 lacc;
#pragma unroll
  for (int i = 0; i < 16; ++i) lacc[i] = 0.f;
  u4 onesu; onesu.x = onesu.y = onesu.z = onesu.w = 0x3F803F80u;
  const bf16x8 ones = __builtin_bit_cast(bf16x8, onesu);

  u4 rk[NKL], rv[NVL];
  auto gload = [&](int kt) {
#pragma unroll
    for (int i = 0; i < NKL; ++i) {
      const int c = tid + i * NTHR;
      if (NKC % NTHR == 0 || c < NKC) {
        const int r = c / KCH, cc = c % KCH;
        rk[i] = *(const u4*)(Kg + (size_t)(kt * 64 + r) * ldk + cc * 8);
      }
    }
#pragma unroll
    for (int i = 0; i < NVL; ++i) {
      const int c = tid + i * NTHR;
      const int r = c >> 3, cc = c & 7;
      rv[i] = *(const u4*)(Vt + (size_t)r * ldv + kt * 64 + cc * 8);
    }
  };
  auto swrite = [&](int s) {
    char* base = smem + s * STAGE;
#pragma unroll
    for (int i = 0; i < NKL; ++i) {
      const int c = tid + i * NTHR;
      if (NKC % NTHR == 0 || c < NKC) {
        const int r = c / KCH, cc = c % KCH;
        *(u4*)(base + r * KS + cc * 16) = rk[i];
      }
    }
#pragma unroll
    for (int i = 0; i < NVL; ++i) {
      const int c = tid + i * NTHR;
      const int r = c >> 3, cc = c & 7;
      *(u4*)(base + KBYTES + r * LDS_ROW + cc * 16) = rv[i];
    }
  };

  __syncthreads();
  gload(0);
  swrite(0);
  __syncthreads();
  for (int kt = 0; kt < nkt; ++kt) {
    const bool more = (kt + 1 < nkt);
    if (more) gload(kt + 1);
    const bool skip = CAUSAL && (kt * 64 > q0w + 31);
    if (!skip) {
      const char* base = smem + (kt & 1) * STAGE;
      f32x16 s[2];
#pragma unroll
      for (int sb = 0; sb < 2; ++sb) {
#pragma unroll
        for (int i = 0; i < 16; ++i) s[sb][i] = 0.f;
        const char* pk = base + (sb * 32 + l31) * KS + (mymap * DK + h * 8) * 2;
#pragma unroll
        for (int kc = 0; kc < NKC16; ++kc) {
          const bf16x8 a = *(const bf16x8*)(pk + kc * 32);
          s[sb] = MFMA(a, qf[kc], s[sb]);
        }
        __builtin_amdgcn_sched_barrier(0);
      }
      const bool need_mask = CAUSAL && (kt * 64 + 63 > q0w);
#pragma unroll
      for (int sb = 0; sb < 2; ++sb)
#pragma unroll
        for (int i = 0; i < 16; ++i) {
          float pz = __builtin_amdgcn_exp2f(s[sb][i]);
          if (need_mask) {
            const int key = kt * 64 + sb * 32 + crow(i, h);
            if (key > q0w + l31) pz = 0.f;
          }
          s[sb][i] = pz;
        }
      const char* pv = base + KBYTES + l31 * LDS_ROW + h * 16;
#pragma unroll
      for (int ks = 0; ks < 4; ++ks) {
        u4 pu;
        pu.x = pack2(s[ks >> 1][(ks & 1) * 8 + 0], s[ks >> 1][(ks & 1) * 8 + 1]);
        pu.y = pack2(s[ks >> 1][(ks & 1) * 8 + 2], s[ks >> 1][(ks & 1) * 8 + 3]);
        pu.z = pack2(s[ks >> 1][(ks & 1) * 8 + 4], s[ks >> 1][(ks & 1) * 8 + 5]);
        pu.w = pack2(s[ks >> 1][(ks & 1) * 8 + 6], s[ks >> 1][(ks & 1) * 8 + 7]);
        const bf16x8 pf = __builtin_bit_cast(bf16x8, pu);
        lacc = MFMA(ones, pf, lacc);
#pragma unroll
        for (int d = 0; d < NDVB; ++d) {
          const u4 au = *(const u4*)(pv + d * 32 * LDS_ROW + ks * 32);
          o[d] = MFMA(__builtin_bit_cast(bf16x8, au), pf, o[d]);
        }
        __builtin_amdgcn_sched_barrier(0);
      }
    }
    if (more) swrite((kt + 1) & 1);
    __syncthreads();
  }
  const float l_tot = lacc[0];
  const float inv = 1.f / l_tot;
#pragma unroll
  for (int d = 0; d < NDVB; ++d)
#pragma unroll
    for (int i = 0; i < 16; ++i) o[d][i] *= inv;

  float rn_out = 1.f;
  if (NM == 2) {
    float* buf = (float*)smem;
    if (wave >= 4) {
#pragma unroll
      for (int d = 0; d < NDVB; ++d)
#pragma unroll
        for (int i = 0; i < 16; ++i) buf[(d * 16 + i) * 256 + (wave & 3) * 64 + lane] = o[d][i];
    }
    __syncthreads();
    if (wave < 4) {
      float ss = 0.f;
#pragma unroll
      for (int d = 0; d < NDVB; ++d) {
#pragma unroll
        for (int i = 0; i < 16; ++i) {
          const float v = o[d][i] - lam * buf[(d * 16 + i) * 256 + wave * 64 + lane];
          o[d][i] = v;
          ss += v * v;
        }
        __builtin_amdgcn_sched_barrier(0);
      }
      ss += __shfl_xor(ss, 32);
      rn_out = rsqrtf(ss * (1.f / DV) + EPSV) * omul;
    }
  }
  if (NM == 1 || wave < 4) {
    bf16_t* op = O + (size_t)(wq * 32 + l31) * ldo + 4 * h;
#pragma unroll
    for (int d = 0; d < NDVB; ++d)
#pragma unroll
      for (int g = 0; g < 4; ++g) {
        f4 gg = {1.f, 1.f, 1.f, 1.f};
        if (NM == 2) gg = *(const f4*)(og + d * 32 + 8 * g + 4 * h);
        u2 u;
        u.x = pack2(o[d][4 * g + 0] * rn_out * gg.x, o[d][4 * g + 1] * rn_out * gg.y);
        u.y = pack2(o[d][4 * g + 2] * rn_out * gg.z, o[d][4 * g + 3] * rn_out * gg.w);
        *(u2*)(op + d * 32 + 8 * g) = u;
      }
  }
}

DI void prep_tile(const float* __restrict__ src, int N, const float* __restrict__ gain, bf16_t* __restrict__ dst, int Kp, int nmode, int kmode, int kt, int nt, char* smem) {
  float* tile = (float*)smem;
  const int tid = ltid();
  __syncthreads();
  {
    const int n = tid & 63;
    const int np = nt * 64 + n;
    int ns = np; bool nv = true;
    if (nmode == 1) {
      if (np < 3712) ns = np;
      else if (np < 3840) { ns = np; nv = (np < 3744); }
      else if (np < 4352) ns = np - 96;
      else ns = np - 96;
    } else if (nmode == 2) {
      const int hh = np >> 7, j = np & 127;
      nv = j < 96; ns = hh * 96 + j;
    }
#pragma unroll
    for (int j = 0; j < 8; ++j) {
      const int kk = (tid >> 6) + 8 * j;
      const int kp = kt * 64 + kk;
      int ks = kp; bool kv = true;
      if (kmode == 1) { const int hh = kp / 96, jj = kp % 96; kv = jj < 64; ks = hh * 64 + jj; }
      float v = 0.f;
      if (nv && kv) { v = src[(size_t)ks * N + ns]; if (gain) v *= gain[ks]; }
      tile[n * 65 + kk] = v;
    }
  }
  __syncthreads();
  {
    const int n = tid >> 3, kc = tid & 7;
    float v[8];
#pragma unroll
    for (int e = 0; e < 8; ++e) v[e] = tile[n * 65 + kc * 8 + e];
    *(u4*)(dst + (size_t)(nt * 64 + n) * Kp + kt * 64 + kc * 8) = pack8(v);
  }
}

DI void prep_item(const Params& p, int l, int it, char* smem) {
  bf16_t* W = (bf16_t*)(p.ws + OFF_W);
  const float* src; const float* gain = nullptr; bf16_t* dst; int N, Kp, nmode = 0, kmode = 0, nkt, loc;
  if (it < 1856)      { loc = it;        src = p.in[4] + (size_t)l * 1024 * 7328; N = 7328; gain = p.in[3] + l * 1024; dst = W + W_IN; Kp = 1024; nmode = 1; nkt = 16; }
  else if (it < 2112) { loc = it - 1856; src = p.in[19] + (size_t)l * 1024 * 1024; N = 1024; gain = p.in[18] + l * 1024; dst = W + W_MEM; Kp = 1024; nkt = 16; }
  else if (it < 2208) { loc = it - 2112; src = p.in[12] + (size_t)l * 384 * 768; N = 768; gain = p.in[11] + l * 384; dst = W + W_QB; Kp = 384; nmode = 2; nkt = 6; }
  else if (it < 2272) { loc = it - 2208; src = p.in[14] + (size_t)l * 256 * 1024; N = 1024; gain = p.in[13] + l * 256; dst = W + W_KVB; Kp = 256; nkt = 4; }
  else if (it < 2528) { loc = it - 2272; src = p.in[10] + (size_t)l * 1024 * 1024; N = 1024; dst = W + W_DO; Kp = 1024; nkt = 16; }
  else if (it < 2720) { loc = it - 2528; src = p.in[17] + (size_t)l * 512 * 1024; N = 1024; dst = W + W_MO; Kp = 768; kmode = 1; nkt = 12; }
  else if (it < 2848) { loc = it - 2720; src = p.in[22] + (size_t)l * 512 * 1024; N = 1024; dst = W + W_CO; Kp = 512; nkt = 8; }
  else if (it < 3104) { loc = it - 2848; src = p.in[23] + (size_t)l * 1024 * 1024; N = 1024; dst = W + W_OUT; Kp = 1024; nkt = 16; }
  else if (it < 4128) { loc = it - 3104; src = p.in[25] + (size_t)l * 1024 * 4096; N = 4096; gain = p.in[24] + l * 1024; dst = W + W_1; Kp = 1024; nkt = 16; }
  else                { loc = it - 4128; src = p.in[26] + (size_t)l * 4096 * 1024; N = 1024; dst = W + W_2; Kp = 4096; nkt = 64; }
  prep_tile(src, N, gain, dst, Kp, nmode, kmode, loc % nkt, loc / nkt, smem);
}
DI void prep_range(const Params& p, int l, int lo, int hi, char* smem) {
  for (int it = lo + blockIdx.x; it < hi; it += gridDim.x) prep_item(p, l, it, smem);
}

DI void phase_init(const Params& p) {
  const int tid_ = ltid(); const int lane = tid_ & 63, gw = blockIdx.x * 8 + (tid_ >> 6), GW = gridDim.x * 8;
  bf16_t* XB = (bf16_t*)(p.ws + OFF_XB); bf16_t* MB = (bf16_t*)(p.ws + OFF_MEMB);
  float* SX = (float*)(p.ws + OFF_SSQX); float* SM = (float*)(p.ws + OFF_SSQMEM);
  for (int r = gw; r < T + MEMR; r += GW) {
    const bool isx = r < T;
    const float* src = isx ? p.in[0] + (size_t)r * 1024 : p.in[1] + (size_t)(r - T) * 1024;
    bf16_t* dst = isx ? XB + (size_t)r * 1024 : MB + (size_t)(r - T) * 1024;
    float ss = 0.f;
#pragma unroll
    for (int j = 0; j < 4; ++j) {
      const f4 v = *(const f4*)(src + j * 256 + lane * 4);
      ss += v.x * v.x + v.y * v.y + v.z * v.z + v.w * v.w;
      u2 u; u.x = pack2(v.x, v.y); u.y = pack2(v.z, v.w);
      *(u2*)(dst + j * 256 + lane * 4) = u;
    }
#pragma unroll
    for (int m = 32; m >= 1; m >>= 1) ss += __shfl_xor(ss, m);
    if (isx) { if (lane < 8) SX[(size_t)lane * T + r] = (lane == 0) ? ss : 0.f; }
    else if (lane == 0) SM[r - T] = ss;
  }
}

DI void run_epilogue(const Params& p, const Tile& t, char* smem) {
  float* Cs = (float*)smem;
  float* rs = (float*)(smem + RS_OFF);
  const int tid = ltid();
  const int q = tid & 15, rsub = tid >> 4;
  const int* pos = (const int*)p.in[2];
  if (t.epi == EP_VT) {
    const int c = tid >> 2, rq = tid & 3;
#pragma unroll
    for (int j = 0; j < 8; ++j) {
      float v[8];
#pragma unroll
      for (int e = 0; e < 8; ++e) { const int r = rq * 64 + j * 8 + e; v[e] = Cs[r * CS_LD + c] * rs[r]; }
      bf16_t* d16 = t.dst + (size_t)c * t.ldd + rq * 64 + (j >> 1) * 16;
      u2 lo, hi; lo.x = pack2(v[0], v[1]); lo.y = pack2(v[2], v[3]); hi.x = pack2(v[4], v[5]); hi.y = pack2(v[6], v[7]);
      *(u2*)(d16 + ((j & 1) ? 4 : 0)) = lo;
      *(u2*)(d16 + ((j & 1) ? 12 : 8)) = hi;
    }
    return;
  }
#pragma unroll 1
  for (int pass = 0; pass < 8; ++pass) {
    const int r = rsub + 32 * pass;
    const int row = t.row0 + r;
    float v[8];
    load8(Cs, r, q, v);
    const float rsv = rs[r];
#pragma unroll
    for (int e = 0; e < 8; ++e) v[e] *= rsv;
    switch (t.epi) {
      case EP_HEADROT: {
        float ss = 0.f;
#pragma unroll
        for (int e = 0; e < 8; ++e) ss += v[e] * v[e];
        ss += __shfl_xor(ss, 1); ss += __shfl_xor(ss, 2); ss += __shfl_xor(ss, 4);
        const float rn = rsqrtf(ss * (1.f / 64) + EPSV);
        const int pp = q & 7; const bool first = pp < 4; const int i0 = (pp & 3) * 8;
        const int ps = pos[row];
        float ov[8];
#pragma unroll
        for (int e = 0; e < 8; ++e) {
          const float y = v[e] * rn * t.gain[pp * 8 + e];
          const float yp = __shfl_xor(y, 4);
          float c, s; rot_cs(ps, INVF64[i0 + e], c, s);
          ov[e] = (first ? (y * c - yp * s) : (y * c + yp * s)) * t.oscale;
        }
        *(u4*)(t.dst + (size_t)row * t.ldd + t.cb * 128 + q * 8) = pack8(ov);
      } break;
      case EP_PLAIN: {
        float ss = 0.f;
#pragma unroll
        for (int e = 0; e < 8; ++e) ss += v[e] * v[e];
        ss += __shfl_xor(ss, 1); ss += __shfl_xor(ss, 2); ss += __shfl_xor(ss, 4); ss += __shfl_xor(ss, 8);
        *(u4*)(t.dst + (size_t)row * t.ldd + t.cb * 128 + q * 8) = pack8(v);
        if (q == 0) t.ssq_out[row] = ss;
      } break;
      case EP_KROPE: {
        const bool first = (q & 2) == 0; const int i0 = (q & 1) * 8;
        const int ps = pos[row];
        float ov[8];
#pragma unroll
        for (int e = 0; e < 8; ++e) {
          const float yp = __shfl_xor(v[e], 2);
          float c, s; rot_cs(ps, INVF32[i0 + e], c, s);
          ov[e] = first ? (v[e] * c - yp * s) : (v[e] * c + yp * s);
        }
        if (q < 4) {
          float* kr = (float*)(p.ws + OFF_KR) + (size_t)row * 32 + q * 8;
          *(f4*)kr = f4{ov[0], ov[1], ov[2], ov[3]};
          *(f4*)(kr + 4) = f4{ov[4], ov[5], ov[6], ov[7]};
        }
      } break;
      case EP_NORM128: {
        float ss = 0.f;
#pragma unroll
        for (int e = 0; e < 8; ++e) ss += v[e] * v[e];
        ss += __shfl_xor(ss, 1); ss += __shfl_xor(ss, 2); ss += __shfl_xor(ss, 4); ss += __shfl_xor(ss, 8);
        const float rn = rsqrtf(ss * (1.f / 128) + EPSV);
#pragma unroll
        for (int e = 0; e < 8; ++e) v[e] *= rn * t.oscale * t.gain[q * 8 + e];
        *(u4*)(t.dst + (size_t)row * t.ldd + t.cb * 128 + q * 8) = pack8(v);
      } break;
      case EP_QB: {
        const bool isr = (q >= 8 && q < 12);
        const bool first = (q & 2) == 0; const int i0 = (q & 1) * 8;
        const int ps = pos[row];
        float ss = 0.f;
#pragma unroll
        for (int e = 0; e < 8; ++e) {
          const float yp = __shfl_xor(v[e], 2);
          float c, s; rot_cs(ps, INVF32[i0 + e], c, s);
          const float rv = first ? (v[e] * c - yp * s) : (v[e] * c + yp * s);
          v[e] = isr ? rv : v[e];
          ss += v[e] * v[e];
        }
        ss += __shfl_xor(ss, 1); ss += __shfl_xor(ss, 2); ss += __shfl_xor(ss, 4); ss += __shfl_xor(ss, 8);
        const float rn = rsqrtf(ss * (1.f / 96) + EPSV);
        if (q < 12) {
#pragma unroll
          for (int e = 0; e < 8; ++e) v[e] *= rn * t.oscale * t.gain[q * 8 + e];
          *(u4*)(t.dst + (size_t)row * 768 + t.cb * 96 + q * 8) = pack8(v);
        }
      } break;
      case EP_KVB: {
        if (q >= 8) {
          if (q < 12) {
            const float* kr = (const float*)(p.ws + OFF_KR) + (size_t)row * 32 + (q - 8) * 8;
            const f4 a = *(const f4*)kr, b = *(const f4*)(kr + 4);
            v[0] = a.x; v[1] = a.y; v[2] = a.z; v[3] = a.w; v[4] = b.x; v[5] = b.y; v[6] = b.z; v[7] = b.w;
          } else {
#pragma unroll
            for (int e = 0; e < 8; ++e) v[e] = 0.f;
          }
        }
        float ss = 0.f;
#pragma unroll
        for (int e = 0; e < 8; ++e) ss += v[e] * v[e];
        ss += __shfl_xor(ss, 1); ss += __shfl_xor(ss, 2); ss += __shfl_xor(ss, 4); ss += __shfl_xor(ss, 8);
        const float rn = rsqrtf(ss * (1.f / 96) + EPSV);
        if (q < 12) {
#pragma unroll
          for (int e = 0; e < 8; ++e) v[e] *= rn * t.oscale * t.gain[q * 8 + e];
          *(u4*)(t.dst + (size_t)row * 768 + t.cb * 96 + q * 8) = pack8(v);
        }
      } break;
      case EP_RES: {
        const float* xs = t.xsrc + (size_t)row * 1024 + t.cb * 128 + q * 8;
        const f4 a = *(const f4*)xs, b = *(const f4*)(xs + 4);
        v[0] += a.x; v[1] += a.y; v[2] += a.z; v[3] += a.w; v[4] += b.x; v[5] += b.y; v[6] += b.z; v[7] += b.w;
        float ss = 0.f;
#pragma unroll
        for (int e = 0; e < 8; ++e) ss += v[e] * v[e];
        ss += __shfl_xor(ss, 1); ss += __shfl_xor(ss, 2); ss += __shfl_xor(ss, 4); ss += __shfl_xor(ss, 8);
        float* xo = p.out + (size_t)row * 1024 + t.cb * 128 + q * 8;
        *(f4*)xo = f4{v[0], v[1], v[2], v[3]};
        *(f4*)(xo + 4) = f4{v[4], v[5], v[6], v[7]};
        *(u4*)(t.dst + (size_t)row * 1024 + t.cb * 128 + q * 8) = pack8(v);
        if (q == 0) t.ssq_out[row] = ss;
      } break;
      case EP_MLP1: {
#pragma unroll
        for (int e = 0; e < 8; ++e) { const float u = fmaxf(v[e], 0.f); v[e] = u * u; }
        *(u4*)(t.dst + (size_t)row * t.ldd + t.cb * 128 + q * 8) = pack8(v);
      } break;
      default: break;
    }
  }
  if (t.epi == EP_KVB) {
    bf16_t* VMT = (bf16_t*)(p.ws + OFF_VMT);
    const int c = tid >> 3, r8 = tid & 7;
    const int b = t.row0 >> 11, s0 = t.row0 & 2047;
    bf16_t* d = VMT + ((size_t)(b * 512 + t.cb * 64 + c)) * SEQ + s0 + r8 * 32;
#pragma unroll
    for (int j = 0; j < 4; ++j) {
      float v[8];
#pragma unroll
      for (int e = 0; e < 8; ++e) { const int r = r8 * 32 + j * 8 + e; v[e] = Cs[r * CS_LD + 64 + c] * rs[r]; }
      bf16_t* d16 = d + (j >> 1) * 16;
      u2 lo, hi; lo.x = pack2(v[0], v[1]); lo.y = pack2(v[2], v[3]); hi.x = pack2(v[4], v[5]); hi.y = pack2(v[6], v[7]);
      *(u2*)(d16 + ((j & 1) ? 4 : 0)) = lo;
      *(u2*)(d16 + ((j & 1) ? 12 : 8)) = hi;
    }
  }
}

__global__ void __launch_bounds__(NTHR) mega_fwd(Params p) {
  __shared__ __attribute__((aligned(16))) char smem[LDS_BYTES];
  cg::grid_group grid = cg::this_grid();
  const int G = gridDim.x, bid = blockIdx.x;
  for (int ph = p.ph_lo; ph < p.ph_hi; ++ph) {
      char* ws = p.ws; asm volatile("" : "+s"(ws));
    bf16_t* XB = (bf16_t*)(ws + OFF_XB);   bf16_t* QD = (bf16_t*)(ws + OFF_QD);   bf16_t* KD = (bf16_t*)(ws + OFF_KD);
    bf16_t* VDT = (bf16_t*)(ws + OFF_VDT); bf16_t* CQ = (bf16_t*)(ws + OFF_CQ);   bf16_t* CKV = (bf16_t*)(ws + OFF_CKV);
    bf16_t* XQ = (bf16_t*)(ws + OFF_XQ);   bf16_t* QM = (bf16_t*)(ws + OFF_QM);   bf16_t* KM = (bf16_t*)(ws + OFF_KM);
    bf16_t* VMT = (bf16_t*)(ws + OFF_VMT); bf16_t* MEMB = (bf16_t*)(ws + OFF_MEMB); bf16_t* KC = (bf16_t*)(ws + OFF_KC);
    bf16_t* VCT = (bf16_t*)(ws + OFF_VCT); bf16_t* W = (bf16_t*)(ws + OFF_W);     bf16_t* U = (bf16_t*)(ws + OFF_U);
    bf16_t* MERGED = KD;
    float* SSQX = (float*)(ws + OFF_SSQX); float* SSQCQ = (float*)(ws + OFF_SSQCQ); float* SSQCKV = (float*)(ws + OFF_SSQCKV);
    float* SSQMEM = (float*)(ws + OFF_SSQMEM);

    if (ph == 0) {
      phase_init(p);
      prep_range(p, 0, 0, 5152, smem);
    } else {
      const int l = (ph - 1) / p.per, kr = (ph - 1) % p.per;
      const int k = (kr > p.dupk) ? kr - (p.per - 7) : kr;
#ifndef NO_GEMM
      if (k == 0 || k == 1 || k == 4 || k == 5 || k == 6) {
        int nits = 0, total = 0;
        if (k == 0) { nits = 18; total = 4480; if (l > 0) prep_range(p, l, 4128, 5152, smem); }
        else if (k == 1) { nits = 8; total = 2048; }
        else if (k == 4) { nits = 4; total = 1024; }
        else if (k == 5) { nits = 16; total = 4096; if (l + 1 < NL) prep_range(p, l + 1, 0, 3104, smem); }
        else { nits = 4; total = 1024; if (l + 1 < NL) prep_range(p, l + 1, 3104, 4128, smem); }
        const bool xmap = (G == 256);
        if (!xmap) nits = (total + G - 1) / G;
#pragma unroll 1
        for (int it = 0; it < nits; ++it) {
          int list = 0, rb = -1, CB = 0;
          if (xmap) {
            if (k == 0) {
              if (it < 16) map_regular(it, bid, 16, rb, CB);
              else if (it == 16) { rb = bid; CB = 16; }
              else if (bid < 128) { list = 1; rb = bid >> 2; CB = bid & 3; }
            } else if (k == 1) { list = it >> 2; map_regular(it & 3, bid, 4, rb, CB); }
            else if (k == 5) map_regular(it, bid, 16, rb, CB);
            else map_regular(it, bid, 4, rb, CB);
          } else {
            const int li = it * G + bid;
            if (li < total) {
              if (k == 0) { if (li < 4352) { rb = li / 17; CB = li % 17; } else { list = 1; rb = (li - 4352) >> 2; CB = (li - 4352) & 3; } }
              else if (k == 1) { list = li >> 10; rb = (li & 1023) >> 2; CB = li & 3; }
              else if (k == 5) { rb = li >> 4; CB = li & 15; }
              else { rb = li >> 2; CB = li & 3; }
            }
          }
          if (rb < 0) continue;
          const int row0 = rb * 256;
          const bf16_t* Ap; const bf16_t* Bp; int lda, Kd;
          const float* ssq = nullptr; int nparts = 0, pstride = T; float invK = 0.f;
          if (k == 0) {
            if (list == 0) { Ap = XB + (size_t)row0 * 1024; lda = 1024; Bp = W + W_IN + (size_t)CB * 256 * 1024; Kd = 1024; ssq = SSQX; nparts = 8; invK = 1.f / 1024; }
            else           { Ap = MEMB + (size_t)row0 * 1024; lda = 1024; Bp = W + W_MEM + (size_t)CB * 256 * 1024; Kd = 1024; ssq = SSQMEM; nparts = 1; pstride = 0; invK = 1.f / 1024; }
          } else if (k == 1) {
            if (list == 0) { Ap = CQ + (size_t)row0 * 384; lda = 384; Bp = W + W_QB + (size_t)CB * 256 * 384; Kd = 384; ssq = SSQCQ; nparts = 3; invK = 1.f / 384; }
            else           { Ap = CKV + (size_t)row0 * 256; lda = 256; Bp = W + W_KVB + (size_t)CB * 256 * 256; Kd = 256; ssq = SSQCKV; nparts = 2; invK = 1.f / 256; }
          } else if (k == 4) { Ap = MERGED + (size_t)row0 * 1024; lda = 1024; Bp = W + W_OUT + (size_t)CB * 256 * 1024; Kd = 1024; }
          else if (k == 5)   { Ap = XB + (size_t)row0 * 1024; lda = 1024; Bp = W + W_1 + (size_t)CB * 256 * 1024; Kd = 1024; ssq = SSQX; nparts = 8; invK = 1.f / 1024; }
          else               { Ap = U + (size_t)row0 * 4096; lda = 4096; Bp = W + W_2 + (size_t)CB * 256 * 4096; Kd = 4096; }
          f32x16 acc[4][2];
          gemm_mainloop<4, 2, 4, true>(Ap, lda, Bp, Kd, Kd, acc, smem);
          float* Cs = (float*)smem;
#pragma unroll 1
          for (int half = 0; half < 2; ++half) {
            if (half) __syncthreads();
            {
              const int tq = ltid(); const int lane = tq & 63, wave = tq >> 6, wm = wave >> 2, wn = wave & 3, h = lane >> 5;
              if ((wn >> 1) == half) {
#pragma unroll
                for (int mi = 0; mi < 4; ++mi)
#pragma unroll
                  for (int ni = 0; ni < 2; ++ni)
#pragma unroll
                    for (int i = 0; i < 16; ++i)
                      Cs[(wm * 128 + mi * 32 + crow(i, h)) * CS_LD + (wn & 1) * 64 + ni * 32 + (lane & 31)] = acc[mi][ni][i];
              }
            }
            if (half == 0) fill_rs((float*)(smem + RS_OFF), ssq, nparts, pstride, row0, invK);
            __syncthreads();
            const int cb = CB * 2 + half;
            Tile t;
            t.row0 = row0; t.cb = cb; t.epi = EP_PLAIN;
            t.dst = nullptr; t.ldd = 0; t.gain = nullptr; t.ssq_out = nullptr; t.xsrc = nullptr; t.oscale = 1.f;
            if (k == 0) {
              if (list == 0) {
                if (cb < 8)       { t.epi = EP_HEADROT; t.cb = cb; t.dst = QD; t.ldd = 1024; t.gain = p.in[6] + l * 64; t.oscale = 0.125f * 1.4426950408889634f; }
                else if (cb < 16) { t.epi = EP_HEADROT; t.cb = cb - 8; t.dst = KD; t.ldd = 1024; t.gain = p.in[7] + l * 64; }
                else if (cb < 24) { t.epi = EP_VT; t.cb = cb - 16; const int b = row0 >> 11, s0 = row0 & 2047; t.dst = VDT + ((size_t)(b * 1024 + (cb - 16) * 128)) * SEQ + s0; t.ldd = SEQ; }
                else if (cb < 27) { t.epi = EP_PLAIN; t.cb = cb - 24; t.dst = CQ; t.ldd = 384; t.ssq_out = SSQCQ + (size_t)(cb - 24) * T; }
                else if (cb < 29) { t.epi = EP_PLAIN; t.cb = cb - 27; t.dst = CKV; t.ldd = 256; t.ssq_out = SSQCKV + (size_t)(cb - 27) * T; }
                else if (cb == 29) { t.epi = EP_KROPE; t.cb = 0; }
                else              { t.epi = EP_NORM128; t.cb = cb - 30; t.dst = XQ; t.ldd = 512; t.gain = p.in[20] + l * 128; t.oscale = 0.08838834764831845f * 1.4426950408889634f; }
              } else {
                if (cb < 4) { t.epi = EP_NORM128; t.cb = cb; t.dst = KC; t.ldd = 512; t.gain = p.in[21] + l * 128; }
                else        { t.epi = EP_VT; t.cb = cb - 4; t.dst = VCT + ((size_t)(rb * 512 + (cb - 4) * 128)) * MEML; t.ldd = MEML; }
              }
            } else if (k == 1) {
              if (list == 0) { t.epi = EP_QB; t.dst = QM; t.gain = p.in[15] + l * 96; t.oscale = 0.10206207261596575f * 1.4426950408889634f; }
              else           { t.epi = EP_KVB; t.dst = KM; t.gain = p.in[16] + l * 96; }
            } else if (k == 4) { t.epi = EP_RES; t.dst = XB; t.xsrc = (l == 0) ? p.in[0] : p.out; t.ssq_out = SSQX + (size_t)cb * T; }
            else if (k == 5)   { t.epi = EP_MLP1; t.dst = U; t.ldd = 4096; }
            else               { t.epi = EP_RES; t.dst = XB; t.xsrc = p.out; t.ssq_out = SSQX + (size_t)cb * T; }
            run_epilogue(p, t, smem);
          }
        }
      } else
#endif
#ifndef NO_ATT
      if (k == 2) {
        float lam;
        const float lam_init = 0.8f - 0.6f * expf(-0.3f * (float)l);
        {
          const int lane = ltid() & 63;
          const float* lv = p.in[8] + l * 256;
          float sa = lv[lane] * lv[64 + lane], sb = lv[128 + lane] * lv[192 + lane];
#pragma unroll
          for (int m = 32; m >= 1; m >>= 1) { sa += __shfl_xor(sa, m); sb += __shfl_xor(sb, m); }
          lam = expf(sa) - expf(sb) + lam_init;
        }
        const float L2E = 1.4426950408889634f;
#pragma unroll 1
        for (int it = 0; it < ((G == 256) ? 16 : (4096 + G - 1) / G); ++it) {
          int w;
          if (G == 256) {
            const int xcd = bid & 7, slot = bid >> 3;
            if (it < 8)       w = ((it * 32 + (slot >> 3) * 8 + xcd) << 3) + (slot & 7);
            else if (it < 12) w = 2048 + ((((it - 8) * 64 + (slot >> 2) * 8 + xcd) << 2) + (slot & 3));
            else              w = 3072 + ((((it - 12) * 32 + (slot >> 3) * 8 + xcd) << 3) + (slot & 7));
          } else { w = it * G + bid; if (w >= 4096) continue; }
#ifndef NO_A1
          if (w < 2048) {
            const int bh = w >> 3, j = w & 7, b = bh >> 3, hh = bh & 7;
#pragma unroll 1
            for (int half = 0; half < 2; ++half) {
              const int qb = half ? j : 15 - j;
              const int q0 = qb * 128;
              bf16_t* Qp = QD + ((size_t)(b * SEQ + q0)) * 1024 + hh * 128;
              attn_block<64, 128, 2, true>(Qp, 1024, KD + (size_t)b * SEQ * 1024 + hh * 128, 1024, VDT + ((size_t)(b * 1024 + hh * 128)) * SEQ, SEQ,
                                            (q0 + 128) >> 6, q0, Qp, 1024, 0.125f * L2E, lam, p.in[9] + l * 128, 1.f - lam_init, smem);
            }
          } else
#endif
#ifndef NO_A2
          if (w < 3072) {
            const int wj = w - 2048; const int bh = wj >> 2, j = wj & 3, b = bh >> 3, hh = bh & 7;
#pragma unroll 1
            for (int half = 0; half < 2; ++half) {
              const int qb = half ? j : 7 - j;
              const int q0 = qb * 256;
              bf16_t* Qp = QM + ((size_t)(b * SEQ + q0)) * 768 + hh * 96;
              attn_block<96, 64, 1, true>(Qp, 768, KM + (size_t)b * SEQ * 768 + hh * 96, 768, VMT + ((size_t)(b * 512 + hh * 64)) * SEQ, SEQ,
                                           (q0 + 256) >> 6, q0, Qp, 768, 0.10206207261596575f * L2E, 0.f, nullptr, 1.f, smem);
            }
          } else
#endif
#ifndef NO_A3
          {
            const int wj = w - 3072; const int bh = wj >> 3, qb = wj & 7, b = bh >> 2, hh = bh & 3;
            const int q0 = qb * 256;
            bf16_t* Qp = XQ + ((size_t)(b * SEQ + q0)) * 512 + hh * 128;
            attn_block<128, 128, 1, false>(Qp, 512, KC + (size_t)b * MEML * 512 + hh * 128, 512, VCT + ((size_t)(b * 512 + hh * 128)) * MEML, MEML,
                                            4, q0, Qp, 512, 0.08838834764831845f * L2E, 0.f, nullptr, 1.f, smem);
          }
#endif
          {}
        }
      } else
#endif
#ifndef NO_D
      if (k == 3) {
        float* Cs = (float*)smem;
        float* rs = (float*)(smem + RS_OFF);
#pragma unroll 1
        for (int it = 0; it < ((G == 256) ? 8 : (2048 + G - 1) / G); ++it) {
          int rb, cb;
          if (G == 256) map_regular(it, bid, 8, rb, cb);
          else { const int li = it * G + bid; if (li >= 2048) continue; rb = li >> 3; cb = li & 7; }
          const int tidd = ltid(); const int lane = tidd & 63, wave = tidd >> 6, wm = wave >> 1, wn = wave & 1, h = lane >> 5;
          const int row0 = rb * 256, col0 = cb * 128;
          __syncthreads();
          fill_rs(rs, SSQX, 8, T, row0, 1.f / 1024);
          f32x16 acc[2][2];
          unsigned gp[2][2][8], mp[2][2][8];
#pragma unroll
          for (int mi = 0; mi < 2; ++mi)
#pragma unroll
            for (int ni = 0; ni < 2; ++ni)
#pragma unroll
              for (int i = 0; i < 8; ++i) mp[mi][ni][i] = 0u;
#pragma unroll 1
          for (int st = 0; st < 6; ++st) {
            const int br = st >> 1, half = st & 1;
            const bf16_t* Ab; const bf16_t* Bb; int Kb;
            if (half == 0)    { Ab = XB + (size_t)row0 * 1024; Bb = W + W_IN + (size_t)(WIN_GATE0 + br * 1024 + col0) * 1024; Kb = 1024; }
            else if (br == 0) { Ab = QD + (size_t)row0 * 1024; Bb = W + W_DO + (size_t)col0 * 1024; Kb = 1024; }
            else if (br == 1) { Ab = QM + (size_t)row0 * 768;  Bb = W + W_MO + (size_t)col0 * 768;  Kb = 768; }
            else              { Ab = XQ + (size_t)row0 * 512;  Bb = W + W_CO + (size_t)col0 * 512;  Kb = 512; }
            gemm_mainloop<2, 2, 2, false>(Ab, Kb, Bb, Kb, Kb, acc, smem);
            if (half == 0) {
              const float* bg = p.in[5] + (size_t)l * 3072 + br * 1024 + col0 + wn * 64 + (lane & 31);
              const float bgv0 = bg[0], bgv1 = bg[32];
#pragma unroll
              for (int mi = 0; mi < 2; ++mi) {
                float rsv[16];
#pragma unroll
                for (int i = 0; i < 16; ++i) rsv[i] = rs[wm * 64 + mi * 32 + crow(i, h)];
#pragma unroll
                for (int ni = 0; ni < 2; ++ni) {
                  const float bgv = ni ? bgv1 : bgv0;
#pragma unroll
                  for (int i = 0; i < 16; i += 2) {
                    const float z0 = acc[mi][ni][i] * rsv[i] + bgv;
                    const float z1 = acc[mi][ni][i + 1] * rsv[i + 1] + bgv;
                    gp[mi][ni][i >> 1] = pack2(1.f / (1.f + __expf(-z0)), 1.f / (1.f + __expf(-z1)));
                  }
                }
                __builtin_amdgcn_sched_barrier(0);
              }
            } else {
#pragma unroll
              for (int mi = 0; mi < 2; ++mi)
#pragma unroll
                for (int ni = 0; ni < 2; ++ni)
#pragma unroll
                  for (int i = 0; i < 16; i += 2) {
                    const unsigned g2 = gp[mi][ni][i >> 1], m2 = mp[mi][ni][i >> 1];
                    const float m0 = __uint_as_float(m2 << 16) + __uint_as_float(g2 << 16) * acc[mi][ni][i];
                    const float m1 = __uint_as_float(m2 & 0xffff0000u) + __uint_as_float(g2 & 0xffff0000u) * acc[mi][ni][i + 1];
                    mp[mi][ni][i >> 1] = pack2(m0, m1);
                  }
            }
          }
#pragma unroll
          for (int mi = 0; mi < 2; ++mi)
#pragma unroll
            for (int ni = 0; ni < 2; ++ni)
#pragma unroll
              for (int i = 0; i < 16; ++i) {
                const unsigned m2 = mp[mi][ni][i >> 1];
                Cs[(wm * 64 + mi * 32 + crow(i, h)) * CS_LD + wn * 64 + ni * 32 + (lane & 31)] = __uint_as_float((i & 1) ? (m2 & 0xffff0000u) : (m2 << 16));
              }
          __syncthreads();
          const int q = tidd & 15, rsub = tidd >> 4;
#pragma unroll 1
          for (int pass = 0; pass < 8; ++pass) {
            const int r = rsub + 32 * pass;
            float v[8];
            load8(Cs, r, q, v);
            *(u4*)(MERGED + (size_t)(row0 + r) * 1024 + col0 + q * 8) = pack8(v);
          }
        }
      }
#endif
      {}
    }
    if (ph + 1 < p.ph_hi) grid.sync();
  }
}

extern "C" void kernel_launch(void* const* d_in, const int* in_sizes, int n_in, void* d_out, int out_size, void* d_ws, size_t ws_size, hipStream_t stream) {
  static int grid_blocks = 0;
  if (grid_blocks == 0) {
    if (n_in != 27 || ws_size < WS_NEED) { fprintf(stderr, "kernel_launch: unexpected inputs (n_in %d) or workspace (%zu < %zu)\n", n_in, ws_size, (size_t)WS_NEED); grid_blocks = -1; return; }
    int dev = 0, cus = 0, per_cu = 0;
    hipGetDevice(&dev);
    hipDeviceGetAttribute(&cus, hipDeviceAttributeMultiprocessorCount, dev);
    hipOccupancyMaxActiveBlocksPerMultiprocessor(&per_cu, mega_fwd, NTHR, 0);
    if (per_cu < 1) per_cu = 1;
    if (per_cu > 1) per_cu = 1;
    grid_blocks = cus * per_cu;
  }
  if (grid_blocks < 0) return;
  Params p{};
  for (int i = 0; i < 27; ++i) p.in[i] = (const float*)d_in[i];
  p.out = (float*)d_out;
  p.ws = (char*)d_ws;
  p.ph_lo = 0;
  p.dupk = (DUP_K >= 0) ? DUP_K : 100;
  p.per = (DUP_K >= 0) ? 8 : 7;
  p.ph_hi = 1 + NL * p.per;
  void* args[] = {&p};
  hipError_t e = hipLaunchCooperativeKernel((void*)mega_fwd, dim3(grid_blocks), dim3(NTHR), args, 0, stream);
  if (e != hipSuccess) fprintf(stderr, "cooperative launch failed: %s (grid %d)\n", hipGetErrorString(e), grid_blocks);
}
```

```cpp
#include <hip/hip_runtime.h>
#include <hip/hip_cooperative_groups.h>
#include <stdint.h>
#include <stdio.h>
namespace cg = cooperative_groups;

typedef unsigned short bf16_t;
using bf16x8 = __attribute__((ext_vector_type(8))) short;
using f32x16 = __attribute__((ext_vector_type(16))) float;
typedef unsigned u4 __attribute__((ext_vector_type(4)));
typedef unsigned u2 __attribute__((ext_vector_type(2)));
typedef float f4 __attribute__((ext_vector_type(4)));
#define DI __device__ __forceinline__
#define MFMA(a, b, c) __builtin_amdgcn_mfma_f32_32x32x16_bf16((a), (b), (c), 0, 0, 0)

constexpr int T = 65536, DM = 1024, NB = 32, SEQ = 2048, NL = 4, MEML = 256, MEMR = NB * MEML;
constexpr int NTHR = 512;
constexpr int DUP_K = -1;
constexpr float EPSV = 1e-6f;
constexpr int WIN_N = 7424;
constexpr int WIN_GATE0 = 4352;

constexpr size_t MiB = 1024ull * 1024ull;
constexpr size_t OFF_XB = 0;
constexpr size_t OFF_QD = OFF_XB + 128 * MiB;
constexpr size_t OFF_KD = OFF_QD + 128 * MiB;
constexpr size_t OFF_VDT = OFF_KD + 128 * MiB;
constexpr size_t OFF_CQ = OFF_VDT + 128 * MiB;
constexpr size_t OFF_CKV = OFF_CQ + 48 * MiB;
constexpr size_t OFF_KR = OFF_CKV + 32 * MiB;
constexpr size_t OFF_XQ = OFF_KR + 8 * MiB;
constexpr size_t OFF_QM = OFF_XQ + 64 * MiB;
constexpr size_t OFF_KM = OFF_QM + 96 * MiB;
constexpr size_t OFF_VMT = OFF_KM + 96 * MiB;
constexpr size_t OFF_MEMB = OFF_VMT + 64 * MiB;
constexpr size_t OFF_KC = OFF_MEMB + 16 * MiB;
constexpr size_t OFF_VCT = OFF_KC + 8 * MiB;
constexpr size_t OFF_SSQX = OFF_VCT + 8 * MiB;
constexpr size_t OFF_SSQCQ = OFF_SSQX + 2 * MiB;
constexpr size_t OFF_SSQCKV = OFF_SSQCQ + 1 * MiB;
constexpr size_t OFF_SSQMEM = OFF_SSQCKV + 1 * MiB;
constexpr size_t OFF_W = OFF_SSQMEM + 1 * MiB;
constexpr size_t OFF_U = OFF_QD;
constexpr size_t W_IN = 0;
constexpr size_t W_MEM = W_IN + (size_t)WIN_N * 1024;
constexpr size_t W_QB = W_MEM + 1024 * 1024;
constexpr size_t W_KVB = W_QB + 1024 * 384;
constexpr size_t W_DO = W_KVB + 1024 * 256;
constexpr size_t W_MO = W_DO + 1024 * 1024;
constexpr size_t W_CO = W_MO + 1024 * 768;
constexpr size_t W_OUT = W_CO + 1024 * 512;
constexpr size_t W_1 = W_OUT + 1024 * 1024;
constexpr size_t W_2 = W_1 + 4096 * 1024;
constexpr size_t W_END = W_2 + 4096 * 1024;
constexpr size_t WS_NEED = OFF_W + W_END * 2;

constexpr int LDS_ROW = 144;
constexpr int CS_LD = 132;
constexpr int CS_BYTES = 256 * CS_LD * 4;
constexpr int RS_OFF = 2 * 512 * LDS_ROW;
constexpr int LDS_BYTES = RS_OFF + 1024;

__constant__ float INVF64[32] = {1.000000000e+00f,7.498942614e-01f,5.623413324e-01f,4.216965139e-01f,3.162277639e-01f,2.371373773e-01f,1.778279394e-01f,1.333521307e-01f,1.000000015e-01f,7.498941571e-02f,5.623413250e-02f,4.216965288e-02f,3.162277490e-02f,2.371373773e-02f,1.778279431e-02f,1.333521493e-02f,9.999999776e-03f,7.498941850e-03f,5.623413250e-03f,4.216964822e-03f,3.162277630e-03f,2.371373586e-03f,1.778279431e-03f,1.333521446e-03f,1.000000047e-03f,7.498942432e-04f,5.623413017e-04f,4.216965172e-04f,3.162277571e-04f,2.371373703e-04f,1.778279402e-04f,1.333521504e-04f};
__constant__ float INVF32[16] = {1.000000000e+00f,5.623413324e-01f,3.162277639e-01f,1.778279394e-01f,1.000000015e-01f,5.623413250e-02f,3.162277490e-02f,1.778279431e-02f,9.999999776e-03f,5.623413250e-03f,3.162277630e-03f,1.778279431e-03f,1.000000047e-03f,5.623413017e-04f,3.162277571e-04f,1.778279402e-04f};

struct Params {
  const float* in[27];
  float* out;
  char* ws;
  int ph_lo, ph_hi;
  int dupk, per;
};

typedef __bf16 bf2_t __attribute__((ext_vector_type(2)));
typedef float fl2_t __attribute__((ext_vector_type(2)));
DI unsigned pack2(float a, float b) { fl2_t f = {a, b}; bf2_t r = __builtin_convertvector(f, bf2_t); return __builtin_bit_cast(unsigned, r); }
DI u4 pack8(const float* v) { u4 u; u.x = pack2(v[0], v[1]); u.y = pack2(v[2], v[3]); u.z = pack2(v[4], v[5]); u.w = pack2(v[6], v[7]); return u; }
DI int ltid() { int t = threadIdx.x; asm volatile("" : "+v"(t)); return t; }
DI int crow(int i, int h) { return (i & 3) + 8 * (i >> 2) + 4 * h; }
DI void rot_cs(int pos, float invf, float& c, float& s) {
  const float ang = (float)pos * invf;
  double rev = (double)ang * 0.15915494309189535;
  rev -= floor(rev);
  const float rf = (float)rev;
  c = __builtin_amdgcn_cosf(rf);
  s = __builtin_amdgcn_sinf(rf);
}
DI void load8(const float* Cs, int r, int q, float* v) {
  const f4 a = *(const f4*)(Cs + r * CS_LD + q * 8);
  const f4 b = *(const f4*)(Cs + r * CS_LD + q * 8 + 4);
  v[0] = a.x; v[1] = a.y; v[2] = a.z; v[3] = a.w; v[4] = b.x; v[5] = b.y; v[6] = b.z; v[7] = b.w;
}

template <int MI, int NI, int WGN, bool FDB>
DI void gemm_mainloop(const bf16_t* __restrict__ A, int lda, const bf16_t* __restrict__ B, int ldb, int K, f32x16 (&acc)[MI][NI], char* smem) {
  constexpr int BM = (8 / WGN) * MI * 32, BN = WGN * NI * 32;
  constexpr int ASZ = BM * 64, STAGE = (BM + BN) * 64;
  constexpr int NGA = BM / 128, NGB = BN / 128, NLD = NGA + NGB;
  static_assert(4 * STAGE <= RS_OFF, "ring");
  const int tid = ltid(), lane = tid & 63, wave = tid >> 6, l31 = lane & 31, h = lane >> 5;
  const int wu = __builtin_amdgcn_readfirstlane(wave);
  const int wm = wave / WGN, wn = wave % WGN;
  const int lrow = lane >> 2, lchk = (lane & 3) ^ ((lane >> 4) & 3);
  const bf16_t* ga = A + (size_t)(wu * NGA * 16 + lrow) * lda + lchk * 8;
  const bf16_t* gb = B + (size_t)(wu * NGB * 16 + lrow) * ldb + lchk * 8;
#pragma unroll
  for (int mi = 0; mi < MI; ++mi)
#pragma unroll
    for (int ni = 0; ni < NI; ++ni)
#pragma unroll
      for (int i = 0; i < 16; ++i) acc[mi][ni][i] = 0.f;
  auto issue = [&](int j) {
    char* st = smem + (j & 3) * STAGE;
    const int k0 = j * 32;
#pragma unroll
    for (int i = 0; i < NGA; ++i)
      __builtin_amdgcn_global_load_lds((const unsigned*)(ga + (size_t)(i * 16) * lda + k0), (unsigned*)(st + (wu * NGA + i) * 1024), 16, 0, 0);
#pragma unroll
    for (int i = 0; i < NGB; ++i)
      __builtin_amdgcn_global_load_lds((const unsigned*)(gb + (size_t)(i * 16) * ldb + k0), (unsigned*)(st + ASZ + (wu * NGB + i) * 1024), 16, 0, 0);
  };
  asm volatile("s_waitcnt vmcnt(0)" ::: "memory");
  __syncthreads();
  const int nk = K >> 5;
  issue(0); issue(1); issue(2);
  const int sw = (l31 >> 2) & 3;
  const int oa = (wm * MI * 32 + l31) * 64, ob = ASZ + (wn * NI * 32 + l31) * 64;
  const int c0 = ((0 + h) ^ sw) * 16, c1 = ((2 + h) ^ sw) * 16;
#pragma unroll 1
  for (int j = 0; j < nk; ++j) {
    if (j + 2 < nk) asm volatile("s_waitcnt vmcnt(%0)" ::"n"(2 * NLD) : "memory");
    else if (j + 1 < nk) asm volatile("s_waitcnt vmcnt(%0)" ::"n"(NLD) : "memory");
    else asm volatile("s_waitcnt vmcnt(0)" ::: "memory");
    asm volatile("s_waitcnt lgkmcnt(0)" ::: "memory");
    __builtin_amdgcn_s_barrier();
    if (j + 3 < nk) issue(j + 3);
    const char* st = smem + (j & 3) * STAGE;
    const char* pa = st + oa;
    const char* pb = st + ob;
    bf16x8 fa0[MI], fb0[NI], fa1[MI], fb1[NI];
#pragma unroll
    for (int mi = 0; mi < MI; ++mi) fa0[mi] = *(const bf16x8*)(pa + mi * 2048 + c0);
#pragma unroll
    for (int ni = 0; ni < NI; ++ni) fb0[ni] = *(const bf16x8*)(pb + ni * 2048 + c0);
    if (FDB) {
#pragma unroll
      for (int mi = 0; mi < MI; ++mi) fa1[mi] = *(const bf16x8*)(pa + mi * 2048 + c1);
#pragma unroll
      for (int ni = 0; ni < NI; ++ni) fb1[ni] = *(const bf16x8*)(pb + ni * 2048 + c1);
    }
#pragma unroll
    for (int mi = 0; mi < MI; ++mi)
#pragma unroll
      for (int ni = 0; ni < NI; ++ni) acc[mi][ni] = MFMA(fa0[mi], fb0[ni], acc[mi][ni]);
    __builtin_amdgcn_sched_barrier(0);
    if (!FDB) {
#pragma unroll
      for (int mi = 0; mi < MI; ++mi) fa1[mi] = *(const bf16x8*)(pa + mi * 2048 + c1);
#pragma unroll
      for (int ni = 0; ni < NI; ++ni) fb1[ni] = *(const bf16x8*)(pb + ni * 2048 + c1);
    }
#pragma unroll
    for (int mi = 0; mi < MI; ++mi)
#pragma unroll
      for (int ni = 0; ni < NI; ++ni) acc[mi][ni] = MFMA(fa1[mi], fb1[ni], acc[mi][ni]);
    __builtin_amdgcn_sched_barrier(0);
  }
  asm volatile("s_waitcnt lgkmcnt(0)" ::: "memory");
  __builtin_amdgcn_s_barrier();
}

DI void fill_rs(float* rs, const float* ssq, int nparts, int pstride, int row0, float invK) {
  const int t = ltid();
  if (t < 256) {
    float r = 1.f;
    if (ssq) {
      float s = 0.f;
      for (int p = 0; p < nparts; ++p) s += ssq[(size_t)p * pstride + row0 + t];
      r = rsqrtf(s * invK + EPSV);
    }
    rs[t] = r;
  }
}

enum { EP_HEADROT = 0, EP_VT, EP_PLAIN, EP_KROPE, EP_NORM128, EP_QB, EP_KVB, EP_RES, EP_MLP1 };

struct Tile {
  int epi, row0, cb;
  bf16_t* dst; int ldd;
  const float* gain;
  float* ssq_out;
  const float* xsrc;
  float oscale;
};

DI void map_regular(int it, int bid, int NCB, int& rb, int& CB) {
  const int xcd = bid & 7, slot = bid >> 3;
  const int c = xcd * NCB + it;
  const int cgrp = c >> 5, rgrp = c & 31;
  rb = rgrp * 8 + (slot >> 2);
  CB = cgrp * 4 + (slot & 3);
}

template <int DK, int DV, int NM, bool CAUSAL>
DI void attn_block(const bf16_t* __restrict__ Q, int ldq, const bf16_t* __restrict__ Kg, int ldk, const bf16_t* __restrict__ Vt, int ldv,
                   int nkt, int q0, bf16_t* O, int ldo, float sc, float lam, const float* og, float omul, char* smem) {
  constexpr int KW = NM * DK, KCHV = KW / 8;
  constexpr int KBYTES = 64 * 256, VBYTES = DV * 128, STAGE = KBYTES + VBYTES;
  constexpr int NVI = DV / 64;
  constexpr int NLD = 2 + NVI;
  static_assert(KCHV <= 16 && 4 * STAGE <= RS_OFF, "lds");
  constexpr int NKC16 = DK / 16, NDVB = DV / 32;
  const int tid = ltid(), lane = tid & 63, wave = tid >> 6, h = lane >> 5, l31 = lane & 31;
  const int wq = (NM == 2) ? (wave & 3) : wave;
  const int mymap = (NM == 2) ? (wave >> 2) : 0;
  const int q0w = q0 + wq * 32;

  bf16x8 qf[NKC16];
  {
    const bf16_t* qp = Q + (size_t)(wq * 32 + l31) * ldq + mymap * DK + h * 8;
#pragma unroll
    for (int kc = 0; kc < NKC16; ++kc) qf[kc] = *(const bf16x8*)(qp + kc * 16);
#pragma unroll
    for (int kc = 0; kc < NKC16; ++kc) asm volatile("" : "+v"(qf[kc]));
  }
  f32x16 o[NDVB];
#pragma unroll
  for (int d = 0; d < NDVB; ++d)
#pragma unroll
    for (int i = 0; i < 16; ++i) o[d][i] = 0.f;
  f32x16 lacc;
#pragma unroll
  for (int i = 0; i < 16; ++i) lacc[i] = 0.f;
  u4 onesu; onesu.x = onesu.y = onesu.z = onesu.w = 0x3F803F80u;
  const bf16x8 ones = __builtin_bit_cast(bf16x8, onesu);

  const int wu = __builtin_amdgcn_readfirstlane(wave);
  const int krow = lane >> 4, kslot = lane & 15;
  const int vrow = lane >> 3, vslot = lane & 7;
  auto issue = [&](int kt) {
    char* st = smem + (kt & 3) * STAGE;
#pragma unroll
    for (int i = 0; i < 2; ++i) {
      const int r = (wu * 2 + i) * 4 + krow;
      const int c = kslot ^ (r & 15);
      if (KCHV == 16 || c < KCHV)
        __builtin_amdgcn_global_load_lds((const unsigned*)(Kg + (size_t)(kt * 64 + r) * ldk + c * 8), (unsigned*)(st + (wu * 2 + i) * 1024), 16, 0, 0);
    }
#pragma unroll
    for (int i = 0; i < NVI; ++i) {
      const int d = (wu * NVI + i) * 8 + vrow;
      const int c = vslot ^ ((d >> 1) & 7);
      __builtin_amdgcn_global_load_lds((const unsigned*)(Vt + (size_t)d * ldv + kt * 64 + c * 8), (unsigned*)(st + KBYTES + (wu * NVI + i) * 1024), 16, 0, 0);
    }
  };
  asm volatile("s_waitcnt vmcnt(0)" ::: "memory");
  __syncthreads();
  if (0 < nkt) issue(0);
  if (1 < nkt) issue(1);
  if (2 < nkt) issue(2);
  for (int kt = 0; kt < nkt; ++kt) {
    if (kt + 2 < nkt) asm volatile("s_waitcnt vmcnt(%0)" ::"n"(2 * NLD) : "memory");
    else if (kt + 1 < nkt) asm volatile("s_waitcnt vmcnt(%0)" ::"n"(NLD) : "memory");
    else asm volatile("s_waitcnt vmcnt(0)" ::: "memory");
    asm volatile("s_waitcnt lgkmcnt(0)" ::: "memory");
    __builtin_amdgcn_s_barrier();
    if (kt + 3 < nkt) issue(kt + 3);
    const bool skip = CAUSAL && (kt * 64 > q0w + 31);
    if (!skip) {
      const char* base = smem + (kt & 3) * STAGE;
      f32x16 s[2];
#pragma unroll
      for (int sb = 0; sb < 2; ++sb) {
#pragma unroll
        for (int i = 0; i < 16; ++i) s[sb][i] = 0.f;
        const char* pk = base + (sb * 32 + l31) * 256;
#pragma unroll
        for (int kc = 0; kc < NKC16; ++kc) {
          const bf16x8 a = *(const bf16x8*)(pk + (((mymap * (DK / 8) + kc * 2 + h) ^ (l31 & 15)) * 16));
          s[sb] = MFMA(a, qf[kc], s[sb]);
        }
        __builtin_amdgcn_sched_barrier(0);
      }
      const bool need_mask = CAUSAL && (kt * 64 + 63 > q0w);
#pragma unroll
      for (int sb = 0; sb < 2; ++sb)
#pragma unroll
        for (int i = 0; i < 16; ++i) {
          float pz = __builtin_amdgcn_exp2f(s[sb][i]);
          if (need_mask) {
            const int key = kt * 64 + sb * 32 + crow(i, h);
            if (key > q0w + l31) pz = 0.f;
          }
          s[sb][i] = pz;
        }
      const char* pv = base + KBYTES + l31 * 128;
      const int vsw = (l31 >> 1) & 7;
#pragma unroll
      for (int ks = 0; ks < 4; ++ks) {
        u4 pu;
        pu.x = pack2(s[ks >> 1][(ks & 1) * 8 + 0], s[ks >> 1][(ks & 1) * 8 + 1]);
        pu.y = pack2(s[ks >> 1][(ks & 1) * 8 + 2], s[ks >> 1][(ks & 1) * 8 + 3]);
        pu.z = pack2(s[ks >> 1][(ks & 1) * 8 + 4], s[ks >> 1][(ks & 1) * 8 + 5]);
        pu.w = pack2(s[ks >> 1][(ks & 1) * 8 + 6], s[ks >> 1][(ks & 1) * 8 + 7]);
        const bf16x8 pf = __builtin_bit_cast(bf16x8, pu);
        lacc = MFMA(ones, pf, lacc);
#pragma unroll
        for (int d = 0; d < NDVB; ++d) {
          const u4 au = *(const u4*)(pv + d * 32 * 128 + (((ks * 2 + h) ^ vsw) * 16));
          o[d] = MFMA(__builtin_bit_cast(bf16x8, au), pf, o[d]);
        }
        __builtin_amdgcn_sched_barrier(0);
      }
    }
  }
  asm volatile("s_waitcnt lgkmcnt(0)" ::: "memory");
  __builtin_amdgcn_s_barrier();
  const float l_tot = lacc[0];
  const float inv = 1.f / l_tot;
#pragma unroll
  for (int d = 0; d < NDVB; ++d)
#pragma unroll
    for (int i = 0; i < 16; ++i) o[d][i] *= inv;

  float rn_out = 1.f;
  if (NM == 2) {
    float* buf = (float*)smem;
    if (wave >= 4) {
#pragma unroll
      for (int d = 0; d < NDVB; ++d)
#pragma unroll
        for (int i = 0; i < 16; ++i) buf[(d * 16 + i) * 256 + (wave & 3) * 64 + lane] = o[d][i];
    }
    __syncthreads();
    if (wave < 4) {
      float ss = 0.f;
#pragma unroll
      for (int d = 0; d < NDVB; ++d) {
#pragma unroll
        for (int i = 0; i < 16; ++i) {
          const float v = o[d][i] - lam * buf[(d * 16 + i) * 256 + wave * 64 + lane];
          o[d][i] = v;
          ss += v * v;
        }
        __builtin_amdgcn_sched_barrier(0);
      }
      ss += __shfl_xor(ss, 32);
      rn_out = rsqrtf(ss * (1.f / DV) + EPSV) * omul;
    }
  }
  if (NM == 1 || wave < 4) {
    bf16_t* op = O + (size_t)(wq * 32 + l31) * ldo + 4 * h;
#pragma unroll
    for (int d = 0; d < NDVB; ++d)
#pragma unroll
      for (int g = 0; g < 4; ++g) {
        f4 gg = {1.f, 1.f, 1.f, 1.f};
        if (NM == 2) gg = *(const f4*)(og + d * 32 + 8 * g + 4 * h);
        u2 u;
        u.x = pack2(o[d][4 * g + 0] * rn_out * gg.x, o[d][4 * g + 1] * rn_out * gg.y);
        u.y = pack2(o[d][4 * g + 2] * rn_out * gg.z, o[d][4 * g + 3] * rn_out * gg.w);
        *(u2*)(op + d * 32 + 8 * g) = u;
      }
  }
}

DI void prep_tile(const float* __restrict__ src, int N, const float* __restrict__ gain, bf16_t* __restrict__ dst, int Kp, int nmode, int kmode, int kt, int nt, char* smem) {
  float* tile = (float*)smem;
  const int tid = ltid();
  __syncthreads();
  {
    const int n = tid & 63;
    const int np = nt * 64 + n;
    int ns = np; bool nv = true;
    if (nmode == 1) {
      if (np < 3712) ns = np;
      else if (np < 3840) { ns = np; nv = (np < 3744); }
      else if (np < 4352) ns = np - 96;
      else ns = np - 96;
    } else if (nmode == 2) {
      const int hh = np >> 7, j = np & 127;
      nv = j < 96; ns = hh * 96 + j;
    }
#pragma unroll
    for (int j = 0; j < 8; ++j) {
      const int kk = (tid >> 6) + 8 * j;
      const int kp = kt * 64 + kk;
      int ks = kp; bool kv = true;
      if (kmode == 1) { const int hh = kp / 96, jj = kp % 96; kv = jj < 64; ks = hh * 64 + jj; }
      float v = 0.f;
      if (nv && kv) { v = src[(size_t)ks * N + ns]; if (gain) v *= gain[ks]; }
      tile[n * 65 + kk] = v;
    }
  }
  __syncthreads();
  {
    const int n = tid >> 3, kc = tid & 7;
    float v[8];
#pragma unroll
    for (int e = 0; e < 8; ++e) v[e] = tile[n * 65 + kc * 8 + e];
    *(u4*)(dst + (size_t)(nt * 64 + n) * Kp + kt * 64 + kc * 8) = pack8(v);
  }
}

DI void prep_item(const Params& p, int l, int it, char* smem) {
  bf16_t* W = (bf16_t*)(p.ws + OFF_W);
  const float* src; const float* gain = nullptr; bf16_t* dst; int N, Kp, nmode = 0, kmode = 0, nkt, loc;
  if (it < 1856)      { loc = it;        src = p.in[4] + (size_t)l * 1024 * 7328; N = 7328; gain = p.in[3] + l * 1024; dst = W + W_IN; Kp = 1024; nmode = 1; nkt = 16; }
  else if (it < 2112) { loc = it - 1856; src = p.in[19] + (size_t)l * 1024 * 1024; N = 1024; gain = p.in[18] + l * 1024; dst = W + W_MEM; Kp = 1024; nkt = 16; }
  else if (it < 2208) { loc = it - 2112; src = p.in[12] + (size_t)l * 384 * 768; N = 768; gain = p.in[11] + l * 384; dst = W + W_QB; Kp = 384; nmode = 2; nkt = 6; }
  else if (it < 2272) { loc = it - 2208; src = p.in[14] + (size_t)l * 256 * 1024; N = 1024; gain = p.in[13] + l * 256; dst = W + W_KVB; Kp = 256; nkt = 4; }
  else if (it < 2528) { loc = it - 2272; src = p.in[10] + (size_t)l * 1024 * 1024; N = 1024; dst = W + W_DO; Kp = 1024; nkt = 16; }
  else if (it < 2720) { loc = it - 2528; src = p.in[17] + (size_t)l * 512 * 1024; N = 1024; dst = W + W_MO; Kp = 768; kmode = 1; nkt = 12; }
  else if (it < 2848) { loc = it - 2720; src = p.in[22] + (size_t)l * 512 * 1024; N = 1024; dst = W + W_CO; Kp = 512; nkt = 8; }
  else if (it < 3104) { loc = it - 2848; src = p.in[23] + (size_t)l * 1024 * 1024; N = 1024; dst = W + W_OUT; Kp = 1024; nkt = 16; }
  else if (it < 4128) { loc = it - 3104; src = p.in[25] + (size_t)l * 1024 * 4096; N = 4096; gain = p.in[24] + l * 1024; dst = W + W_1; Kp = 1024; nkt = 16; }
  else                { loc = it - 4128; src = p.in[26] + (size_t)l * 4096 * 1024; N = 1024; dst = W + W_2; Kp = 4096; nkt = 64; }
  prep_tile(src, N, gain, dst, Kp, nmode, kmode, loc % nkt, loc / nkt, smem);
}
DI void prep_range(const Params& p, int l, int lo, int hi, char* smem) {
  for (int it = lo + blockIdx.x; it < hi; it += gridDim.x) prep_item(p, l, it, smem);
}

DI void phase_init(const Params& p) {
  const int tid_ = ltid(); const int lane = tid_ & 63, gw = blockIdx.x * 8 + (tid_ >> 6), GW = gridDim.x * 8;
  bf16_t* XB = (bf16_t*)(p.ws + OFF_XB); bf16_t* MB = (bf16_t*)(p.ws + OFF_MEMB);
  float* SX = (float*)(p.ws + OFF_SSQX); float* SM = (float*)(p.ws + OFF_SSQMEM);
  for (int r = gw; r < T + MEMR; r += GW) {
    const bool isx = r < T;
    const float* src = isx ? p.in[0] + (size_t)r * 1024 : p.in[1] + (size_t)(r - T) * 1024;
    bf16_t* dst = isx ? XB + (size_t)r * 1024 : MB + (size_t)(r - T) * 1024;
    float ss = 0.f;
#pragma unroll
    for (int j = 0; j < 4; ++j) {
      const f4 v = *(const f4*)(src + j * 256 + lane * 4);
      ss += v.x * v.x + v.y * v.y + v.z * v.z + v.w * v.w;
      u2 u; u.x = pack2(v.x, v.y); u.y = pack2(v.z, v.w);
      *(u2*)(dst + j * 256 + lane * 4) = u;
    }
#pragma unroll
    for (int m = 32; m >= 1; m >>= 1) ss += __shfl_xor(ss, m);
    if (isx) { if (lane < 8) SX[(size_t)lane * T + r] = (lane == 0) ? ss : 0.f; }
    else if (lane == 0) SM[r - T] = ss;
  }
}

DI void run_epilogue(const Params& p, const Tile& t, char* smem) {
  float* Cs = (float*)smem;
  float* rs = (float*)(smem + RS_OFF);
  const int tid = ltid();
  const int q = tid & 15, rsub = tid >> 4;
  const int* pos = (const int*)p.in[2];
  if (t.epi == EP_VT) {
    const int c = tid >> 2, rq = tid & 3;
#pragma unroll
    for (int j = 0; j < 8; ++j) {
      float v[8];
#pragma unroll
      for (int e = 0; e < 8; ++e) { const int r = rq * 64 + j * 8 + e; v[e] = Cs[r * CS_LD + c] * rs[r]; }
      bf16_t* d16 = t.dst + (size_t)c * t.ldd + rq * 64 + (j >> 1) * 16;
      u2 lo, hi; lo.x = pack2(v[0], v[1]); lo.y = pack2(v[2], v[3]); hi.x = pack2(v[4], v[5]); hi.y = pack2(v[6], v[7]);
      *(u2*)(d16 + ((j & 1) ? 4 : 0)) = lo;
      *(u2*)(d16 + ((j & 1) ? 12 : 8)) = hi;
    }
    return;
  }
#pragma unroll 1
  for (int pass = 0; pass < 8; ++pass) {
    const int r = rsub + 32 * pass;
    const int row = t.row0 + r;
    float v[8];
    load8(Cs, r, q, v);
    const float rsv = rs[r];
#pragma unroll
    for (int e = 0; e < 8; ++e) v[e] *= rsv;
    switch (t.epi) {
      case EP_HEADROT: {
        float ss = 0.f;
#pragma unroll
        for (int e = 0; e < 8; ++e) ss += v[e] * v[e];
        ss += __shfl_xor(ss, 1); ss += __shfl_xor(ss, 2); ss += __shfl_xor(ss, 4);
        const float rn = rsqrtf(ss * (1.f / 64) + EPSV);
        const int pp = q & 7; const bool first = pp < 4; const int i0 = (pp & 3) * 8;
        const int ps = pos[row];
        float ov[8];
#pragma unroll
        for (int e = 0; e < 8; ++e) {
          const float y = v[e] * rn * t.gain[pp * 8 + e];
          const float yp = __shfl_xor(y, 4);
          float c, s; rot_cs(ps, INVF64[i0 + e], c, s);
          ov[e] = (first ? (y * c - yp * s) : (y * c + yp * s)) * t.oscale;
        }
        *(u4*)(t.dst + (size_t)row * t.ldd + t.cb * 128 + q * 8) = pack8(ov);
      } break;
      case EP_PLAIN: {
        float ss = 0.f;
#pragma unroll
        for (int e = 0; e < 8; ++e) ss += v[e] * v[e];
        ss += __shfl_xor(ss, 1); ss += __shfl_xor(ss, 2); ss += __shfl_xor(ss, 4); ss += __shfl_xor(ss, 8);
        *(u4*)(t.dst + (size_t)row * t.ldd + t.cb * 128 + q * 8) = pack8(v);
        if (q == 0) t.ssq_out[row] = ss;
      } break;
      case EP_KROPE: {
        const bool first = (q & 2) == 0; const int i0 = (q & 1) * 8;
        const int ps = pos[row];
        float ov[8];
#pragma unroll
        for (int e = 0; e < 8; ++e) {
          const float yp = __shfl_xor(v[e], 2);
          float c, s; rot_cs(ps, INVF32[i0 + e], c, s);
          ov[e] = first ? (v[e] * c - yp * s) : (v[e] * c + yp * s);
        }
        if (q < 4) {
          float* kr = (float*)(p.ws + OFF_KR) + (size_t)row * 32 + q * 8;
          *(f4*)kr = f4{ov[0], ov[1], ov[2], ov[3]};
          *(f4*)(kr + 4) = f4{ov[4], ov[5], ov[6], ov[7]};
        }
      } break;
      case EP_NORM128: {
        float ss = 0.f;
#pragma unroll
        for (int e = 0; e < 8; ++e) ss += v[e] * v[e];
        ss += __shfl_xor(ss, 1); ss += __shfl_xor(ss, 2); ss += __shfl_xor(ss, 4); ss += __shfl_xor(ss, 8);
        const float rn = rsqrtf(ss * (1.f / 128) + EPSV);
#pragma unroll
        for (int e = 0; e < 8; ++e) v[e] *= rn * t.oscale * t.gain[q * 8 + e];
        *(u4*)(t.dst + (size_t)row * t.ldd + t.cb * 128 + q * 8) = pack8(v);
      } break;
      case EP_QB: {
        const bool isr = (q >= 8 && q < 12);
        const bool first = (q & 2) == 0; const int i0 = (q & 1) * 8;
        const int ps = pos[row];
        float ss = 0.f;
#pragma unroll
        for (int e = 0; e < 8; ++e) {
          const float yp = __shfl_xor(v[e], 2);
          float c, s; rot_cs(ps, INVF32[i0 + e], c, s);
          const float rv = first ? (v[e] * c - yp * s) : (v[e] * c + yp * s);
          v[e] = isr ? rv : v[e];
          ss += v[e] * v[e];
        }
        ss += __shfl_xor(ss, 1); ss += __shfl_xor(ss, 2); ss += __shfl_xor(ss, 4); ss += __shfl_xor(ss, 8);
        const float rn = rsqrtf(ss * (1.f / 96) + EPSV);
        if (q < 12) {
#pragma unroll
          for (int e = 0; e < 8; ++e) v[e] *= rn * t.oscale * t.gain[q * 8 + e];
          *(u4*)(t.dst + (size_t)row * 768 + t.cb * 96 + q * 8) = pack8(v);
        }
      } break;
      case EP_KVB: {
        if (q >= 8) {
          if (q < 12) {
            const float* kr = (const float*)(p.ws + OFF_KR) + (size_t)row * 32 + (q - 8) * 8;
            const f4 a = *(const f4*)kr, b = *(const f4*)(kr + 4);
            v[0] = a.x; v[1] = a.y; v[2] = a.z; v[3] = a.w; v[4] = b.x; v[5] = b.y; v[6] = b.z; v[7] = b.w;
          } else {
#pragma unroll
            for (int e = 0; e < 8; ++e) v[e] = 0.f;
          }
        }
        float ss = 0.f;
#pragma unroll
        for (int e = 0; e < 8; ++e) ss += v[e] * v[e];
        ss += __shfl_xor(ss, 1); ss += __shfl_xor(ss, 2); ss += __shfl_xor(ss, 4); ss += __shfl_xor(ss, 8);
        const float rn = rsqrtf(ss * (1.f / 96) + EPSV);
        if (q < 12) {
#pragma unroll
          for (int e = 0; e < 8; ++e) v[e] *= rn * t.oscale * t.gain[q * 8 + e];
          *(u4*)(t.dst + (size_t)row * 768 + t.cb * 96 + q * 8) = pack8(v);
        }
      } break;
      case EP_RES: {
        const float* xs = t.xsrc + (size_t)row * 1024 + t.cb * 128 + q * 8;
        const f4 a = *(const f4*)xs, b = *(const f4*)(xs + 4);
        v[0] += a.x; v[1] += a.y; v[2] += a.z; v[3] += a.w; v[4] += b.x; v[5] += b.y; v[6] += b.z; v[7] += b.w;
        float ss = 0.f;
#pragma unroll
        for (int e = 0; e < 8; ++e) ss += v[e] * v[e];
        ss += __shfl_xor(ss, 1); ss += __shfl_xor(ss, 2); ss += __shfl_xor(ss, 4); ss += __shfl_xor(ss, 8);
        float* xo = p.out + (size_t)row * 1024 + t.cb * 128 + q * 8;
        *(f4*)xo = f4{v[0], v[1], v[2], v[3]};
        *(f4*)(xo + 4) = f4{v[4], v[5], v[6], v[7]};
        *(u4*)(t.dst + (size_t)row * 1024 + t.cb * 128 + q * 8) = pack8(v);
        if (q == 0) t.ssq_out[row] = ss;
      } break;
      case EP_MLP1: {
#pragma unroll
        for (int e = 0; e < 8; ++e) { const float u = fmaxf(v[e], 0.f); v[e] = u * u; }
        *(u4*)(t.dst + (size_t)row * t.ldd + t.cb * 128 + q * 8) = pack8(v);
      } break;
      default: break;
    }
  }
  if (t.epi == EP_KVB) {
    bf16_t* VMT = (bf16_t*)(p.ws + OFF_VMT);
    const int c = tid >> 3, r8 = tid & 7;
    const int b = t.row0 >> 11, s0 = t.row0 & 2047;
    bf16_t* d = VMT + ((size_t)(b * 512 + t.cb * 64 + c)) * SEQ + s0 + r8 * 32;
#pragma unroll
    for (int j = 0; j < 4; ++j) {
      float v[8];
#pragma unroll
      for (int e = 0; e < 8; ++e) { const int r = r8 * 32 + j * 8 + e; v[e] = Cs[r * CS_LD + 64 + c] * rs[r]; }
      bf16_t* d16 = d + (j >> 1) * 16;
      u2 lo, hi; lo.x = pack2(v[0], v[1]); lo.y = pack2(v[2], v[3]); hi.x = pack2(v[4], v[5]); hi.y = pack2(v[6], v[7]);
      *(u2*)(d16 + ((j & 1) ? 4 : 0)) = lo;
      *(u2*)(d16 + ((j & 1) ? 12 : 8)) = hi;
    }
  }
}

__global__ void __launch_bounds__(NTHR) mega_fwd(Params p) {
  __shared__ __attribute__((aligned(16))) char smem[LDS_BYTES];
  cg::grid_group grid = cg::this_grid();
  const int G = gridDim.x, bid = blockIdx.x;
  for (int ph = p.ph_lo; ph < p.ph_hi; ++ph) {
      char* ws = p.ws; asm volatile("" : "+s"(ws));
    bf16_t* XB = (bf16_t*)(ws + OFF_XB);   bf16_t* QD = (bf16_t*)(ws + OFF_QD);   bf16_t* KD = (bf16_t*)(ws + OFF_KD);
    bf16_t* VDT = (bf16_t*)(ws + OFF_VDT); bf16_t* CQ = (bf16_t*)(ws + OFF_CQ);   bf16_t* CKV = (bf16_t*)(ws + OFF_CKV);
    bf16_t* XQ = (bf16_t*)(ws + OFF_XQ);   bf16_t* QM = (bf16_t*)(ws + OFF_QM);   bf16_t* KM = (bf16_t*)(ws + OFF_KM);
    bf16_t* VMT = (bf16_t*)(ws + OFF_VMT); bf16_t* MEMB = (bf16_t*)(ws + OFF_MEMB); bf16_t* KC = (bf16_t*)(ws + OFF_KC);
    bf16_t* VCT = (bf16_t*)(ws + OFF_VCT); bf16_t* W = (bf16_t*)(ws + OFF_W);     bf16_t* U = (bf16_t*)(ws + OFF_U);
    bf16_t* MERGED = KD;
    float* SSQX = (float*)(ws + OFF_SSQX); float* SSQCQ = (float*)(ws + OFF_SSQCQ); float* SSQCKV = (float*)(ws + OFF_SSQCKV);
    float* SSQMEM = (float*)(ws + OFF_SSQMEM);

    if (ph == 0) {
      phase_init(p);
      prep_range(p, 0, 0, 5152, smem);
    } else {
      const int l = (ph - 1) / p.per, kr = (ph - 1) % p.per;
      const int k = (kr > p.dupk) ? kr - (p.per - 7) : kr;
#ifndef NO_GEMM
      if (k == 0 || k == 1 || k == 4 || k == 5 || k == 6) {
        int nits = 0, total = 0;
        if (k == 0) { nits = 18; total = 4480; if (l > 0) prep_range(p, l, 4128, 5152, smem); }
        else if (k == 1) { nits = 8; total = 2048; }
        else if (k == 4) { nits = 4; total = 1024; }
        else if (k == 5) { nits = 16; total = 4096; if (l + 1 < NL) prep_range(p, l + 1, 0, 3104, smem); }
        else { nits = 4; total = 1024; if (l + 1 < NL) prep_range(p, l + 1, 3104, 4128, smem); }
        const bool xmap = (G == 256);
        if (!xmap) nits = (total + G - 1) / G;
#pragma unroll 1
        for (int it = 0; it < nits; ++it) {
          int list = 0, rb = -1, CB = 0;
          if (xmap) {
            if (k == 0) {
              if (it < 16) map_regular(it, bid, 16, rb, CB);
              else if (it == 16) { rb = bid; CB = 16; }
              else if (bid < 128) { list = 1; rb = bid >> 2; CB = bid & 3; }
            } else if (k == 1) { list = it >> 2; map_regular(it & 3, bid, 4, rb, CB); }
            else if (k == 5) map_regular(it, bid, 16, rb, CB);
            else map_regular(it, bid, 4, rb, CB);
          } else {
            const int li = it * G + bid;
            if (li < total) {
              if (k == 0) { if (li < 4352) { rb = li / 17; CB = li % 17; } else { list = 1; rb = (li - 4352) >> 2; CB = (li - 4352) & 3; } }
              else if (k == 1) { list = li >> 10; rb = (li & 1023) >> 2; CB = li & 3; }
              else if (k == 5) { rb = li >> 4; CB = li & 15; }
              else { rb = li >> 2; CB = li & 3; }
            }
          }
          if (rb < 0) continue;
          const int row0 = rb * 256;
          const bf16_t* Ap; const bf16_t* Bp; int lda, Kd;
          const float* ssq = nullptr; int nparts = 0, pstride = T; float invK = 0.f;
          if (k == 0) {
            if (list == 0) { Ap = XB + (size_t)row0 * 1024; lda = 1024; Bp = W + W_IN + (size_t)CB * 256 * 1024; Kd = 1024; ssq = SSQX; nparts = 8; invK = 1.f / 1024; }
            else           { Ap = MEMB + (size_t)row0 * 1024; lda = 1024; Bp = W + W_MEM + (size_t)CB * 256 * 1024; Kd = 1024; ssq = SSQMEM; nparts = 1; pstride = 0; invK = 1.f / 1024; }
          } else if (k == 1) {
            if (list == 0) { Ap = CQ + (size_t)row0 * 384; lda = 384; Bp = W + W_QB + (size_t)CB * 256 * 384; Kd = 384; ssq = SSQCQ; nparts = 3; invK = 1.f / 384; }
            else           { Ap = CKV + (size_t)row0 * 256; lda = 256; Bp = W + W_KVB + (size_t)CB * 256 * 256; Kd = 256; ssq = SSQCKV; nparts = 2; invK = 1.f / 256; }
          } else if (k == 4) { Ap = MERGED + (size_t)row0 * 1024; lda = 1024; Bp = W + W_OUT + (size_t)CB * 256 * 1024; Kd = 1024; }
          else if (k == 5)   { Ap = XB + (size_t)row0 * 1024; lda = 1024; Bp = W + W_1 + (size_t)CB * 256 * 1024; Kd = 1024; ssq = SSQX; nparts = 8; invK = 1.f / 1024; }
          else               { Ap = U + (size_t)row0 * 4096; lda = 4096; Bp = W + W_2 + (size_t)CB * 256 * 4096; Kd = 4096; }
          f32x16 acc[4][2];
          gemm_mainloop<4, 2, 4, true>(Ap, lda, Bp, Kd, Kd, acc, smem);
          float* Cs = (float*)smem;
#pragma unroll 1
          for (int half = 0; half < 2; ++half) {
            if (half) __syncthreads();
            {
              const int tq = ltid(); const int lane = tq & 63, wave = tq >> 6, wm = wave >> 2, wn = wave & 3, h = lane >> 5;
              if ((wn >> 1) == half) {
#pragma unroll
                for (int mi = 0; mi < 4; ++mi)
#pragma unroll
                  for (int ni = 0; ni < 2; ++ni)
#pragma unroll
                    for (int i = 0; i < 16; ++i)
                      Cs[(wm * 128 + mi * 32 + crow(i, h)) * CS_LD + (wn & 1) * 64 + ni * 32 + (lane & 31)] = acc[mi][ni][i];
              }
            }
            if (half == 0) fill_rs((float*)(smem + RS_OFF), ssq, nparts, pstride, row0, invK);
            __syncthreads();
            const int cb = CB * 2 + half;
            Tile t;
            t.row0 = row0; t.cb = cb; t.epi = EP_PLAIN;
            t.dst = nullptr; t.ldd = 0; t.gain = nullptr; t.ssq_out = nullptr; t.xsrc = nullptr; t.oscale = 1.f;
            if (k == 0) {
              if (list == 0) {
                if (cb < 8)       { t.epi = EP_HEADROT; t.cb = cb; t.dst = QD; t.ldd = 1024; t.gain = p.in[6] + l * 64; t.oscale = 0.125f * 1.4426950408889634f; }
                else if (cb < 16) { t.epi = EP_HEADROT; t.cb = cb - 8; t.dst = KD; t.ldd = 1024; t.gain = p.in[7] + l * 64; }
                else if (cb < 24) { t.epi = EP_VT; t.cb = cb - 16; const int b = row0 >> 11, s0 = row0 & 2047; t.dst = VDT + ((size_t)(b * 1024 + (cb - 16) * 128)) * SEQ + s0; t.ldd = SEQ; }
                else if (cb < 27) { t.epi = EP_PLAIN; t.cb = cb - 24; t.dst = CQ; t.ldd = 384; t.ssq_out = SSQCQ + (size_t)(cb - 24) * T; }
                else if (cb < 29) { t.epi = EP_PLAIN; t.cb = cb - 27; t.dst = CKV; t.ldd = 256; t.ssq_out = SSQCKV + (size_t)(cb - 27) * T; }
                else if (cb == 29) { t.epi = EP_KROPE; t.cb = 0; }
                else              { t.epi = EP_NORM128; t.cb = cb - 30; t.dst = XQ; t.ldd = 512; t.gain = p.in[20] + l * 128; t.oscale = 0.08838834764831845f * 1.4426950408889634f; }
              } else {
                if (cb < 4) { t.epi = EP_NORM128; t.cb = cb; t.dst = KC; t.ldd = 512; t.gain = p.in[21] + l * 128; }
                else        { t.epi = EP_VT; t.cb = cb - 4; t.dst = VCT + ((size_t)(rb * 512 + (cb - 4) * 128)) * MEML; t.ldd = MEML; }
              }
            } else if (k == 1) {
              if (list == 0) { t.epi = EP_QB; t.dst = QM; t.gain = p.in[15] + l * 96; t.oscale = 0.10206207261596575f * 1.4426950408889634f; }
              else           { t.epi = EP_KVB; t.dst = KM; t.gain = p.in[16] + l * 96; }
            } else if (k == 4) { t.epi = EP_RES; t.dst = XB; t.xsrc = (l == 0) ? p.in[0] : p.out; t.ssq_out = SSQX + (size_t)cb * T; }
            else if (k == 5)   { t.epi = EP_MLP1; t.dst = U; t.ldd = 4096; }
            else               { t.epi = EP_RES; t.dst = XB; t.xsrc = p.out; t.ssq_out = SSQX + (size_t)cb * T; }
            run_epilogue(p, t, smem);
          }
        }
      } else
#endif
#ifndef NO_ATT
      if (k == 2) {
        float lam;
        const float lam_init = 0.8f - 0.6f * expf(-0.3f * (float)l);
        {
          const int lane = ltid() & 63;
          const float* lv = p.in[8] + l * 256;
          float sa = lv[lane] * lv[64 + lane], sb = lv[128 + lane] * lv[192 + lane];
#pragma unroll
          for (int m = 32; m >= 1; m >>= 1) { sa += __shfl_xor(sa, m); sb += __shfl_xor(sb, m); }
          lam = expf(sa) - expf(sb) + lam_init;
        }
        const float L2E = 1.4426950408889634f;
#pragma unroll 1
        for (int it = 0; it < ((G == 256) ? 16 : (4096 + G - 1) / G); ++it) {
          int w;
          if (G == 256) {
            const int xcd = bid & 7, slot = bid >> 3;
            if (it < 8)       w = ((it * 32 + (slot >> 3) * 8 + xcd) << 3) + (slot & 7);
            else if (it < 12) w = 2048 + ((((it - 8) * 64 + (slot >> 2) * 8 + xcd) << 2) + (slot & 3));
            else              w = 3072 + ((((it - 12) * 32 + (slot >> 3) * 8 + xcd) << 3) + (slot & 7));
          } else { w = it * G + bid; if (w >= 4096) continue; }
#ifndef NO_A1
          if (w < 2048) {
            const int bh = w >> 3, j = w & 7, b = bh >> 3, hh = bh & 7;
#pragma unroll 1
            for (int half = 0; half < 2; ++half) {
              const int qb = half ? j : 15 - j;
              const int q0 = qb * 128;
              bf16_t* Qp = QD + ((size_t)(b * SEQ + q0)) * 1024 + hh * 128;
              attn_block<64, 128, 2, true>(Qp, 1024, KD + (size_t)b * SEQ * 1024 + hh * 128, 1024, VDT + ((size_t)(b * 1024 + hh * 128)) * SEQ, SEQ,
                                            (q0 + 128) >> 6, q0, Qp, 1024, 0.125f * L2E, lam, p.in[9] + l * 128, 1.f - lam_init, smem);
            }
          } else
#endif
#ifndef NO_A2
          if (w < 3072) {
            const int wj = w - 2048; const int bh = wj >> 2, j = wj & 3, b = bh >> 3, hh = bh & 7;
#pragma unroll 1
            for (int half = 0; half < 2; ++half) {
              const int qb = half ? j : 7 - j;
              const int q0 = qb * 256;
              bf16_t* Qp = QM + ((size_t)(b * SEQ + q0)) * 768 + hh * 96;
              attn_block<96, 64, 1, true>(Qp, 768, KM + (size_t)b * SEQ * 768 + hh * 96, 768, VMT + ((size_t)(b * 512 + hh * 64)) * SEQ, SEQ,
                                           (q0 + 256) >> 6, q0, Qp, 768, 0.10206207261596575f * L2E, 0.f, nullptr, 1.f, smem);
            }
          } else
#endif
#ifndef NO_A3
          {
            const int wj = w - 3072; const int bh = wj >> 3, qb = wj & 7, b = bh >> 2, hh = bh & 3;
            const int q0 = qb * 256;
            bf16_t* Qp = XQ + ((size_t)(b * SEQ + q0)) * 512 + hh * 128;
            attn_block<128, 128, 1, false>(Qp, 512, KC + (size_t)b * MEML * 512 + hh * 128, 512, VCT + ((size_t)(b * 512 + hh * 128)) * MEML, MEML,
                                            4, q0, Qp, 512, 0.08838834764831845f * L2E, 0.f, nullptr, 1.f, smem);
          }
#endif
          {}
        }
      } else
#endif
#ifndef NO_D
      if (k == 3) {
        float* Cs = (float*)smem;
        float* rs = (float*)(smem + RS_OFF);
#pragma unroll 1
        for (int it = 0; it < ((G == 256) ? 8 : (2048 + G - 1) / G); ++it) {
          int rb, cb;
          if (G == 256) map_regular(it, bid, 8, rb, cb);
          else { const int li = it * G + bid; if (li >= 2048) continue; rb = li >> 3; cb = li & 7; }
          const int tidd = ltid(); const int lane = tidd & 63, wave = tidd >> 6, wm = wave >> 1, wn = wave & 1, h = lane >> 5;
          const int row0 = rb * 256, col0 = cb * 128;
          __syncthreads();
          fill_rs(rs, SSQX, 8, T, row0, 1.f / 1024);
          f32x16 acc[2][2];
          unsigned gp[2][2][8], mp[2][2][8];
#pragma unroll
          for (int mi = 0; mi < 2; ++mi)
#pragma unroll
            for (int ni = 0; ni < 2; ++ni)
#pragma unroll
              for (int i = 0; i < 8; ++i) mp[mi][ni][i] = 0u;
#pragma unroll 1
          for (int st = 0; st < 6; ++st) {
            const int br = st >> 1, half = st & 1;
            const bf16_t* Ab; const bf16_t* Bb; int Kb;
            if (half == 0)    { Ab = XB + (size_t)row0 * 1024; Bb = W + W_IN + (size_t)(WIN_GATE0 + br * 1024 + col0) * 1024; Kb = 1024; }
            else if (br == 0) { Ab = QD + (size_t)row0 * 1024; Bb = W + W_DO + (size_t)col0 * 1024; Kb = 1024; }
            else if (br == 1) { Ab = QM + (size_t)row0 * 768;  Bb = W + W_MO + (size_t)col0 * 768;  Kb = 768; }
            else              { Ab = XQ + (size_t)row0 * 512;  Bb = W + W_CO + (size_t)col0 * 512;  Kb = 512; }
            gemm_mainloop<2, 2, 2, false>(Ab, Kb, Bb, Kb, Kb, acc, smem);
            if (half == 0) {
              const float* bg = p.in[5] + (size_t)l * 3072 + br * 1024 + col0 + wn * 64 + (lane & 31);
              const float bgv0 = bg[0], bgv1 = bg[32];
#pragma unroll
              for (int mi = 0; mi < 2; ++mi) {
                float rsv[16];
#pragma unroll
                for (int i = 0; i < 16; ++i) rsv[i] = rs[wm * 64 + mi * 32 + crow(i, h)];
#pragma unroll
                for (int ni = 0; ni < 2; ++ni) {
                  const float bgv = ni ? bgv1 : bgv0;
#pragma unroll
                  for (int i = 0; i < 16; i += 2) {
                    const float z0 = acc[mi][ni][i] * rsv[i] + bgv;
                    const float z1 = acc[mi][ni][i + 1] * rsv[i + 1] + bgv;
                    gp[mi][ni][i >> 1] = pack2(1.f / (1.f + __expf(-z0)), 1.f / (1.f + __expf(-z1)));
                  }
                }
                __builtin_amdgcn_sched_barrier(0);
              }
            } else {
#pragma unroll
              for (int mi = 0; mi < 2; ++mi)
#pragma unroll
                for (int ni = 0; ni < 2; ++ni)
#pragma unroll
                  for (int i = 0; i < 16; i += 2) {
                    const unsigned g2 = gp[mi][ni][i >> 1], m2 = mp[mi][ni][i >> 1];
                    const float m0 = __uint_as_float(m2 << 16) + __uint_as_float(g2 << 16) * acc[mi][ni][i];
                    const float m1 = __uint_as_float(m2 & 0xffff0000u) + __uint_as_float(g2 & 0xffff0000u) * acc[mi][ni][i + 1];
                    mp[mi][ni][i >> 1] = pack2(m0, m1);
                  }
            }
          }
#pragma unroll
          for (int mi = 0; mi < 2; ++mi)
#pragma unroll
            for (int ni = 0; ni < 2; ++ni)
#pragma unroll
              for (int i = 0; i < 16; ++i) {
                const unsigned m2 = mp[mi][ni][i >> 1];
                Cs[(wm * 64 + mi * 32 + crow(i, h)) * CS_LD + wn * 64 + ni * 32 + (lane & 31)] = __uint_as_float((i & 1) ? (m2 & 0xffff0000u) : (m2 << 16));
              }
          __syncthreads();
          const int q = tidd & 15, rsub = tidd >> 4;
#pragma unroll 1
          for (int pass = 0; pass < 8; ++pass) {
            const int r = rsub + 32 * pass;
            float v[8];
            load8(Cs, r, q, v);
            *(u4*)(MERGED + (size_t)(row0 + r) * 1024 + col0 + q * 8) = pack8(v);
          }
        }
      }
#endif
      {}
    }
    if (ph + 1 < p.ph_hi) grid.sync();
  }
}

extern "C" void kernel_launch(void* const* d_in, const int* in_sizes, int n_in, void* d_out, int out_size, void* d_ws, size_t ws_size, hipStream_t stream) {
  static int grid_blocks = 0;
  if (grid_blocks == 0) {
    if (n_in != 27 || ws_size < WS_NEED) { fprintf(stderr, "kernel_launch: unexpected inputs (n_in %d) or workspace (%zu < %zu)\n", n_in, ws_size, (size_t)WS_NEED); grid_blocks = -1; return; }
    int dev = 0, cus = 0, per_cu = 0;
    hipGetDevice(&dev);
    hipDeviceGetAttribute(&cus, hipDeviceAttributeMultiprocessorCount, dev);
    hipOccupancyMaxActiveBlocksPerMultiprocessor(&per_cu, mega_fwd, NTHR, 0);
    if (per_cu < 1) per_cu = 1;
    if (per_cu > 1) per_cu = 1;
    grid_blocks = cus * per_cu;
  }
  if (grid_blocks < 0) return;
  Params p{};
  for (int i = 0; i < 27; ++i) p.in[i] = (const float*)d_in[i];
  p.out = (float*)d_out;
  p.ws = (char*)d_ws;
  p.ph_lo = 0;
  p.dupk = (DUP_K >= 0) ? DUP_K : 100;
  p.per = (DUP_K >= 0) ? 8 : 7;
  p.ph_hi = 1 + NL * p.per;
  void* args[] = {&p};
  hipError_t e = hipLaunchCooperativeKernel((void*)mega_fwd, dim3(grid_blocks), dim3(NTHR), args, 0, stream);
  if (e != hipSuccess) fprintf(stderr, "cooperative launch failed: %s (grid %d)\n", hipGetErrorString(e), grid_blocks);
}
```

```cpp
#include <hip/hip_runtime.h>
#include <hip/hip_cooperative_groups.h>
#include <stdint.h>
#include <stdio.h>
#define NO_D 1
namespace cg = cooperative_groups;

typedef unsigned short bf16_t;
using bf16x8 = __attribute__((ext_vector_type(8))) short;
using f32x16 = __attribute__((ext_vector_type(16))) float;
typedef unsigned u4 __attribute__((ext_vector_type(4)));
typedef unsigned u2 __attribute__((ext_vector_type(2)));
typedef float f4 __attribute__((ext_vector_type(4)));
#define DI __device__ __forceinline__
#define MFMA(a, b, c) __builtin_amdgcn_mfma_f32_32x32x16_bf16((a), (b), (c), 0, 0, 0)

constexpr int T = 65536, DM = 1024, NB = 32, SEQ = 2048, NL = 4, MEML = 256, MEMR = NB * MEML;
constexpr int NTHR = 512;
constexpr int DUP_K = -1;
constexpr float EPSV = 1e-6f;
constexpr int WIN_N = 7424;
constexpr int WIN_GATE0 = 4352;

constexpr size_t MiB = 1024ull * 1024ull;
constexpr size_t OFF_XB = 0;
constexpr size_t OFF_QD = OFF_XB + 128 * MiB;
constexpr size_t OFF_KD = OFF_QD + 128 * MiB;
constexpr size_t OFF_VDT = OFF_KD + 128 * MiB;
constexpr size_t OFF_CQ = OFF_VDT + 128 * MiB;
constexpr size_t OFF_CKV = OFF_CQ + 48 * MiB;
constexpr size_t OFF_KR = OFF_CKV + 32 * MiB;
constexpr size_t OFF_XQ = OFF_KR + 8 * MiB;
constexpr size_t OFF_QM = OFF_XQ + 64 * MiB;
constexpr size_t OFF_KM = OFF_QM + 96 * MiB;
constexpr size_t OFF_VMT = OFF_KM + 96 * MiB;
constexpr size_t OFF_MEMB = OFF_VMT + 64 * MiB;
constexpr size_t OFF_KC = OFF_MEMB + 16 * MiB;
constexpr size_t OFF_VCT = OFF_KC + 8 * MiB;
constexpr size_t OFF_SSQX = OFF_VCT + 8 * MiB;
constexpr size_t OFF_SSQCQ = OFF_SSQX + 2 * MiB;
constexpr size_t OFF_SSQCKV = OFF_SSQCQ + 1 * MiB;
constexpr size_t OFF_SSQMEM = OFF_SSQCKV + 1 * MiB;
constexpr size_t OFF_W = OFF_SSQMEM + 1 * MiB;
constexpr size_t OFF_U = OFF_QD;
constexpr size_t W_IN = 0;
constexpr size_t W_MEM = W_IN + (size_t)WIN_N * 1024;
constexpr size_t W_QB = W_MEM + 1024 * 1024;
constexpr size_t W_KVB = W_QB + 1024 * 384;
constexpr size_t W_DO = W_KVB + 1024 * 256;
constexpr size_t W_MO = W_DO + 1024 * 1024;
constexpr size_t W_CO = W_MO + 1024 * 768;
constexpr size_t W_OUT = W_CO + 1024 * 512;
constexpr size_t W_1 = W_OUT + 1024 * 1024;
constexpr size_t W_2 = W_1 + 4096 * 1024;
constexpr size_t W_END = W_2 + 4096 * 1024;
constexpr size_t WS_NEED = OFF_W + W_END * 2;

constexpr int LDS_ROW = 144;
constexpr int CS_LD = 132;
constexpr int CS_BYTES = 256 * CS_LD * 4;
constexpr int RS_OFF = 2 * 512 * LDS_ROW;
constexpr int LDS_BYTES = RS_OFF + 1024;

__constant__ float INVF64[32] = {1.000000000e+00f,7.498942614e-01f,5.623413324e-01f,4.216965139e-01f,3.162277639e-01f,2.371373773e-01f,1.778279394e-01f,1.333521307e-01f,1.000000015e-01f,7.498941571e-02f,5.623413250e-02f,4.216965288e-02f,3.162277490e-02f,2.371373773e-02f,1.778279431e-02f,1.333521493e-02f,9.999999776e-03f,7.498941850e-03f,5.623413250e-03f,4.216964822e-03f,3.162277630e-03f,2.371373586e-03f,1.778279431e-03f,1.333521446e-03f,1.000000047e-03f,7.498942432e-04f,5.623413017e-04f,4.216965172e-04f,3.162277571e-04f,2.371373703e-04f,1.778279402e-04f,1.333521504e-04f};
__constant__ float INVF32[16] = {1.000000000e+00f,5.623413324e-01f,3.162277639e-01f,1.778279394e-01f,1.000000015e-01f,5.623413250e-02f,3.162277490e-02f,1.778279431e-02f,9.999999776e-03f,5.623413250e-03f,3.162277630e-03f,1.778279431e-03f,1.000000047e-03f,5.623413017e-04f,3.162277571e-04f,1.778279402e-04f};

struct Params {
  const float* in[27];
  float* out;
  char* ws;
  int ph_lo, ph_hi;
  int dupk, per;
};

typedef __bf16 bf2_t __attribute__((ext_vector_type(2)));
typedef float fl2_t __attribute__((ext_vector_type(2)));
DI unsigned pack2(float a, float b) { fl2_t f = {a, b}; bf2_t r = __builtin_convertvector(f, bf2_t); return __builtin_bit_cast(unsigned, r); }
DI u4 pack8(const float* v) { u4 u; u.x = pack2(v[0], v[1]); u.y = pack2(v[2], v[3]); u.z = pack2(v[4], v[5]); u.w = pack2(v[6], v[7]); return u; }
DI int ltid() { int t = threadIdx.x; asm volatile("" : "+v"(t)); return t; }
DI int crow(int i, int h) { return (i & 3) + 8 * (i >> 2) + 4 * h; }
DI void rot_cs(int pos, float invf, float& c, float& s) {
  const float ang = (float)pos * invf;
  double rev = (double)ang * 0.15915494309189535;
  rev -= floor(rev);
  const float rf = (float)rev;
  c = __builtin_amdgcn_cosf(rf);
  s = __builtin_amdgcn_sinf(rf);
}
DI void load8(const float* Cs, int r, int q, float* v) {
  const f4 a = *(const f4*)(Cs + r * CS_LD + q * 8);
  const f4 b = *(const f4*)(Cs + r * CS_LD + q * 8 + 4);
  v[0] = a.x; v[1] = a.y; v[2] = a.z; v[3] = a.w; v[4] = b.x; v[5] = b.y; v[6] = b.z; v[7] = b.w;
}

template <int MI, int NI, int WGN, bool FDB>
DI void gemm_mainloop(const bf16_t* __restrict__ A, int lda, const bf16_t* __restrict__ B, int ldb, int K, f32x16 (&acc)[MI][NI], char* smem) {
  constexpr int BM = (8 / WGN) * MI * 32, BN = WGN * NI * 32;
  constexpr int ASZ = BM * 64, STAGE = (BM + BN) * 64;
  constexpr int NGA = BM / 128, NGB = BN / 128, NLD = NGA + NGB;
  static_assert(4 * STAGE <= RS_OFF, "ring");
  const int tid = ltid(), lane = tid & 63, wave = tid >> 6, l31 = lane & 31, h = lane >> 5;
  const int wu = __builtin_amdgcn_readfirstlane(wave);
  const int wm = wave / WGN, wn = wave % WGN;
  const int lrow = lane >> 2, lchk = (lane & 3) ^ ((lane >> 4) & 3);
  const bf16_t* ga = A + (size_t)(wu * NGA * 16 + lrow) * lda + lchk * 8;
  const bf16_t* gb = B + (size_t)(wu * NGB * 16 + lrow) * ldb + lchk * 8;
#pragma unroll
  for (int mi = 0; mi < MI; ++mi)
#pragma unroll
    for (int ni = 0; ni < NI; ++ni)
#pragma unroll
      for (int i = 0; i < 16; ++i) acc[mi][ni][i] = 0.f;
  auto issue = [&](int j) {
    char* st = smem + (j & 3) * STAGE;
    const int k0 = j * 32;
#pragma unroll
    for (int i = 0; i < NGA; ++i)
      __builtin_amdgcn_global_load_lds((const unsigned*)(ga + (size_t)(i * 16) * lda + k0), (unsigned*)(st + (wu * NGA + i) * 1024), 16, 0, 0);
#pragma unroll
    for (int i = 0; i < NGB; ++i)
      __builtin_amdgcn_global_load_lds((const unsigned*)(gb + (size_t)(i * 16) * ldb + k0), (unsigned*)(st + ASZ + (wu * NGB + i) * 1024), 16, 0, 0);
  };
  asm volatile("s_waitcnt vmcnt(0)" ::: "memory");
  __syncthreads();
  const int nk = K >> 5;
  issue(0); issue(1); issue(2);
  const int sw = (l31 >> 2) & 3;
  const int oa = (wm * MI * 32 + l31) * 64, ob = ASZ + (wn * NI * 32 + l31) * 64;
  const int c0 = ((0 + h) ^ sw) * 16, c1 = ((2 + h) ^ sw) * 16;
#pragma unroll 1
  for (int j = 0; j < nk; ++j) {
    if (j + 2 < nk) asm volatile("s_waitcnt vmcnt(%0)" ::"n"(2 * NLD) : "memory");
    else if (j + 1 < nk) asm volatile("s_waitcnt vmcnt(%0)" ::"n"(NLD) : "memory");
    else asm volatile("s_waitcnt vmcnt(0)" ::: "memory");
    asm volatile("s_waitcnt lgkmcnt(0)" ::: "memory");
    __builtin_amdgcn_s_barrier();
    if (j + 3 < nk) issue(j + 3);
    const char* st = smem + (j & 3) * STAGE;
    const char* pa = st + oa;
    const char* pb = st + ob;
    bf16x8 fa0[MI], fb0[NI], fa1[MI], fb1[NI];
#pragma unroll
    for (int mi = 0; mi < MI; ++mi) fa0[mi] = *(const bf16x8*)(pa + mi * 2048 + c0);
#pragma unroll
    for (int ni = 0; ni < NI; ++ni) fb0[ni] = *(const bf16x8*)(pb + ni * 2048 + c0);
    if (FDB) {
#pragma unroll
      for (int mi = 0; mi < MI; ++mi) fa1[mi] = *(const bf16x8*)(pa + mi * 2048 + c1);
#pragma unroll
      for (int ni = 0; ni < NI; ++ni) fb1[ni] = *(const bf16x8*)(pb + ni * 2048 + c1);
    }
#pragma unroll
    for (int mi = 0; mi < MI; ++mi)
#pragma unroll
      for (int ni = 0; ni < NI; ++ni) acc[mi][ni] = MFMA(fa0[mi], fb0[ni], acc[mi][ni]);
    __builtin_amdgcn_sched_barrier(0);
    if (!FDB) {
#pragma unroll
      for (int mi = 0; mi < MI; ++mi) fa1[mi] = *(const bf16x8*)(pa + mi * 2048 + c1);
#pragma unroll
      for (int ni = 0; ni < NI; ++ni) fb1[ni] = *(const bf16x8*)(pb + ni * 2048 + c1);
    }
#pragma unroll
    for (int mi = 0; mi < MI; ++mi)
#pragma unroll
      for (int ni = 0; ni < NI; ++ni) acc[mi][ni] = MFMA(fa1[mi], fb1[ni], acc[mi][ni]);
    __builtin_amdgcn_sched_barrier(0);
  }
  asm volatile("s_waitcnt lgkmcnt(0)" ::: "memory");
  __builtin_amdgcn_s_barrier();
}

using f32x4v = __attribute__((ext_vector_type(4))) float;
DI int lds_byte8(int r, int c) {
  const int st = (r >> 4) * 2 + (c >> 5), rr = r & 15, cc = c & 31, ob = rr * 64 + cc * 2;
  return st * 1024 + (ob ^ (((ob >> 9) & 1) << 5));
}
DI void stage_rc8(int b, int& R, int& C) {
  const int st = b / 1024, sb = b % 1024, swz = sb ^ (((sb >> 9) & 1) << 5);
  R = (st >> 1) * 16 + swz / 64; C = (st & 1) * 32 + (swz % 64) / 2;
}
DI void gemm8p(const bf16_t* __restrict__ A, const bf16_t* __restrict__ Bt, int K, f32x4v (&acc)[2][2][4][2], char* smem) {
  constexpr int BK8 = 64, HALF8 = 128, HTB = HALF8 * BK8 * 2;
  const int tid = ltid(), wid = tid >> 6, lane = tid & 63, wr = wid >> 2, wc = wid & 3, fr = lane & 15, fq = lane >> 4;
  const int wu8 = __builtin_amdgcn_readfirstlane(wid);
  unsigned goff[2];
#pragma unroll
  for (int i_ = 0; i_ < 2; ++i_) { int r_, c_; stage_rc8(tid * 16 + i_ * 8192, r_, c_); goff[i_] = (unsigned)(r_ * K + c_); }
  const int lfrag = ((fr * 64 + fq * 16) ^ ((fr >> 3) << 5));
  const char* la = smem + wr * 8192 + lfrag;
  const char* lb = smem + 4 * HTB + wc * 4096 + lfrag;
#define SA8(b, h) ((b) * 2 + (h))
#define SB8(b, h) (4 + (b) * 2 + (h))
#define STAGE8(Q, BASE, br, kt) do { const bf16_t* sb_ = (BASE) + ((long)(br) * K + (long)(kt) * BK8); \
    _Pragma("unroll") for (int i_ = 0; i_ < 2; ++i_) \
      __builtin_amdgcn_global_load_lds((const unsigned*)(sb_ + goff[i_]), (unsigned*)(smem + (Q) * HTB + i_ * 8192 + wu8 * 1024), 16, 0, 0); } while (0)
#define LDA8(dst, b, h) _Pragma("unroll") for (int m = 0; m < 4; ++m) _Pragma("unroll") for (int k = 0; k < 2; ++k) \
    dst[m][k] = *(const bf16x8*)(la + ((b) * 2 + (h)) * HTB + (m * 2 + k) * 1024)
#define LDB8(dst, b, h) _Pragma("unroll") for (int n = 0; n < 2; ++n) _Pragma("unroll") for (int k = 0; k < 2; ++k) \
    dst[n][k] = *(const bf16x8*)(lb + ((b) * 2 + (h)) * HTB + (n * 2 + k) * 1024)
#define MMA8(ai, bj, At_, Bt_) do { __builtin_amdgcn_s_setprio(1); \
    _Pragma("unroll") for (int m = 0; m < 4; ++m) _Pragma("unroll") for (int n = 0; n < 2; ++n) _Pragma("unroll") for (int k = 0; k < 2; ++k) \
      acc[ai][bj][m][n] = __builtin_amdgcn_mfma_f32_16x16x32_bf16(At_[m][k], Bt_[n][k], acc[ai][bj][m][n], 0, 0, 0); \
    __builtin_amdgcn_s_setprio(0); } while (0)
#define WAIT_V8(n) asm volatile("s_waitcnt vmcnt(" #n ")" ::: "memory")
#define WAIT_L8(n) asm volatile("s_waitcnt lgkmcnt(" #n ")" ::: "memory")
#define BAR8 __builtin_amdgcn_s_barrier()
#define SCHED8 __builtin_amdgcn_sched_barrier(0)
#pragma unroll
  for (int a = 0; a < 2; ++a)
#pragma unroll
    for (int b = 0; b < 2; ++b)
#pragma unroll
      for (int m = 0; m < 4; ++m)
#pragma unroll
        for (int n = 0; n < 2; ++n) acc[a][b][m][n] = f32x4v{0.f, 0.f, 0.f, 0.f};
  bf16x8 At[4][2], B0[2][2], B1[2][2];
  const int nt = K / BK8;
  asm volatile("s_waitcnt vmcnt(0)" ::: "memory");
  __syncthreads();
  STAGE8(SB8(0, 0), Bt, 0, 0); STAGE8(SA8(0, 0), A, 0, 0);
  STAGE8(SB8(0, 1), Bt, HALF8, 0); STAGE8(SA8(0, 1), A, HALF8, 0);
  if (wr == 1) BAR8;
  WAIT_V8(4); BAR8;
  STAGE8(SB8(1, 0), Bt, 0, 1); STAGE8(SA8(1, 0), A, 0, 1); STAGE8(SB8(1, 1), Bt, HALF8, 1);
  WAIT_V8(6); BAR8;
#pragma unroll 1
  for (int t = 0; t < nt - 2; t += 2) {
    LDB8(B0, 0, 0); SCHED8; LDA8(At, 0, 0); STAGE8(SA8(1, 1), A, HALF8, t + 1);
    WAIT_L8(8); BAR8; WAIT_L8(0); MMA8(0, 0, At, B0); BAR8; SCHED8;
    LDB8(B1, 0, 1); STAGE8(SB8(0, 0), Bt, 0, t + 2);
    BAR8; WAIT_L8(0); MMA8(0, 1, At, B1); BAR8;
    LDA8(At, 0, 1); STAGE8(SA8(0, 0), A, 0, t + 2);
    BAR8; WAIT_L8(0); MMA8(1, 0, At, B0); BAR8; SCHED8;
    STAGE8(SB8(0, 1), Bt, HALF8, t + 2);
    WAIT_V8(6); BAR8; MMA8(1, 1, At, B1); BAR8;
    LDB8(B0, 1, 0); SCHED8; LDA8(At, 1, 0); STAGE8(SA8(0, 1), A, HALF8, t + 2);
    WAIT_L8(8); BAR8; WAIT_L8(0); MMA8(0, 0, At, B0); BAR8; SCHED8;
    LDB8(B1, 1, 1); STAGE8(SB8(1, 0), Bt, 0, t + 3);
    BAR8; WAIT_L8(0); MMA8(0, 1, At, B1); BAR8;
    LDA8(At, 1, 1); STAGE8(SA8(1, 0), A, 0, t + 3);
    BAR8; WAIT_L8(0); MMA8(1, 0, At, B0); BAR8; SCHED8;
    STAGE8(SB8(1, 1), Bt, HALF8, t + 3);
    WAIT_V8(6); BAR8; MMA8(1, 1, At, B1); BAR8;
  }
  { LDB8(B0, 0, 0); LDA8(At, 0, 0); STAGE8(SA8(1, 1), A, HALF8, nt - 1);
    BAR8; WAIT_L8(0); MMA8(0, 0, At, B0); BAR8;
    LDB8(B1, 0, 1); BAR8; WAIT_L8(0); MMA8(0, 1, At, B1); BAR8;
    LDA8(At, 0, 1); WAIT_V8(4); BAR8; WAIT_L8(0); MMA8(1, 0, At, B0); MMA8(1, 1, At, B1); BAR8; }
  { LDB8(B0, 1, 0); LDA8(At, 1, 0); WAIT_V8(2); BAR8; WAIT_L8(0); MMA8(0, 0, At, B0); BAR8;
    LDB8(B1, 1, 1); WAIT_V8(0); BAR8; WAIT_L8(0); MMA8(0, 1, At, B1); BAR8;
    LDA8(At, 1, 1); BAR8; WAIT_L8(0); MMA8(1, 0, At, B0); MMA8(1, 1, At, B1); BAR8; }
  if (wr == 0) BAR8;
  asm volatile("s_waitcnt lgkmcnt(0)" ::: "memory");
  BAR8;
#undef SA8
#undef SB8
#undef STAGE8
#undef LDA8
#undef LDB8
#undef MMA8
#undef WAIT_V8
#undef WAIT_L8
#undef BAR8
#undef SCHED8
}

DI void fill_rs(float* rs, const float* ssq, int nparts, int pstride, int row0, float invK) {
  const int t = ltid();
  if (t < 256) {
    float r = 1.f;
    if (ssq) {
      float s = 0.f;
      for (int p = 0; p < nparts; ++p) s += ssq[(size_t)p * pstride + row0 + t];
      r = rsqrtf(s * invK + EPSV);
    }
    rs[t] = r;
  }
}

enum { EP_HEADROT = 0, EP_VT, EP_PLAIN, EP_KROPE, EP_NORM128, EP_QB, EP_KVB, EP_RES, EP_MLP1, EP_YTMP, EP_GATE };

struct Tile {
  int epi, row0, cb;
  bf16_t* dst; int ldd;
  const float* gain;
  float* ssq_out;
  const float* xsrc;
  float oscale;
  const bf16_t* ysrc;
  int accum;
};

DI void map_regular(int it, int bid, int NCB, int& rb, int& CB) {
  const int xcd = bid & 7, slot = bid >> 3;
  const int c = xcd * NCB + it;
  const int cgrp = c >> 5, rgrp = c & 31;
  rb = rgrp * 8 + (slot >> 2);
  CB = cgrp * 4 + (slot & 3);
}

template <int DK, int DV, int NM, bool CAUSAL>
DI void attn_block(const bf16_t* __restrict__ Q, int ldq, const bf16_t* __restrict__ Kg, int ldk, const bf16_t* __restrict__ Vt, int ldv,
                   int nkt, int q0, bf16_t* O, int ldo, float sc, float lam, const float* og, float omul, char* smem) {
  constexpr int KW = NM * DK, KCHV = KW / 8;
  constexpr int KBYTES = 64 * 256, VBYTES = DV * 128, STAGE = KBYTES + VBYTES;
  constexpr int NVI = DV / 64;
  constexpr int NLD = 2 + NVI;
  static_assert(KCHV <= 16 && 4 * STAGE <= RS_OFF, "lds");
  constexpr int NKC16 = DK / 16, NDVB = DV / 32;
  const int tid = ltid(), lane = tid & 63, wave = tid >> 6, h = lane >> 5, l31 = lane & 31;
  const int wq = (NM == 2) ? (wave & 3) : wave;
  const int mymap = (NM == 2) ? (wave >> 2) : 0;
  const int q0w = q0 + wq * 32;

  bf16x8 qf[NKC16];
  {
    const bf16_t* qp = Q + (size_t)(wq * 32 + l31) * ldq + mymap * DK + h * 8;
#pragma unroll
    for (int kc = 0; kc < NKC16; ++kc) qf[kc] = *(const bf16x8*)(qp + kc * 16);
#pragma unroll
    for (int kc = 0; kc < NKC16; ++kc) asm volatile("" : "+v"(qf[kc]));
  }
  f32x16 o[NDVB];
#pragma unroll
  for (int d = 0; d < NDVB; ++d)
#pragma unroll
    for (int i = 0; i < 16; ++i) o[d][i] = 0.f;
  f32x16 lacc;
#pragma unroll
  for (int i = 0; i < 16; ++i) lacc[i] = 0.f;
  u4 onesu; onesu.x = onesu.y = onesu.z = onesu.w = 0x3F803F80u;
  const bf16x8 ones = __builtin_bit_cast(bf16x8, onesu);

  const int wu = __builtin_amdgcn_readfirstlane(wave);
  const int krow = lane >> 4, kslot = lane & 15;
  const int vrow = lane >> 3, vslot = lane & 7;
  auto issue = [&](int kt) {
    char* st = smem + (kt & 3) * STAGE;
#pragma unroll
    for (int i = 0; i < 2; ++i) {
      const int r = (wu * 2 + i) * 4 + krow;
      const int c = kslot ^ (r & 15);
      if (KCHV == 16 || c < KCHV)
        __builtin_amdgcn_global_load_lds((const unsigned*)(Kg + (size_t)(kt * 64 + r) * ldk + c * 8), (unsigned*)(st + (wu * 2 + i) * 1024), 16, 0, 0);
    }
#pragma unroll
    for (int i = 0; i < NVI; ++i) {
      const int d = (wu * NVI + i) * 8 + vrow;
      const int c = vslot ^ ((d >> 1) & 7);
      __builtin_amdgcn_global_load_lds((const unsigned*)(Vt + (size_t)d * ldv + kt * 64 + c * 8), (unsigned*)(st + KBYTES + (wu * NVI + i) * 1024), 16, 0, 0);
    }
  };
  asm volatile("s_waitcnt vmcnt(0)" ::: "memory");
  __syncthreads();
  if (0 < nkt) issue(0);
  if (1 < nkt) issue(1);
  if (2 < nkt) issue(2);
  for (int kt = 0; kt < nkt; ++kt) {
    if (kt + 2 < nkt) asm volatile("s_waitcnt vmcnt(%0)" ::"n"(2 * NLD) : "memory");
    else if (kt + 1 < nkt) asm volatile("s_waitcnt vmcnt(%0)" ::"n"(NLD) : "memory");
    else asm volatile("s_waitcnt vmcnt(0)" ::: "memory");
    asm volatile("s_waitcnt lgkmcnt(0)" ::: "memory");
    __builtin_amdgcn_s_barrier();
    if (kt + 3 < nkt) issue(kt + 3);
    const bool skip = CAUSAL && (kt * 64 > q0w + 31);
    if (!skip) {
      const char* base = smem + (kt & 3) * STAGE;
      f32x16 s[2];
#pragma unroll
      for (int sb = 0; sb < 2; ++sb) {
#pragma unroll
        for (int i = 0; i < 16; ++i) s[sb][i] = 0.f;
        const char* pk = base + (sb * 32 + l31) * 256;
#pragma unroll
        for (int kc = 0; kc < NKC16; ++kc) {
          const bf16x8 a = *(const bf16x8*)(pk + (((mymap * (DK / 8) + kc * 2 + h) ^ (l31 & 15)) * 16));
          s[sb] = MFMA(a, qf[kc], s[sb]);
        }
        __builtin_amdgcn_sched_barrier(0);
      }
      const bool need_mask = CAUSAL && (kt * 64 + 63 > q0w);
#pragma unroll
      for (int sb = 0; sb < 2; ++sb)
#pragma unroll
        for (int i = 0; i < 16; ++i) {
          float pz = __builtin_amdgcn_exp2f(s[sb][i]);
          if (need_mask) {
            const int key = kt * 64 + sb * 32 + crow(i, h);
            if (key > q0w + l31) pz = 0.f;
          }
          s[sb][i] = pz;
        }
      const char* pv = base + KBYTES + l31 * 128;
      const int vsw = (l31 >> 1) & 7;
#pragma unroll
      for (int ks = 0; ks < 4; ++ks) {
        u4 pu;
        pu.x = pack2(s[ks >> 1][(ks & 1) * 8 + 0], s[ks >> 1][(ks & 1) * 8 + 1]);
        pu.y = pack2(s[ks >> 1][(ks & 1) * 8 + 2], s[ks >> 1][(ks & 1) * 8 + 3]);
        pu.z = pack2(s[ks >> 1][(ks & 1) * 8 + 4], s[ks >> 1][(ks & 1) * 8 + 5]);
        pu.w = pack2(s[ks >> 1][(ks & 1) * 8 + 6], s[ks >> 1][(ks & 1) * 8 + 7]);
        const bf16x8 pf = __builtin_bit_cast(bf16x8, pu);
        lacc = MFMA(ones, pf, lacc);
#pragma unroll
        for (int d = 0; d < NDVB; ++d) {
          const u4 au = *(const u4*)(pv + d * 32 * 128 + (((ks * 2 + h) ^ vsw) * 16));
          o[d] = MFMA(__builtin_bit_cast(bf16x8, au), pf, o[d]);
        }
        __builtin_amdgcn_sched_barrier(0);
      }
    }
  }
  asm volatile("s_waitcnt lgkmcnt(0)" ::: "memory");
  __builtin_amdgcn_s_barrier();
  const float l_tot = lacc[0];
  const float inv = 1.f / l_tot;
#pragma unroll
  for (int d = 0; d < NDVB; ++d)
#pragma unroll
    for (int i = 0; i < 16; ++i) o[d][i] *= inv;

  float rn_out = 1.f;
  if (NM == 2) {
    float* buf = (float*)smem;
    if (wave >= 4) {
#pragma unroll
      for (int d = 0; d < NDVB; ++d)
#pragma unroll
        for (int i = 0; i < 16; ++i) buf[(d * 16 + i) * 256 + (wave & 3) * 64 + lane] = o[d][i];
    }
    __syncthreads();
    if (wave < 4) {
      float ss = 0.f;
#pragma unroll
      for (int d = 0; d < NDVB; ++d) {
#pragma unroll
        for (int i = 0; i < 16; ++i) {
          const float v = o[d][i] - lam * buf[(d * 16 + i) * 256 + wave * 64 + lane];
          o[d][i] = v;
          ss += v * v;
        }
        __builtin_amdgcn_sched_barrier(0);
      }
      ss += __shfl_xor(ss, 32);
      rn_out = rsqrtf(ss * (1.f / DV) + EPSV) * omul;
    }
  }
  if (NM == 1 || wave < 4) {
    bf16_t* op = O + (size_t)(wq * 32 + l31) * ldo + 4 * h;
#pragma unroll
    for (int d = 0; d < NDVB; ++d)
#pragma unroll
      for (int g = 0; g < 4; ++g) {
        f4 gg = {1.f, 1.f, 1.f, 1.f};
        if (NM == 2) gg = *(const f4*)(og + d * 32 + 8 * g + 4 * h);
        u2 u;
        u.x = pack2(o[d][4 * g + 0] * rn_out * gg.x, o[d][4 * g + 1] * rn_out * gg.y);
        u.y = pack2(o[d][4 * g + 2] * rn_out * gg.z, o[d][4 * g + 3] * rn_out * gg.w);
        *(u2*)(op + d * 32 + 8 * g) = u;
      }
  }
}

DI void prep_tile(const float* __restrict__ src, int N, const float* __restrict__ gain, bf16_t* __restrict__ dst, int Kp, int nmode, int kmode, int kt, int nt, char* smem) {
  float* tile = (float*)smem;
  const int tid = ltid();
  __syncthreads();
  {
    const int n = tid & 63;
    const int np = nt * 64 + n;
    int ns = np; bool nv = true;
    if (nmode == 1) {
      if (np < 3712) ns = np;
      else if (np < 3840) { ns = np; nv = (np < 3744); }
      else if (np < 4352) ns = np - 96;
      else ns = np - 96;
    } else if (nmode == 2) {
      const int hh = np >> 7, j = np & 127;
      nv = j < 96; ns = hh * 96 + j;
    }
#pragma unroll
    for (int j = 0; j < 8; ++j) {
      const int kk = (tid >> 6) + 8 * j;
      const int kp = kt * 64 + kk;
      int ks = kp; bool kv = true;
      if (kmode == 1) { const int hh = kp / 96, jj = kp % 96; kv = jj < 64; ks = hh * 64 + jj; }
      float v = 0.f;
      if (nv && kv) { v = src[(size_t)ks * N + ns]; if (gain) v *= gain[ks]; }
      tile[n * 65 + kk] = v;
    }
  }
  __syncthreads();
  {
    const int n = tid >> 3, kc = tid & 7;
    float v[8];
#pragma unroll
    for (int e = 0; e < 8; ++e) v[e] = tile[n * 65 + kc * 8 + e];
    *(u4*)(dst + (size_t)(nt * 64 + n) * Kp + kt * 64 + kc * 8) = pack8(v);
  }
}

DI void prep_item(const Params& p, int l, int it, char* smem) {
  bf16_t* W = (bf16_t*)(p.ws + OFF_W);
  const float* src; const float* gain = nullptr; bf16_t* dst; int N, Kp, nmode = 0, kmode = 0, nkt, loc;
  if (it < 1856)      { loc = it;        src = p.in[4] + (size_t)l * 1024 * 7328; N = 7328; gain = p.in[3] + l * 1024; dst = W + W_IN; Kp = 1024; nmode = 1; nkt = 16; }
  else if (it < 2112) { loc = it - 1856; src = p.in[19] + (size_t)l * 1024 * 1024; N = 1024; gain = p.in[18] + l * 1024; dst = W + W_MEM; Kp = 1024; nkt = 16; }
  else if (it < 2208) { loc = it - 2112; src = p.in[12] + (size_t)l * 384 * 768; N = 768; gain = p.in[11] + l * 384; dst = W + W_QB; Kp = 384; nmode = 2; nkt = 6; }
  else if (it < 2272) { loc = it - 2208; src = p.in[14] + (size_t)l * 256 * 1024; N = 1024; gain = p.in[13] + l * 256; dst = W + W_KVB; Kp = 256; nkt = 4; }
  else if (it < 2528) { loc = it - 2272; src = p.in[10] + (size_t)l * 1024 * 1024; N = 1024; dst = W + W_DO; Kp = 1024; nkt = 16; }
  else if (it < 2720) { loc = it - 2528; src = p.in[17] + (size_t)l * 512 * 1024; N = 1024; dst = W + W_MO; Kp = 768; kmode = 1; nkt = 12; }
  else if (it < 2848) { loc = it - 2720; src = p.in[22] + (size_t)l * 512 * 1024; N = 1024; dst = W + W_CO; Kp = 512; nkt = 8; }
  else if (it < 3104) { loc = it - 2848; src = p.in[23] + (size_t)l * 1024 * 1024; N = 1024; dst = W + W_OUT; Kp = 1024; nkt = 16; }
  else if (it < 4128) { loc = it - 3104; src = p.in[25] + (size_t)l * 1024 * 4096; N = 4096; gain = p.in[24] + l * 1024; dst = W + W_1; Kp = 1024; nkt = 16; }
  else                { loc = it - 4128; src = p.in[26] + (size_t)l * 4096 * 1024; N = 1024; dst = W + W_2; Kp = 4096; nkt = 64; }
  prep_tile(src, N, gain, dst, Kp, nmode, kmode, loc % nkt, loc / nkt, smem);
}
DI void prep_range(const Params& p, int l, int lo, int hi, char* smem) {
  for (int it = lo + blockIdx.x; it < hi; it += gridDim.x) prep_item(p, l, it, smem);
}

DI void phase_init(const Params& p) {
  const int tid_ = ltid(); const int lane = tid_ & 63, gw = blockIdx.x * 8 + (tid_ >> 6), GW = gridDim.x * 8;
  bf16_t* XB = (bf16_t*)(p.ws + OFF_XB); bf16_t* MB = (bf16_t*)(p.ws + OFF_MEMB);
  float* SX = (float*)(p.ws + OFF_SSQX); float* SM = (float*)(p.ws + OFF_SSQMEM);
  for (int r = gw; r < T + MEMR; r += GW) {
    const bool isx = r < T;
    const float* src = isx ? p.in[0] + (size_t)r * 1024 : p.in[1] + (size_t)(r - T) * 1024;
    bf16_t* dst = isx ? XB + (size_t)r * 1024 : MB + (size_t)(r - T) * 1024;
    float ss = 0.f;
#pragma unroll
    for (int j = 0; j < 4; ++j) {
      const f4 v = *(const f4*)(src + j * 256 + lane * 4);
      ss += v.x * v.x + v.y * v.y + v.z * v.z + v.w * v.w;
      u2 u; u.x = pack2(v.x, v.y); u.y = pack2(v.z, v.w);
      *(u2*)(dst + j * 256 + lane * 4) = u;
    }
#pragma unroll
    for (int m = 32; m >= 1; m >>= 1) ss += __shfl_xor(ss, m);
    if (isx) { if (lane < 8) SX[(size_t)lane * T + r] = (lane == 0) ? ss : 0.f; }
    else if (lane == 0) SM[r - T] = ss;
  }
}

DI void run_epilogue(const Params& p, const Tile& t, char* smem) {
  float* Cs = (float*)smem;
  float* rs = (float*)(smem + RS_OFF);
  const int tid = ltid();
  const int q = tid & 15, rsub = tid >> 4;
  const int* pos = (const int*)p.in[2];
  if (t.epi == EP_VT) {
    const int c = tid >> 2, rq = tid & 3;
#pragma unroll
    for (int j = 0; j < 8; ++j) {
      float v[8];
#pragma unroll
      for (int e = 0; e < 8; ++e) { const int r = rq * 64 + j * 8 + e; v[e] = Cs[r * CS_LD + c] * rs[r]; }
      bf16_t* d16 = t.dst + (size_t)c * t.ldd + rq * 64 + (j >> 1) * 16;
      u2 lo, hi; lo.x = pack2(v[0], v[1]); lo.y = pack2(v[2], v[3]); hi.x = pack2(v[4], v[5]); hi.y = pack2(v[6], v[7]);
      *(u2*)(d16 + ((j & 1) ? 4 : 0)) = lo;
      *(u2*)(d16 + ((j & 1) ? 12 : 8)) = hi;
    }
    return;
  }
#pragma unroll 1
  for (int pass = 0; pass < 8; ++pass) {
    const int r = rsub + 32 * pass;
    const int row = t.row0 + r;
    float v[8];
    load8(Cs, r, q, v);
    const float rsv = rs[r];
#pragma unroll
    for (int e = 0; e < 8; ++e) v[e] *= rsv;
    switch (t.epi) {
      case EP_HEADROT: {
        float ss = 0.f;
#pragma unroll
        for (int e = 0; e < 8; ++e) ss += v[e] * v[e];
        ss += __shfl_xor(ss, 1); ss += __shfl_xor(ss, 2); ss += __shfl_xor(ss, 4);
        const float rn = rsqrtf(ss * (1.f / 64) + EPSV);
        const int pp = q & 7; const bool first = pp < 4; const int i0 = (pp & 3) * 8;
        const int ps = pos[row];
        float ov[8];
#pragma unroll
        for (int e = 0; e < 8; ++e) {
          const float y = v[e] * rn * t.gain[pp * 8 + e];
          const float yp = __shfl_xor(y, 4);
          float c, s; rot_cs(ps, INVF64[i0 + e], c, s);
          ov[e] = (first ? (y * c - yp * s) : (y * c + yp * s)) * t.oscale;
        }
        *(u4*)(t.dst + (size_t)row * t.ldd + t.cb * 128 + q * 8) = pack8(ov);
      } break;
      case EP_PLAIN: {
        float ss = 0.f;
#pragma unroll
        for (int e = 0; e < 8; ++e) ss += v[e] * v[e];
        ss += __shfl_xor(ss, 1); ss += __shfl_xor(ss, 2); ss += __shfl_xor(ss, 4); ss += __shfl_xor(ss, 8);
        *(u4*)(t.dst + (size_t)row * t.ldd + t.cb * 128 + q * 8) = pack8(v);
        if (q == 0) t.ssq_out[row] = ss;
      } break;
      case EP_KROPE: {
        const bool first = (q & 2) == 0; const int i0 = (q & 1) * 8;
        const int ps = pos[row];
        float ov[8];
#pragma unroll
        for (int e = 0; e < 8; ++e) {
          const float yp = __shfl_xor(v[e], 2);
          float c, s; rot_cs(ps, INVF32[i0 + e], c, s);
          ov[e] = first ? (v[e] * c - yp * s) : (v[e] * c + yp * s);
        }
        if (q < 4) {
          float* kr = (float*)(p.ws + OFF_KR) + (size_t)row * 32 + q * 8;
          *(f4*)kr = f4{ov[0], ov[1], ov[2], ov[3]};
          *(f4*)(kr + 4) = f4{ov[4], ov[5], ov[6], ov[7]};
        }
      } break;
      case EP_NORM128: {
        float ss = 0.f;
#pragma unroll
        for (int e = 0; e < 8; ++e) ss += v[e] * v[e];
        ss += __shfl_xor(ss, 1); ss += __shfl_xor(ss, 2); ss += __shfl_xor(ss, 4); ss += __shfl_xor(ss, 8);
        const float rn = rsqrtf(ss * (1.f / 128) + EPSV);
#pragma unroll
        for (int e = 0; e < 8; ++e) v[e] *= rn * t.oscale * t.gain[q * 8 + e];
        *(u4*)(t.dst + (size_t)row * t.ldd + t.cb * 128 + q * 8) = pack8(v);
      } break;
      case EP_QB: {
        const bool isr = (q >= 8 && q < 12);
        const bool first = (q & 2) == 0; const int i0 = (q & 1) * 8;
        const int ps = pos[row];
        float ss = 0.f;
#pragma unroll
        for (int e = 0; e < 8; ++e) {
          const float yp = __shfl_xor(v[e], 2);
          float c, s; rot_cs(ps, INVF32[i0 + e], c, s);
          const float rv = first ? (v[e] * c - yp * s) : (v[e] * c + yp * s);
          v[e] = isr ? rv : v[e];
          ss += v[e] * v[e];
        }
        ss += __shfl_xor(ss, 1); ss += __shfl_xor(ss, 2); ss += __shfl_xor(ss, 4); ss += __shfl_xor(ss, 8);
        const float rn = rsqrtf(ss * (1.f / 96) + EPSV);
        if (q < 12) {
#pragma unroll
          for (int e = 0; e < 8; ++e) v[e] *= rn * t.oscale * t.gain[q * 8 + e];
          *(u4*)(t.dst + (size_t)row * 768 + t.cb * 96 + q * 8) = pack8(v);
        }
      } break;
      case EP_KVB: {
        if (q >= 8) {
          if (q < 12) {
            const float* kr = (const float*)(p.ws + OFF_KR) + (size_t)row * 32 + (q - 8) * 8;
            const f4 a = *(const f4*)kr, b = *(const f4*)(kr + 4);
            v[0] = a.x; v[1] = a.y; v[2] = a.z; v[3] = a.w; v[4] = b.x; v[5] = b.y; v[6] = b.z; v[7] = b.w;
          } else {
#pragma unroll
            for (int e = 0; e < 8; ++e) v[e] = 0.f;
          }
        }
        float ss = 0.f;
#pragma unroll
        for (int e = 0; e < 8; ++e) ss += v[e] * v[e];
        ss += __shfl_xor(ss, 1); ss += __shfl_xor(ss, 2); ss += __shfl_xor(ss, 4); ss += __shfl_xor(ss, 8);
        const float rn = rsqrtf(ss * (1.f / 96) + EPSV);
        if (q < 12) {
#pragma unroll
          for (int e = 0; e < 8; ++e) v[e] *= rn * t.oscale * t.gain[q * 8 + e];
          *(u4*)(t.dst + (size_t)row * 768 + t.cb * 96 + q * 8) = pack8(v);
        }
      } break;
      case EP_RES: {
        const float* xs = t.xsrc + (size_t)row * 1024 + t.cb * 128 + q * 8;
        const f4 a = *(const f4*)xs, b = *(const f4*)(xs + 4);
        v[0] += a.x; v[1] += a.y; v[2] += a.z; v[3] += a.w; v[4] += b.x; v[5] += b.y; v[6] += b.z; v[7] += b.w;
        float ss = 0.f;
#pragma unroll
        for (int e = 0; e < 8; ++e) ss += v[e] * v[e];
        ss += __shfl_xor(ss, 1); ss += __shfl_xor(ss, 2); ss += __shfl_xor(ss, 4); ss += __shfl_xor(ss, 8);
        float* xo = p.out + (size_t)row * 1024 + t.cb * 128 + q * 8;
        *(f4*)xo = f4{v[0], v[1], v[2], v[3]};
        *(f4*)(xo + 4) = f4{v[4], v[5], v[6], v[7]};
        *(u4*)(t.dst + (size_t)row * 1024 + t.cb * 128 + q * 8) = pack8(v);
        if (q == 0) t.ssq_out[row] = ss;
      } break;
      case EP_YTMP: {
        *(u4*)(t.dst + (size_t)r * 256 + t.cb * 128 + q * 8) = pack8(v);
      } break;
      case EP_GATE: {
        const u4 yu = *(const u4*)(t.ysrc + (size_t)r * 256 + q * 8);
        const f4 ba = *(const f4*)(t.gain + q * 8), bb = *(const f4*)(t.gain + q * 8 + 4);
        bf16_t* mp_ = t.dst + (size_t)row * 1024 + t.cb * 128 + q * 8;
        u4 mu; mu.x = mu.y = mu.z = mu.w = 0u;
        if (t.accum) mu = *(const u4*)mp_;
        const float bs[8] = {ba.x, ba.y, ba.z, ba.w, bb.x, bb.y, bb.z, bb.w};
        const unsigned yw[4] = {yu.x, yu.y, yu.z, yu.w}, mw[4] = {mu.x, mu.y, mu.z, mu.w};
#pragma unroll
        for (int e = 0; e < 8; ++e) {
          const float g = 1.f / (1.f + __expf(-(v[e] + bs[e])));
          const float y = __uint_as_float((e & 1) ? (yw[e >> 1] & 0xffff0000u) : (yw[e >> 1] << 16));
          const float m = __uint_as_float((e & 1) ? (mw[e >> 1] & 0xffff0000u) : (mw[e >> 1] << 16));
          v[e] = m + g * y;
        }
        *(u4*)mp_ = pack8(v);
      } break;
      case EP_MLP1: {
#pragma unroll
        for (int e = 0; e < 8; ++e) { const float u = fmaxf(v[e], 0.f); v[e] = u * u; }
        *(u4*)(t.dst + (size_t)row * t.ldd + t.cb * 128 + q * 8) = pack8(v);
      } break;
      default: break;
    }
  }
  if (t.epi == EP_KVB) {
    bf16_t* VMT = (bf16_t*)(p.ws + OFF_VMT);
    const int c = tid >> 3, r8 = tid & 7;
    const int b = t.row0 >> 11, s0 = t.row0 & 2047;
    bf16_t* d = VMT + ((size_t)(b * 512 + t.cb * 64 + c)) * SEQ + s0 + r8 * 32;
#pragma unroll
    for (int j = 0; j < 4; ++j) {
      float v[8];
#pragma unroll
      for (int e = 0; e < 8; ++e) { const int r = r8 * 32 + j * 8 + e; v[e] = Cs[r * CS_LD + 64 + c] * rs[r]; }
      bf16_t* d16 = d + (j >> 1) * 16;
      u2 lo, hi; lo.x = pack2(v[0], v[1]); lo.y = pack2(v[2], v[3]); hi.x = pack2(v[4], v[5]); hi.y = pack2(v[6], v[7]);
      *(u2*)(d16 + ((j & 1) ? 4 : 0)) = lo;
      *(u2*)(d16 + ((j & 1) ? 12 : 8)) = hi;
    }
  }
}

__global__ void __launch_bounds__(NTHR) mega_fwd(Params p) {
  __shared__ __attribute__((aligned(16))) char smem[LDS_BYTES];
  cg::grid_group grid = cg::this_grid();
  const int G = gridDim.x, bid = blockIdx.x;
  for (int ph = p.ph_lo; ph < p.ph_hi; ++ph) {
      char* ws = p.ws; asm volatile("" : "+s"(ws));
    bf16_t* XB = (bf16_t*)(ws + OFF_XB);   bf16_t* QD = (bf16_t*)(ws + OFF_QD);   bf16_t* KD = (bf16_t*)(ws + OFF_KD);
    bf16_t* VDT = (bf16_t*)(ws + OFF_VDT); bf16_t* CQ = (bf16_t*)(ws + OFF_CQ);   bf16_t* CKV = (bf16_t*)(ws + OFF_CKV);
    bf16_t* XQ = (bf16_t*)(ws + OFF_XQ);   bf16_t* QM = (bf16_t*)(ws + OFF_QM);   bf16_t* KM = (bf16_t*)(ws + OFF_KM);
    bf16_t* VMT = (bf16_t*)(ws + OFF_VMT); bf16_t* MEMB = (bf16_t*)(ws + OFF_MEMB); bf16_t* KC = (bf16_t*)(ws + OFF_KC);
    bf16_t* VCT = (bf16_t*)(ws + OFF_VCT); bf16_t* W = (bf16_t*)(ws + OFF_W);     bf16_t* U = (bf16_t*)(ws + OFF_U);
    bf16_t* MERGED = KD;
    float* SSQX = (float*)(ws + OFF_SSQX); float* SSQCQ = (float*)(ws + OFF_SSQCQ); float* SSQCKV = (float*)(ws + OFF_SSQCKV);
    float* SSQMEM = (float*)(ws + OFF_SSQMEM);

    if (ph == 0) {
      phase_init(p);
      prep_range(p, 0, 0, 5152, smem);
    } else {
      const int l = (ph - 1) / p.per, kr = (ph - 1) % p.per;
      const int k = (kr > p.dupk) ? kr - (p.per - 7) : kr;
#ifndef NO_GEMM
      if (k == 0 || k == 1 || k == 3 || k == 4 || k == 5 || k == 6) {
        int nits = 0, total = 0;
        if (k == 0) { nits = 18; total = 4480; if (l > 0) prep_range(p, l, 4128, 5152, smem); }
        else if (k == 1) { nits = 8; total = 2048; }
        else if (k == 3) { nits = 24; total = 1024; }
        else if (k == 4) { nits = 4; total = 1024; }
        else if (k == 5) { nits = 16; total = 4096; if (l + 1 < NL) prep_range(p, l + 1, 0, 3104, smem); }
        else { nits = 4; total = 1024; if (l + 1 < NL) prep_range(p, l + 1, 3104, 4128, smem); }
        const bool xmap = (G == 256);
        if (!xmap) nits = ((total + G - 1) / G) * ((k == 3) ? 6 : 1);
#pragma unroll 1
        for (int it = 0; it < nits; ++it) {
          int list = 0, rb = -1, CB = 0;
          if (xmap) {
            if (k == 0) {
              if (it < 16) map_regular(it, bid, 16, rb, CB);
              else if (it == 16) { rb = bid; CB = 16; }
              else if (bid < 128) { list = 1; rb = bid >> 2; CB = bid & 3; }
            } else if (k == 1) { list = it >> 2; map_regular(it & 3, bid, 4, rb, CB); }
            else if (k == 3) map_regular(it / 6, bid, 4, rb, CB);
            else if (k == 5) map_regular(it, bid, 16, rb, CB);
            else map_regular(it, bid, 4, rb, CB);
          } else {
            const int li = ((k == 3) ? (it / 6) : it) * G + bid;
            if (li < total) {
              if (k == 0) { if (li < 4352) { rb = li / 17; CB = li % 17; } else { list = 1; rb = (li - 4352) >> 2; CB = (li - 4352) & 3; } }
              else if (k == 1) { list = li >> 10; rb = (li & 1023) >> 2; CB = li & 3; }
              else if (k == 5) { rb = li >> 4; CB = li & 15; }
              else { rb = li >> 2; CB = li & 3; }
            }
          }
          if (rb < 0) continue;
          const int row0 = rb * 256;
          const bf16_t* Ap; const bf16_t* Bp; int lda, Kd;
          const float* ssq = nullptr; int nparts = 0, pstride = T; float invK = 0.f;
          if (k == 0) {
            if (list == 0) { Ap = XB + (size_t)row0 * 1024; lda = 1024; Bp = W + W_IN + (size_t)CB * 256 * 1024; Kd = 1024; ssq = SSQX; nparts = 8; invK = 1.f / 1024; }
            else           { Ap = MEMB + (size_t)row0 * 1024; lda = 1024; Bp = W + W_MEM + (size_t)CB * 256 * 1024; Kd = 1024; ssq = SSQMEM; nparts = 1; pstride = 0; invK = 1.f / 1024; }
          } else if (k == 1) {
            if (list == 0) { Ap = CQ + (size_t)row0 * 384; lda = 384; Bp = W + W_QB + (size_t)CB * 256 * 384; Kd = 384; ssq = SSQCQ; nparts = 3; invK = 1.f / 384; }
            else           { Ap = CKV + (size_t)row0 * 256; lda = 256; Bp = W + W_KVB + (size_t)CB * 256 * 256; Kd = 256; ssq = SSQCKV; nparts = 2; invK = 1.f / 256; }
          } else if (k == 3) {
            const int st = it % 6, br = st >> 1;
            if (st & 1)       { Ap = XB + (size_t)row0 * 1024; lda = 1024; Bp = W + W_IN + (size_t)(WIN_GATE0 + br * 1024 + CB * 256) * 1024; Kd = 1024; ssq = SSQX; nparts = 8; invK = 1.f / 1024; }
            else if (br == 0) { Ap = QD + (size_t)row0 * 1024; lda = 1024; Bp = W + W_DO + (size_t)CB * 256 * 1024; Kd = 1024; }
            else if (br == 1) { Ap = QM + (size_t)row0 * 768;  lda = 768;  Bp = W + W_MO + (size_t)CB * 256 * 768;  Kd = 768; }
            else              { Ap = XQ + (size_t)row0 * 512;  lda = 512;  Bp = W + W_CO + (size_t)CB * 256 * 512;  Kd = 512; }
          } else if (k == 4) { Ap = MERGED + (size_t)row0 * 1024; lda = 1024; Bp = W + W_OUT + (size_t)CB * 256 * 1024; Kd = 1024; }
          else if (k == 5)   { Ap = XB + (size_t)row0 * 1024; lda = 1024; Bp = W + W_1 + (size_t)CB * 256 * 1024; Kd = 1024; ssq = SSQX; nparts = 8; invK = 1.f / 1024; }
          else               { Ap = U + (size_t)row0 * 4096; lda = 4096; Bp = W + W_2 + (size_t)CB * 256 * 4096; Kd = 4096; }
          f32x4v acc[2][2][4][2];
          gemm8p(Ap, Bp, Kd, acc, smem);
          float* Cs = (float*)smem;
#pragma unroll 1
          for (int half = 0; half < 2; ++half) {
            if (half) __syncthreads();
            {
              const int tq = ltid(); const int lane = tq & 63, wave = tq >> 6, wr = wave >> 2, wc = wave & 3, fr = lane & 15, fq = lane >> 4;
#pragma unroll
              for (int ai = 0; ai < 2; ++ai)
#pragma unroll
                for (int m = 0; m < 4; ++m)
#pragma unroll
                  for (int n = 0; n < 2; ++n)
#pragma unroll
                    for (int j = 0; j < 4; ++j)
                      Cs[(ai * 128 + wr * 64 + m * 16 + fq * 4 + j) * CS_LD + wc * 32 + n * 16 + fr] = half ? acc[ai][1][m][n][j] : acc[ai][0][m][n][j];
            }
            if (half == 0) fill_rs((float*)(smem + RS_OFF), ssq, nparts, pstride, row0, invK);
            __syncthreads();
            const int cb = CB * 2 + half;
            Tile t;
            t.row0 = row0; t.cb = cb; t.epi = EP_PLAIN;
            t.dst = nullptr; t.ldd = 0; t.gain = nullptr; t.ssq_out = nullptr; t.xsrc = nullptr; t.oscale = 1.f; t.ysrc = nullptr; t.accum = 0;
            if (k == 0) {
              if (list == 0) {
                if (cb < 8)       { t.epi = EP_HEADROT; t.cb = cb; t.dst = QD; t.ldd = 1024; t.gain = p.in[6] + l * 64; t.oscale = 0.125f * 1.4426950408889634f; }
                else if (cb < 16) { t.epi = EP_HEADROT; t.cb = cb - 8; t.dst = KD; t.ldd = 1024; t.gain = p.in[7] + l * 64; }
                else if (cb < 24) { t.epi = EP_VT; t.cb = cb - 16; const int b = row0 >> 11, s0 = row0 & 2047; t.dst = VDT + ((size_t)(b * 1024 + (cb - 16) * 128)) * SEQ + s0; t.ldd = SEQ; }
                else if (cb < 27) { t.epi = EP_PLAIN; t.cb = cb - 24; t.dst = CQ; t.ldd = 384; t.ssq_out = SSQCQ + (size_t)(cb - 24) * T; }
                else if (cb < 29) { t.epi = EP_PLAIN; t.cb = cb - 27; t.dst = CKV; t.ldd = 256; t.ssq_out = SSQCKV + (size_t)(cb - 27) * T; }
                else if (cb == 29) { t.epi = EP_KROPE; t.cb = 0; }
                else              { t.epi = EP_NORM128; t.cb = cb - 30; t.dst = XQ; t.ldd = 512; t.gain = p.in[20] + l * 128; t.oscale = 0.08838834764831845f * 1.4426950408889634f; }
              } else {
                if (cb < 4) { t.epi = EP_NORM128; t.cb = cb; t.dst = KC; t.ldd = 512; t.gain = p.in[21] + l * 128; }
                else        { t.epi = EP_VT; t.cb = cb - 4; t.dst = VCT + ((size_t)(rb * 512 + (cb - 4) * 128)) * MEML; t.ldd = MEML; }
              }
            } else if (k == 1) {
              if (list == 0) { t.epi = EP_QB; t.dst = QM; t.gain = p.in[15] + l * 96; t.oscale = 0.10206207261596575f * 1.4426950408889634f; }
              else           { t.epi = EP_KVB; t.dst = KM; t.gain = p.in[16] + l * 96; }
            } else if (k == 3) {
              const int st = it % 6, br = st >> 1;
              bf16_t* YS = VDT + (size_t)blockIdx.x * 65536;
              if (st & 1) { t.epi = EP_GATE; t.dst = MERGED; t.ysrc = YS + half * 128; t.gain = p.in[5] + (size_t)l * 3072 + br * 1024 + cb * 128; t.accum = (br > 0); }
              else        { t.epi = EP_YTMP; t.dst = YS; t.cb = half; }
            } else if (k == 4) { t.epi = EP_RES; t.dst = XB; t.xsrc = (l == 0) ? p.in[0] : p.out; t.ssq_out = SSQX + (size_t)cb * T; }
            else if (k == 5)   { t.epi = EP_MLP1; t.dst = U; t.ldd = 4096; }
            else               { t.epi = EP_RES; t.dst = XB; t.xsrc = p.out; t.ssq_out = SSQX + (size_t)cb * T; }
            run_epilogue(p, t, smem);
          }
        }
      } else
#endif
#ifndef NO_ATT
      if (k == 2) {
        float lam;
        const float lam_init = 0.8f - 0.6f * expf(-0.3f * (float)l);
        {
          const int lane = ltid() & 63;
          const float* lv = p.in[8] + l * 256;
          float sa = lv[lane] * lv[64 + lane], sb = lv[128 + lane] * lv[192 + lane];
#pragma unroll
          for (int m = 32; m >= 1; m >>= 1) { sa += __shfl_xor(sa, m); sb += __shfl_xor(sb, m); }
          lam = expf(sa) - expf(sb) + lam_init;
        }
        const float L2E = 1.4426950408889634f;
#pragma unroll 1
        for (int it = 0; it < ((G == 256) ? 16 : (4096 + G - 1) / G); ++it) {
          int w;
          if (G == 256) {
            const int xcd = bid & 7, slot = bid >> 3;
            if (it < 8)       w = ((it * 32 + (slot >> 3) * 8 + xcd) << 3) + (slot & 7);
            else if (it < 12) w = 2048 + ((((it - 8) * 64 + (slot >> 2) * 8 + xcd) << 2) + (slot & 3));
            else              w = 3072 + ((((it - 12) * 32 + (slot >> 3) * 8 + xcd) << 3) + (slot & 7));
          } else { w = it * G + bid; if (w >= 4096) continue; }
#ifndef NO_A1
          if (w < 2048) {
            const int bh = w >> 3, j = w & 7, b = bh >> 3, hh = bh & 7;
#pragma unroll 1
            for (int half = 0; half < 2; ++half) {
              const int qb = half ? j : 15 - j;
              const int q0 = qb * 128;
              bf16_t* Qp = QD + ((size_t)(b * SEQ + q0)) * 1024 + hh * 128;
              attn_block<64, 128, 2, true>(Qp, 1024, KD + (size_t)b * SEQ * 1024 + hh * 128, 1024, VDT + ((size_t)(b * 1024 + hh * 128)) * SEQ, SEQ,
                                            (q0 + 128) >> 6, q0, Qp, 1024, 0.125f * L2E, lam, p.in[9] + l * 128, 1.f - lam_init, smem);
            }
          } else
#endif
#ifndef NO_A2
          if (w < 3072) {
            const int wj = w - 2048; const int bh = wj >> 2, j = wj & 3, b = bh >> 3, hh = bh & 7;
#pragma unroll 1
            for (int half = 0; half < 2; ++half) {
              const int qb = half ? j : 7 - j;
              const int q0 = qb * 256;
              bf16_t* Qp = QM + ((size_t)(b * SEQ + q0)) * 768 + hh * 96;
              attn_block<96, 64, 1, true>(Qp, 768, KM + (size_t)b * SEQ * 768 + hh * 96, 768, VMT + ((size_t)(b * 512 + hh * 64)) * SEQ, SEQ,
                                           (q0 + 256) >> 6, q0, Qp, 768, 0.10206207261596575f * L2E, 0.f, nullptr, 1.f, smem);
            }
          } else
#endif
#ifndef NO_A3
          {
            const int wj = w - 3072; const int bh = wj >> 3, qb = wj & 7, b = bh >> 2, hh = bh & 3;
            const int q0 = qb * 256;
            bf16_t* Qp = XQ + ((size_t)(b * SEQ + q0)) * 512 + hh * 128;
            attn_block<128, 128, 1, false>(Qp, 512, KC + (size_t)b * MEML * 512 + hh * 128, 512, VCT + ((size_t)(b * 512 + hh * 128)) * MEML, MEML,
                                            4, q0, Qp, 512, 0.08838834764831845f * L2E, 0.f, nullptr, 1.f, smem);
          }
#endif
          {}
        }
      } else
#endif
#ifndef NO_D
      if (k == 3) {
        float* Cs = (float*)smem;
        float* rs = (float*)(smem + RS_OFF);
#pragma unroll 1
        for (int it = 0; it < ((G == 256) ? 8 : (2048 + G - 1) / G); ++it) {
          int rb, cb;
          if (G == 256) map_regular(it, bid, 8, rb, cb);
          else { const int li = it * G + bid; if (li >= 2048) continue; rb = li >> 3; cb = li & 7; }
          const int tidd = ltid(); const int lane = tidd & 63, wave = tidd >> 6, wm = wave >> 1, wn = wave & 1, h = lane >> 5;
          const int row0 = rb * 256, col0 = cb * 128;
          __syncthreads();
          fill_rs(rs, SSQX, 8, T, row0, 1.f / 1024);
          f32x16 acc[2][2];
          unsigned gp[2][2][8], mp[2][2][8];
#pragma unroll
          for (int mi = 0; mi < 2; ++mi)
#pragma unroll
            for (int ni = 0; ni < 2; ++ni)
#pragma unroll
              for (int i = 0; i < 8; ++i) mp[mi][ni][i] = 0u;
#pragma unroll 1
          for (int st = 0; st < 6; ++st) {
            const int br = st >> 1, half = st & 1;
            const bf16_t* Ab; const bf16_t* Bb; int Kb;
            if (half == 0)    { Ab = XB + (size_t)row0 * 1024; Bb = W + W_IN + (size_t)(WIN_GATE0 + br * 1024 + col0) * 1024; Kb = 1024; }
            else if (br == 0) { Ab = QD + (size_t)row0 * 1024; Bb = W + W_DO + (size_t)col0 * 1024; Kb = 1024; }
            else if (br == 1) { Ab = QM + (size_t)row0 * 768;  Bb = W + W_MO + (size_t)col0 * 768;  Kb = 768; }
            else              { Ab = XQ + (size_t)row0 * 512;  Bb = W + W_CO + (size_t)col0 * 512;  Kb = 512; }
            gemm_mainloop<2, 2, 2, false>(Ab, Kb, Bb, Kb, Kb, acc, smem);
            if (half == 0) {
              const float* bg = p.in[5] + (size_t)l * 3072 + br * 1024 + col0 + wn * 64 + (lane & 31);
              const float bgv0 = bg[0], bgv1 = bg[32];
#pragma unroll
              for (int mi = 0; mi < 2; ++mi) {
                float rsv[16];
#pragma unroll
                for (int i = 0; i < 16; ++i) rsv[i] = rs[wm * 64 + mi * 32 + crow(i, h)];
#pragma unroll
                for (int ni = 0; ni < 2; ++ni) {
                  const float bgv = ni ? bgv1 : bgv0;
#pragma unroll
                  for (int i = 0; i < 16; i += 2) {
                    const float z0 = acc[mi][ni][i] * rsv[i] + bgv;
                    const float z1 = acc[mi][ni][i + 1] * rsv[i + 1] + bgv;
                    gp[mi][ni][i >> 1] = pack2(1.f / (1.f + __expf(-z0)), 1.f / (1.f + __expf(-z1)));
                  }
                }
                __builtin_amdgcn_sched_barrier(0);
              }
            } else {
#pragma unroll
              for (int mi = 0; mi < 2; ++mi)
#pragma unroll
                for (int ni = 0; ni < 2; ++ni)
#pragma unroll
                  for (int i = 0; i < 16; i += 2) {
                    const unsigned g2 = gp[mi][ni][i >> 1], m2 = mp[mi][ni][i >> 1];
                    const float m0 = __uint_as_float(m2 << 16) + __uint_as_float(g2 << 16) * acc[mi][ni][i];
                    const float m1 = __uint_as_float(m2 & 0xffff0000u) + __uint_as_float(g2 & 0xffff0000u) * acc[mi][ni][i + 1];
                    mp[mi][ni][i >> 1] = pack2(m0, m1);
                  }
            }
          }
#pragma unroll
          for (int mi = 0; mi < 2; ++mi)
#pragma unroll
            for (int ni = 0; ni < 2; ++ni)
#pragma unroll
              for (int i = 0; i < 16; ++i) {
                const unsigned m2 = mp[mi][ni][i >> 1];
                Cs[(wm * 64 + mi * 32 + crow(i, h)) * CS_LD + wn * 64 + ni * 32 + (lane & 31)] = __uint_as_float((i & 1) ? (m2 & 0xffff0000u) : (m2 << 16));
              }
          __syncthreads();
          const int q = tidd & 15, rsub = tidd >> 4;
#pragma unroll 1
          for (int pass = 0; pass < 8; ++pass) {
            const int r = rsub + 32 * pass;
            float v[8];
            load8(Cs, r, q, v);
            *(u4*)(MERGED + (size_t)(row0 + r) * 1024 + col0 + q * 8) = pack8(v);
          }
        }
      }
#endif
      {}
    }
    if (ph + 1 < p.ph_hi) grid.sync();
  }
}

extern "C" void kernel_launch(void* const* d_in, const int* in_sizes, int n_in, void* d_out, int out_size, void* d_ws, size_t ws_size, hipStream_t stream) {
  static int grid_blocks = 0;
  if (grid_blocks == 0) {
    if (n_in != 27 || ws_size < WS_NEED) { fprintf(stderr, "kernel_launch: unexpected inputs (n_in %d) or workspace (%zu < %zu)\n", n_in, ws_size, (size_t)WS_NEED); grid_blocks = -1; return; }
    int dev = 0, cus = 0, per_cu = 0;
    hipGetDevice(&dev);
    hipDeviceGetAttribute(&cus, hipDeviceAttributeMultiprocessorCount, dev);
    hipOccupancyMaxActiveBlocksPerMultiprocessor(&per_cu, mega_fwd, NTHR, 0);
    if (per_cu < 1) per_cu = 1;
    if (per_cu > 1) per_cu = 1;
    grid_blocks = cus * per_cu;
  }
  if (grid_blocks < 0) return;
  Params p{};
  for (int i = 0; i < 27; ++i) p.in[i] = (const float*)d_in[i];
  p.out = (float*)d_out;
  p.ws = (char*)d_ws;
  p.ph_lo = 0;
  p.dupk = (DUP_K >= 0) ? DUP_K : 100;
  p.per = (DUP_K >= 0) ? 8 : 7;
  p.ph_hi = 1 + NL * p.per;
  void* args[] = {&p};
  hipError_t e = hipLaunchCooperativeKernel((void*)mega_fwd, dim3(grid_blocks), dim3(NTHR), args, 0, stream);
  if (e != hipSuccess) fprintf(stderr, "cooperative launch failed: %s (grid %d)\n", hipGetErrorString(e), grid_blocks);
}
```

```cpp
#include <hip/hip_runtime.h>
#include <hip/hip_cooperative_groups.h>
#include <stdint.h>
#include <stdio.h>
#define NO_D 1
namespace cg = cooperative_groups;

typedef unsigned short bf16_t;
using bf16x8 = __attribute__((ext_vector_type(8))) short;
using f32x16 = __attribute__((ext_vector_type(16))) float;
typedef unsigned u4 __attribute__((ext_vector_type(4)));
typedef unsigned u2 __attribute__((ext_vector_type(2)));
typedef float f4 __attribute__((ext_vector_type(4)));
#define DI __device__ __forceinline__
#define MFMA(a, b, c) __builtin_amdgcn_mfma_f32_32x32x16_bf16((a), (b), (c), 0, 0, 0)

constexpr int T = 65536, DM = 1024, NB = 32, SEQ = 2048, NL = 4, MEML = 256, MEMR = NB * MEML;
constexpr int NTHR = 512;
constexpr int DUP_K = -1;
constexpr float EPSV = 1e-6f;
constexpr int WIN_N = 7424;
constexpr int WIN_GATE0 = 4352;

constexpr size_t MiB = 1024ull * 1024ull;
constexpr size_t OFF_XB = 0;
constexpr size_t OFF_QD = OFF_XB + 128 * MiB;
constexpr size_t OFF_KD = OFF_QD + 128 * MiB;
constexpr size_t OFF_VDT = OFF_KD + 128 * MiB;
constexpr size_t OFF_CQ = OFF_VDT + 128 * MiB;
constexpr size_t OFF_CKV = OFF_CQ + 48 * MiB;
constexpr size_t OFF_KR = OFF_CKV + 32 * MiB;
constexpr size_t OFF_XQ = OFF_KR + 8 * MiB;
constexpr size_t OFF_QM = OFF_XQ + 64 * MiB;
constexpr size_t OFF_KM = OFF_QM + 96 * MiB;
constexpr size_t OFF_VMT = OFF_KM + 96 * MiB;
constexpr size_t OFF_MEMB = OFF_VMT + 64 * MiB;
constexpr size_t OFF_KC = OFF_MEMB + 16 * MiB;
constexpr size_t OFF_VCT = OFF_KC + 8 * MiB;
constexpr size_t OFF_SSQX = OFF_VCT + 8 * MiB;
constexpr size_t OFF_SSQCQ = OFF_SSQX + 2 * MiB;
constexpr size_t OFF_SSQCKV = OFF_SSQCQ + 1 * MiB;
constexpr size_t OFF_SSQMEM = OFF_SSQCKV + 1 * MiB;
constexpr size_t OFF_W = OFF_SSQMEM + 1 * MiB;
constexpr size_t OFF_U = OFF_QD;
constexpr size_t W_IN = 0;
constexpr size_t W_MEM = W_IN + (size_t)WIN_N * 1024;
constexpr size_t W_QB = W_MEM + 1024 * 1024;
constexpr size_t W_KVB = W_QB + 1024 * 384;
constexpr size_t W_DO = W_KVB + 1024 * 256;
constexpr size_t W_MO = W_DO + 1024 * 1024;
constexpr size_t W_CO = W_MO + 1024 * 768;
constexpr size_t W_OUT = W_CO + 1024 * 512;
constexpr size_t W_1 = W_OUT + 1024 * 1024;
constexpr size_t W_2 = W_1 + 4096 * 1024;
constexpr size_t W_END = W_2 + 4096 * 1024;
constexpr size_t WS_NEED = OFF_W + W_END * 2;

constexpr int LDS_ROW = 144;
constexpr int CS_LD = 132;
constexpr int CS_BYTES = 256 * CS_LD * 4;
constexpr int RS_OFF = 2 * 512 * LDS_ROW;
constexpr int LDS_BYTES = RS_OFF + 1024;

__constant__ float INVF64[32] = {1.000000000e+00f,7.498942614e-01f,5.623413324e-01f,4.216965139e-01f,3.162277639e-01f,2.371373773e-01f,1.778279394e-01f,1.333521307e-01f,1.000000015e-01f,7.498941571e-02f,5.623413250e-02f,4.216965288e-02f,3.162277490e-02f,2.371373773e-02f,1.778279431e-02f,1.333521493e-02f,9.999999776e-03f,7.498941850e-03f,5.623413250e-03f,4.216964822e-03f,3.162277630e-03f,2.371373586e-03f,1.778279431e-03f,1.333521446e-03f,1.000000047e-03f,7.498942432e-04f,5.623413017e-04f,4.216965172e-04f,3.162277571e-04f,2.371373703e-04f,1.778279402e-04f,1.333521504e-04f};
__constant__ float INVF32[16] = {1.000000000e+00f,5.623413324e-01f,3.162277639e-01f,1.778279394e-01f,1.000000015e-01f,5.623413250e-02f,3.162277490e-02f,1.778279431e-02f,9.999999776e-03f,5.623413250e-03f,3.162277630e-03f,1.778279431e-03f,1.000000047e-03f,5.623413017e-04f,3.162277571e-04f,1.778279402e-04f};

struct Params {
  const float* in[27];
  float* out;
  char* ws;
  int ph_lo, ph_hi;
  int dupk, per;
};

typedef __bf16 bf2_t __attribute__((ext_vector_type(2)));
typedef float fl2_t __attribute__((ext_vector_type(2)));
DI unsigned pack2(float a, float b) { fl2_t f = {a, b}; bf2_t r = __builtin_convertvector(f, bf2_t); return __builtin_bit_cast(unsigned, r); }
DI u4 pack8(const float* v) { u4 u; u.x = pack2(v[0], v[1]); u.y = pack2(v[2], v[3]); u.z = pack2(v[4], v[5]); u.w = pack2(v[6], v[7]); return u; }
DI int ltid() { int t = threadIdx.x; asm volatile("" : "+v"(t)); return t; }
DI int crow(int i, int h) { return (i & 3) + 8 * (i >> 2) + 4 * h; }
DI void rot_cs(int pos, float invf, float& c, float& s) {
  const float ang = (float)pos * invf;
  double rev = (double)ang * 0.15915494309189535;
  rev -= floor(rev);
  const float rf = (float)rev;
  c = __builtin_amdgcn_cosf(rf);
  s = __builtin_amdgcn_sinf(rf);
}
DI void load8(const float* Cs, int r, int q, float* v) {
  const f4 a = *(const f4*)(Cs + r * CS_LD + q * 8);
  const f4 b = *(const f4*)(Cs + r * CS_LD + q * 8 + 4);
  v[0] = a.x; v[1] = a.y; v[2] = a.z; v[3] = a.w; v[4] = b.x; v[5] = b.y; v[6] = b.z; v[7] = b.w;
}

template <int MI, int NI, int WGN, bool FDB>
DI void gemm_mainloop(const bf16_t* __restrict__ A, int lda, const bf16_t* __restrict__ B, int ldb, int K, f32x16 (&acc)[MI][NI], char* smem) {
  constexpr int BM = (8 / WGN) * MI * 32, BN = WGN * NI * 32;
  constexpr int ASZ = BM * 64, STAGE = (BM + BN) * 64;
  constexpr int NGA = BM / 128, NGB = BN / 128, NLD = NGA + NGB;
  static_assert(4 * STAGE <= RS_OFF, "ring");
  const int tid = ltid(), lane = tid & 63, wave = tid >> 6, l31 = lane & 31, h = lane >> 5;
  const int wu = __builtin_amdgcn_readfirstlane(wave);
  const int wm = wave / WGN, wn = wave % WGN;
  const int lrow = lane >> 2, lchk = (lane & 3) ^ ((lane >> 4) & 3);
  const bf16_t* ga = A + (size_t)(wu * NGA * 16 + lrow) * lda + lchk * 8;
  const bf16_t* gb = B + (size_t)(wu * NGB * 16 + lrow) * ldb + lchk * 8;
#pragma unroll
  for (int mi = 0; mi < MI; ++mi)
#pragma unroll
    for (int ni = 0; ni < NI; ++ni)
#pragma unroll
      for (int i = 0; i < 16; ++i) acc[mi][ni][i] = 0.f;
  auto issue = [&](int j) {
    char* st = smem + (j & 3) * STAGE;
    const int k0 = j * 32;
#pragma unroll
    for (int i = 0; i < NGA; ++i)
      __builtin_amdgcn_global_load_lds((const unsigned*)(ga + (size_t)(i * 16) * lda + k0), (unsigned*)(st + (wu * NGA + i) * 1024), 16, 0, 0);
#pragma unroll
    for (int i = 0; i < NGB; ++i)
      __builtin_amdgcn_global_load_lds((const unsigned*)(gb + (size_t)(i * 16) * ldb + k0), (unsigned*)(st + ASZ + (wu * NGB + i) * 1024), 16, 0, 0);
  };
  asm volatile("s_waitcnt vmcnt(0)" ::: "memory");
  __syncthreads();
  const int nk = K >> 5;
  issue(0); issue(1); issue(2);
  const int sw = (l31 >> 2) & 3;
  const int oa = (wm * MI * 32 + l31) * 64, ob = ASZ + (wn * NI * 32 + l31) * 64;
  const int c0 = ((0 + h) ^ sw) * 16, c1 = ((2 + h) ^ sw) * 16;
#pragma unroll 1
  for (int j = 0; j < nk; ++j) {
    if (j + 2 < nk) asm volatile("s_waitcnt vmcnt(%0)" ::"n"(2 * NLD) : "memory");
    else if (j + 1 < nk) asm volatile("s_waitcnt vmcnt(%0)" ::"n"(NLD) : "memory");
    else asm volatile("s_waitcnt vmcnt(0)" ::: "memory");
    asm volatile("s_waitcnt lgkmcnt(0)" ::: "memory");
    __builtin_amdgcn_s_barrier();
    if (j + 3 < nk) issue(j + 3);
    const char* st = smem + (j & 3) * STAGE;
    const char* pa = st + oa;
    const char* pb = st + ob;
    bf16x8 fa0[MI], fb0[NI], fa1[MI], fb1[NI];
#pragma unroll
    for (int mi = 0; mi < MI; ++mi) fa0[mi] = *(const bf16x8*)(pa + mi * 2048 + c0);
#pragma unroll
    for (int ni = 0; ni < NI; ++ni) fb0[ni] = *(const bf16x8*)(pb + ni * 2048 + c0);
    if (FDB) {
#pragma unroll
      for (int mi = 0; mi < MI; ++mi) fa1[mi] = *(const bf16x8*)(pa + mi * 2048 + c1);
#pragma unroll
      for (int ni = 0; ni < NI; ++ni) fb1[ni] = *(const bf16x8*)(pb + ni * 2048 + c1);
    }
#pragma unroll
    for (int mi = 0; mi < MI; ++mi)
#pragma unroll
      for (int ni = 0; ni < NI; ++ni) acc[mi][ni] = MFMA(fa0[mi], fb0[ni], acc[mi][ni]);
    __builtin_amdgcn_sched_barrier(0);
    if (!FDB) {
#pragma unroll
      for (int mi = 0; mi < MI; ++mi) fa1[mi] = *(const bf16x8*)(pa + mi * 2048 + c1);
#pragma unroll
      for (int ni = 0; ni < NI; ++ni) fb1[ni] = *(const bf16x8*)(pb + ni * 2048 + c1);
    }
#pragma unroll
    for (int mi = 0; mi < MI; ++mi)
#pragma unroll
      for (int ni = 0; ni < NI; ++ni) acc[mi][ni] = MFMA(fa1[mi], fb1[ni], acc[mi][ni]);
    __builtin_amdgcn_sched_barrier(0);
  }
  asm volatile("s_waitcnt lgkmcnt(0)" ::: "memory");
  __builtin_amdgcn_s_barrier();
}

using f32x4v = __attribute__((ext_vector_type(4))) float;
DI int lds_byte8(int r, int c) {
  const int st = (r >> 4) * 2 + (c >> 5), rr = r & 15, cc = c & 31, ob = rr * 64 + cc * 2;
  return st * 1024 + (ob ^ (((ob >> 9) & 1) << 5));
}
DI void stage_rc8(int b, int& R, int& C) {
  const int st = b / 1024, sb = b % 1024, swz = sb ^ (((sb >> 9) & 1) << 5);
  R = (st >> 1) * 16 + swz / 64; C = (st & 1) * 32 + (swz % 64) / 2;
}
DI void gemm8p(const bf16_t* __restrict__ A, const bf16_t* __restrict__ Bt, int K, f32x4v (&acc)[2][2][4][2], char* smem) {
  constexpr int BK8 = 64, HALF8 = 128, HTB = HALF8 * BK8 * 2;
  const int tid = ltid(), wid = tid >> 6, lane = tid & 63, wr = wid >> 2, wc = wid & 3, fr = lane & 15, fq = lane >> 4;
  const int wu8 = __builtin_amdgcn_readfirstlane(wid);
  unsigned goff[2];
#pragma unroll
  for (int i_ = 0; i_ < 2; ++i_) { int r_, c_; stage_rc8(tid * 16 + i_ * 8192, r_, c_); goff[i_] = (unsigned)(r_ * K + c_); }
  const int lfrag = ((fr * 64 + fq * 16) ^ ((fr >> 3) << 5));
  const char* la = smem + wr * 8192 + lfrag;
  const char* lb = smem + 4 * HTB + wc * 4096 + lfrag;
#define SA8(b, h) ((b) * 2 + (h))
#define SB8(b, h) (4 + (b) * 2 + (h))
#define STAGE8(Q, BASE, br, kt) do { const bf16_t* sb_ = (BASE) + ((long)(br) * K + (long)(kt) * BK8); \
    _Pragma("unroll") for (int i_ = 0; i_ < 2; ++i_) \
      __builtin_amdgcn_global_load_lds((const unsigned*)(sb_ + goff[i_]), (unsigned*)(smem + (Q) * HTB + i_ * 8192 + wu8 * 1024), 16, 0, 0); } while (0)
#define LDA8(dst, b, h) _Pragma("unroll") for (int m = 0; m < 4; ++m) _Pragma("unroll") for (int k = 0; k < 2; ++k) \
    dst[m][k] = *(const bf16x8*)(la + ((b) * 2 + (h)) * HTB + (m * 2 + k) * 1024)
#define LDB8(dst, b, h) _Pragma("unroll") for (int n = 0; n < 2; ++n) _Pragma("unroll") for (int k = 0; k < 2; ++k) \
    dst[n][k] = *(const bf16x8*)(lb + ((b) * 2 + (h)) * HTB + (n * 2 + k) * 1024)
#define MMA8(ai, bj, At_, Bt_) do { __builtin_amdgcn_s_setprio(1); \
    _Pragma("unroll") for (int m = 0; m < 4; ++m) _Pragma("unroll") for (int n = 0; n < 2; ++n) _Pragma("unroll") for (int k = 0; k < 2; ++k) \
      acc[ai][bj][m][n] = __builtin_amdgcn_mfma_f32_16x16x32_bf16(Bt_[n][k], At_[m][k], acc[ai][bj][m][n], 0, 0, 0); \
    __builtin_amdgcn_s_setprio(0); } while (0)
#define WAIT_V8(n) asm volatile("s_waitcnt vmcnt(" #n ")" ::: "memory")
#define WAIT_L8(n) asm volatile("s_waitcnt lgkmcnt(" #n ")" ::: "memory")
#define BAR8 __builtin_amdgcn_s_barrier()
#define SCHED8 __builtin_amdgcn_sched_barrier(0)
#pragma unroll
  for (int a = 0; a < 2; ++a)
#pragma unroll
    for (int b = 0; b < 2; ++b)
#pragma unroll
      for (int m = 0; m < 4; ++m)
#pragma unroll
        for (int n = 0; n < 2; ++n) acc[a][b][m][n] = f32x4v{0.f, 0.f, 0.f, 0.f};
  bf16x8 At[4][2], B0[2][2], B1[2][2];
  const int nt = K / BK8;
  asm volatile("s_waitcnt vmcnt(0)" ::: "memory");
  __syncthreads();
  STAGE8(SB8(0, 0), Bt, 0, 0); STAGE8(SA8(0, 0), A, 0, 0);
  STAGE8(SB8(0, 1), Bt, HALF8, 0); STAGE8(SA8(0, 1), A, HALF8, 0);
  if (wr == 1) BAR8;
  WAIT_V8(4); BAR8;
  STAGE8(SB8(1, 0), Bt, 0, 1); STAGE8(SA8(1, 0), A, 0, 1); STAGE8(SB8(1, 1), Bt, HALF8, 1);
  WAIT_V8(6); BAR8;
#pragma unroll 1
  for (int t = 0; t < nt - 2; t += 2) {
    LDB8(B0, 0, 0); SCHED8; LDA8(At, 0, 0); STAGE8(SA8(1, 1), A, HALF8, t + 1);
    WAIT_L8(8); BAR8; WAIT_L8(0); MMA8(0, 0, At, B0); BAR8; SCHED8;
    LDB8(B1, 0, 1); STAGE8(SB8(0, 0), Bt, 0, t + 2);
    BAR8; WAIT_L8(0); MMA8(0, 1, At, B1); BAR8;
    LDA8(At, 0, 1); STAGE8(SA8(0, 0), A, 0, t + 2);
    BAR8; WAIT_L8(0); MMA8(1, 0, At, B0); BAR8; SCHED8;
    STAGE8(SB8(0, 1), Bt, HALF8, t + 2);
    WAIT_V8(6); BAR8; MMA8(1, 1, At, B1); BAR8;
    LDB8(B0, 1, 0); SCHED8; LDA8(At, 1, 0); STAGE8(SA8(0, 1), A, HALF8, t + 2);
    WAIT_L8(8); BAR8; WAIT_L8(0); MMA8(0, 0, At, B0); BAR8; SCHED8;
    LDB8(B1, 1, 1); STAGE8(SB8(1, 0), Bt, 0, t + 3);
    BAR8; WAIT_L8(0); MMA8(0, 1, At, B1); BAR8;
    LDA8(At, 1, 1); STAGE8(SA8(1, 0), A, 0, t + 3);
    BAR8; WAIT_L8(0); MMA8(1, 0, At, B0); BAR8; SCHED8;
    STAGE8(SB8(1, 1), Bt, HALF8, t + 3);
    WAIT_V8(6); BAR8; MMA8(1, 1, At, B1); BAR8;
  }
  { LDB8(B0, 0, 0); LDA8(At, 0, 0); STAGE8(SA8(1, 1), A, HALF8, nt - 1);
    BAR8; WAIT_L8(0); MMA8(0, 0, At, B0); BAR8;
    LDB8(B1, 0, 1); BAR8; WAIT_L8(0); MMA8(0, 1, At, B1); BAR8;
    LDA8(At, 0, 1); WAIT_V8(4); BAR8; WAIT_L8(0); MMA8(1, 0, At, B0); MMA8(1, 1, At, B1); BAR8; }
  { LDB8(B0, 1, 0); LDA8(At, 1, 0); WAIT_V8(2); BAR8; WAIT_L8(0); MMA8(0, 0, At, B0); BAR8;
    LDB8(B1, 1, 1); WAIT_V8(0); BAR8; WAIT_L8(0); MMA8(0, 1, At, B1); BAR8;
    LDA8(At, 1, 1); BAR8; WAIT_L8(0); MMA8(1, 0, At, B0); MMA8(1, 1, At, B1); BAR8; }
  if (wr == 0) BAR8;
  asm volatile("s_waitcnt lgkmcnt(0)" ::: "memory");
  BAR8;
#undef SA8
#undef SB8
#undef STAGE8
#undef LDA8
#undef LDB8
#undef MMA8
#undef WAIT_V8
#undef WAIT_L8
#undef BAR8
#undef SCHED8
}

DI void fill_rs(float* rs, const float* ssq, int nparts, int pstride, int row0, float invK) {
  const int t = ltid();
  if (t < 256) {
    float r = 1.f;
    if (ssq) {
      float s = 0.f;
      for (int p = 0; p < nparts; ++p) s += ssq[(size_t)p * pstride + row0 + t];
      r = rsqrtf(s * invK + EPSV);
    }
    rs[t] = r;
  }
}

enum { EP_HEADROT = 0, EP_VT, EP_PLAIN, EP_KROPE, EP_NORM128, EP_QB, EP_KVB, EP_RES, EP_MLP1, EP_YTMP, EP_GATE };

struct Tile {
  int epi, row0, cb;
  bf16_t* dst; int ldd;
  const float* gain;
  float* ssq_out;
  const float* xsrc;
  float oscale;
  const bf16_t* ysrc;
  int accum;
};

DI void map_regular(int it, int bid, int NCB, int& rb, int& CB) {
  const int xcd = bid & 7, slot = bid >> 3;
  const int c = xcd * NCB + it;
  const int cgrp = c >> 5, rgrp = c & 31;
  rb = rgrp * 8 + (slot >> 2);
  CB = cgrp * 4 + (slot & 3);
}

template <int DK, int DV, int NM, bool CAUSAL>
DI void attn_block(const bf16_t* __restrict__ Q, int ldq, const bf16_t* __restrict__ Kg, int ldk, const bf16_t* __restrict__ Vt, int ldv,
                   int nkt, int q0, bf16_t* O, int ldo, float sc, float lam, const float* og, float omul, char* smem) {
  constexpr int KW = NM * DK, KCHV = KW / 8;
  constexpr int KBYTES = 64 * 256, VBYTES = DV * 128, STAGE = KBYTES + VBYTES;
  constexpr int NVI = DV / 64;
  constexpr int NLD = 2 + NVI;
  static_assert(KCHV <= 16 && 4 * STAGE <= RS_OFF, "lds");
  constexpr int NKC16 = DK / 16, NDVB = DV / 32;
  const int tid = ltid(), lane = tid & 63, wave = tid >> 6, h = lane >> 5, l31 = lane & 31;
  const int wq = (NM == 2) ? (wave & 3) : wave;
  const int mymap = (NM == 2) ? (wave >> 2) : 0;
  const int q0w = q0 + wq * 32;

  bf16x8 qf[NKC16];
  {
    const bf16_t* qp = Q + (size_t)(wq * 32 + l31) * ldq + mymap * DK + h * 8;
#pragma unroll
    for (int kc = 0; kc < NKC16; ++kc) qf[kc] = *(const bf16x8*)(qp + kc * 16);
#pragma unroll
    for (int kc = 0; kc < NKC16; ++kc) asm volatile("" : "+v"(qf[kc]));
  }
  f32x16 o[NDVB];
#pragma unroll
  for (int d = 0; d < NDVB; ++d)
#pragma unroll
    for (int i = 0; i < 16; ++i) o[d][i] = 0.f;
  f32x16 lacc;
#pragma unroll
  for (int i = 0; i < 16; ++i) lacc[i] = 0.f;
  u4 onesu; onesu.x = onesu.y = onesu.z = onesu.w = 0x3F803F80u;
  const bf16x8 ones = __builtin_bit_cast(bf16x8, onesu);

  const int wu = __builtin_amdgcn_readfirstlane(wave);
  const int krow = lane >> 4, kslot = lane & 15;
  const int vrow = lane >> 3, vslot = lane & 7;
  auto issue = [&](int kt) {
    char* st = smem + (kt & 3) * STAGE;
#pragma unroll
    for (int i = 0; i < 2; ++i) {
      const int r = (wu * 2 + i) * 4 + krow;
      const int c = kslot ^ (r & 15);
      if (KCHV == 16 || c < KCHV)
        __builtin_amdgcn_global_load_lds((const unsigned*)(Kg + (size_t)(kt * 64 + r) * ldk + c * 8), (unsigned*)(st + (wu * 2 + i) * 1024), 16, 0, 0);
    }
#pragma unroll
    for (int i = 0; i < NVI; ++i) {
      const int d = (wu * NVI + i) * 8 + vrow;
      const int c = vslot ^ ((d >> 1) & 7);
      __builtin_amdgcn_global_load_lds((const unsigned*)(Vt + (size_t)d * ldv + kt * 64 + c * 8), (unsigned*)(st + KBYTES + (wu * NVI + i) * 1024), 16, 0, 0);
    }
  };
  asm volatile("s_waitcnt vmcnt(0)" ::: "memory");
  __syncthreads();
  if (0 < nkt) issue(0);
  if (1 < nkt) issue(1);
  if (2 < nkt) issue(2);
  for (int kt = 0; kt < nkt; ++kt) {
    if (kt + 2 < nkt) asm volatile("s_waitcnt vmcnt(%0)" ::"n"(2 * NLD) : "memory");
    else if (kt + 1 < nkt) asm volatile("s_waitcnt vmcnt(%0)" ::"n"(NLD) : "memory");
    else asm volatile("s_waitcnt vmcnt(0)" ::: "memory");
    asm volatile("s_waitcnt lgkmcnt(0)" ::: "memory");
    __builtin_amdgcn_s_barrier();
    if (kt + 3 < nkt) issue(kt + 3);
    const bool skip = CAUSAL && (kt * 64 > q0w + 31);
    if (!skip) {
      const char* base = smem + (kt & 3) * STAGE;
      f32x16 s[2];
#pragma unroll
      for (int sb = 0; sb < 2; ++sb) {
#pragma unroll
        for (int i = 0; i < 16; ++i) s[sb][i] = 0.f;
        const char* pk = base + (sb * 32 + l31) * 256;
#pragma unroll
        for (int kc = 0; kc < NKC16; ++kc) {
          const bf16x8 a = *(const bf16x8*)(pk + (((mymap * (DK / 8) + kc * 2 + h) ^ (l31 & 15)) * 16));
          s[sb] = MFMA(a, qf[kc], s[sb]);
        }
        __builtin_amdgcn_sched_barrier(0);
      }
      const bool need_mask = CAUSAL && (kt * 64 + 63 > q0w);
#pragma unroll
      for (int sb = 0; sb < 2; ++sb)
#pragma unroll
        for (int i = 0; i < 16; ++i) {
          float pz = __builtin_amdgcn_exp2f(s[sb][i]);
          if (need_mask) {
            const int key = kt * 64 + sb * 32 + crow(i, h);
            if (key > q0w + l31) pz = 0.f;
          }
          s[sb][i] = pz;
        }
      const char* pv = base + KBYTES + l31 * 128;
      const int vsw = (l31 >> 1) & 7;
#pragma unroll
      for (int ks = 0; ks < 4; ++ks) {
        u4 pu;
        pu.x = pack2(s[ks >> 1][(ks & 1) * 8 + 0], s[ks >> 1][(ks & 1) * 8 + 1]);
        pu.y = pack2(s[ks >> 1][(ks & 1) * 8 + 2], s[ks >> 1][(ks & 1) * 8 + 3]);
        pu.z = pack2(s[ks >> 1][(ks & 1) * 8 + 4], s[ks >> 1][(ks & 1) * 8 + 5]);
        pu.w = pack2(s[ks >> 1][(ks & 1) * 8 + 6], s[ks >> 1][(ks & 1) * 8 + 7]);
        const bf16x8 pf = __builtin_bit_cast(bf16x8, pu);
        lacc = MFMA(ones, pf, lacc);
#pragma unroll
        for (int d = 0; d < NDVB; ++d) {
          const u4 au = *(const u4*)(pv + d * 32 * 128 + (((ks * 2 + h) ^ vsw) * 16));
          o[d] = MFMA(__builtin_bit_cast(bf16x8, au), pf, o[d]);
        }
        __builtin_amdgcn_sched_barrier(0);
      }
    }
  }
  asm volatile("s_waitcnt lgkmcnt(0)" ::: "memory");
  __builtin_amdgcn_s_barrier();
  const float l_tot = lacc[0];
  const float inv = 1.f / l_tot;
#pragma unroll
  for (int d = 0; d < NDVB; ++d)
#pragma unroll
    for (int i = 0; i < 16; ++i) o[d][i] *= inv;

  float rn_out = 1.f;
  if (NM == 2) {
    float* buf = (float*)smem;
    if (wave >= 4) {
#pragma unroll
      for (int d = 0; d < NDVB; ++d)
#pragma unroll
        for (int i = 0; i < 16; ++i) buf[(d * 16 + i) * 256 + (wave & 3) * 64 + lane] = o[d][i];
    }
    __syncthreads();
    if (wave < 4) {
      float ss = 0.f;
#pragma unroll
      for (int d = 0; d < NDVB; ++d) {
#pragma unroll
        for (int i = 0; i < 16; ++i) {
          const float v = o[d][i] - lam * buf[(d * 16 + i) * 256 + wave * 64 + lane];
          o[d][i] = v;
          ss += v * v;
        }
        __builtin_amdgcn_sched_barrier(0);
      }
      ss += __shfl_xor(ss, 32);
      rn_out = rsqrtf(ss * (1.f / DV) + EPSV) * omul;
    }
  }
  if (NM == 1 || wave < 4) {
    bf16_t* op = O + (size_t)(wq * 32 + l31) * ldo + 4 * h;
#pragma unroll
    for (int d = 0; d < NDVB; ++d)
#pragma unroll
      for (int g = 0; g < 4; ++g) {
        f4 gg = {1.f, 1.f, 1.f, 1.f};
        if (NM == 2) gg = *(const f4*)(og + d * 32 + 8 * g + 4 * h);
        u2 u;
        u.x = pack2(o[d][4 * g + 0] * rn_out * gg.x, o[d][4 * g + 1] * rn_out * gg.y);
        u.y = pack2(o[d][4 * g + 2] * rn_out * gg.z, o[d][4 * g + 3] * rn_out * gg.w);
        *(u2*)(op + d * 32 + 8 * g) = u;
      }
  }
}

DI void prep_tile(const float* __restrict__ src, int N, const float* __restrict__ gain, bf16_t* __restrict__ dst, int Kp, int nmode, int kmode, int kt, int nt, char* smem) {
  float* tile = (float*)smem;
  const int tid = ltid();
  __syncthreads();
  {
    const int n = tid & 63;
    const int np = nt * 64 + n;
    int ns = np; bool nv = true;
    if (nmode == 1) {
      if (np < 3712) ns = np;
      else if (np < 3840) { ns = np; nv = (np < 3744); }
      else if (np < 4352) ns = np - 96;
      else ns = np - 96;
    } else if (nmode == 2) {
      const int hh = np >> 7, j = np & 127;
      nv = j < 96; ns = hh * 96 + j;
    }
#pragma unroll
    for (int j = 0; j < 8; ++j) {
      const int kk = (tid >> 6) + 8 * j;
      const int kp = kt * 64 + kk;
      int ks = kp; bool kv = true;
      if (kmode == 1) { const int hh = kp / 96, jj = kp % 96; kv = jj < 64; ks = hh * 64 + jj; }
      float v = 0.f;
      if (nv && kv) { v = src[(size_t)ks * N + ns]; if (gain) v *= gain[ks]; }
      tile[n * 65 + kk] = v;
    }
  }
  __syncthreads();
  {
    const int n = tid >> 3, kc = tid & 7;
    float v[8];
#pragma unroll
    for (int e = 0; e < 8; ++e) v[e] = tile[n * 65 + kc * 8 + e];
    *(u4*)(dst + (size_t)(nt * 64 + n) * Kp + kt * 64 + kc * 8) = pack8(v);
  }
}

DI void prep_item(const Params& p, int l, int it, char* smem) {
  bf16_t* W = (bf16_t*)(p.ws + OFF_W);
  const float* src; const float* gain = nullptr; bf16_t* dst; int N, Kp, nmode = 0, kmode = 0, nkt, loc;
  if (it < 1856)      { loc = it;        src = p.in[4] + (size_t)l * 1024 * 7328; N = 7328; gain = p.in[3] + l * 1024; dst = W + W_IN; Kp = 1024; nmode = 1; nkt = 16; }
  else if (it < 2112) { loc = it - 1856; src = p.in[19] + (size_t)l * 1024 * 1024; N = 1024; gain = p.in[18] + l * 1024; dst = W + W_MEM; Kp = 1024; nkt = 16; }
  else if (it < 2208) { loc = it - 2112; src = p.in[12] + (size_t)l * 384 * 768; N = 768; gain = p.in[11] + l * 384; dst = W + W_QB; Kp = 384; nmode = 2; nkt = 6; }
  else if (it < 2272) { loc = it - 2208; src = p.in[14] + (size_t)l * 256 * 1024; N = 1024; gain = p.in[13] + l * 256; dst = W + W_KVB; Kp = 256; nkt = 4; }
  else if (it < 2528) { loc = it - 2272; src = p.in[10] + (size_t)l * 1024 * 1024; N = 1024; dst = W + W_DO; Kp = 1024; nkt = 16; }
  else if (it < 2720) { loc = it - 2528; src = p.in[17] + (size_t)l * 512 * 1024; N = 1024; dst = W + W_MO; Kp = 768; kmode = 1; nkt = 12; }
  else if (it < 2848) { loc = it - 2720; src = p.in[22] + (size_t)l * 512 * 1024; N = 1024; dst = W + W_CO; Kp = 512; nkt = 8; }
  else if (it < 3104) { loc = it - 2848; src = p.in[23] + (size_t)l * 1024 * 1024; N = 1024; dst = W + W_OUT; Kp = 1024; nkt = 16; }
  else if (it < 4128) { loc = it - 3104; src = p.in[25] + (size_t)l * 1024 * 4096; N = 4096; gain = p.in[24] + l * 1024; dst = W + W_1; Kp = 1024; nkt = 16; }
  else                { loc = it - 4128; src = p.in[26] + (size_t)l * 4096 * 1024; N = 1024; dst = W + W_2; Kp = 4096; nkt = 64; }
  prep_tile(src, N, gain, dst, Kp, nmode, kmode, loc % nkt, loc / nkt, smem);
}
DI void prep_range(const Params& p, int l, int lo, int hi, char* smem) {
  for (int it = lo + blockIdx.x; it < hi; it += gridDim.x) prep_item(p, l, it, smem);
}

DI void phase_init(const Params& p) {
  const int tid_ = ltid(); const int lane = tid_ & 63, gw = blockIdx.x * 8 + (tid_ >> 6), GW = gridDim.x * 8;
  bf16_t* XB = (bf16_t*)(p.ws + OFF_XB); bf16_t* MB = (bf16_t*)(p.ws + OFF_MEMB);
  float* SX = (float*)(p.ws + OFF_SSQX); float* SM = (float*)(p.ws + OFF_SSQMEM);
  for (int r = gw; r < T + MEMR; r += GW) {
    const bool isx = r < T;
    const float* src = isx ? p.in[0] + (size_t)r * 1024 : p.in[1] + (size_t)(r - T) * 1024;
    bf16_t* dst = isx ? XB + (size_t)r * 1024 : MB + (size_t)(r - T) * 1024;
    float ss = 0.f;
#pragma unroll
    for (int j = 0; j < 4; ++j) {
      const f4 v = *(const f4*)(src + j * 256 + lane * 4);
      ss += v.x * v.x + v.y * v.y + v.z * v.z + v.w * v.w;
      u2 u; u.x = pack2(v.x, v.y); u.y = pack2(v.z, v.w);
      *(u2*)(dst + j * 256 + lane * 4) = u;
    }
#pragma unroll
    for (int m = 32; m >= 1; m >>= 1) ss += __shfl_xor(ss, m);
    if (isx) { if (lane < 8) SX[(size_t)lane * T + r] = (lane == 0) ? ss : 0.f; }
    else if (lane == 0) SM[r - T] = ss;
  }
}

DI void run_epilogue(const Params& p, const Tile& t, char* smem) {
  float* Cs = (float*)smem;
  float* rs = (float*)(smem + RS_OFF);
  const int tid = ltid();
  const int q = tid & 15, rsub = tid >> 4;
  const int* pos = (const int*)p.in[2];
  if (t.epi == EP_VT) {
    const int c = tid >> 2, rq = tid & 3;
#pragma unroll
    for (int j = 0; j < 8; ++j) {
      float v[8];
#pragma unroll
      for (int e = 0; e < 8; ++e) { const int r = rq * 64 + j * 8 + e; v[e] = Cs[r * CS_LD + c] * rs[r]; }
      bf16_t* d16 = t.dst + (size_t)c * t.ldd + rq * 64 + (j >> 1) * 16;
      u2 lo, hi; lo.x = pack2(v[0], v[1]); lo.y = pack2(v[2], v[3]); hi.x = pack2(v[4], v[5]); hi.y = pack2(v[6], v[7]);
      *(u2*)(d16 + ((j & 1) ? 4 : 0)) = lo;
      *(u2*)(d16 + ((j & 1) ? 12 : 8)) = hi;
    }
    return;
  }
#pragma unroll 1
  for (int pass = 0; pass < 8; ++pass) {
    const int r = rsub + 32 * pass;
    const int row = t.row0 + r;
    float v[8];
    load8(Cs, r, q, v);
    const float rsv = rs[r];
#pragma unroll
    for (int e = 0; e < 8; ++e) v[e] *= rsv;
    switch (t.epi) {
      case EP_HEADROT: {
        float ss = 0.f;
#pragma unroll
        for (int e = 0; e < 8; ++e) ss += v[e] * v[e];
        ss += __shfl_xor(ss, 1); ss += __shfl_xor(ss, 2); ss += __shfl_xor(ss, 4);
        const float rn = rsqrtf(ss * (1.f / 64) + EPSV);
        const int pp = q & 7; const bool first = pp < 4; const int i0 = (pp & 3) * 8;
        const int ps = pos[row];
        float ov[8];
#pragma unroll
        for (int e = 0; e < 8; ++e) {
          const float y = v[e] * rn * t.gain[pp * 8 + e];
          const float yp = __shfl_xor(y, 4);
          float c, s; rot_cs(ps, INVF64[i0 + e], c, s);
          ov[e] = (first ? (y * c - yp * s) : (y * c + yp * s)) * t.oscale;
        }
        *(u4*)(t.dst + (size_t)row * t.ldd + t.cb * 128 + q * 8) = pack8(ov);
      } break;
      case EP_PLAIN: {
        float ss = 0.f;
#pragma unroll
        for (int e = 0; e < 8; ++e) ss += v[e] * v[e];
        ss += __shfl_xor(ss, 1); ss += __shfl_xor(ss, 2); ss += __shfl_xor(ss, 4); ss += __shfl_xor(ss, 8);
        *(u4*)(t.dst + (size_t)row * t.ldd + t.cb * 128 + q * 8) = pack8(v);
        if (q == 0) t.ssq_out[row] = ss;
      } break;
      case EP_KROPE: {
        const bool first = (q & 2) == 0; const int i0 = (q & 1) * 8;
        const int ps = pos[row];
        float ov[8];
#pragma unroll
        for (int e = 0; e < 8; ++e) {
          const float yp = __shfl_xor(v[e], 2);
          float c, s; rot_cs(ps, INVF32[i0 + e], c, s);
          ov[e] = first ? (v[e] * c - yp * s) : (v[e] * c + yp * s);
        }
        if (q < 4) {
          float* kr = (float*)(p.ws + OFF_KR) + (size_t)row * 32 + q * 8;
          *(f4*)kr = f4{ov[0], ov[1], ov[2], ov[3]};
          *(f4*)(kr + 4) = f4{ov[4], ov[5], ov[6], ov[7]};
        }
      } break;
      case EP_NORM128: {
        float ss = 0.f;
#pragma unroll
        for (int e = 0; e < 8; ++e) ss += v[e] * v[e];
        ss += __shfl_xor(ss, 1); ss += __shfl_xor(ss, 2); ss += __shfl_xor(ss, 4); ss += __shfl_xor(ss, 8);
        const float rn = rsqrtf(ss * (1.f / 128) + EPSV);
#pragma unroll
        for (int e = 0; e < 8; ++e) v[e] *= rn * t.oscale * t.gain[q * 8 + e];
        *(u4*)(t.dst + (size_t)row * t.ldd + t.cb * 128 + q * 8) = pack8(v);
      } break;
      case EP_QB: {
        const bool isr = (q >= 8 && q < 12);
        const bool first = (q & 2) == 0; const int i0 = (q & 1) * 8;
        const int ps = pos[row];
        float ss = 0.f;
#pragma unroll
        for (int e = 0; e < 8; ++e) {
          const float yp = __shfl_xor(v[e], 2);
          float c, s; rot_cs(ps, INVF32[i0 + e], c, s);
          const float rv = first ? (v[e] * c - yp * s) : (v[e] * c + yp * s);
          v[e] = isr ? rv : v[e];
          ss += v[e] * v[e];
        }
        ss += __shfl_xor(ss, 1); ss += __shfl_xor(ss, 2); ss += __shfl_xor(ss, 4); ss += __shfl_xor(ss, 8);
        const float rn = rsqrtf(ss * (1.f / 96) + EPSV);
        if (q < 12) {
#pragma unroll
          for (int e = 0; e < 8; ++e) v[e] *= rn * t.oscale * t.gain[q * 8 + e];
          *(u4*)(t.dst + (size_t)row * 768 + t.cb * 96 + q * 8) = pack8(v);
        }
      } break;
      case EP_KVB: {
        if (q >= 8) {
          if (q < 12) {
            const float* kr = (const float*)(p.ws + OFF_KR) + (size_t)row * 32 + (q - 8) * 8;
            const f4 a = *(const f4*)kr, b = *(const f4*)(kr + 4);
            v[0] = a.x; v[1] = a.y; v[2] = a.z; v[3] = a.w; v[4] = b.x; v[5] = b.y; v[6] = b.z; v[7] = b.w;
          } else {
#pragma unroll
            for (int e = 0; e < 8; ++e) v[e] = 0.f;
          }
        }
        float ss = 0.f;
#pragma unroll
        for (int e = 0; e < 8; ++e) ss += v[e] * v[e];
        ss += __shfl_xor(ss, 1); ss += __shfl_xor(ss, 2); ss += __shfl_xor(ss, 4); ss += __shfl_xor(ss, 8);
        const float rn = rsqrtf(ss * (1.f / 96) + EPSV);
        if (q < 12) {
#pragma unroll
          for (int e = 0; e < 8; ++e) v[e] *= rn * t.oscale * t.gain[q * 8 + e];
          *(u4*)(t.dst + (size_t)row * 768 + t.cb * 96 + q * 8) = pack8(v);
        }
      } break;
      case EP_RES: {
        const float* xs = t.xsrc + (size_t)row * 1024 + t.cb * 128 + q * 8;
        const f4 a = *(const f4*)xs, b = *(const f4*)(xs + 4);
        v[0] += a.x; v[1] += a.y; v[2] += a.z; v[3] += a.w; v[4] += b.x; v[5] += b.y; v[6] += b.z; v[7] += b.w;
        float ss = 0.f;
#pragma unroll
        for (int e = 0; e < 8; ++e) ss += v[e] * v[e];
        ss += __shfl_xor(ss, 1); ss += __shfl_xor(ss, 2); ss += __shfl_xor(ss, 4); ss += __shfl_xor(ss, 8);
        float* xo = p.out + (size_t)row * 1024 + t.cb * 128 + q * 8;
        *(f4*)xo = f4{v[0], v[1], v[2], v[3]};
        *(f4*)(xo + 4) = f4{v[4], v[5], v[6], v[7]};
        *(u4*)(t.dst + (size_t)row * 1024 + t.cb * 128 + q * 8) = pack8(v);
        if (q == 0) t.ssq_out[row] = ss;
      } break;
      case EP_YTMP: {
        *(u4*)(t.dst + (size_t)r * 256 + t.cb * 128 + q * 8) = pack8(v);
      } break;
      case EP_GATE: {
        const u4 yu = *(const u4*)(t.ysrc + (size_t)r * 256 + q * 8);
        const f4 ba = *(const f4*)(t.gain + q * 8), bb = *(const f4*)(t.gain + q * 8 + 4);
        bf16_t* mp_ = t.dst + (size_t)row * 1024 + t.cb * 128 + q * 8;
        u4 mu; mu.x = mu.y = mu.z = mu.w = 0u;
        if (t.accum) mu = *(const u4*)mp_;
        const float bs[8] = {ba.x, ba.y, ba.z, ba.w, bb.x, bb.y, bb.z, bb.w};
        const unsigned yw[4] = {yu.x, yu.y, yu.z, yu.w}, mw[4] = {mu.x, mu.y, mu.z, mu.w};
#pragma unroll
        for (int e = 0; e < 8; ++e) {
          const float g = 1.f / (1.f + __expf(-(v[e] + bs[e])));
          const float y = __uint_as_float((e & 1) ? (yw[e >> 1] & 0xffff0000u) : (yw[e >> 1] << 16));
          const float m = __uint_as_float((e & 1) ? (mw[e >> 1] & 0xffff0000u) : (mw[e >> 1] << 16));
          v[e] = m + g * y;
        }
        *(u4*)mp_ = pack8(v);
      } break;
      case EP_MLP1: {
#pragma unroll
        for (int e = 0; e < 8; ++e) { const float u = fmaxf(v[e], 0.f); v[e] = u * u; }
        *(u4*)(t.dst + (size_t)row * t.ldd + t.cb * 128 + q * 8) = pack8(v);
      } break;
      default: break;
    }
  }
  if (t.epi == EP_KVB) {
    bf16_t* VMT = (bf16_t*)(p.ws + OFF_VMT);
    const int c = tid >> 3, r8 = tid & 7;
    const int b = t.row0 >> 11, s0 = t.row0 & 2047;
    bf16_t* d = VMT + ((size_t)(b * 512 + t.cb * 64 + c)) * SEQ + s0 + r8 * 32;
#pragma unroll
    for (int j = 0; j < 4; ++j) {
      float v[8];
#pragma unroll
      for (int e = 0; e < 8; ++e) { const int r = r8 * 32 + j * 8 + e; v[e] = Cs[r * CS_LD + 64 + c] * rs[r]; }
      bf16_t* d16 = d + (j >> 1) * 16;
      u2 lo, hi; lo.x = pack2(v[0], v[1]); lo.y = pack2(v[2], v[3]); hi.x = pack2(v[4], v[5]); hi.y = pack2(v[6], v[7]);
      *(u2*)(d16 + ((j & 1) ? 4 : 0)) = lo;
      *(u2*)(d16 + ((j & 1) ? 12 : 8)) = hi;
    }
  }
}

__global__ void __launch_bounds__(NTHR) mega_fwd(Params p) {
  __shared__ __attribute__((aligned(16))) char smem[LDS_BYTES];
  cg::grid_group grid = cg::this_grid();
  const int G = gridDim.x, bid = blockIdx.x;
  for (int ph = p.ph_lo; ph < p.ph_hi; ++ph) {
      char* ws = p.ws; asm volatile("" : "+s"(ws));
    bf16_t* XB = (bf16_t*)(ws + OFF_XB);   bf16_t* QD = (bf16_t*)(ws + OFF_QD);   bf16_t* KD = (bf16_t*)(ws + OFF_KD);
    bf16_t* VDT = (bf16_t*)(ws + OFF_VDT); bf16_t* CQ = (bf16_t*)(ws + OFF_CQ);   bf16_t* CKV = (bf16_t*)(ws + OFF_CKV);
    bf16_t* XQ = (bf16_t*)(ws + OFF_XQ);   bf16_t* QM = (bf16_t*)(ws + OFF_QM);   bf16_t* KM = (bf16_t*)(ws + OFF_KM);
    bf16_t* VMT = (bf16_t*)(ws + OFF_VMT); bf16_t* MEMB = (bf16_t*)(ws + OFF_MEMB); bf16_t* KC = (bf16_t*)(ws + OFF_KC);
    bf16_t* VCT = (bf16_t*)(ws + OFF_VCT); bf16_t* W = (bf16_t*)(ws + OFF_W);     bf16_t* U = (bf16_t*)(ws + OFF_U);
    bf16_t* MERGED = KD;
    float* SSQX = (float*)(ws + OFF_SSQX); float* SSQCQ = (float*)(ws + OFF_SSQCQ); float* SSQCKV = (float*)(ws + OFF_SSQCKV);
    float* SSQMEM = (float*)(ws + OFF_SSQMEM);

    if (ph == 0) {
      phase_init(p);
      prep_range(p, 0, 0, 5152, smem);
    } else {
      const int l = (ph - 1) / p.per, kr = (ph - 1) % p.per;
      const int k = (kr > p.dupk) ? kr - (p.per - 7) : kr;
#ifndef NO_GEMM
      if (k == 0 || k == 1 || k == 3 || k == 4 || k == 5 || k == 6) {
        int nits = 0, total = 0;
        if (k == 0) { nits = 18; total = 4480; if (l > 0) prep_range(p, l, 4128, 5152, smem); }
        else if (k == 1) { nits = 8; total = 2048; }
        else if (k == 3) { nits = 24; total = 1024; }
        else if (k == 4) { nits = 4; total = 1024; }
        else if (k == 5) { nits = 16; total = 4096; if (l + 1 < NL) prep_range(p, l + 1, 0, 3104, smem); }
        else { nits = 4; total = 1024; if (l + 1 < NL) prep_range(p, l + 1, 3104, 4128, smem); }
        const bool xmap = (G == 256);
        if (!xmap) nits = ((total + G - 1) / G) * ((k == 3) ? 6 : 1);
#pragma unroll 1
        for (int it = 0; it < nits; ++it) {
          int list = 0, rb = -1, CB = 0;
          if (xmap) {
            if (k == 0) {
              if (it < 16) map_regular(it, bid, 16, rb, CB);
              else if (it == 16) { rb = bid; CB = 16; }
              else if (bid < 128) { list = 1; rb = bid >> 2; CB = bid & 3; }
            } else if (k == 1) { list = it >> 2; map_regular(it & 3, bid, 4, rb, CB); }
            else if (k == 3) map_regular(it / 6, bid, 4, rb, CB);
            else if (k == 5) map_regular(it, bid, 16, rb, CB);
            else map_regular(it, bid, 4, rb, CB);
          } else {
            const int li = ((k == 3) ? (it / 6) : it) * G + bid;
            if (li < total) {
              if (k == 0) { if (li < 4352) { rb = li / 17; CB = li % 17; } else { list = 1; rb = (li - 4352) >> 2; CB = (li - 4352) & 3; } }
              else if (k == 1) { list = li >> 10; rb = (li & 1023) >> 2; CB = li & 3; }
              else if (k == 5) { rb = li >> 4; CB = li & 15; }
              else { rb = li >> 2; CB = li & 3; }
            }
          }
          if (rb < 0) continue;
          const int row0 = rb * 256;
          const bf16_t* Ap; const bf16_t* Bp; int lda, Kd;
          const float* ssq = nullptr; int nparts = 0, pstride = T; float invK = 0.f;
          if (k == 0) {
            if (list == 0) { Ap = XB + (size_t)row0 * 1024; lda = 1024; Bp = W + W_IN + (size_t)CB * 256 * 1024; Kd = 1024; ssq = SSQX; nparts = 8; invK = 1.f / 1024; }
            else           { Ap = MEMB + (size_t)row0 * 1024; lda = 1024; Bp = W + W_MEM + (size_t)CB * 256 * 1024; Kd = 1024; ssq = SSQMEM; nparts = 1; pstride = 0; invK = 1.f / 1024; }
          } else if (k == 1) {
            if (list == 0) { Ap = CQ + (size_t)row0 * 384; lda = 384; Bp = W + W_QB + (size_t)CB * 256 * 384; Kd = 384; ssq = SSQCQ; nparts = 3; invK = 1.f / 384; }
            else           { Ap = CKV + (size_t)row0 * 256; lda = 256; Bp = W + W_KVB + (size_t)CB * 256 * 256; Kd = 256; ssq = SSQCKV; nparts = 2; invK = 1.f / 256; }
          } else if (k == 3) {
            const int st = it % 6, br = st >> 1;
            if (st & 1)       { Ap = XB + (size_t)row0 * 1024; lda = 1024; Bp = W + W_IN + (size_t)(WIN_GATE0 + br * 1024 + CB * 256) * 1024; Kd = 1024; ssq = SSQX; nparts = 8; invK = 1.f / 1024; }
            else if (br == 0) { Ap = QD + (size_t)row0 * 1024; lda = 1024; Bp = W + W_DO + (size_t)CB * 256 * 1024; Kd = 1024; }
            else if (br == 1) { Ap = QM + (size_t)row0 * 768;  lda = 768;  Bp = W + W_MO + (size_t)CB * 256 * 768;  Kd = 768; }
            else              { Ap = XQ + (size_t)row0 * 512;  lda = 512;  Bp = W + W_CO + (size_t)CB * 256 * 512;  Kd = 512; }
          } else if (k == 4) { Ap = MERGED + (size_t)row0 * 1024; lda = 1024; Bp = W + W_OUT + (size_t)CB * 256 * 1024; Kd = 1024; }
          else if (k == 5)   { Ap = XB + (size_t)row0 * 1024; lda = 1024; Bp = W + W_1 + (size_t)CB * 256 * 1024; Kd = 1024; ssq = SSQX; nparts = 8; invK = 1.f / 1024; }
          else               { Ap = U + (size_t)row0 * 4096; lda = 4096; Bp = W + W_2 + (size_t)CB * 256 * 4096; Kd = 4096; }
          f32x4v acc[2][2][4][2];
          gemm8p(Ap, Bp, Kd, acc, smem);
          float* Cs = (float*)smem;
          if (k == 5 || k == 3) {
            float* rsL = (float*)(smem + RS_OFF);
            fill_rs(rsL, ssq, nparts, pstride, row0, invK);
            __syncthreads();
            const int tq = ltid(); const int lane = tq & 63, wave = tq >> 6, wr = wave >> 2, wc = wave & 3, fr = lane & 15, fq = lane >> 4;
            const int st = it % 6, br = st >> 1;
            bf16_t* YS = VDT + (size_t)blockIdx.x * 65536;
#pragma unroll
            for (int ai = 0; ai < 2; ++ai)
#pragma unroll
              for (int m = 0; m < 4; ++m) {
                const int row = ai * 128 + wr * 64 + m * 16 + fr;
                const float rsv = rsL[row];
#pragma unroll
                for (int bj = 0; bj < 2; ++bj)
#pragma unroll
                  for (int n = 0; n < 2; ++n) {
                    const int col = bj * 128 + wc * 32 + n * 16 + fq * 4;
                    const f32x4v a4 = acc[ai][bj][m][n];
                    float o4[4];
                    if (k == 5) {
#pragma unroll
                      for (int j = 0; j < 4; ++j) { const float u = fmaxf(a4[j] * rsv, 0.f); o4[j] = u * u; }
                      u2 w; w.x = pack2(o4[0], o4[1]); w.y = pack2(o4[2], o4[3]);
                      *(u2*)(U + (size_t)(row0 + row) * 4096 + CB * 256 + col) = w;
                    } else if (!(st & 1)) {
                      u2 w; w.x = pack2(a4[0], a4[1]); w.y = pack2(a4[2], a4[3]);
                      *(u2*)(YS + (size_t)row * 256 + col) = w;
                    } else {
                      const f4 bs = *(const f4*)(p.in[5] + (size_t)l * 3072 + br * 1024 + CB * 256 + col);
                      const u2 yu = *(const u2*)(YS + (size_t)row * 256 + col);
                      bf16_t* mp_ = MERGED + (size_t)(row0 + row) * 1024 + CB * 256 + col;
                      u2 mu; mu.x = mu.y = 0u;
                      if (br > 0) mu = *(const u2*)mp_;
                      const float bsv[4] = {bs.x, bs.y, bs.z, bs.w};
                      const unsigned yw[2] = {yu.x, yu.y}, mw[2] = {mu.x, mu.y};
#pragma unroll
                      for (int j = 0; j < 4; ++j) {
                        const float g = 1.f / (1.f + __expf(-(a4[j] * rsv + bsv[j])));
                        const float y = __uint_as_float((j & 1) ? (yw[j >> 1] & 0xffff0000u) : (yw[j >> 1] << 16));
                        const float mv = __uint_as_float((j & 1) ? (mw[j >> 1] & 0xffff0000u) : (mw[j >> 1] << 16));
                        o4[j] = mv + g * y;
                      }
                      u2 w; w.x = pack2(o4[0], o4[1]); w.y = pack2(o4[2], o4[3]);
                      *(u2*)mp_ = w;
                    }
                  }
              }
          } else
#pragma unroll 1
          for (int half = 0; half < 2; ++half) {
            if (half) __syncthreads();
            {
              const int tq = ltid(); const int lane = tq & 63, wave = tq >> 6, wr = wave >> 2, wc = wave & 3, fr = lane & 15, fq = lane >> 4;
#pragma unroll
              for (int ai = 0; ai < 2; ++ai)
#pragma unroll
                for (int m = 0; m < 4; ++m)
#pragma unroll
                  for (int n = 0; n < 2; ++n) {
                    f32x4v v4;
#pragma unroll
                    for (int j = 0; j < 4; ++j) v4[j] = half ? acc[ai][1][m][n][j] : acc[ai][0][m][n][j];
                    *(f32x4v*)(Cs + (ai * 128 + wr * 64 + m * 16 + fr) * CS_LD + wc * 32 + n * 16 + fq * 4) = v4;
                  }
            }
            if (half == 0) fill_rs((float*)(smem + RS_OFF), ssq, nparts, pstride, row0, invK);
            __syncthreads();
            const int cb = CB * 2 + half;
            Tile t;
            t.row0 = row0; t.cb = cb; t.epi = EP_PLAIN;
            t.dst = nullptr; t.ldd = 0; t.gain = nullptr; t.ssq_out = nullptr; t.xsrc = nullptr; t.oscale = 1.f; t.ysrc = nullptr; t.accum = 0;
            if (k == 0) {
              if (list == 0) {
                if (cb < 8)       { t.epi = EP_HEADROT; t.cb = cb; t.dst = QD; t.ldd = 1024; t.gain = p.in[6] + l * 64; t.oscale = 0.125f * 1.4426950408889634f; }
                else if (cb < 16) { t.epi = EP_HEADROT; t.cb = cb - 8; t.dst = KD; t.ldd = 1024; t.gain = p.in[7] + l * 64; }
                else if (cb < 24) { t.epi = EP_VT; t.cb = cb - 16; const int b = row0 >> 11, s0 = row0 & 2047; t.dst = VDT + ((size_t)(b * 1024 + (cb - 16) * 128)) * SEQ + s0; t.ldd = SEQ; }
                else if (cb < 27) { t.epi = EP_PLAIN; t.cb = cb - 24; t.dst = CQ; t.ldd = 384; t.ssq_out = SSQCQ + (size_t)(cb - 24) * T; }
                else if (cb < 29) { t.epi = EP_PLAIN; t.cb = cb - 27; t.dst = CKV; t.ldd = 256; t.ssq_out = SSQCKV + (size_t)(cb - 27) * T; }
                else if (cb == 29) { t.epi = EP_KROPE; t.cb = 0; }
                else              { t.epi = EP_NORM128; t.cb = cb - 30; t.dst = XQ; t.ldd = 512; t.gain = p.in[20] + l * 128; t.oscale = 0.08838834764831845f * 1.4426950408889634f; }
              } else {
                if (cb < 4) { t.epi = EP_NORM128; t.cb = cb; t.dst = KC; t.ldd = 512; t.gain = p.in[21] + l * 128; }
                else        { t.epi = EP_VT; t.cb = cb - 4; t.dst = VCT + ((size_t)(rb * 512 + (cb - 4) * 128)) * MEML; t.ldd = MEML; }
              }
            } else if (k == 1) {
              if (list == 0) { t.epi = EP_QB; t.dst = QM; t.gain = p.in[15] + l * 96; t.oscale = 0.10206207261596575f * 1.4426950408889634f; }
              else           { t.epi = EP_KVB; t.dst = KM; t.gain = p.in[16] + l * 96; }
            } else if (k == 3) {
              const int st = it % 6, br = st >> 1;
              bf16_t* YS = VDT + (size_t)blockIdx.x * 65536;
              if (st & 1) { t.epi = EP_GATE; t.dst = MERGED; t.ysrc = YS + half * 128; t.gain = p.in[5] + (size_t)l * 3072 + br * 1024 + cb * 128; t.accum = (br > 0); }
              else        { t.epi = EP_YTMP; t.dst = YS; t.cb = half; }
            } else if (k == 4) { t.epi = EP_RES; t.dst = XB; t.xsrc = (l == 0) ? p.in[0] : p.out; t.ssq_out = SSQX + (size_t)cb * T; }
            else if (k == 5)   { t.epi = EP_MLP1; t.dst = U; t.ldd = 4096; }
            else               { t.epi = EP_RES; t.dst = XB; t.xsrc = p.out; t.ssq_out = SSQX + (size_t)cb * T; }
            run_epilogue(p, t, smem);
          }
        }
      } else
#endif
#ifndef NO_ATT
      if (k == 2) {
        float lam;
        const float lam_init = 0.8f - 0.6f * expf(-0.3f * (float)l);
        {
          const int lane = ltid() & 63;
          const float* lv = p.in[8] + l * 256;
          float sa = lv[lane] * lv[64 + lane], sb = lv[128 + lane] * lv[192 + lane];
#pragma unroll
          for (int m = 32; m >= 1; m >>= 1) { sa += __shfl_xor(sa, m); sb += __shfl_xor(sb, m); }
          lam = expf(sa) - expf(sb) + lam_init;
        }
        const float L2E = 1.4426950408889634f;
#pragma unroll 1
        for (int it = 0; it < ((G == 256) ? 16 : (4096 + G - 1) / G); ++it) {
          int w;
          if (G == 256) {
            const int xcd = bid & 7, slot = bid >> 3;
            if (it < 8)       w = ((it * 32 + (slot >> 3) * 8 + xcd) << 3) + (slot & 7);
            else if (it < 12) w = 2048 + ((((it - 8) * 64 + (slot >> 2) * 8 + xcd) << 2) + (slot & 3));
            else              w = 3072 + ((((it - 12) * 32 + (slot >> 3) * 8 + xcd) << 3) + (slot & 7));
          } else { w = it * G + bid; if (w >= 4096) continue; }
#ifndef NO_A1
          if (w < 2048) {
            const int bh = w >> 3, j = w & 7, b = bh >> 3, hh = bh & 7;
#pragma unroll 1
            for (int half = 0; half < 2; ++half) {
              const int qb = half ? j : 15 - j;
              const int q0 = qb * 128;
              bf16_t* Qp = QD + ((size_t)(b * SEQ + q0)) * 1024 + hh * 128;
              attn_block<64, 128, 2, true>(Qp, 1024, KD + (size_t)b * SEQ * 1024 + hh * 128, 1024, VDT + ((size_t)(b * 1024 + hh * 128)) * SEQ, SEQ,
                                            (q0 + 128) >> 6, q0, Qp, 1024, 0.125f * L2E, lam, p.in[9] + l * 128, 1.f - lam_init, smem);
            }
          } else
#endif
#ifndef NO_A2
          if (w < 3072) {
            const int wj = w - 2048; const int bh = wj >> 2, j = wj & 3, b = bh >> 3, hh = bh & 7;
#pragma unroll 1
            for (int half = 0; half < 2; ++half) {
              const int qb = half ? j : 7 - j;
              const int q0 = qb * 256;
              bf16_t* Qp = QM + ((size_t)(b * SEQ + q0)) * 768 + hh * 96;
              attn_block<96, 64, 1, true>(Qp, 768, KM + (size_t)b * SEQ * 768 + hh * 96, 768, VMT + ((size_t)(b * 512 + hh * 64)) * SEQ, SEQ,
                                           (q0 + 256) >> 6, q0, Qp, 768, 0.10206207261596575f * L2E, 0.f, nullptr, 1.f, smem);
            }
          } else
#endif
#ifndef NO_A3
          {
            const int wj = w - 3072; const int bh = wj >> 3, qb = wj & 7, b = bh >> 2, hh = bh & 3;
            const int q0 = qb * 256;
            bf16_t* Qp = XQ + ((size_t)(b * SEQ + q0)) * 512 + hh * 128;
            attn_block<128, 128, 1, false>(Qp, 512, KC + (size_t)b * MEML * 512 + hh * 128, 512, VCT + ((size_t)(b * 512 + hh * 128)) * MEML, MEML,
                                            4, q0, Qp, 512, 0.08838834764831845f * L2E, 0.f, nullptr, 1.f, smem);
          }
#endif
          {}
        }
      } else
#endif
#ifndef NO_D
      if (k == 3) {
        float* Cs = (float*)smem;
        float* rs = (float*)(smem + RS_OFF);
#pragma unroll 1
        for (int it = 0; it < ((G == 256) ? 8 : (2048 + G - 1) / G); ++it) {
          int rb, cb;
          if (G == 256) map_regular(it, bid, 8, rb, cb);
          else { const int li = it * G + bid; if (li >= 2048) continue; rb = li >> 3; cb = li & 7; }
          const int tidd = ltid(); const int lane = tidd & 63, wave = tidd >> 6, wm = wave >> 1, wn = wave & 1, h = lane >> 5;
          const int row0 = rb * 256, col0 = cb * 128;
          __syncthreads();
          fill_rs(rs, SSQX, 8, T, row0, 1.f / 1024);
          f32x16 acc[2][2];
          unsigned gp[2][2][8], mp[2][2][8];
#pragma unroll
          for (int mi = 0; mi < 2; ++mi)
#pragma unroll
            for (int ni = 0; ni < 2; ++ni)
#pragma unroll
              for (int i = 0; i < 8; ++i) mp[mi][ni][i] = 0u;
#pragma unroll 1
          for (int st = 0; st < 6; ++st) {
            const int br = st >> 1, half = st & 1;
            const bf16_t* Ab; const bf16_t* Bb; int Kb;
            if (half == 0)    { Ab = XB + (size_t)row0 * 1024; Bb = W + W_IN + (size_t)(WIN_GATE0 + br * 1024 + col0) * 1024; Kb = 1024; }
            else if (br == 0) { Ab = QD + (size_t)row0 * 1024; Bb = W + W_DO + (size_t)col0 * 1024; Kb = 1024; }
            else if (br == 1) { Ab = QM + (size_t)row0 * 768;  Bb = W + W_MO + (size_t)col0 * 768;  Kb = 768; }
            else              { Ab = XQ + (size_t)row0 * 512;  Bb = W + W_CO + (size_t)col0 * 512;  Kb = 512; }
            gemm_mainloop<2, 2, 2, false>(Ab, Kb, Bb, Kb, Kb, acc, smem);
            if (half == 0) {
              const float* bg = p.in[5] + (size_t)l * 3072 + br * 1024 + col0 + wn * 64 + (lane & 31);
              const float bgv0 = bg[0], bgv1 = bg[32];
#pragma unroll
              for (int mi = 0; mi < 2; ++mi) {
                float rsv[16];
#pragma unroll
                for (int i = 0; i < 16; ++i) rsv[i] = rs[wm * 64 + mi * 32 + crow(i, h)];
#pragma unroll
                for (int ni = 0; ni < 2; ++ni) {
                  const float bgv = ni ? bgv1 : bgv0;
#pragma unroll
                  for (int i = 0; i < 16; i += 2) {
                    const float z0 = acc[mi][ni][i] * rsv[i] + bgv;
                    const float z1 = acc[mi][ni][i + 1] * rsv[i + 1] + bgv;
                    gp[mi][ni][i >> 1] = pack2(1.f / (1.f + __expf(-z0)), 1.f / (1.f + __expf(-z1)));
                  }
                }
                __builtin_amdgcn_sched_barrier(0);
              }
            } else {
#pragma unroll
              for (int mi = 0; mi < 2; ++mi)
#pragma unroll
                for (int ni = 0; ni < 2; ++ni)
#pragma unroll
                  for (int i = 0; i < 16; i += 2) {
                    const unsigned g2 = gp[mi][ni][i >> 1], m2 = mp[mi][ni][i >> 1];
                    const float m0 = __uint_as_float(m2 << 16) + __uint_as_float(g2 << 16) * acc[mi][ni][i];
                    const float m1 = __uint_as_float(m2 & 0xffff0000u) + __uint_as_float(g2 & 0xffff0000u) * acc[mi][ni][i + 1];
                    mp[mi][ni][i >> 1] = pack2(m0, m1);
                  }
            }
          }
#pragma unroll
          for (int mi = 0; mi < 2; ++mi)
#pragma unroll
            for (int ni = 0; ni < 2; ++ni)
#pragma unroll
              for (int i = 0; i < 16; ++i) {
                const unsigned m2 = mp[mi][ni][i >> 1];
                Cs[(wm * 64 + mi * 32 + crow(i, h)) * CS_LD + wn * 64 + ni * 32 + (lane & 31)] = __uint_as_float((i & 1) ? (m2 & 0xffff0000u) : (m2 << 16));
              }
          __syncthreads();
          const int q = tidd & 15, rsub = tidd >> 4;
#pragma unroll 1
          for (int pass = 0; pass < 8; ++pass) {
            const int r = rsub + 32 * pass;
            float v[8];
            load8(Cs, r, q, v);
            *(u4*)(MERGED + (size_t)(row0 + r) * 1024 + col0 + q * 8) = pack8(v);
          }
        }
      }
#endif
      {}
    }
    if (ph + 1 < p.ph_hi) grid.sync();
  }
}

extern "C" void kernel_launch(void* const* d_in, const int* in_sizes, int n_in, void* d_out, int out_size, void* d_ws, size_t ws_size, hipStream_t stream) {
  static int grid_blocks = 0;
  if (grid_blocks == 0) {
    if (n_in != 27 || ws_size < WS_NEED) { fprintf(stderr, "kernel_launch: unexpected inputs (n_in %d) or workspace (%zu < %zu)\n", n_in, ws_size, (size_t)WS_NEED); grid_blocks = -1; return; }
    int dev = 0, cus = 0, per_cu = 0;
    hipGetDevice(&dev);
    hipDeviceGetAttribute(&cus, hipDeviceAttributeMultiprocessorCount, dev);
    hipOccupancyMaxActiveBlocksPerMultiprocessor(&per_cu, mega_fwd, NTHR, 0);
    if (per_cu < 1) per_cu = 1;
    if (per_cu > 1) per_cu = 1;
    grid_blocks = cus * per_cu;
  }
  if (grid_blocks < 0) return;
  Params p{};
  for (int i = 0; i < 27; ++i) p.in[i] = (const float*)d_in[i];
  p.out = (float*)d_out;
  p.ws = (char*)d_ws;
  p.ph_lo = 0;
  p.dupk = (DUP_K >= 0) ? DUP_K : 100;
  p.per = (DUP_K >= 0) ? 8 : 7;
  p.ph_hi = 1 + NL * p.per;
  void* args[] = {&p};
  hipError_t e = hipLaunchCooperativeKernel((void*)mega_fwd, dim3(grid_blocks), dim3(NTHR), args, 0, stream);
  if (e != hipSuccess) fprintf(stderr, "cooperative launch failed: %s (grid %d)\n", hipGetErrorString(e), grid_blocks);
}
```

```cpp
#include <hip/hip_runtime.h>
#include <hip/hip_cooperative_groups.h>
#include <stdint.h>
#include <stdio.h>
#define NO_D 1
namespace cg = cooperative_groups;

typedef unsigned short bf16_t;
using bf16x8 = __attribute__((ext_vector_type(8))) short;
using f32x16 = __attribute__((ext_vector_type(16))) float;
typedef unsigned u4 __attribute__((ext_vector_type(4)));
typedef unsigned u2 __attribute__((ext_vector_type(2)));
typedef float f4 __attribute__((ext_vector_type(4)));
#define DI __device__ __forceinline__
#define MFMA(a, b, c) __builtin_amdgcn_mfma_f32_32x32x16_bf16((a), (b), (c), 0, 0, 0)

constexpr int T = 65536, DM = 1024, NB = 32, SEQ = 2048, NL = 4, MEML = 256, MEMR = NB * MEML;
constexpr int NTHR = 512;
constexpr int DUP_K = -1;
constexpr float EPSV = 1e-6f;
constexpr int WIN_N = 7424;
constexpr int WIN_GATE0 = 4352;

constexpr size_t MiB = 1024ull * 1024ull;
constexpr size_t OFF_XB = 0;
constexpr size_t OFF_QD = OFF_XB + 128 * MiB;
constexpr size_t OFF_KD = OFF_QD + 128 * MiB;
constexpr size_t OFF_VDT = OFF_KD + 128 * MiB;
constexpr size_t OFF_CQ = OFF_VDT + 128 * MiB;
constexpr size_t OFF_CKV = OFF_CQ + 48 * MiB;
constexpr size_t OFF_KR = OFF_CKV + 32 * MiB;
constexpr size_t OFF_XQ = OFF_KR + 8 * MiB;
constexpr size_t OFF_QM = OFF_XQ + 64 * MiB;
constexpr size_t OFF_KM = OFF_QM + 96 * MiB;
constexpr size_t OFF_VMT = OFF_KM + 96 * MiB;
constexpr size_t OFF_MEMB = OFF_VMT + 64 * MiB;
constexpr size_t OFF_KC = OFF_MEMB + 16 * MiB;
constexpr size_t OFF_VCT = OFF_KC + 8 * MiB;
constexpr size_t OFF_SSQX = OFF_VCT + 8 * MiB;
constexpr size_t OFF_SSQCQ = OFF_SSQX + 2 * MiB;
constexpr size_t OFF_SSQCKV = OFF_SSQCQ + 1 * MiB;
constexpr size_t OFF_SSQMEM = OFF_SSQCKV + 1 * MiB;
constexpr size_t OFF_W = OFF_SSQMEM + 1 * MiB;
constexpr size_t OFF_U = OFF_QD;
constexpr size_t W_IN = 0;
constexpr size_t W_MEM = W_IN + (size_t)WIN_N * 1024;
constexpr size_t W_QB = W_MEM + 1024 * 1024;
constexpr size_t W_KVB = W_QB + 1024 * 384;
constexpr size_t W_DO = W_KVB + 1024 * 256;
constexpr size_t W_MO = W_DO + 1024 * 1024;
constexpr size_t W_CO = W_MO + 1024 * 768;
constexpr size_t W_OUT = W_CO + 1024 * 512;
constexpr size_t W_1 = W_OUT + 1024 * 1024;
constexpr size_t W_2 = W_1 + 4096 * 1024;
constexpr size_t W_END = W_2 + 4096 * 1024;
constexpr size_t WS_NEED = OFF_W + W_END * 2;

constexpr int LDS_ROW = 144;
constexpr int CS_LD = 132;
constexpr int CS_BYTES = 256 * CS_LD * 4;
constexpr int RS_OFF = 2 * 512 * LDS_ROW;
constexpr int LDS_BYTES = RS_OFF + 1024;

__constant__ float INVF64[32] = {1.000000000e+00f,7.498942614e-01f,5.623413324e-01f,4.216965139e-01f,3.162277639e-01f,2.371373773e-01f,1.778279394e-01f,1.333521307e-01f,1.000000015e-01f,7.498941571e-02f,5.623413250e-02f,4.216965288e-02f,3.162277490e-02f,2.371373773e-02f,1.778279431e-02f,1.333521493e-02f,9.999999776e-03f,7.498941850e-03f,5.623413250e-03f,4.216964822e-03f,3.162277630e-03f,2.371373586e-03f,1.778279431e-03f,1.333521446e-03f,1.000000047e-03f,7.498942432e-04f,5.623413017e-04f,4.216965172e-04f,3.162277571e-04f,2.371373703e-04f,1.778279402e-04f,1.333521504e-04f};
__constant__ float INVF32[16] = {1.000000000e+00f,5.623413324e-01f,3.162277639e-01f,1.778279394e-01f,1.000000015e-01f,5.623413250e-02f,3.162277490e-02f,1.778279431e-02f,9.999999776e-03f,5.623413250e-03f,3.162277630e-03f,1.778279431e-03f,1.000000047e-03f,5.623413017e-04f,3.162277571e-04f,1.778279402e-04f};

struct Params {
  const float* in[27];
  float* out;
  char* ws;
  int ph_lo, ph_hi;
  int dupk, per;
};

typedef __bf16 bf2_t __attribute__((ext_vector_type(2)));
typedef float fl2_t __attribute__((ext_vector_type(2)));
DI unsigned pack2(float a, float b) { fl2_t f = {a, b}; bf2_t r = __builtin_convertvector(f, bf2_t); return __builtin_bit_cast(unsigned, r); }
DI u4 pack8(const float* v) { u4 u; u.x = pack2(v[0], v[1]); u.y = pack2(v[2], v[3]); u.z = pack2(v[4], v[5]); u.w = pack2(v[6], v[7]); return u; }
DI int ltid() { int t = threadIdx.x; asm volatile("" : "+v"(t)); return t; }
DI int crow(int i, int h) { return (i & 3) + 8 * (i >> 2) + 4 * h; }
DI void rot_cs(int pos, float invf, float& c, float& s) {
  const float ang = (float)pos * invf;
  double rev = (double)ang * 0.15915494309189535;
  rev -= floor(rev);
  const float rf = (float)rev;
  c = __builtin_amdgcn_cosf(rf);
  s = __builtin_amdgcn_sinf(rf);
}
DI void load8(const float* Cs, int r, int q, float* v) {
  const f4 a = *(const f4*)(Cs + r * CS_LD + q * 8);
  const f4 b = *(const f4*)(Cs + r * CS_LD + q * 8 + 4);
  v[0] = a.x; v[1] = a.y; v[2] = a.z; v[3] = a.w; v[4] = b.x; v[5] = b.y; v[6] = b.z; v[7] = b.w;
}

template <int MI, int NI, int WGN, bool FDB>
DI void gemm_mainloop(const bf16_t* __restrict__ A, int lda, const bf16_t* __restrict__ B, int ldb, int K, f32x16 (&acc)[MI][NI], char* smem) {
  constexpr int BM = (8 / WGN) * MI * 32, BN = WGN * NI * 32;
  constexpr int ASZ = BM * 64, STAGE = (BM + BN) * 64;
  constexpr int NGA = BM / 128, NGB = BN / 128, NLD = NGA + NGB;
  static_assert(4 * STAGE <= RS_OFF, "ring");
  const int tid = ltid(), lane = tid & 63, wave = tid >> 6, l31 = lane & 31, h = lane >> 5;
  const int wu = __builtin_amdgcn_readfirstlane(wave);
  const int wm = wave / WGN, wn = wave % WGN;
  const int lrow = lane >> 2, lchk = (lane & 3) ^ ((lane >> 4) & 3);
  const bf16_t* ga = A + (size_t)(wu * NGA * 16 + lrow) * lda + lchk * 8;
  const bf16_t* gb = B + (size_t)(wu * NGB * 16 + lrow) * ldb + lchk * 8;
#pragma unroll
  for (int mi = 0; mi < MI; ++mi)
#pragma unroll
    for (int ni = 0; ni < NI; ++ni)
#pragma unroll
      for (int i = 0; i < 16; ++i) acc[mi][ni][i] = 0.f;
  auto issue = [&](int j) {
    char* st = smem + (j & 3) * STAGE;
    const int k0 = j * 32;
#pragma unroll
    for (int i = 0; i < NGA; ++i)
      __builtin_amdgcn_global_load_lds((const unsigned*)(ga + (size_t)(i * 16) * lda + k0), (unsigned*)(st + (wu * NGA + i) * 1024), 16, 0, 0);
#pragma unroll
    for (int i = 0; i < NGB; ++i)
      __builtin_amdgcn_global_load_lds((const unsigned*)(gb + (size_t)(i * 16) * ldb + k0), (unsigned*)(st + ASZ + (wu * NGB + i) * 1024), 16, 0, 0);
  };
  asm volatile("s_waitcnt vmcnt(0)" ::: "memory");
  __syncthreads();
  const int nk = K >> 5;
  issue(0); issue(1); issue(2);
  const int sw = (l31 >> 2) & 3;
  const int oa = (wm * MI * 32 + l31) * 64, ob = ASZ + (wn * NI * 32 + l31) * 64;
  const int c0 = ((0 + h) ^ sw) * 16, c1 = ((2 + h) ^ sw) * 16;
#pragma unroll 1
  for (int j = 0; j < nk; ++j) {
    if (j + 2 < nk) asm volatile("s_waitcnt vmcnt(%0)" ::"n"(2 * NLD) : "memory");
    else if (j + 1 < nk) asm volatile("s_waitcnt vmcnt(%0)" ::"n"(NLD) : "memory");
    else asm volatile("s_waitcnt vmcnt(0)" ::: "memory");
    asm volatile("s_waitcnt lgkmcnt(0)" ::: "memory");
    __builtin_amdgcn_s_barrier();
    if (j + 3 < nk) issue(j + 3);
    const char* st = smem + (j & 3) * STAGE;
    const char* pa = st + oa;
    const char* pb = st + ob;
    bf16x8 fa0[MI], fb0[NI], fa1[MI], fb1[NI];
#pragma unroll
    for (int mi = 0; mi < MI; ++mi) fa0[mi] = *(const bf16x8*)(pa + mi * 2048 + c0);
#pragma unroll
    for (int ni = 0; ni < NI; ++ni) fb0[ni] = *(const bf16x8*)(pb + ni * 2048 + c0);
    if (FDB) {
#pragma unroll
      for (int mi = 0; mi < MI; ++mi) fa1[mi] = *(const bf16x8*)(pa + mi * 2048 + c1);
#pragma unroll
      for (int ni = 0; ni < NI; ++ni) fb1[ni] = *(const bf16x8*)(pb + ni * 2048 + c1);
    }
#pragma unroll
    for (int mi = 0; mi < MI; ++mi)
#pragma unroll
      for (int ni = 0; ni < NI; ++ni) acc[mi][ni] = MFMA(fa0[mi], fb0[ni], acc[mi][ni]);
    __builtin_amdgcn_sched_barrier(0);
    if (!FDB) {
#pragma unroll
      for (int mi = 0; mi < MI; ++mi) fa1[mi] = *(const bf16x8*)(pa + mi * 2048 + c1);
#pragma unroll
      for (int ni = 0; ni < NI; ++ni) fb1[ni] = *(const bf16x8*)(pb + ni * 2048 + c1);
    }
#pragma unroll
    for (int mi = 0; mi < MI; ++mi)
#pragma unroll
      for (int ni = 0; ni < NI; ++ni) acc[mi][ni] = MFMA(fa1[mi], fb1[ni], acc[mi][ni]);
    __builtin_amdgcn_sched_barrier(0);
  }
  asm volatile("s_waitcnt lgkmcnt(0)" ::: "memory");
  __builtin_amdgcn_s_barrier();
}

using f32x4v = __attribute__((ext_vector_type(4))) float;
DI int lds_byte8(int r, int c) {
  const int st = (r >> 4) * 2 + (c >> 5), rr = r & 15, cc = c & 31, ob = rr * 64 + cc * 2;
  return st * 1024 + (ob ^ (((ob >> 9) & 1) << 5));
}
DI void stage_rc8(int b, int& R, int& C) {
  const int st = b / 1024, sb = b % 1024, swz = sb ^ (((sb >> 9) & 1) << 5);
  R = (st >> 1) * 16 + swz / 64; C = (st & 1) * 32 + (swz % 64) / 2;
}
DI void gemm8p(const bf16_t* __restrict__ A, const bf16_t* __restrict__ Bt, int K, f32x4v (&acc)[2][2][4][2], char* smem) {
  constexpr int BK8 = 64, HALF8 = 128, HTB = HALF8 * BK8 * 2;
  const int tid = ltid(), wid = tid >> 6, lane = tid & 63, wr = wid >> 2, wc = wid & 3, fr = lane & 15, fq = lane >> 4;
  const int wu8 = __builtin_amdgcn_readfirstlane(wid);
  unsigned goff[2];
#pragma unroll
  for (int i_ = 0; i_ < 2; ++i_) { int r_, c_; stage_rc8(tid * 16 + i_ * 8192, r_, c_); goff[i_] = (unsigned)(r_ * K + c_); }
  const int lfrag = ((fr * 64 + fq * 16) ^ ((fr >> 3) << 5));
  const char* la = smem + wr * 8192 + lfrag;
  const char* lb = smem + 4 * HTB + wc * 4096 + lfrag;
#define SA8(b, h) ((b) * 2 + (h))
#define SB8(b, h) (4 + (b) * 2 + (h))
#define STAGE8(Q, BASE, br, kt) do { const bf16_t* sb_ = (BASE) + ((long)(br) * K + (long)(kt) * BK8); \
    _Pragma("unroll") for (int i_ = 0; i_ < 2; ++i_) \
      __builtin_amdgcn_global_load_lds((const unsigned*)(sb_ + goff[i_]), (unsigned*)(smem + (Q) * HTB + i_ * 8192 + wu8 * 1024), 16, 0, 0); } while (0)
#define LDA8(dst, b, h) _Pragma("unroll") for (int m = 0; m < 4; ++m) _Pragma("unroll") for (int k = 0; k < 2; ++k) \
    dst[m][k] = *(const bf16x8*)(la + ((b) * 2 + (h)) * HTB + (m * 2 + k) * 1024)
#define LDB8(dst, b, h) _Pragma("unroll") for (int n = 0; n < 2; ++n) _Pragma("unroll") for (int k = 0; k < 2; ++k) \
    dst[n][k] = *(const bf16x8*)(lb + ((b) * 2 + (h)) * HTB + (n * 2 + k) * 1024)
#define MMA8(ai, bj, At_, Bt_) do { __builtin_amdgcn_s_setprio(1); \
    _Pragma("unroll") for (int m = 0; m < 4; ++m) _Pragma("unroll") for (int n = 0; n < 2; ++n) _Pragma("unroll") for (int k = 0; k < 2; ++k) \
      acc[ai][bj][m][n] = __builtin_amdgcn_mfma_f32_16x16x32_bf16(Bt_[n][k], At_[m][k], acc[ai][bj][m][n], 0, 0, 0); \
    __builtin_amdgcn_s_setprio(0); } while (0)
#define WAIT_V8(n) asm volatile("s_waitcnt vmcnt(" #n ")" ::: "memory")
#define WAIT_L8(n) asm volatile("s_waitcnt lgkmcnt(" #n ")" ::: "memory")
#define BAR8 __builtin_amdgcn_s_barrier()
#define SCHED8 __builtin_amdgcn_sched_barrier(0)
#pragma unroll
  for (int a = 0; a < 2; ++a)
#pragma unroll
    for (int b = 0; b < 2; ++b)
#pragma unroll
      for (int m = 0; m < 4; ++m)
#pragma unroll
        for (int n = 0; n < 2; ++n) acc[a][b][m][n] = f32x4v{0.f, 0.f, 0.f, 0.f};
  bf16x8 At[4][2], B0[2][2], B1[2][2];
  const int nt = K / BK8;
  asm volatile("s_waitcnt vmcnt(0)" ::: "memory");
  __syncthreads();
  STAGE8(SB8(0, 0), Bt, 0, 0); STAGE8(SA8(0, 0), A, 0, 0);
  STAGE8(SB8(0, 1), Bt, HALF8, 0); STAGE8(SA8(0, 1), A, HALF8, 0);
  if (wr == 1) BAR8;
  WAIT_V8(4); BAR8;
  STAGE8(SB8(1, 0), Bt, 0, 1); STAGE8(SA8(1, 0), A, 0, 1); STAGE8(SB8(1, 1), Bt, HALF8, 1);
  WAIT_V8(6); BAR8;
#pragma unroll 1
  for (int t = 0; t < nt - 2; t += 2) {
    LDB8(B0, 0, 0); SCHED8; LDA8(At, 0, 0); STAGE8(SA8(1, 1), A, HALF8, t + 1);
    WAIT_L8(8); BAR8; WAIT_L8(0); MMA8(0, 0, At, B0); BAR8; SCHED8;
    LDB8(B1, 0, 1); STAGE8(SB8(0, 0), Bt, 0, t + 2);
    BAR8; WAIT_L8(0); MMA8(0, 1, At, B1); BAR8;
    LDA8(At, 0, 1); STAGE8(SA8(0, 0), A, 0, t + 2);
    BAR8; WAIT_L8(0); MMA8(1, 0, At, B0); BAR8; SCHED8;
    STAGE8(SB8(0, 1), Bt, HALF8, t + 2);
    WAIT_V8(6); BAR8; MMA8(1, 1, At, B1); BAR8;
    LDB8(B0, 1, 0); SCHED8; LDA8(At, 1, 0); STAGE8(SA8(0, 1), A, HALF8, t + 2);
    WAIT_L8(8); BAR8; WAIT_L8(0); MMA8(0, 0, At, B0); BAR8; SCHED8;
    LDB8(B1, 1, 1); STAGE8(SB8(1, 0), Bt, 0, t + 3);
    BAR8; WAIT_L8(0); MMA8(0, 1, At, B1); BAR8;
    LDA8(At, 1, 1); STAGE8(SA8(1, 0), A, 0, t + 3);
    BAR8; WAIT_L8(0); MMA8(1, 0, At, B0); BAR8; SCHED8;
    STAGE8(SB8(1, 1), Bt, HALF8, t + 3);
    WAIT_V8(6); BAR8; MMA8(1, 1, At, B1); BAR8;
  }
  { LDB8(B0, 0, 0); LDA8(At, 0, 0); STAGE8(SA8(1, 1), A, HALF8, nt - 1);
    BAR8; WAIT_L8(0); MMA8(0, 0, At, B0); BAR8;
    LDB8(B1, 0, 1); BAR8; WAIT_L8(0); MMA8(0, 1, At, B1); BAR8;
    LDA8(At, 0, 1); WAIT_V8(4); BAR8; WAIT_L8(0); MMA8(1, 0, At, B0); MMA8(1, 1, At, B1); BAR8; }
  { LDB8(B0, 1, 0); LDA8(At, 1, 0); WAIT_V8(2); BAR8; WAIT_L8(0); MMA8(0, 0, At, B0); BAR8;
    LDB8(B1, 1, 1); WAIT_V8(0); BAR8; WAIT_L8(0); MMA8(0, 1, At, B1); BAR8;
    LDA8(At, 1, 1); BAR8; WAIT_L8(0); MMA8(1, 0, At, B0); MMA8(1, 1, At, B1); BAR8; }
  if (wr == 0) BAR8;
  asm volatile("s_waitcnt lgkmcnt(0)" ::: "memory");
  BAR8;
#undef SA8
#undef SB8
#undef STAGE8
#undef LDA8
#undef LDB8
#undef MMA8
#undef WAIT_V8
#undef WAIT_L8
#undef BAR8
#undef SCHED8
}

DI void fill_rs(float* rs, const float* ssq, int nparts, int pstride, int row0, float invK) {
  const int t = ltid();
  if (t < 256) {
    float r = 1.f;
    if (ssq) {
      float s = 0.f;
      for (int p = 0; p < nparts; ++p) s += ssq[(size_t)p * pstride + row0 + t];
      r = rsqrtf(s * invK + EPSV);
    }
    rs[t] = r;
  }
}

enum { EP_HEADROT = 0, EP_VT, EP_PLAIN, EP_KROPE, EP_NORM128, EP_QB, EP_KVB, EP_RES, EP_MLP1, EP_YTMP, EP_GATE };

struct Tile {
  int epi, row0, cb;
  bf16_t* dst; int ldd;
  const float* gain;
  float* ssq_out;
  const float* xsrc;
  float oscale;
  const bf16_t* ysrc;
  int accum;
};

DI void map_regular(int it, int bid, int NCB, int& rb, int& CB) {
  const int xcd = bid & 7, slot = bid >> 3;
  const int c = xcd * NCB + it;
  const int cgrp = c >> 5, rgrp = c & 31;
  rb = rgrp * 8 + (slot >> 2);
  CB = cgrp * 4 + (slot & 3);
}

template <int DK, int DV, int NM, bool CAUSAL>
DI void attn_block(const bf16_t* __restrict__ Q, int ldq, const bf16_t* __restrict__ Kg, int ldk, const bf16_t* __restrict__ Vt, int ldv,
                   int nkt, int q0, bf16_t* O, int ldo, float sc, float lam, const float* og, float omul, char* smem) {
  constexpr int KW = NM * DK, KCHV = KW / 8;
  constexpr int KBYTES = 64 * 256, VBYTES = DV * 128, STAGE = KBYTES + VBYTES;
  constexpr int NVI = DV / 64;
  constexpr int NLD = 2 + NVI;
  static_assert(KCHV <= 16 && 4 * STAGE <= RS_OFF, "lds");
  constexpr int NKC16 = DK / 16, NDVB = DV / 32;
  const int tid = ltid(), lane = tid & 63, wave = tid >> 6, h = lane >> 5, l31 = lane & 31;
  const int wq = (NM == 2) ? (wave & 3) : wave;
  const int mymap = (NM == 2) ? (wave >> 2) : 0;
  const int q0w = q0 + wq * 32;

  bf16x8 qf[NKC16];
  {
    const bf16_t* qp = Q + (size_t)(wq * 32 + l31) * ldq + mymap * DK + h * 8;
#pragma unroll
    for (int kc = 0; kc < NKC16; ++kc) qf[kc] = *(const bf16x8*)(qp + kc * 16);
#pragma unroll
    for (int kc = 0; kc < NKC16; ++kc) asm volatile("" : "+v"(qf[kc]));
  }
  f32x16 o[NDVB];
#pragma unroll
  for (int d = 0; d < NDVB; ++d)
#pragma unroll
    for (int i = 0; i < 16; ++i) o[d][i] = 0.f;
  f32x16 lacc;
#pragma unroll
  for (int i = 0; i < 16; ++i) lacc[i] = 0.f;
  u4 onesu; onesu.x = onesu.y = onesu.z = onesu.w = 0x3F803F80u;
  const bf16x8 ones = __builtin_bit_cast(bf16x8, onesu);

  const int wu = __builtin_amdgcn_readfirstlane(wave);
  const int krow = lane >> 4, kslot = lane & 15;
  const int vrow = lane >> 3, vslot = lane & 7;
  auto issue = [&](int kt) {
    char* st = smem + (kt & 3) * STAGE;
#pragma unroll
    for (int i = 0; i < 2; ++i) {
      const int r = (wu * 2 + i) * 4 + krow;
      const int c = kslot ^ (r & 15);
      if (KCHV == 16 || c < KCHV)
        __builtin_amdgcn_global_load_lds((const unsigned*)(Kg + (size_t)(kt * 64 + r) * ldk + c * 8), (unsigned*)(st + (wu * 2 + i) * 1024), 16, 0, 0);
    }
#pragma unroll
    for (int i = 0; i < NVI; ++i) {
      const int d = (wu * NVI + i) * 8 + vrow;
      const int c = vslot ^ ((d >> 1) & 7);
      __builtin_amdgcn_global_load_lds((const unsigned*)(Vt + (size_t)d * ldv + kt * 64 + c * 8), (unsigned*)(st + KBYTES + (wu * NVI + i) * 1024), 16, 0, 0);
    }
  };
  asm volatile("s_waitcnt vmcnt(0)" ::: "memory");
  __syncthreads();
  if (0 < nkt) issue(0);
  if (1 < nkt) issue(1);
  if (2 < nkt) issue(2);
  for (int kt = 0; kt < nkt; ++kt) {
    if (kt + 2 < nkt) asm volatile("s_waitcnt vmcnt(%0)" ::"n"(2 * NLD) : "memory");
    else if (kt + 1 < nkt) asm volatile("s_waitcnt vmcnt(%0)" ::"n"(NLD) : "memory");
    else asm volatile("s_waitcnt vmcnt(0)" ::: "memory");
    asm volatile("s_waitcnt lgkmcnt(0)" ::: "memory");
    __builtin_amdgcn_s_barrier();
    if (kt + 3 < nkt) issue(kt + 3);
    const bool skip = CAUSAL && (kt * 64 > q0w + 31);
    if (!skip) {
      const char* base = smem + (kt & 3) * STAGE;
      f32x16 s[2];
#pragma unroll
      for (int sb = 0; sb < 2; ++sb) {
#pragma unroll
        for (int i = 0; i < 16; ++i) s[sb][i] = 0.f;
        const char* pk = base + (sb * 32 + l31) * 256;
#pragma unroll
        for (int kc = 0; kc < NKC16; ++kc) {
          const bf16x8 a = *(const bf16x8*)(pk + (((mymap * (DK / 8) + kc * 2 + h) ^ (l31 & 15)) * 16));
          s[sb] = MFMA(a, qf[kc], s[sb]);
        }
        __builtin_amdgcn_sched_barrier(0);
      }
      const bool need_mask = CAUSAL && (kt * 64 + 63 > q0w);
#pragma unroll
      for (int sb = 0; sb < 2; ++sb)
#pragma unroll
        for (int i = 0; i < 16; ++i) {
          float pz = __builtin_amdgcn_exp2f(s[sb][i]);
          if (need_mask) {
            const int key = kt * 64 + sb * 32 + crow(i, h);
            if (key > q0w + l31) pz = 0.f;
          }
          s[sb][i] = pz;
        }
      const char* pv = base + KBYTES + l31 * 128;
      const int vsw = (l31 >> 1) & 7;
#pragma unroll
      for (int ks = 0; ks < 4; ++ks) {
        u4 pu;
        pu.x = pack2(s[ks >> 1][(ks & 1) * 8 + 0], s[ks >> 1][(ks & 1) * 8 + 1]);
        pu.y = pack2(s[ks >> 1][(ks & 1) * 8 + 2], s[ks >> 1][(ks & 1) * 8 + 3]);
        pu.z = pack2(s[ks >> 1][(ks & 1) * 8 + 4], s[ks >> 1][(ks & 1) * 8 + 5]);
        pu.w = pack2(s[ks >> 1][(ks & 1) * 8 + 6], s[ks >> 1][(ks & 1) * 8 + 7]);
        const bf16x8 pf = __builtin_bit_cast(bf16x8, pu);
        lacc = MFMA(ones, pf, lacc);
#pragma unroll
        for (int d = 0; d < NDVB; ++d) {
          const u4 au = *(const u4*)(pv + d * 32 * 128 + (((ks * 2 + h) ^ vsw) * 16));
          o[d] = MFMA(__builtin_bit_cast(bf16x8, au), pf, o[d]);
        }
        __builtin_amdgcn_sched_barrier(0);
      }
    }
  }
  asm volatile("s_waitcnt lgkmcnt(0)" ::: "memory");
  __builtin_amdgcn_s_barrier();
  const float l_tot = lacc[0];
  const float inv = 1.f / l_tot;
#pragma unroll
  for (int d = 0; d < NDVB; ++d)
#pragma unroll
    for (int i = 0; i < 16; ++i) o[d][i] *= inv;

  float rn_out = 1.f;
  if (NM == 2) {
    float* buf = (float*)smem;
    if (wave >= 4) {
#pragma unroll
      for (int d = 0; d < NDVB; ++d)
#pragma unroll
        for (int i = 0; i < 16; ++i) buf[(d * 16 + i) * 256 + (wave & 3) * 64 + lane] = o[d][i];
    }
    __syncthreads();
    if (wave < 4) {
      float ss = 0.f;
#pragma unroll
      for (int d = 0; d < NDVB; ++d) {
#pragma unroll
        for (int i = 0; i < 16; ++i) {
          const float v = o[d][i] - lam * buf[(d * 16 + i) * 256 + wave * 64 + lane];
          o[d][i] = v;
          ss += v * v;
        }
        __builtin_amdgcn_sched_barrier(0);
      }
      ss += __shfl_xor(ss, 32);
      rn_out = rsqrtf(ss * (1.f / DV) + EPSV) * omul;
    }
  }
  if (NM == 1 || wave < 4) {
    bf16_t* op = O + (size_t)(wq * 32 + l31) * ldo + 4 * h;
#pragma unroll
    for (int d = 0; d < NDVB; ++d)
#pragma unroll
      for (int g = 0; g < 4; ++g) {
        f4 gg = {1.f, 1.f, 1.f, 1.f};
        if (NM == 2) gg = *(const f4*)(og + d * 32 + 8 * g + 4 * h);
        u2 u;
        u.x = pack2(o[d][4 * g + 0] * rn_out * gg.x, o[d][4 * g + 1] * rn_out * gg.y);
        u.y = pack2(o[d][4 * g + 2] * rn_out * gg.z, o[d][4 * g + 3] * rn_out * gg.w);
        *(u2*)(op + d * 32 + 8 * g) = u;
      }
  }
}

DI void prep_tile(const float* __restrict__ src, int N, const float* __restrict__ gain, bf16_t* __restrict__ dst, int Kp, int nmode, int kmode, int kt, int nt, char* smem) {
  float* tile = (float*)smem;
  const int tid = ltid();
  __syncthreads();
  {
    const int n = tid & 63;
    const int np = nt * 64 + n;
    int ns = np; bool nv = true;
    if (nmode == 1) {
      if (np < 3712) ns = np;
      else if (np < 3840) { ns = np; nv = (np < 3744); }
      else if (np < 4352) ns = np - 96;
      else ns = np - 96;
    } else if (nmode == 2) {
      const int hh = np >> 7, j = np & 127;
      nv = j < 96; ns = hh * 96 + j;
    }
#pragma unroll
    for (int j = 0; j < 8; ++j) {
      const int kk = (tid >> 6) + 8 * j;
      const int kp = kt * 64 + kk;
      int ks = kp; bool kv = true;
      if (kmode == 1) { const int hh = kp / 96, jj = kp % 96; kv = jj < 64; ks = hh * 64 + jj; }
      float v = 0.f;
      if (nv && kv) { v = src[(size_t)ks * N + ns]; if (gain) v *= gain[ks]; }
      tile[n * 65 + kk] = v;
    }
  }
  __syncthreads();
  {
    const int n = tid >> 3, kc = tid & 7;
    float v[8];
#pragma unroll
    for (int e = 0; e < 8; ++e) v[e] = tile[n * 65 + kc * 8 + e];
    *(u4*)(dst + (size_t)(nt * 64 + n) * Kp + kt * 64 + kc * 8) = pack8(v);
  }
}

DI void prep_item(const Params& p, int l, int it, char* smem) {
  bf16_t* W = (bf16_t*)(p.ws + OFF_W);
  const float* src; const float* gain = nullptr; bf16_t* dst; int N, Kp, nmode = 0, kmode = 0, nkt, loc;
  if (it < 1856)      { loc = it;        src = p.in[4] + (size_t)l * 1024 * 7328; N = 7328; gain = p.in[3] + l * 1024; dst = W + W_IN; Kp = 1024; nmode = 1; nkt = 16; }
  else if (it < 2112) { loc = it - 1856; src = p.in[19] + (size_t)l * 1024 * 1024; N = 1024; gain = p.in[18] + l * 1024; dst = W + W_MEM; Kp = 1024; nkt = 16; }
  else if (it < 2208) { loc = it - 2112; src = p.in[12] + (size_t)l * 384 * 768; N = 768; gain = p.in[11] + l * 384; dst = W + W_QB; Kp = 384; nmode = 2; nkt = 6; }
  else if (it < 2272) { loc = it - 2208; src = p.in[14] + (size_t)l * 256 * 1024; N = 1024; gain = p.in[13] + l * 256; dst = W + W_KVB; Kp = 256; nkt = 4; }
  else if (it < 2528) { loc = it - 2272; src = p.in[10] + (size_t)l * 1024 * 1024; N = 1024; dst = W + W_DO; Kp = 1024; nkt = 16; }
  else if (it < 2720) { loc = it - 2528; src = p.in[17] + (size_t)l * 512 * 1024; N = 1024; dst = W + W_MO; Kp = 768; kmode = 1; nkt = 12; }
  else if (it < 2848) { loc = it - 2720; src = p.in[22] + (size_t)l * 512 * 1024; N = 1024; dst = W + W_CO; Kp = 512; nkt = 8; }
  else if (it < 3104) { loc = it - 2848; src = p.in[23] + (size_t)l * 1024 * 1024; N = 1024; dst = W + W_OUT; Kp = 1024; nkt = 16; }
  else if (it < 4128) { loc = it - 3104; src = p.in[25] + (size_t)l * 1024 * 4096; N = 4096; gain = p.in[24] + l * 1024; dst = W + W_1; Kp = 1024; nkt = 16; }
  else                { loc = it - 4128; src = p.in[26] + (size_t)l * 4096 * 1024; N = 1024; dst = W + W_2; Kp = 4096; nkt = 64; }
  prep_tile(src, N, gain, dst, Kp, nmode, kmode, loc % nkt, loc / nkt, smem);
}
DI void prep_range(const Params& p, int l, int lo, int hi, char* smem) {
  for (int it = lo + blockIdx.x; it < hi; it += gridDim.x) prep_item(p, l, it, smem);
}

DI void phase_init(const Params& p) {
  const int tid_ = ltid(); const int lane = tid_ & 63, gw = blockIdx.x * 8 + (tid_ >> 6), GW = gridDim.x * 8;
  bf16_t* XB = (bf16_t*)(p.ws + OFF_XB); bf16_t* MB = (bf16_t*)(p.ws + OFF_MEMB);
  float* SX = (float*)(p.ws + OFF_SSQX); float* SM = (float*)(p.ws + OFF_SSQMEM);
  for (int r = gw; r < T + MEMR; r += GW) {
    const bool isx = r < T;
    const float* src = isx ? p.in[0] + (size_t)r * 1024 : p.in[1] + (size_t)(r - T) * 1024;
    bf16_t* dst = isx ? XB + (size_t)r * 1024 : MB + (size_t)(r - T) * 1024;
    float ss = 0.f;
#pragma unroll
    for (int j = 0; j < 4; ++j) {
      const f4 v = *(const f4*)(src + j * 256 + lane * 4);
      ss += v.x * v.x + v.y * v.y + v.z * v.z + v.w * v.w;
      u2 u; u.x = pack2(v.x, v.y); u.y = pack2(v.z, v.w);
      *(u2*)(dst + j * 256 + lane * 4) = u;
    }
#pragma unroll
    for (int m = 32; m >= 1; m >>= 1) ss += __shfl_xor(ss, m);
    if (isx) { if (lane < 8) SX[(size_t)lane * T + r] = (lane == 0) ? ss : 0.f; }
    else if (lane == 0) SM[r - T] = ss;
  }
}

DI void run_epilogue(const Params& p, const Tile& t, char* smem) {
  float* Cs = (float*)smem;
  float* rs = (float*)(smem + RS_OFF);
  const int tid = ltid();
  const int q = tid & 15, rsub = tid >> 4;
  const int* pos = (const int*)p.in[2];
  if (t.epi == EP_VT) {
    const int c = tid >> 2, rq = tid & 3;
#pragma unroll
    for (int j = 0; j < 8; ++j) {
      float v[8];
#pragma unroll
      for (int e = 0; e < 8; ++e) { const int r = rq * 64 + j * 8 + e; v[e] = Cs[r * CS_LD + c] * rs[r]; }
      bf16_t* d16 = t.dst + (size_t)c * t.ldd + rq * 64 + (j >> 1) * 16;
      u2 lo, hi; lo.x = pack2(v[0], v[1]); lo.y = pack2(v[2], v[3]); hi.x = pack2(v[4], v[5]); hi.y = pack2(v[6], v[7]);
      *(u2*)(d16 + ((j & 1) ? 4 : 0)) = lo;
      *(u2*)(d16 + ((j & 1) ? 12 : 8)) = hi;
    }
    return;
  }
#pragma unroll 1
  for (int pass = 0; pass < 8; ++pass) {
    const int r = rsub + 32 * pass;
    const int row = t.row0 + r;
    float v[8];
    load8(Cs, r, q, v);
    const float rsv = rs[r];
#pragma unroll
    for (int e = 0; e < 8; ++e) v[e] *= rsv;
    switch (t.epi) {
      case EP_HEADROT: {
        const float* cr = Cs + r * CS_LD + 2 * q;
        float x1[2][2], x2[2][2];
#pragma unroll
        for (int m = 0; m < 2; ++m) {
          const fl2_t a = *(const fl2_t*)(cr + m * 64), b = *(const fl2_t*)(cr + m * 64 + 32);
          x1[m][0] = a.x * rsv; x1[m][1] = a.y * rsv; x2[m][0] = b.x * rsv; x2[m][1] = b.y * rsv;
        }
        float ssm[2];
#pragma unroll
        for (int m = 0; m < 2; ++m) {
          float ss = x1[m][0] * x1[m][0] + x1[m][1] * x1[m][1] + x2[m][0] * x2[m][0] + x2[m][1] * x2[m][1];
          ss += __shfl_xor(ss, 1); ss += __shfl_xor(ss, 2); ss += __shfl_xor(ss, 4); ss += __shfl_xor(ss, 8);
          ssm[m] = rsqrtf(ss * (1.f / 64) + EPSV) * t.oscale;
        }
        const int ps = pos[row];
        const fl2_t g1 = *(const fl2_t*)(t.gain + 2 * q), g2 = *(const fl2_t*)(t.gain + 32 + 2 * q);
        const float g1v[2] = {g1.x, g1.y}, g2v[2] = {g2.x, g2.y};
        float cc[2], sn[2];
#pragma unroll
        for (int e = 0; e < 2; ++e) rot_cs(ps, INVF64[2 * q + e], cc[e], sn[e]);
#pragma unroll
        for (int m = 0; m < 2; ++m) {
          float o1[2], o2[2];
#pragma unroll
          for (int e = 0; e < 2; ++e) {
            const float y1 = x1[m][e] * ssm[m] * g1v[e], y2 = x2[m][e] * ssm[m] * g2v[e];
            o1[e] = y1 * cc[e] - y2 * sn[e];
            o2[e] = y2 * cc[e] + y1 * sn[e];
          }
          bf16_t* d = t.dst + (size_t)row * t.ldd + t.cb * 128 + m * 64 + 2 * q;
          *(unsigned*)d = pack2(o1[0], o1[1]);
          *(unsigned*)(d + 32) = pack2(o2[0], o2[1]);
        }
      } break;
      case EP_PLAIN: {
        float ss = 0.f;
#pragma unroll
        for (int e = 0; e < 8; ++e) ss += v[e] * v[e];
        ss += __shfl_xor(ss, 1); ss += __shfl_xor(ss, 2); ss += __shfl_xor(ss, 4); ss += __shfl_xor(ss, 8);
        *(u4*)(t.dst + (size_t)row * t.ldd + t.cb * 128 + q * 8) = pack8(v);
        if (q == 0) t.ssq_out[row] = ss;
      } break;
      case EP_KROPE: {
        const bool first = (q & 2) == 0; const int i0 = (q & 1) * 8;
        const int ps = pos[row];
        float ov[8];
#pragma unroll
        for (int e = 0; e < 8; ++e) {
          const float yp = __shfl_xor(v[e], 2);
          float c, s; rot_cs(ps, INVF32[i0 + e], c, s);
          ov[e] = first ? (v[e] * c - yp * s) : (v[e] * c + yp * s);
        }
        if (q < 4) {
          float* kr = (float*)(p.ws + OFF_KR) + (size_t)row * 32 + q * 8;
          *(f4*)kr = f4{ov[0], ov[1], ov[2], ov[3]};
          *(f4*)(kr + 4) = f4{ov[4], ov[5], ov[6], ov[7]};
        }
      } break;
      case EP_NORM128: {
        float ss = 0.f;
#pragma unroll
        for (int e = 0; e < 8; ++e) ss += v[e] * v[e];
        ss += __shfl_xor(ss, 1); ss += __shfl_xor(ss, 2); ss += __shfl_xor(ss, 4); ss += __shfl_xor(ss, 8);
        const float rn = rsqrtf(ss * (1.f / 128) + EPSV);
#pragma unroll
        for (int e = 0; e < 8; ++e) v[e] *= rn * t.oscale * t.gain[q * 8 + e];
        *(u4*)(t.dst + (size_t)row * t.ldd + t.cb * 128 + q * 8) = pack8(v);
      } break;
      case EP_QB: {
        const bool isr = (q >= 8 && q < 12);
        const bool first = (q & 2) == 0; const int i0 = (q & 1) * 8;
        const int ps = pos[row];
        float ss = 0.f;
#pragma unroll
        for (int e = 0; e < 8; ++e) {
          const float yp = __shfl_xor(v[e], 2);
          float c, s; rot_cs(ps, INVF32[i0 + e], c, s);
          const float rv = first ? (v[e] * c - yp * s) : (v[e] * c + yp * s);
          v[e] = isr ? rv : v[e];
          ss += v[e] * v[e];
        }
        ss += __shfl_xor(ss, 1); ss += __shfl_xor(ss, 2); ss += __shfl_xor(ss, 4); ss += __shfl_xor(ss, 8);
        const float rn = rsqrtf(ss * (1.f / 96) + EPSV);
        if (q < 12) {
#pragma unroll
          for (int e = 0; e < 8; ++e) v[e] *= rn * t.oscale * t.gain[q * 8 + e];
          *(u4*)(t.dst + (size_t)row * 768 + t.cb * 96 + q * 8) = pack8(v);
        }
      } break;
      case EP_KVB: {
        if (q >= 8) {
          if (q < 12) {
            const float* kr = (const float*)(p.ws + OFF_KR) + (size_t)row * 32 + (q - 8) * 8;
            const f4 a = *(const f4*)kr, b = *(const f4*)(kr + 4);
            v[0] = a.x; v[1] = a.y; v[2] = a.z; v[3] = a.w; v[4] = b.x; v[5] = b.y; v[6] = b.z; v[7] = b.w;
          } else {
#pragma unroll
            for (int e = 0; e < 8; ++e) v[e] = 0.f;
          }
        }
        float ss = 0.f;
#pragma unroll
        for (int e = 0; e < 8; ++e) ss += v[e] * v[e];
        ss += __shfl_xor(ss, 1); ss += __shfl_xor(ss, 2); ss += __shfl_xor(ss, 4); ss += __shfl_xor(ss, 8);
        const float rn = rsqrtf(ss * (1.f / 96) + EPSV);
        if (q < 12) {
#pragma unroll
          for (int e = 0; e < 8; ++e) v[e] *= rn * t.oscale * t.gain[q * 8 + e];
          *(u4*)(t.dst + (size_t)row * 768 + t.cb * 96 + q * 8) = pack8(v);
        }
      } break;
      case EP_RES: {
        const float* xs = t.xsrc + (size_t)row * 1024 + t.cb * 128 + q * 8;
        const f4 a = *(const f4*)xs, b = *(const f4*)(xs + 4);
        v[0] += a.x; v[1] += a.y; v[2] += a.z; v[3] += a.w; v[4] += b.x; v[5] += b.y; v[6] += b.z; v[7] += b.w;
        float ss = 0.f;
#pragma unroll
        for (int e = 0; e < 8; ++e) ss += v[e] * v[e];
        ss += __shfl_xor(ss, 1); ss += __shfl_xor(ss, 2); ss += __shfl_xor(ss, 4); ss += __shfl_xor(ss, 8);
        float* xo = p.out + (size_t)row * 1024 + t.cb * 128 + q * 8;
        *(f4*)xo = f4{v[0], v[1], v[2], v[3]};
        *(f4*)(xo + 4) = f4{v[4], v[5], v[6], v[7]};
        *(u4*)(t.dst + (size_t)row * 1024 + t.cb * 128 + q * 8) = pack8(v);
        if (q == 0) t.ssq_out[row] = ss;
      } break;
      case EP_YTMP: {
        *(u4*)(t.dst + (size_t)r * 256 + t.cb * 128 + q * 8) = pack8(v);
      } break;
      case EP_GATE: {
        const u4 yu = *(const u4*)(t.ysrc + (size_t)r * 256 + q * 8);
        const f4 ba = *(const f4*)(t.gain + q * 8), bb = *(const f4*)(t.gain + q * 8 + 4);
        bf16_t* mp_ = t.dst + (size_t)row * 1024 + t.cb * 128 + q * 8;
        u4 mu; mu.x = mu.y = mu.z = mu.w = 0u;
        if (t.accum) mu = *(const u4*)mp_;
        const float bs[8] = {ba.x, ba.y, ba.z, ba.w, bb.x, bb.y, bb.z, bb.w};
        const unsigned yw[4] = {yu.x, yu.y, yu.z, yu.w}, mw[4] = {mu.x, mu.y, mu.z, mu.w};
#pragma unroll
        for (int e = 0; e < 8; ++e) {
          const float g = 1.f / (1.f + __expf(-(v[e] + bs[e])));
          const float y = __uint_as_float((e & 1) ? (yw[e >> 1] & 0xffff0000u) : (yw[e >> 1] << 16));
          const float m = __uint_as_float((e & 1) ? (mw[e >> 1] & 0xffff0000u) : (mw[e >> 1] << 16));
          v[e] = m + g * y;
        }
        *(u4*)mp_ = pack8(v);
      } break;
      case EP_MLP1: {
#pragma unroll
        for (int e = 0; e < 8; ++e) { const float u = fmaxf(v[e], 0.f); v[e] = u * u; }
        *(u4*)(t.dst + (size_t)row * t.ldd + t.cb * 128 + q * 8) = pack8(v);
      } break;
      default: break;
    }
  }
  if (t.epi == EP_KVB) {
    bf16_t* VMT = (bf16_t*)(p.ws + OFF_VMT);
    const int c = tid >> 3, r8 = tid & 7;
    const int b = t.row0 >> 11, s0 = t.row0 & 2047;
    bf16_t* d = VMT + ((size_t)(b * 512 + t.cb * 64 + c)) * SEQ + s0 + r8 * 32;
#pragma unroll
    for (int j = 0; j < 4; ++j) {
      float v[8];
#pragma unroll
      for (int e = 0; e < 8; ++e) { const int r = r8 * 32 + j * 8 + e; v[e] = Cs[r * CS_LD + 64 + c] * rs[r]; }
      bf16_t* d16 = d + (j >> 1) * 16;
      u2 lo, hi; lo.x = pack2(v[0], v[1]); lo.y = pack2(v[2], v[3]); hi.x = pack2(v[4], v[5]); hi.y = pack2(v[6], v[7]);
      *(u2*)(d16 + ((j & 1) ? 4 : 0)) = lo;
      *(u2*)(d16 + ((j & 1) ? 12 : 8)) = hi;
    }
  }
}

__global__ void __launch_bounds__(NTHR) mega_fwd(Params p) {
  __shared__ __attribute__((aligned(16))) char smem[LDS_BYTES];
  cg::grid_group grid = cg::this_grid();
  const int G = gridDim.x, bid = blockIdx.x;
  for (int ph = p.ph_lo; ph < p.ph_hi; ++ph) {
      char* ws = p.ws; asm volatile("" : "+s"(ws));
    bf16_t* XB = (bf16_t*)(ws + OFF_XB);   bf16_t* QD = (bf16_t*)(ws + OFF_QD);   bf16_t* KD = (bf16_t*)(ws + OFF_KD);
    bf16_t* VDT = (bf16_t*)(ws + OFF_VDT); bf16_t* CQ = (bf16_t*)(ws + OFF_CQ);   bf16_t* CKV = (bf16_t*)(ws + OFF_CKV);
    bf16_t* XQ = (bf16_t*)(ws + OFF_XQ);   bf16_t* QM = (bf16_t*)(ws + OFF_QM);   bf16_t* KM = (bf16_t*)(ws + OFF_KM);
    bf16_t* VMT = (bf16_t*)(ws + OFF_VMT); bf16_t* MEMB = (bf16_t*)(ws + OFF_MEMB); bf16_t* KC = (bf16_t*)(ws + OFF_KC);
    bf16_t* VCT = (bf16_t*)(ws + OFF_VCT); bf16_t* W = (bf16_t*)(ws + OFF_W);     bf16_t* U = (bf16_t*)(ws + OFF_U);
    bf16_t* MERGED = KD;
    float* SSQX = (float*)(ws + OFF_SSQX); float* SSQCQ = (float*)(ws + OFF_SSQCQ); float* SSQCKV = (float*)(ws + OFF_SSQCKV);
    float* SSQMEM = (float*)(ws + OFF_SSQMEM);

    if (ph == 0) {
      phase_init(p);
      prep_range(p, 0, 0, 5152, smem);
    } else {
      const int l = (ph - 1) / p.per, kr = (ph - 1) % p.per;
      const int k = (kr > p.dupk) ? kr - (p.per - 7) : kr;
#ifndef NO_GEMM
      if (k == 0 || k == 1 || k == 3 || k == 4 || k == 5 || k == 6) {
        int nits = 0, total = 0;
        if (k == 0) { nits = 18; total = 4480; if (l > 0) prep_range(p, l, 4128, 5152, smem); }
        else if (k == 1) { nits = 8; total = 2048; }
        else if (k == 3) { nits = 24; total = 1024; }
        else if (k == 4) { nits = 4; total = 1024; }
        else if (k == 5) { nits = 16; total = 4096; if (l + 1 < NL) prep_range(p, l + 1, 0, 3104, smem); }
        else { nits = 4; total = 1024; if (l + 1 < NL) prep_range(p, l + 1, 3104, 4128, smem); }
        const bool xmap = (G == 256);
        if (!xmap) nits = ((total + G - 1) / G) * ((k == 3) ? 6 : 1);
#pragma unroll 1
        for (int it = 0; it < nits; ++it) {
          int list = 0, rb = -1, CB = 0;
          if (xmap) {
            if (k == 0) {
              if (it < 16) map_regular(it, bid, 16, rb, CB);
              else if (it == 16) { rb = bid; CB = 16; }
              else if (bid < 128) { list = 1; rb = bid >> 2; CB = bid & 3; }
            } else if (k == 1) { list = it >> 2; map_regular(it & 3, bid, 4, rb, CB); }
            else if (k == 3) map_regular(it / 6, bid, 4, rb, CB);
            else if (k == 5) map_regular(it, bid, 16, rb, CB);
            else map_regular(it, bid, 4, rb, CB);
          } else {
            const int li = ((k == 3) ? (it / 6) : it) * G + bid;
            if (li < total) {
              if (k == 0) { if (li < 4352) { rb = li / 17; CB = li % 17; } else { list = 1; rb = (li - 4352) >> 2; CB = (li - 4352) & 3; } }
              else if (k == 1) { list = li >> 10; rb = (li & 1023) >> 2; CB = li & 3; }
              else if (k == 5) { rb = li >> 4; CB = li & 15; }
              else { rb = li >> 2; CB = li & 3; }
            }
          }
          if (rb < 0) continue;
          const int row0 = rb * 256;
          const bf16_t* Ap; const bf16_t* Bp; int lda, Kd;
          const float* ssq = nullptr; int nparts = 0, pstride = T; float invK = 0.f;
          if (k == 0) {
            if (list == 0) { Ap = XB + (size_t)row0 * 1024; lda = 1024; Bp = W + W_IN + (size_t)CB * 256 * 1024; Kd = 1024; ssq = SSQX; nparts = 8; invK = 1.f / 1024; }
            else           { Ap = MEMB + (size_t)row0 * 1024; lda = 1024; Bp = W + W_MEM + (size_t)CB * 256 * 1024; Kd = 1024; ssq = SSQMEM; nparts = 1; pstride = 0; invK = 1.f / 1024; }
          } else if (k == 1) {
            if (list == 0) { Ap = CQ + (size_t)row0 * 384; lda = 384; Bp = W + W_QB + (size_t)CB * 256 * 384; Kd = 384; ssq = SSQCQ; nparts = 3; invK = 1.f / 384; }
            else           { Ap = CKV + (size_t)row0 * 256; lda = 256; Bp = W + W_KVB + (size_t)CB * 256 * 256; Kd = 256; ssq = SSQCKV; nparts = 2; invK = 1.f / 256; }
          } else if (k == 3) {
            const int st = it % 6, br = st >> 1;
            if (st & 1)       { Ap = XB + (size_t)row0 * 1024; lda = 1024; Bp = W + W_IN + (size_t)(WIN_GATE0 + br * 1024 + CB * 256) * 1024; Kd = 1024; ssq = SSQX; nparts = 8; invK = 1.f / 1024; }
            else if (br == 0) { Ap = QD + (size_t)row0 * 1024; lda = 1024; Bp = W + W_DO + (size_t)CB * 256 * 1024; Kd = 1024; }
            else if (br == 1) { Ap = QM + (size_t)row0 * 768;  lda = 768;  Bp = W + W_MO + (size_t)CB * 256 * 768;  Kd = 768; }
            else              { Ap = XQ + (size_t)row0 * 512;  lda = 512;  Bp = W + W_CO + (size_t)CB * 256 * 512;  Kd = 512; }
          } else if (k == 4) { Ap = MERGED + (size_t)row0 * 1024; lda = 1024; Bp = W + W_OUT + (size_t)CB * 256 * 1024; Kd = 1024; }
          else if (k == 5)   { Ap = XB + (size_t)row0 * 1024; lda = 1024; Bp = W + W_1 + (size_t)CB * 256 * 1024; Kd = 1024; ssq = SSQX; nparts = 8; invK = 1.f / 1024; }
          else               { Ap = U + (size_t)row0 * 4096; lda = 4096; Bp = W + W_2 + (size_t)CB * 256 * 4096; Kd = 4096; }
          f32x4v acc[2][2][4][2];
          gemm8p(Ap, Bp, Kd, acc, smem);
          float* Cs = (float*)smem;
          if (k == 5 || k == 3) {
            float* rsL = (float*)(smem + RS_OFF);
            fill_rs(rsL, ssq, nparts, pstride, row0, invK);
            __syncthreads();
            const int tq = ltid(); const int lane = tq & 63, wave = tq >> 6, wr = wave >> 2, wc = wave & 3, fr = lane & 15, fq = lane >> 4;
            const int st = it % 6, br = st >> 1;
            bf16_t* YS = VDT + (size_t)blockIdx.x * 65536;
#pragma unroll
            for (int ai = 0; ai < 2; ++ai)
#pragma unroll
              for (int m = 0; m < 4; ++m) {
                const int row = ai * 128 + wr * 64 + m * 16 + fr;
                const float rsv = rsL[row];
#pragma unroll
                for (int bj = 0; bj < 2; ++bj)
#pragma unroll
                  for (int n = 0; n < 2; ++n) {
                    const int col = bj * 128 + wc * 32 + n * 16 + fq * 4;
                    const f32x4v a4 = acc[ai][bj][m][n];
                    float o4[4];
                    if (k == 5) {
#pragma unroll
                      for (int j = 0; j < 4; ++j) { const float u = fmaxf(a4[j] * rsv, 0.f); o4[j] = u * u; }
                      u2 w; w.x = pack2(o4[0], o4[1]); w.y = pack2(o4[2], o4[3]);
                      *(u2*)(U + (size_t)(row0 + row) * 4096 + CB * 256 + col) = w;
                    } else if (!(st & 1)) {
                      u2 w; w.x = pack2(a4[0], a4[1]); w.y = pack2(a4[2], a4[3]);
                      *(u2*)(YS + (size_t)row * 256 + col) = w;
                    } else {
                      const f4 bs = *(const f4*)(p.in[5] + (size_t)l * 3072 + br * 1024 + CB * 256 + col);
                      const u2 yu = *(const u2*)(YS + (size_t)row * 256 + col);
                      bf16_t* mp_ = MERGED + (size_t)(row0 + row) * 1024 + CB * 256 + col;
                      u2 mu; mu.x = mu.y = 0u;
                      if (br > 0) mu = *(const u2*)mp_;
                      const float bsv[4] = {bs.x, bs.y, bs.z, bs.w};
                      const unsigned yw[2] = {yu.x, yu.y}, mw[2] = {mu.x, mu.y};
#pragma unroll
                      for (int j = 0; j < 4; ++j) {
                        const float g = 1.f / (1.f + __expf(-(a4[j] * rsv + bsv[j])));
                        const float y = __uint_as_float((j & 1) ? (yw[j >> 1] & 0xffff0000u) : (yw[j >> 1] << 16));
                        const float mv = __uint_as_float((j & 1) ? (mw[j >> 1] & 0xffff0000u) : (mw[j >> 1] << 16));
                        o4[j] = mv + g * y;
                      }
                      u2 w; w.x = pack2(o4[0], o4[1]); w.y = pack2(o4[2], o4[3]);
                      *(u2*)mp_ = w;
                    }
                  }
              }
          } else
#pragma unroll 1
          for (int half = 0; half < 2; ++half) {
            if (half) __syncthreads();
            {
              const int tq = ltid(); const int lane = tq & 63, wave = tq >> 6, wr = wave >> 2, wc = wave & 3, fr = lane & 15, fq = lane >> 4;
#pragma unroll
              for (int ai = 0; ai < 2; ++ai)
#pragma unroll
                for (int m = 0; m < 4; ++m)
#pragma unroll
                  for (int n = 0; n < 2; ++n) {
                    f32x4v v4;
#pragma unroll
                    for (int j = 0; j < 4; ++j) v4[j] = half ? acc[ai][1][m][n][j] : acc[ai][0][m][n][j];
                    *(f32x4v*)(Cs + (ai * 128 + wr * 64 + m * 16 + fr) * CS_LD + wc * 32 + n * 16 + fq * 4) = v4;
                  }
            }
            if (half == 0) fill_rs((float*)(smem + RS_OFF), ssq, nparts, pstride, row0, invK);
            __syncthreads();
            const int cb = CB * 2 + half;
            Tile t;
            t.row0 = row0; t.cb = cb; t.epi = EP_PLAIN;
            t.dst = nullptr; t.ldd = 0; t.gain = nullptr; t.ssq_out = nullptr; t.xsrc = nullptr; t.oscale = 1.f; t.ysrc = nullptr; t.accum = 0;
            if (k == 0) {
              if (list == 0) {
                if (cb < 8)       { t.epi = EP_HEADROT; t.cb = cb; t.dst = QD; t.ldd = 1024; t.gain = p.in[6] + l * 64; t.oscale = 0.125f * 1.4426950408889634f; }
                else if (cb < 16) { t.epi = EP_HEADROT; t.cb = cb - 8; t.dst = KD; t.ldd = 1024; t.gain = p.in[7] + l * 64; }
                else if (cb < 24) { t.epi = EP_VT; t.cb = cb - 16; const int b = row0 >> 11, s0 = row0 & 2047; t.dst = VDT + ((size_t)(b * 1024 + (cb - 16) * 128)) * SEQ + s0; t.ldd = SEQ; }
                else if (cb < 27) { t.epi = EP_PLAIN; t.cb = cb - 24; t.dst = CQ; t.ldd = 384; t.ssq_out = SSQCQ + (size_t)(cb - 24) * T; }
                else if (cb < 29) { t.epi = EP_PLAIN; t.cb = cb - 27; t.dst = CKV; t.ldd = 256; t.ssq_out = SSQCKV + (size_t)(cb - 27) * T; }
                else if (cb == 29) { t.epi = EP_KROPE; t.cb = 0; }
                else              { t.epi = EP_NORM128; t.cb = cb - 30; t.dst = XQ; t.ldd = 512; t.gain = p.in[20] + l * 128; t.oscale = 0.08838834764831845f * 1.4426950408889634f; }
              } else {
                if (cb < 4) { t.epi = EP_NORM128; t.cb = cb; t.dst = KC; t.ldd = 512; t.gain = p.in[21] + l * 128; }
                else        { t.epi = EP_VT; t.cb = cb - 4; t.dst = VCT + ((size_t)(rb * 512 + (cb - 4) * 128)) * MEML; t.ldd = MEML; }
              }
            } else if (k == 1) {
              if (list == 0) { t.epi = EP_QB; t.dst = QM; t.gain = p.in[15] + l * 96; t.oscale = 0.10206207261596575f * 1.4426950408889634f; }
              else           { t.epi = EP_KVB; t.dst = KM; t.gain = p.in[16] + l * 96; }
            } else if (k == 3) {
              const int st = it % 6, br = st >> 1;
              bf16_t* YS = VDT + (size_t)blockIdx.x * 65536;
              if (st & 1) { t.epi = EP_GATE; t.dst = MERGED; t.ysrc = YS + half * 128; t.gain = p.in[5] + (size_t)l * 3072 + br * 1024 + cb * 128; t.accum = (br > 0); }
              else        { t.epi = EP_YTMP; t.dst = YS; t.cb = half; }
            } else if (k == 4) { t.epi = EP_RES; t.dst = XB; t.xsrc = (l == 0) ? p.in[0] : p.out; t.ssq_out = SSQX + (size_t)cb * T; }
            else if (k == 5)   { t.epi = EP_MLP1; t.dst = U; t.ldd = 4096; }
            else               { t.epi = EP_RES; t.dst = XB; t.xsrc = p.out; t.ssq_out = SSQX + (size_t)cb * T; }
            run_epilogue(p, t, smem);
          }
        }
      } else
#endif
#ifndef NO_ATT
      if (k == 2) {
        float lam;
        const float lam_init = 0.8f - 0.6f * expf(-0.3f * (float)l);
        {
          const int lane = ltid() & 63;
          const float* lv = p.in[8] + l * 256;
          float sa = lv[lane] * lv[64 + lane], sb = lv[128 + lane] * lv[192 + lane];
#pragma unroll
          for (int m = 32; m >= 1; m >>= 1) { sa += __shfl_xor(sa, m); sb += __shfl_xor(sb, m); }
          lam = expf(sa) - expf(sb) + lam_init;
        }
        const float L2E = 1.4426950408889634f;
#pragma unroll 1
        for (int it = 0; it < ((G == 256) ? 16 : (4096 + G - 1) / G); ++it) {
          int w;
          if (G == 256) {
            const int xcd = bid & 7, slot = bid >> 3;
            if (it < 8)       w = ((it * 32 + (slot >> 3) * 8 + xcd) << 3) + (slot & 7);
            else if (it < 12) w = 2048 + ((((it - 8) * 64 + (slot >> 2) * 8 + xcd) << 2) + (slot & 3));
            else              w = 3072 + ((((it - 12) * 32 + (slot >> 3) * 8 + xcd) << 3) + (slot & 7));
          } else { w = it * G + bid; if (w >= 4096) continue; }
#ifndef NO_A1
          if (w < 2048) {
            const int bh = w >> 3, j = w & 7, b = bh >> 3, hh = bh & 7;
#pragma unroll 1
            for (int half = 0; half < 2; ++half) {
              const int qb = half ? j : 15 - j;
              const int q0 = qb * 128;
              bf16_t* Qp = QD + ((size_t)(b * SEQ + q0)) * 1024 + hh * 128;
              attn_block<64, 128, 2, true>(Qp, 1024, KD + (size_t)b * SEQ * 1024 + hh * 128, 1024, VDT + ((size_t)(b * 1024 + hh * 128)) * SEQ, SEQ,
                                            (q0 + 128) >> 6, q0, Qp, 1024, 0.125f * L2E, lam, p.in[9] + l * 128, 1.f - lam_init, smem);
            }
          } else
#endif
#ifndef NO_A2
          if (w < 3072) {
            const int wj = w - 2048; const int bh = wj >> 2, j = wj & 3, b = bh >> 3, hh = bh & 7;
#pragma unroll 1
            for (int half = 0; half < 2; ++half) {
              const int qb = half ? j : 7 - j;
              const int q0 = qb * 256;
              bf16_t* Qp = QM + ((size_t)(b * SEQ + q0)) * 768 + hh * 96;
              attn_block<96, 64, 1, true>(Qp, 768, KM + (size_t)b * SEQ * 768 + hh * 96, 768, VMT + ((size_t)(b * 512 + hh * 64)) * SEQ, SEQ,
                                           (q0 + 256) >> 6, q0, Qp, 768, 0.10206207261596575f * L2E, 0.f, nullptr, 1.f, smem);
            }
          } else
#endif
#ifndef NO_A3
          {
            const int wj = w - 3072; const int bh = wj >> 3, qb = wj & 7, b = bh >> 2, hh = bh & 3;
            const int q0 = qb * 256;
            bf16_t* Qp = XQ + ((size_t)(b * SEQ + q0)) * 512 + hh * 128;
            attn_block<128, 128, 1, false>(Qp, 512, KC + (size_t)b * MEML * 512 + hh * 128, 512, VCT + ((size_t)(b * 512 + hh * 128)) * MEML, MEML,
                                            4, q0, Qp, 512, 0.08838834764831845f * L2E, 0.f, nullptr, 1.f, smem);
          }
#endif
          {}
        }
      } else
#endif
#ifndef NO_D
      if (k == 3) {
        float* Cs = (float*)smem;
        float* rs = (float*)(smem + RS_OFF);
#pragma unroll 1
        for (int it = 0; it < ((G == 256) ? 8 : (2048 + G - 1) / G); ++it) {
          int rb, cb;
          if (G == 256) map_regular(it, bid, 8, rb, cb);
          else { const int li = it * G + bid; if (li >= 2048) continue; rb = li >> 3; cb = li & 7; }
          const int tidd = ltid(); const int lane = tidd & 63, wave = tidd >> 6, wm = wave >> 1, wn = wave & 1, h = lane >> 5;
          const int row0 = rb * 256, col0 = cb * 128;
          __syncthreads();
          fill_rs(rs, SSQX, 8, T, row0, 1.f / 1024);
          f32x16 acc[2][2];
          unsigned gp[2][2][8], mp[2][2][8];
#pragma unroll
          for (int mi = 0; mi < 2; ++mi)
#pragma unroll
            for (int ni = 0; ni < 2; ++ni)
#pragma unroll
              for (int i = 0; i < 8; ++i) mp[mi][ni][i] = 0u;
#pragma unroll 1
          for (int st = 0; st < 6; ++st) {
            const int br = st >> 1, half = st & 1;
            const bf16_t* Ab; const bf16_t* Bb; int Kb;
            if (half == 0)    { Ab = XB + (size_t)row0 * 1024; Bb = W + W_IN + (size_t)(WIN_GATE0 + br * 1024 + col0) * 1024; Kb = 1024; }
            else if (br == 0) { Ab = QD + (size_t)row0 * 1024; Bb = W + W_DO + (size_t)col0 * 1024; Kb = 1024; }
            else if (br == 1) { Ab = QM + (size_t)row0 * 768;  Bb = W + W_MO + (size_t)col0 * 768;  Kb = 768; }
            else              { Ab = XQ + (size_t)row0 * 512;  Bb = W + W_CO + (size_t)col0 * 512;  Kb = 512; }
            gemm_mainloop<2, 2, 2, false>(Ab, Kb, Bb, Kb, Kb, acc, smem);
            if (half == 0) {
              const float* bg = p.in[5] + (size_t)l * 3072 + br * 1024 + col0 + wn * 64 + (lane & 31);
              const float bgv0 = bg[0], bgv1 = bg[32];
#pragma unroll
              for (int mi = 0; mi < 2; ++mi) {
                float rsv[16];
#pragma unroll
                for (int i = 0; i < 16; ++i) rsv[i] = rs[wm * 64 + mi * 32 + crow(i, h)];
#pragma unroll
                for (int ni = 0; ni < 2; ++ni) {
                  const float bgv = ni ? bgv1 : bgv0;
#pragma unroll
                  for (int i = 0; i < 16; i += 2) {
                    const float z0 = acc[mi][ni][i] * rsv[i] + bgv;
                    const float z1 = acc[mi][ni][i + 1] * rsv[i + 1] + bgv;
                    gp[mi][ni][i >> 1] = pack2(1.f / (1.f + __expf(-z0)), 1.f / (1.f + __expf(-z1)));
                  }
                }
                __builtin_amdgcn_sched_barrier(0);
              }
            } else {
#pragma unroll
              for (int mi = 0; mi < 2; ++mi)
#pragma unroll
                for (int ni = 0; ni < 2; ++ni)
#pragma unroll
                  for (int i = 0; i < 16; i += 2) {
                    const unsigned g2 = gp[mi][ni][i >> 1], m2 = mp[mi][ni][i >> 1];
                    const float m0 = __uint_as_float(m2 << 16) + __uint_as_float(g2 << 16) * acc[mi][ni][i];
                    const float m1 = __uint_as_float(m2 & 0xffff0000u) + __uint_as_float(g2 & 0xffff0000u) * acc[mi][ni][i + 1];
                    mp[mi][ni][i >> 1] = pack2(m0, m1);
                  }
            }
          }
#pragma unroll
          for (int mi = 0; mi < 2; ++mi)
#pragma unroll
            for (int ni = 0; ni < 2; ++ni)
#pragma unroll
              for (int i = 0; i < 16; ++i) {
                const unsigned m2 = mp[mi][ni][i >> 1];
                Cs[(wm * 64 + mi * 32 + crow(i, h)) * CS_LD + wn * 64 + ni * 32 + (lane & 31)] = __uint_as_float((i & 1) ? (m2 & 0xffff0000u) : (m2 << 16));
              }
          __syncthreads();
          const int q = tidd & 15, rsub = tidd >> 4;
#pragma unroll 1
          for (int pass = 0; pass < 8; ++pass) {
            const int r = rsub + 32 * pass;
            float v[8];
            load8(Cs, r, q, v);
            *(u4*)(MERGED + (size_t)(row0 + r) * 1024 + col0 + q * 8) = pack8(v);
          }
        }
      }
#endif
      {}
    }
    if (ph + 1 < p.ph_hi) grid.sync();
  }
}

extern "C" void kernel_launch(void* const* d_in, const int* in_sizes, int n_in, void* d_out, int out_size, void* d_ws, size_t ws_size, hipStream_t stream) {
  static int grid_blocks = 0;
  if (grid_blocks == 0) {
    if (n_in != 27 || ws_size < WS_NEED) { fprintf(stderr, "kernel_launch: unexpected inputs (n_in %d) or workspace (%zu < %zu)\n", n_in, ws_size, (size_t)WS_NEED); grid_blocks = -1; return; }
    int dev = 0, cus = 0, per_cu = 0;
    hipGetDevice(&dev);
    hipDeviceGetAttribute(&cus, hipDeviceAttributeMultiprocessorCount, dev);
    hipOccupancyMaxActiveBlocksPerMultiprocessor(&per_cu, mega_fwd, NTHR, 0);
    if (per_cu < 1) per_cu = 1;
    if (per_cu > 1) per_cu = 1;
    grid_blocks = cus * per_cu;
  }
  if (grid_blocks < 0) return;
  Params p{};
  for (int i = 0; i < 27; ++i) p.in[i] = (const float*)d_in[i];
  p.out = (float*)d_out;
  p.ws = (char*)d_ws;
  p.ph_lo = 0;
  p.dupk = (DUP_K >= 0) ? DUP_K : 100;
  p.per = (DUP_K >= 0) ? 8 : 7;
  p.ph_hi = 1 + NL * p.per;
  void* args[] = {&p};
  hipError_t e = hipLaunchCooperativeKernel((void*)mega_fwd, dim3(grid_blocks), dim3(NTHR), args, 0, stream);
  if (e != hipSuccess) fprintf(stderr, "cooperative launch failed: %s (grid %d)\n", hipGetErrorString(e), grid_blocks);
}
```

```cpp
#include <hip/hip_runtime.h>
#include <hip/hip_cooperative_groups.h>
#include <stdint.h>
#include <stdio.h>
#define NO_D 1
namespace cg = cooperative_groups;

typedef unsigned short bf16_t;
using bf16x8 = __attribute__((ext_vector_type(8))) short;
using f32x16 = __attribute__((ext_vector_type(16))) float;
typedef unsigned u4 __attribute__((ext_vector_type(4)));
typedef unsigned u2 __attribute__((ext_vector_type(2)));
typedef float f4 __attribute__((ext_vector_type(4)));
#define DI __device__ __forceinline__
#define MFMA(a, b, c) __builtin_amdgcn_mfma_f32_32x32x16_bf16((a), (b), (c), 0, 0, 0)

constexpr int T = 65536, DM = 1024, NB = 32, SEQ = 2048, NL = 4, MEML = 256, MEMR = NB * MEML;
constexpr int NTHR = 512;
constexpr int DUP_K = -1;
constexpr float EPSV = 1e-6f;
constexpr int WIN_N = 7424;
constexpr int WIN_GATE0 = 4352;

constexpr size_t MiB = 1024ull * 1024ull;
constexpr size_t OFF_XB = 0;
constexpr size_t OFF_QD = OFF_XB + 128 * MiB;
constexpr size_t OFF_KD = OFF_QD + 128 * MiB;
constexpr size_t OFF_VDT = OFF_KD + 128 * MiB;
constexpr size_t OFF_CQ = OFF_VDT + 128 * MiB;
constexpr size_t OFF_CKV = OFF_CQ + 48 * MiB;
constexpr size_t OFF_KR = OFF_CKV + 32 * MiB;
constexpr size_t OFF_XQ = OFF_KR + 8 * MiB;
constexpr size_t OFF_QM = OFF_XQ + 64 * MiB;
constexpr size_t OFF_KM = OFF_QM + 96 * MiB;
constexpr size_t OFF_VMT = OFF_KM + 96 * MiB;
constexpr size_t OFF_MEMB = OFF_VMT + 64 * MiB;
constexpr size_t OFF_KC = OFF_MEMB + 16 * MiB;
constexpr size_t OFF_VCT = OFF_KC + 8 * MiB;
constexpr size_t OFF_SSQX = OFF_VCT + 8 * MiB;
constexpr size_t OFF_SSQCQ = OFF_SSQX + 2 * MiB;
constexpr size_t OFF_SSQCKV = OFF_SSQCQ + 1 * MiB;
constexpr size_t OFF_SSQMEM = OFF_SSQCKV + 1 * MiB;
constexpr size_t OFF_W = OFF_SSQMEM + 1 * MiB;
constexpr size_t OFF_U = OFF_QD;
constexpr size_t W_IN = 0;
constexpr size_t W_MEM = W_IN + (size_t)WIN_N * 1024;
constexpr size_t W_QB = W_MEM + 1024 * 1024;
constexpr size_t W_KVB = W_QB + 1024 * 384;
constexpr size_t W_DO = W_KVB + 1024 * 256;
constexpr size_t W_MO = W_DO + 1024 * 1024;
constexpr size_t W_CO = W_MO + 1024 * 768;
constexpr size_t W_OUT = W_CO + 1024 * 512;
constexpr size_t W_1 = W_OUT + 1024 * 1024;
constexpr size_t W_2 = W_1 + 4096 * 1024;
constexpr size_t W_END = W_2 + 4096 * 1024;
constexpr size_t WS_NEED = OFF_W + W_END * 2;

constexpr int LDS_ROW = 144;
constexpr int CS_LD = 132;
constexpr int CS_BYTES = 256 * CS_LD * 4;
constexpr int RS_OFF = 2 * 512 * LDS_ROW;
constexpr int LDS_BYTES = RS_OFF + 1024;

__constant__ float INVF64[32] = {1.000000000e+00f,7.498942614e-01f,5.623413324e-01f,4.216965139e-01f,3.162277639e-01f,2.371373773e-01f,1.778279394e-01f,1.333521307e-01f,1.000000015e-01f,7.498941571e-02f,5.623413250e-02f,4.216965288e-02f,3.162277490e-02f,2.371373773e-02f,1.778279431e-02f,1.333521493e-02f,9.999999776e-03f,7.498941850e-03f,5.623413250e-03f,4.216964822e-03f,3.162277630e-03f,2.371373586e-03f,1.778279431e-03f,1.333521446e-03f,1.000000047e-03f,7.498942432e-04f,5.623413017e-04f,4.216965172e-04f,3.162277571e-04f,2.371373703e-04f,1.778279402e-04f,1.333521504e-04f};
__constant__ float INVF32[16] = {1.000000000e+00f,5.623413324e-01f,3.162277639e-01f,1.778279394e-01f,1.000000015e-01f,5.623413250e-02f,3.162277490e-02f,1.778279431e-02f,9.999999776e-03f,5.623413250e-03f,3.162277630e-03f,1.778279431e-03f,1.000000047e-03f,5.623413017e-04f,3.162277571e-04f,1.778279402e-04f};

struct Params {
  const float* in[27];
  float* out;
  char* ws;
  int ph_lo, ph_hi;
  int dupk, per;
};

typedef __bf16 bf2_t __attribute__((ext_vector_type(2)));
typedef float fl2_t __attribute__((ext_vector_type(2)));
DI unsigned pack2(float a, float b) { fl2_t f = {a, b}; bf2_t r = __builtin_convertvector(f, bf2_t); return __builtin_bit_cast(unsigned, r); }
DI u4 pack8(const float* v) { u4 u; u.x = pack2(v[0], v[1]); u.y = pack2(v[2], v[3]); u.z = pack2(v[4], v[5]); u.w = pack2(v[6], v[7]); return u; }
DI int ltid() { int t = threadIdx.x; asm volatile("" : "+v"(t)); return t; }
DI int crow(int i, int h) { return (i & 3) + 8 * (i >> 2) + 4 * h; }
DI void rot_cs(int pos, float invf, float& c, float& s) {
  const float ang = (float)pos * invf;
  double rev = (double)ang * 0.15915494309189535;
  rev -= floor(rev);
  const float rf = (float)rev;
  c = __builtin_amdgcn_cosf(rf);
  s = __builtin_amdgcn_sinf(rf);
}
DI void load8(const float* Cs, int r, int q, float* v) {
  const f4 a = *(const f4*)(Cs + r * CS_LD + q * 8);
  const f4 b = *(const f4*)(Cs + r * CS_LD + q * 8 + 4);
  v[0] = a.x; v[1] = a.y; v[2] = a.z; v[3] = a.w; v[4] = b.x; v[5] = b.y; v[6] = b.z; v[7] = b.w;
}

template <int MI, int NI, int WGN, bool FDB>
DI void gemm_mainloop(const bf16_t* __restrict__ A, int lda, const bf16_t* __restrict__ B, int ldb, int K, f32x16 (&acc)[MI][NI], char* smem) {
  constexpr int BM = (8 / WGN) * MI * 32, BN = WGN * NI * 32;
  constexpr int ASZ = BM * 64, STAGE = (BM + BN) * 64;
  constexpr int NGA = BM / 128, NGB = BN / 128, NLD = NGA + NGB;
  static_assert(4 * STAGE <= RS_OFF, "ring");
  const int tid = ltid(), lane = tid & 63, wave = tid >> 6, l31 = lane & 31, h = lane >> 5;
  const int wu = __builtin_amdgcn_readfirstlane(wave);
  const int wm = wave / WGN, wn = wave % WGN;
  const int lrow = lane >> 2, lchk = (lane & 3) ^ ((lane >> 4) & 3);
  const bf16_t* ga = A + (size_t)(wu * NGA * 16 + lrow) * lda + lchk * 8;
  const bf16_t* gb = B + (size_t)(wu * NGB * 16 + lrow) * ldb + lchk * 8;
#pragma unroll
  for (int mi = 0; mi < MI; ++mi)
#pragma unroll
    for (int ni = 0; ni < NI; ++ni)
#pragma unroll
      for (int i = 0; i < 16; ++i) acc[mi][ni][i] = 0.f;
  auto issue = [&](int j) {
    char* st = smem + (j & 3) * STAGE;
    const int k0 = j * 32;
#pragma unroll
    for (int i = 0; i < NGA; ++i)
      __builtin_amdgcn_global_load_lds((const unsigned*)(ga + (size_t)(i * 16) * lda + k0), (unsigned*)(st + (wu * NGA + i) * 1024), 16, 0, 0);
#pragma unroll
    for (int i = 0; i < NGB; ++i)
      __builtin_amdgcn_global_load_lds((const unsigned*)(gb + (size_t)(i * 16) * ldb + k0), (unsigned*)(st + ASZ + (wu * NGB + i) * 1024), 16, 0, 0);
  };
  asm volatile("s_waitcnt vmcnt(0)" ::: "memory");
  __syncthreads();
  const int nk = K >> 5;
  issue(0); issue(1); issue(2);
  const int sw = (l31 >> 2) & 3;
  const int oa = (wm * MI * 32 + l31) * 64, ob = ASZ + (wn * NI * 32 + l31) * 64;
  const int c0 = ((0 + h) ^ sw) * 16, c1 = ((2 + h) ^ sw) * 16;
#pragma unroll 1
  for (int j = 0; j < nk; ++j) {
    if (j + 2 < nk) asm volatile("s_waitcnt vmcnt(%0)" ::"n"(2 * NLD) : "memory");
    else if (j + 1 < nk) asm volatile("s_waitcnt vmcnt(%0)" ::"n"(NLD) : "memory");
    else asm volatile("s_waitcnt vmcnt(0)" ::: "memory");
    asm volatile("s_waitcnt lgkmcnt(0)" ::: "memory");
    __builtin_amdgcn_s_barrier();
    if (j + 3 < nk) issue(j + 3);
    const char* st = smem + (j & 3) * STAGE;
    const char* pa = st + oa;
    const char* pb = st + ob;
    bf16x8 fa0[MI], fb0[NI], fa1[MI], fb1[NI];
#pragma unroll
    for (int mi = 0; mi < MI; ++mi) fa0[mi] = *(const bf16x8*)(pa + mi * 2048 + c0);
#pragma unroll
    for (int ni = 0; ni < NI; ++ni) fb0[ni] = *(const bf16x8*)(pb + ni * 2048 + c0);
    if (FDB) {
#pragma unroll
      for (int mi = 0; mi < MI; ++mi) fa1[mi] = *(const bf16x8*)(pa + mi * 2048 + c1);
#pragma unroll
      for (int ni = 0; ni < NI; ++ni) fb1[ni] = *(const bf16x8*)(pb + ni * 2048 + c1);
    }
#pragma unroll
    for (int mi = 0; mi < MI; ++mi)
#pragma unroll
      for (int ni = 0; ni < NI; ++ni) acc[mi][ni] = MFMA(fa0[mi], fb0[ni], acc[mi][ni]);
    __builtin_amdgcn_sched_barrier(0);
    if (!FDB) {
#pragma unroll
      for (int mi = 0; mi < MI; ++mi) fa1[mi] = *(const bf16x8*)(pa + mi * 2048 + c1);
#pragma unroll
      for (int ni = 0; ni < NI; ++ni) fb1[ni] = *(const bf16x8*)(pb + ni * 2048 + c1);
    }
#pragma unroll
    for (int mi = 0; mi < MI; ++mi)
#pragma unroll
      for (int ni = 0; ni < NI; ++ni) acc[mi][ni] = MFMA(fa1[mi], fb1[ni], acc[mi][ni]);
    __builtin_amdgcn_sched_barrier(0);
  }
  asm volatile("s_waitcnt lgkmcnt(0)" ::: "memory");
  __builtin_amdgcn_s_barrier();
}

using f32x4v = __attribute__((ext_vector_type(4))) float;
DI int lds_byte8(int r, int c) {
  const int st = (r >> 4) * 2 + (c >> 5), rr = r & 15, cc = c & 31, ob = rr * 64 + cc * 2;
  return st * 1024 + (ob ^ (((ob >> 9) & 1) << 5));
}
DI void stage_rc8(int b, int& R, int& C) {
  const int st = b / 1024, sb = b % 1024, swz = sb ^ (((sb >> 9) & 1) << 5);
  R = (st >> 1) * 16 + swz / 64; C = (st & 1) * 32 + (swz % 64) / 2;
}
DI void gemm8p(const bf16_t* __restrict__ A, const bf16_t* __restrict__ Bt, int K, f32x4v (&acc)[2][2][4][2], char* smem) {
  constexpr int BK8 = 64, HALF8 = 128, HTB = HALF8 * BK8 * 2;
  const int tid = ltid(), wid = tid >> 6, lane = tid & 63, wr = wid >> 2, wc = wid & 3, fr = lane & 15, fq = lane >> 4;
  const int wu8 = __builtin_amdgcn_readfirstlane(wid);
  unsigned goff[2];
#pragma unroll
  for (int i_ = 0; i_ < 2; ++i_) { int r_, c_; stage_rc8(tid * 16 + i_ * 8192, r_, c_); goff[i_] = (unsigned)(r_ * K + c_); }
  const int lfrag = ((fr * 64 + fq * 16) ^ ((fr >> 3) << 5));
  const char* la = smem + wr * 8192 + lfrag;
  const char* lb = smem + 4 * HTB + wc * 4096 + lfrag;
#define SA8(b, h) ((b) * 2 + (h))
#define SB8(b, h) (4 + (b) * 2 + (h))
#define STAGE8(Q, BASE, br, kt) do { const bf16_t* sb_ = (BASE) + ((long)(br) * K + (long)(kt) * BK8); \
    _Pragma("unroll") for (int i_ = 0; i_ < 2; ++i_) \
      __builtin_amdgcn_global_load_lds((const unsigned*)(sb_ + goff[i_]), (unsigned*)(smem + (Q) * HTB + i_ * 8192 + wu8 * 1024), 16, 0, 0); } while (0)
#define LDA8(dst, b, h) _Pragma("unroll") for (int m = 0; m < 4; ++m) _Pragma("unroll") for (int k = 0; k < 2; ++k) \
    dst[m][k] = *(const bf16x8*)(la + ((b) * 2 + (h)) * HTB + (m * 2 + k) * 1024)
#define LDB8(dst, b, h) _Pragma("unroll") for (int n = 0; n < 2; ++n) _Pragma("unroll") for (int k = 0; k < 2; ++k) \
    dst[n][k] = *(const bf16x8*)(lb + ((b) * 2 + (h)) * HTB + (n * 2 + k) * 1024)
#define MMA8(ai, bj, At_, Bt_) do { __builtin_amdgcn_s_setprio(1); \
    _Pragma("unroll") for (int m = 0; m < 4; ++m) _Pragma("unroll") for (int n = 0; n < 2; ++n) _Pragma("unroll") for (int k = 0; k < 2; ++k) \
      acc[ai][bj][m][n] = __builtin_amdgcn_mfma_f32_16x16x32_bf16(Bt_[n][k], At_[m][k], acc[ai][bj][m][n], 0, 0, 0); \
    __builtin_amdgcn_s_setprio(0); } while (0)
#define WAIT_V8(n) asm volatile("s_waitcnt vmcnt(" #n ")" ::: "memory")
#define WAIT_L8(n) asm volatile("s_waitcnt lgkmcnt(" #n ")" ::: "memory")
#define BAR8 __builtin_amdgcn_s_barrier()
#define SCHED8 __builtin_amdgcn_sched_barrier(0)
#pragma unroll
  for (int a = 0; a < 2; ++a)
#pragma unroll
    for (int b = 0; b < 2; ++b)
#pragma unroll
      for (int m = 0; m < 4; ++m)
#pragma unroll
        for (int n = 0; n < 2; ++n) acc[a][b][m][n] = f32x4v{0.f, 0.f, 0.f, 0.f};
  bf16x8 At[4][2], B0[2][2], B1[2][2];
  const int nt = K / BK8;
  asm volatile("s_waitcnt vmcnt(0)" ::: "memory");
  __syncthreads();
  STAGE8(SB8(0, 0), Bt, 0, 0); STAGE8(SA8(0, 0), A, 0, 0);
  STAGE8(SB8(0, 1), Bt, HALF8, 0); STAGE8(SA8(0, 1), A, HALF8, 0);
  if (wr == 1) BAR8;
  WAIT_V8(4); BAR8;
  STAGE8(SB8(1, 0), Bt, 0, 1); STAGE8(SA8(1, 0), A, 0, 1); STAGE8(SB8(1, 1), Bt, HALF8, 1);
  WAIT_V8(6); BAR8;
#pragma unroll 1
  for (int t = 0; t < nt - 2; t += 2) {
    LDB8(B0, 0, 0); SCHED8; LDA8(At, 0, 0); STAGE8(SA8(1, 1), A, HALF8, t + 1);
    WAIT_L8(8); BAR8; WAIT_L8(0); MMA8(0, 0, At, B0); BAR8; SCHED8;
    LDB8(B1, 0, 1); STAGE8(SB8(0, 0), Bt, 0, t + 2);
    BAR8; WAIT_L8(0); MMA8(0, 1, At, B1); BAR8;
    LDA8(At, 0, 1); STAGE8(SA8(0, 0), A, 0, t + 2);
    BAR8; WAIT_L8(0); MMA8(1, 0, At, B0); BAR8; SCHED8;
    STAGE8(SB8(0, 1), Bt, HALF8, t + 2);
    WAIT_V8(6); BAR8; MMA8(1, 1, At, B1); BAR8;
    LDB8(B0, 1, 0); SCHED8; LDA8(At, 1, 0); STAGE8(SA8(0, 1), A, HALF8, t + 2);
    WAIT_L8(8); BAR8; WAIT_L8(0); MMA8(0, 0, At, B0); BAR8; SCHED8;
    LDB8(B1, 1, 1); STAGE8(SB8(1, 0), Bt, 0, t + 3);
    BAR8; WAIT_L8(0); MMA8(0, 1, At, B1); BAR8;
    LDA8(At, 1, 1); STAGE8(SA8(1, 0), A, 0, t + 3);
    BAR8; WAIT_L8(0); MMA8(1, 0, At, B0); BAR8; SCHED8;
    STAGE8(SB8(1, 1), Bt, HALF8, t + 3);
    WAIT_V8(6); BAR8; MMA8(1, 1, At, B1); BAR8;
  }
  { LDB8(B0, 0, 0); LDA8(At, 0, 0); STAGE8(SA8(1, 1), A, HALF8, nt - 1);
    BAR8; WAIT_L8(0); MMA8(0, 0, At, B0); BAR8;
    LDB8(B1, 0, 1); BAR8; WAIT_L8(0); MMA8(0, 1, At, B1); BAR8;
    LDA8(At, 0, 1); WAIT_V8(4); BAR8; WAIT_L8(0); MMA8(1, 0, At, B0); MMA8(1, 1, At, B1); BAR8; }
  { LDB8(B0, 1, 0); LDA8(At, 1, 0); WAIT_V8(2); BAR8; WAIT_L8(0); MMA8(0, 0, At, B0); BAR8;
    LDB8(B1, 1, 1); WAIT_V8(0); BAR8; WAIT_L8(0); MMA8(0, 1, At, B1); BAR8;
    LDA8(At, 1, 1); BAR8; WAIT_L8(0); MMA8(1, 0, At, B0); MMA8(1, 1, At, B1); BAR8; }
  if (wr == 0) BAR8;
  asm volatile("s_waitcnt lgkmcnt(0)" ::: "memory");
  BAR8;
#undef SA8
#undef SB8
#undef STAGE8
#undef LDA8
#undef LDB8
#undef MMA8
#undef WAIT_V8
#undef WAIT_L8
#undef BAR8
#undef SCHED8
}

DI void fill_rs(float* rs, const float* ssq, int nparts, int pstride, int row0, float invK) {
  const int t = ltid();
  if (t < 256) {
    float r = 1.f;
    if (ssq) {
      float s = 0.f;
      for (int p = 0; p < nparts; ++p) s += ssq[(size_t)p * pstride + row0 + t];
      r = rsqrtf(s * invK + EPSV);
    }
    rs[t] = r;
  }
}

enum { EP_HEADROT = 0, EP_VT, EP_PLAIN, EP_KROPE, EP_NORM128, EP_QB, EP_KVB, EP_RES, EP_MLP1, EP_YTMP, EP_GATE };

struct Tile {
  int epi, row0, cb;
  bf16_t* dst; int ldd;
  const float* gain;
  float* ssq_out;
  const float* xsrc;
  float oscale;
  const bf16_t* ysrc;
  int accum;
};

DI void map_regular(int it, int bid, int NCB, int& rb, int& CB) {
  const int xcd = bid & 7, slot = bid >> 3;
  const int c = xcd * NCB + it;
  const int cgrp = c >> 5, rgrp = c & 31;
  rb = rgrp * 8 + (slot >> 2);
  CB = cgrp * 4 + (slot & 3);
}

template <int DK, int DV, int NM, bool CAUSAL>
DI void attn_block(const bf16_t* __restrict__ Q, int ldq, const bf16_t* __restrict__ Kg, int ldk, const bf16_t* __restrict__ Vt, int ldv,
                   int nkt, int q0, bf16_t* O, int ldo, float sc, float lam, const float* og, float omul, char* smem) {
  constexpr int KW = NM * DK, KCHV = KW / 8;
  constexpr int KBYTES = 64 * 256, VBYTES = DV * 128, STAGE = KBYTES + VBYTES;
  constexpr int NVI = DV / 64;
  constexpr int NLD = 2 + NVI;
  static_assert(KCHV <= 16 && 4 * STAGE <= RS_OFF, "lds");
  constexpr int NKC16 = DK / 16, NDVB = DV / 32;
  const int tid = ltid(), lane = tid & 63, wave = tid >> 6, h = lane >> 5, l31 = lane & 31;
  const int wq = (NM == 2) ? (wave & 3) : wave;
  const int mymap = (NM == 2) ? (wave >> 2) : 0;
  const int q0w = q0 + wq * 32;

  bf16x8 qf[NKC16];
  {
    const bf16_t* qp = Q + (size_t)(wq * 32 + l31) * ldq + mymap * DK + h * 8;
#pragma unroll
    for (int kc = 0; kc < NKC16; ++kc) qf[kc] = *(const bf16x8*)(qp + kc * 16);
#pragma unroll
    for (int kc = 0; kc < NKC16; ++kc) asm volatile("" : "+v"(qf[kc]));
  }
  f32x16 o[NDVB];
#pragma unroll
  for (int d = 0; d < NDVB; ++d)
#pragma unroll
    for (int i = 0; i < 16; ++i) o[d][i] = 0.f;
  f32x16 lacc;
#pragma unroll
  for (int i = 0; i < 16; ++i) lacc[i] = 0.f;
  u4 onesu; onesu.x = onesu.y = onesu.z = onesu.w = 0x3F803F80u;
  const bf16x8 ones = __builtin_bit_cast(bf16x8, onesu);

  const int wu = __builtin_amdgcn_readfirstlane(wave);
  const int krow = lane >> 4, kslot = lane & 15;
  const int vrow = lane >> 3, vslot = lane & 7;
  auto issue = [&](int kt) {
    char* st = smem + (kt & 3) * STAGE;
#pragma unroll
    for (int i = 0; i < 2; ++i) {
      const int r = (wu * 2 + i) * 4 + krow;
      const int c = kslot ^ (r & 15);
      if (KCHV == 16 || c < KCHV)
        __builtin_amdgcn_global_load_lds((const unsigned*)(Kg + (size_t)(kt * 64 + r) * ldk + c * 8), (unsigned*)(st + (wu * 2 + i) * 1024), 16, 0, 0);
    }
#pragma unroll
    for (int i = 0; i < NVI; ++i) {
      const int d = (wu * NVI + i) * 8 + vrow;
      const int c = vslot ^ ((d >> 1) & 7);
      __builtin_amdgcn_global_load_lds((const unsigned*)(Vt + (size_t)d * ldv + kt * 64 + c * 8), (unsigned*)(st + KBYTES + (wu * NVI + i) * 1024), 16, 0, 0);
    }
  };
  asm volatile("s_waitcnt vmcnt(0)" ::: "memory");
  __syncthreads();
  if (0 < nkt) issue(0);
  if (1 < nkt) issue(1);
  if (2 < nkt) issue(2);
  for (int kt = 0; kt < nkt; ++kt) {
    if (kt + 2 < nkt) asm volatile("s_waitcnt vmcnt(%0)" ::"n"(2 * NLD) : "memory");
    else if (kt + 1 < nkt) asm volatile("s_waitcnt vmcnt(%0)" ::"n"(NLD) : "memory");
    else asm volatile("s_waitcnt vmcnt(0)" ::: "memory");
    asm volatile("s_waitcnt lgkmcnt(0)" ::: "memory");
    __builtin_amdgcn_s_barrier();
    if (kt + 3 < nkt) issue(kt + 3);
    const bool skip = CAUSAL && (kt * 64 > q0w + 31);
    if (!skip) {
      const char* base = smem + (kt & 3) * STAGE;
      f32x16 s[2];
#pragma unroll
      for (int sb = 0; sb < 2; ++sb) {
#pragma unroll
        for (int i = 0; i < 16; ++i) s[sb][i] = 0.f;
        const char* pk = base + (sb * 32 + l31) * 256;
#pragma unroll
        for (int kc = 0; kc < NKC16; ++kc) {
          const bf16x8 a = *(const bf16x8*)(pk + (((mymap * (DK / 8) + kc * 2 + h) ^ (l31 & 15)) * 16));
          s[sb] = MFMA(a, qf[kc], s[sb]);
        }
        __builtin_amdgcn_sched_barrier(0);
      }
      const bool need_mask = CAUSAL && (kt * 64 + 63 > q0w);
      const char* pv = base + KBYTES + l31 * 128;
      const int vsw = (l31 >> 1) & 7;
      bf16x8 pf[4];
      auto expo = [&](int sb) {
#pragma unroll
        for (int i = 0; i < 16; ++i) {
          float pz = __builtin_amdgcn_exp2f(s[sb][i]);
          if (need_mask) {
            const int key = kt * 64 + sb * 32 + crow(i, h);
            if (key > q0w + l31) pz = 0.f;
          }
          s[sb][i] = pz;
        }
#pragma unroll
        for (int k2 = 0; k2 < 2; ++k2) {
          u4 pu;
          pu.x = pack2(s[sb][k2 * 8 + 0], s[sb][k2 * 8 + 1]);
          pu.y = pack2(s[sb][k2 * 8 + 2], s[sb][k2 * 8 + 3]);
          pu.z = pack2(s[sb][k2 * 8 + 4], s[sb][k2 * 8 + 5]);
          pu.w = pack2(s[sb][k2 * 8 + 6], s[sb][k2 * 8 + 7]);
          pf[sb * 2 + k2] = __builtin_bit_cast(bf16x8, pu);
        }
      };
      auto pvmm = [&](int ks) {
        lacc = MFMA(ones, pf[ks], lacc);
#pragma unroll
        for (int d = 0; d < NDVB; ++d) {
          const u4 au = *(const u4*)(pv + d * 32 * 128 + (((ks * 2 + h) ^ vsw) * 16));
          o[d] = MFMA(__builtin_bit_cast(bf16x8, au), pf[ks], o[d]);
        }
      };
      expo(0);
      pvmm(0); pvmm(1);
      expo(1);
      pvmm(2); pvmm(3);
      __builtin_amdgcn_sched_barrier(0);
    }
  }
  asm volatile("s_waitcnt lgkmcnt(0)" ::: "memory");
  __builtin_amdgcn_s_barrier();
  const float l_tot = lacc[0];
  const float inv = 1.f / l_tot;
#pragma unroll
  for (int d = 0; d < NDVB; ++d)
#pragma unroll
    for (int i = 0; i < 16; ++i) o[d][i] *= inv;

  float rn_out = 1.f;
  if (NM == 2) {
    float* buf = (float*)smem;
    if (wave >= 4) {
#pragma unroll
      for (int d = 0; d < NDVB; ++d)
#pragma unroll
        for (int i = 0; i < 16; ++i) buf[(d * 16 + i) * 256 + (wave & 3) * 64 + lane] = o[d][i];
    }
    __syncthreads();
    if (wave < 4) {
      float ss = 0.f;
#pragma unroll
      for (int d = 0; d < NDVB; ++d) {
#pragma unroll
        for (int i = 0; i < 16; ++i) {
          const float v = o[d][i] - lam * buf[(d * 16 + i) * 256 + wave * 64 + lane];
          o[d][i] = v;
          ss += v * v;
        }
        __builtin_amdgcn_sched_barrier(0);
      }
      ss += __shfl_xor(ss, 32);
      rn_out = rsqrtf(ss * (1.f / DV) + EPSV) * omul;
    }
  }
  if (NM == 1 || wave < 4) {
    bf16_t* op = O + (size_t)(wq * 32 + l31) * ldo + 4 * h;
#pragma unroll
    for (int d = 0; d < NDVB; ++d)
#pragma unroll
      for (int g = 0; g < 4; ++g) {
        f4 gg = {1.f, 1.f, 1.f, 1.f};
        if (NM == 2) gg = *(const f4*)(og + d * 32 + 8 * g + 4 * h);
        u2 u;
        u.x = pack2(o[d][4 * g + 0] * rn_out * gg.x, o[d][4 * g + 1] * rn_out * gg.y);
        u.y = pack2(o[d][4 * g + 2] * rn_out * gg.z, o[d][4 * g + 3] * rn_out * gg.w);
        *(u2*)(op + d * 32 + 8 * g) = u;
      }
  }
}

DI void prep_tile(const float* __restrict__ src, int N, const float* __restrict__ gain, bf16_t* __restrict__ dst, int Kp, int nmode, int kmode, int kt, int nt, char* smem) {
  float* tile = (float*)smem;
  const int tid = ltid();
  __syncthreads();
  {
    const int n = tid & 63;
    const int np = nt * 64 + n;
    int ns = np; bool nv = true;
    if (nmode == 1) {
      if (np < 3712) ns = np;
      else if (np < 3840) { ns = np; nv = (np < 3744); }
      else if (np < 4352) ns = np - 96;
      else ns = np - 96;
    } else if (nmode == 2) {
      const int hh = np >> 7, j = np & 127;
      nv = j < 96; ns = hh * 96 + j;
    }
#pragma unroll
    for (int j = 0; j < 8; ++j) {
      const int kk = (tid >> 6) + 8 * j;
      const int kp = kt * 64 + kk;
      int ks = kp; bool kv = true;
      if (kmode == 1) { const int hh = kp / 96, jj = kp % 96; kv = jj < 64; ks = hh * 64 + jj; }
      float v = 0.f;
      if (nv && kv) { v = src[(size_t)ks * N + ns]; if (gain) v *= gain[ks]; }
      tile[n * 65 + kk] = v;
    }
  }
  __syncthreads();
  {
    const int n = tid >> 3, kc = tid & 7;
    float v[8];
#pragma unroll
    for (int e = 0; e < 8; ++e) v[e] = tile[n * 65 + kc * 8 + e];
    *(u4*)(dst + (size_t)(nt * 64 + n) * Kp + kt * 64 + kc * 8) = pack8(v);
  }
}

DI void prep_item(const Params& p, int l, int it, char* smem) {
  bf16_t* W = (bf16_t*)(p.ws + OFF_W);
  const float* src; const float* gain = nullptr; bf16_t* dst; int N, Kp, nmode = 0, kmode = 0, nkt, loc;
  if (it < 1856)      { loc = it;        src = p.in[4] + (size_t)l * 1024 * 7328; N = 7328; gain = p.in[3] + l * 1024; dst = W + W_IN; Kp = 1024; nmode = 1; nkt = 16; }
  else if (it < 2112) { loc = it - 1856; src = p.in[19] + (size_t)l * 1024 * 1024; N = 1024; gain = p.in[18] + l * 1024; dst = W + W_MEM; Kp = 1024; nkt = 16; }
  else if (it < 2208) { loc = it - 2112; src = p.in[12] + (size_t)l * 384 * 768; N = 768; gain = p.in[11] + l * 384; dst = W + W_QB; Kp = 384; nmode = 2; nkt = 6; }
  else if (it < 2272) { loc = it - 2208; src = p.in[14] + (size_t)l * 256 * 1024; N = 1024; gain = p.in[13] + l * 256; dst = W + W_KVB; Kp = 256; nkt = 4; }
  else if (it < 2528) { loc = it - 2272; src = p.in[10] + (size_t)l * 1024 * 1024; N = 1024; dst = W + W_DO; Kp = 1024; nkt = 16; }
  else if (it < 2720) { loc = it - 2528; src = p.in[17] + (size_t)l * 512 * 1024; N = 1024; dst = W + W_MO; Kp = 768; kmode = 1; nkt = 12; }
  else if (it < 2848) { loc = it - 2720; src = p.in[22] + (size_t)l * 512 * 1024; N = 1024; dst = W + W_CO; Kp = 512; nkt = 8; }
  else if (it < 3104) { loc = it - 2848; src = p.in[23] + (size_t)l * 1024 * 1024; N = 1024; dst = W + W_OUT; Kp = 1024; nkt = 16; }
  else if (it < 4128) { loc = it - 3104; src = p.in[25] + (size_t)l * 1024 * 4096; N = 4096; gain = p.in[24] + l * 1024; dst = W + W_1; Kp = 1024; nkt = 16; }
  else                { loc = it - 4128; src = p.in[26] + (size_t)l * 4096 * 1024; N = 1024; dst = W + W_2; Kp = 4096; nkt = 64; }
  prep_tile(src, N, gain, dst, Kp, nmode, kmode, loc % nkt, loc / nkt, smem);
}
DI void prep_range(const Params& p, int l, int lo, int hi, char* smem) {
  for (int it = lo + blockIdx.x; it < hi; it += gridDim.x) prep_item(p, l, it, smem);
}

DI void phase_init(const Params& p) {
  const int tid_ = ltid(); const int lane = tid_ & 63, gw = blockIdx.x * 8 + (tid_ >> 6), GW = gridDim.x * 8;
  bf16_t* XB = (bf16_t*)(p.ws + OFF_XB); bf16_t* MB = (bf16_t*)(p.ws + OFF_MEMB);
  float* SX = (float*)(p.ws + OFF_SSQX); float* SM = (float*)(p.ws + OFF_SSQMEM);
  for (int r = gw; r < T + MEMR; r += GW) {
    const bool isx = r < T;
    const float* src = isx ? p.in[0] + (size_t)r * 1024 : p.in[1] + (size_t)(r - T) * 1024;
    bf16_t* dst = isx ? XB + (size_t)r * 1024 : MB + (size_t)(r - T) * 1024;
    float ss = 0.f;
#pragma unroll
    for (int j = 0; j < 4; ++j) {
      const f4 v = *(const f4*)(src + j * 256 + lane * 4);
      ss += v.x * v.x + v.y * v.y + v.z * v.z + v.w * v.w;
      u2 u; u.x = pack2(v.x, v.y); u.y = pack2(v.z, v.w);
      *(u2*)(dst + j * 256 + lane * 4) = u;
    }
#pragma unroll
    for (int m = 32; m >= 1; m >>= 1) ss += __shfl_xor(ss, m);
    if (isx) { if (lane < 8) SX[(size_t)lane * T + r] = (lane == 0) ? ss : 0.f; }
    else if (lane == 0) SM[r - T] = ss;
  }
}

DI void run_epilogue(const Params& p, const Tile& t, char* smem) {
  float* Cs = (float*)smem;
  float* rs = (float*)(smem + RS_OFF);
  const int tid = ltid();
  const int q = tid & 15, rsub = tid >> 4;
  const int* pos = (const int*)p.in[2];
  if (t.epi == EP_VT) {
    const int c = tid >> 2, rq = tid & 3;
#pragma unroll
    for (int j = 0; j < 8; ++j) {
      float v[8];
#pragma unroll
      for (int e = 0; e < 8; ++e) { const int r = rq * 64 + j * 8 + e; v[e] = Cs[r * CS_LD + c] * rs[r]; }
      bf16_t* d16 = t.dst + (size_t)c * t.ldd + rq * 64 + (j >> 1) * 16;
      u2 lo, hi; lo.x = pack2(v[0], v[1]); lo.y = pack2(v[2], v[3]); hi.x = pack2(v[4], v[5]); hi.y = pack2(v[6], v[7]);
      *(u2*)(d16 + ((j & 1) ? 4 : 0)) = lo;
      *(u2*)(d16 + ((j & 1) ? 12 : 8)) = hi;
    }
    return;
  }
#pragma unroll 1
  for (int pass = 0; pass < 8; ++pass) {
    const int r = rsub + 32 * pass;
    const int row = t.row0 + r;
    float v[8];
    load8(Cs, r, q, v);
    const float rsv = rs[r];
#pragma unroll
    for (int e = 0; e < 8; ++e) v[e] *= rsv;
    switch (t.epi) {
      case EP_HEADROT: {
        const float* cr = Cs + r * CS_LD + 2 * q;
        float x1[2][2], x2[2][2];
#pragma unroll
        for (int m = 0; m < 2; ++m) {
          const fl2_t a = *(const fl2_t*)(cr + m * 64), b = *(const fl2_t*)(cr + m * 64 + 32);
          x1[m][0] = a.x * rsv; x1[m][1] = a.y * rsv; x2[m][0] = b.x * rsv; x2[m][1] = b.y * rsv;
        }
        float ssm[2];
#pragma unroll
        for (int m = 0; m < 2; ++m) {
          float ss = x1[m][0] * x1[m][0] + x1[m][1] * x1[m][1] + x2[m][0] * x2[m][0] + x2[m][1] * x2[m][1];
          ss += __shfl_xor(ss, 1); ss += __shfl_xor(ss, 2); ss += __shfl_xor(ss, 4); ss += __shfl_xor(ss, 8);
          ssm[m] = rsqrtf(ss * (1.f / 64) + EPSV) * t.oscale;
        }
        const int ps = pos[row];
        const fl2_t g1 = *(const fl2_t*)(t.gain + 2 * q), g2 = *(const fl2_t*)(t.gain + 32 + 2 * q);
        const float g1v[2] = {g1.x, g1.y}, g2v[2] = {g2.x, g2.y};
        float cc[2], sn[2];
#pragma unroll
        for (int e = 0; e < 2; ++e) rot_cs(ps, INVF64[2 * q + e], cc[e], sn[e]);
#pragma unroll
        for (int m = 0; m < 2; ++m) {
          float o1[2], o2[2];
#pragma unroll
          for (int e = 0; e < 2; ++e) {
            const float y1 = x1[m][e] * ssm[m] * g1v[e], y2 = x2[m][e] * ssm[m] * g2v[e];
            o1[e] = y1 * cc[e] - y2 * sn[e];
            o2[e] = y2 * cc[e] + y1 * sn[e];
          }
          bf16_t* d = t.dst + (size_t)row * t.ldd + t.cb * 128 + m * 64 + 2 * q;
          *(unsigned*)d = pack2(o1[0], o1[1]);
          *(unsigned*)(d + 32) = pack2(o2[0], o2[1]);
        }
      } break;
      case EP_PLAIN: {
        float ss = 0.f;
#pragma unroll
        for (int e = 0; e < 8; ++e) ss += v[e] * v[e];
        ss += __shfl_xor(ss, 1); ss += __shfl_xor(ss, 2); ss += __shfl_xor(ss, 4); ss += __shfl_xor(ss, 8);
        *(u4*)(t.dst + (size_t)row * t.ldd + t.cb * 128 + q * 8) = pack8(v);
        if (q == 0) t.ssq_out[row] = ss;
      } break;
      case EP_KROPE: {
        const bool first = (q & 2) == 0; const int i0 = (q & 1) * 8;
        const int ps = pos[row];
        float ov[8];
#pragma unroll
        for (int e = 0; e < 8; ++e) {
          const float yp = __shfl_xor(v[e], 2);
          float c, s; rot_cs(ps, INVF32[i0 + e], c, s);
          ov[e] = first ? (v[e] * c - yp * s) : (v[e] * c + yp * s);
        }
        if (q < 4) {
          float* kr = (float*)(p.ws + OFF_KR) + (size_t)row * 32 + q * 8;
          *(f4*)kr = f4{ov[0], ov[1], ov[2], ov[3]};
          *(f4*)(kr + 4) = f4{ov[4], ov[5], ov[6], ov[7]};
        }
      } break;
      case EP_NORM128: {
        float ss = 0.f;
#pragma unroll
        for (int e = 0; e < 8; ++e) ss += v[e] * v[e];
        ss += __shfl_xor(ss, 1); ss += __shfl_xor(ss, 2); ss += __shfl_xor(ss, 4); ss += __shfl_xor(ss, 8);
        const float rn = rsqrtf(ss * (1.f / 128) + EPSV);
#pragma unroll
        for (int e = 0; e < 8; ++e) v[e] *= rn * t.oscale * t.gain[q * 8 + e];
        *(u4*)(t.dst + (size_t)row * t.ldd + t.cb * 128 + q * 8) = pack8(v);
      } break;
      case EP_QB: {
        const bool isr = (q >= 8 && q < 12);
        const bool first = (q & 2) == 0; const int i0 = (q & 1) * 8;
        const int ps = pos[row];
        float ss = 0.f;
#pragma unroll
        for (int e = 0; e < 8; ++e) {
          const float yp = __shfl_xor(v[e], 2);
          float c, s; rot_cs(ps, INVF32[i0 + e], c, s);
          const float rv = first ? (v[e] * c - yp * s) : (v[e] * c + yp * s);
          v[e] = isr ? rv : v[e];
          ss += v[e] * v[e];
        }
        ss += __shfl_xor(ss, 1); ss += __shfl_xor(ss, 2); ss += __shfl_xor(ss, 4); ss += __shfl_xor(ss, 8);
        const float rn = rsqrtf(ss * (1.f / 96) + EPSV);
        if (q < 12) {
#pragma unroll
          for (int e = 0; e < 8; ++e) v[e] *= rn * t.oscale * t.gain[q * 8 + e];
          *(u4*)(t.dst + (size_t)row * 768 + t.cb * 96 + q * 8) = pack8(v);
        }
      } break;
      case EP_KVB: {
        if (q >= 8) {
          if (q < 12) {
            const float* kr = (const float*)(p.ws + OFF_KR) + (size_t)row * 32 + (q - 8) * 8;
            const f4 a = *(const f4*)kr, b = *(const f4*)(kr + 4);
            v[0] = a.x; v[1] = a.y; v[2] = a.z; v[3] = a.w; v[4] = b.x; v[5] = b.y; v[6] = b.z; v[7] = b.w;
          } else {
#pragma unroll
            for (int e = 0; e < 8; ++e) v[e] = 0.f;
          }
        }
        float ss = 0.f;
#pragma unroll
        for (int e = 0; e < 8; ++e) ss += v[e] * v[e];
        ss += __shfl_xor(ss, 1); ss += __shfl_xor(ss, 2); ss += __shfl_xor(ss, 4); ss += __shfl_xor(ss, 8);
        const float rn = rsqrtf(ss * (1.f / 96) + EPSV);
        if (q < 12) {
#pragma unroll
          for (int e = 0; e < 8; ++e) v[e] *= rn * t.oscale * t.gain[q * 8 + e];
          *(u4*)(t.dst + (size_t)row * 768 + t.cb * 96 + q * 8) = pack8(v);
        }
      } break;
      case EP_RES: {
        const float* xs = t.xsrc + (size_t)row * 1024 + t.cb * 128 + q * 8;
        const f4 a = *(const f4*)xs, b = *(const f4*)(xs + 4);
        v[0] += a.x; v[1] += a.y; v[2] += a.z; v[3] += a.w; v[4] += b.x; v[5] += b.y; v[6] += b.z; v[7] += b.w;
        float ss = 0.f;
#pragma unroll
        for (int e = 0; e < 8; ++e) ss += v[e] * v[e];
        ss += __shfl_xor(ss, 1); ss += __shfl_xor(ss, 2); ss += __shfl_xor(ss, 4); ss += __shfl_xor(ss, 8);
        float* xo = p.out + (size_t)row * 1024 + t.cb * 128 + q * 8;
        *(f4*)xo = f4{v[0], v[1], v[2], v[3]};
        *(f4*)(xo + 4) = f4{v[4], v[5], v[6], v[7]};
        *(u4*)(t.dst + (size_t)row * 1024 + t.cb * 128 + q * 8) = pack8(v);
        if (q == 0) t.ssq_out[row] = ss;
      } break;
      case EP_YTMP: {
        *(u4*)(t.dst + (size_t)r * 256 + t.cb * 128 + q * 8) = pack8(v);
      } break;
      case EP_GATE: {
        const u4 yu = *(const u4*)(t.ysrc + (size_t)r * 256 + q * 8);
        const f4 ba = *(const f4*)(t.gain + q * 8), bb = *(const f4*)(t.gain + q * 8 + 4);
        bf16_t* mp_ = t.dst + (size_t)row * 1024 + t.cb * 128 + q * 8;
        u4 mu; mu.x = mu.y = mu.z = mu.w = 0u;
        if (t.accum) mu = *(const u4*)mp_;
        const float bs[8] = {ba.x, ba.y, ba.z, ba.w, bb.x, bb.y, bb.z, bb.w};
        const unsigned yw[4] = {yu.x, yu.y, yu.z, yu.w}, mw[4] = {mu.x, mu.y, mu.z, mu.w};
#pragma unroll
        for (int e = 0; e < 8; ++e) {
          const float g = 1.f / (1.f + __expf(-(v[e] + bs[e])));
          const float y = __uint_as_float((e & 1) ? (yw[e >> 1] & 0xffff0000u) : (yw[e >> 1] << 16));
          const float m = __uint_as_float((e & 1) ? (mw[e >> 1] & 0xffff0000u) : (mw[e >> 1] << 16));
          v[e] = m + g * y;
        }
        *(u4*)mp_ = pack8(v);
      } break;
      case EP_MLP1: {
#pragma unroll
        for (int e = 0; e < 8; ++e) { const float u = fmaxf(v[e], 0.f); v[e] = u * u; }
        *(u4*)(t.dst + (size_t)row * t.ldd + t.cb * 128 + q * 8) = pack8(v);
      } break;
      default: break;
    }
  }
  if (t.epi == EP_KVB) {
    bf16_t* VMT = (bf16_t*)(p.ws + OFF_VMT);
    const int c = tid >> 3, r8 = tid & 7;
    const int b = t.row0 >> 11, s0 = t.row0 & 2047;
    bf16_t* d = VMT + ((size_t)(b * 512 + t.cb * 64 + c)) * SEQ + s0 + r8 * 32;
#pragma unroll
    for (int j = 0; j < 4; ++j) {
      float v[8];
#pragma unroll
      for (int e = 0; e < 8; ++e) { const int r = r8 * 32 + j * 8 + e; v[e] = Cs[r * CS_LD + 64 + c] * rs[r]; }
      bf16_t* d16 = d + (j >> 1) * 16;
      u2 lo, hi; lo.x = pack2(v[0], v[1]); lo.y = pack2(v[2], v[3]); hi.x = pack2(v[4], v[5]); hi.y = pack2(v[6], v[7]);
      *(u2*)(d16 + ((j & 1) ? 4 : 0)) = lo;
      *(u2*)(d16 + ((j & 1) ? 12 : 8)) = hi;
    }
  }
}

__global__ void __launch_bounds__(NTHR) mega_fwd(Params p) {
  __shared__ __attribute__((aligned(16))) char smem[LDS_BYTES];
  cg::grid_group grid = cg::this_grid();
  const int G = gridDim.x, bid = blockIdx.x;
  for (int ph = p.ph_lo; ph < p.ph_hi; ++ph) {
      char* ws = p.ws; asm volatile("" : "+s"(ws));
    bf16_t* XB = (bf16_t*)(ws + OFF_XB);   bf16_t* QD = (bf16_t*)(ws + OFF_QD);   bf16_t* KD = (bf16_t*)(ws + OFF_KD);
    bf16_t* VDT = (bf16_t*)(ws + OFF_VDT); bf16_t* CQ = (bf16_t*)(ws + OFF_CQ);   bf16_t* CKV = (bf16_t*)(ws + OFF_CKV);
    bf16_t* XQ = (bf16_t*)(ws + OFF_XQ);   bf16_t* QM = (bf16_t*)(ws + OFF_QM);   bf16_t* KM = (bf16_t*)(ws + OFF_KM);
    bf16_t* VMT = (bf16_t*)(ws + OFF_VMT); bf16_t* MEMB = (bf16_t*)(ws + OFF_MEMB); bf16_t* KC = (bf16_t*)(ws + OFF_KC);
    bf16_t* VCT = (bf16_t*)(ws + OFF_VCT); bf16_t* W = (bf16_t*)(ws + OFF_W);     bf16_t* U = (bf16_t*)(ws + OFF_U);
    bf16_t* MERGED = KD;
    float* SSQX = (float*)(ws + OFF_SSQX); float* SSQCQ = (float*)(ws + OFF_SSQCQ); float* SSQCKV = (float*)(ws + OFF_SSQCKV);
    float* SSQMEM = (float*)(ws + OFF_SSQMEM);

    if (ph == 0) {
      phase_init(p);
      prep_range(p, 0, 0, 5152, smem);
    } else {
      const int l = (ph - 1) / p.per, kr = (ph - 1) % p.per;
      const int k = (kr > p.dupk) ? kr - (p.per - 7) : kr;
#ifndef NO_GEMM
      if (k == 0 || k == 1 || k == 3 || k == 4 || k == 5 || k == 6) {
        int nits = 0, total = 0;
        if (k == 0) { nits = 18; total = 4480; if (l > 0) prep_range(p, l, 4128, 5152, smem); }
        else if (k == 1) { nits = 8; total = 2048; }
        else if (k == 3) { nits = 24; total = 1024; }
        else if (k == 4) { nits = 4; total = 1024; }
        else if (k == 5) { nits = 16; total = 4096; if (l + 1 < NL) prep_range(p, l + 1, 0, 3104, smem); }
        else { nits = 4; total = 1024; if (l + 1 < NL) prep_range(p, l + 1, 3104, 4128, smem); }
        const bool xmap = (G == 256);
        if (!xmap) nits = ((total + G - 1) / G) * ((k == 3) ? 6 : 1);
#pragma unroll 1
        for (int it = 0; it < nits; ++it) {
          int list = 0, rb = -1, CB = 0;
          if (xmap) {
            if (k == 0) {
              if (it < 16) map_regular(it, bid, 16, rb, CB);
              else if (it == 16) { rb = bid; CB = 16; }
              else if (bid < 128) { list = 1; rb = bid >> 2; CB = bid & 3; }
            } else if (k == 1) { list = it >> 2; map_regular(it & 3, bid, 4, rb, CB); }
            else if (k == 3) map_regular(it / 6, bid, 4, rb, CB);
            else if (k == 5) map_regular(it, bid, 16, rb, CB);
            else map_regular(it, bid, 4, rb, CB);
          } else {
            const int li = ((k == 3) ? (it / 6) : it) * G + bid;
            if (li < total) {
              if (k == 0) { if (li < 4352) { rb = li / 17; CB = li % 17; } else { list = 1; rb = (li - 4352) >> 2; CB = (li - 4352) & 3; } }
              else if (k == 1) { list = li >> 10; rb = (li & 1023) >> 2; CB = li & 3; }
              else if (k == 5) { rb = li >> 4; CB = li & 15; }
              else { rb = li >> 2; CB = li & 3; }
            }
          }
          if (rb < 0) continue;
          const int row0 = rb * 256;
          const bf16_t* Ap; const bf16_t* Bp; int lda, Kd;
          const float* ssq = nullptr; int nparts = 0, pstride = T; float invK = 0.f;
          if (k == 0) {
            if (list == 0) { Ap = XB + (size_t)row0 * 1024; lda = 1024; Bp = W + W_IN + (size_t)CB * 256 * 1024; Kd = 1024; ssq = SSQX; nparts = 8; invK = 1.f / 1024; }
            else           { Ap = MEMB + (size_t)row0 * 1024; lda = 1024; Bp = W + W_MEM + (size_t)CB * 256 * 1024; Kd = 1024; ssq = SSQMEM; nparts = 1; pstride = 0; invK = 1.f / 1024; }
          } else if (k == 1) {
            if (list == 0) { Ap = CQ + (size_t)row0 * 384; lda = 384; Bp = W + W_QB + (size_t)CB * 256 * 384; Kd = 384; ssq = SSQCQ; nparts = 3; invK = 1.f / 384; }
            else           { Ap = CKV + (size_t)row0 * 256; lda = 256; Bp = W + W_KVB + (size_t)CB * 256 * 256; Kd = 256; ssq = SSQCKV; nparts = 2; invK = 1.f / 256; }
          } else if (k == 3) {
            const int st = it % 6, br = st >> 1;
            if (st & 1)       { Ap = XB + (size_t)row0 * 1024; lda = 1024; Bp = W + W_IN + (size_t)(WIN_GATE0 + br * 1024 + CB * 256) * 1024; Kd = 1024; ssq = SSQX; nparts = 8; invK = 1.f / 1024; }
            else if (br == 0) { Ap = QD + (size_t)row0 * 1024; lda = 1024; Bp = W + W_DO + (size_t)CB * 256 * 1024; Kd = 1024; }
            else if (br == 1) { Ap = QM + (size_t)row0 * 768;  lda = 768;  Bp = W + W_MO + (size_t)CB * 256 * 768;  Kd = 768; }
            else              { Ap = XQ + (size_t)row0 * 512;  lda = 512;  Bp = W + W_CO + (size_t)CB * 256 * 512;  Kd = 512; }
          } else if (k == 4) { Ap = MERGED + (size_t)row0 * 1024; lda = 1024; Bp = W + W_OUT + (size_t)CB * 256 * 1024; Kd = 1024; }
          else if (k == 5)   { Ap = XB + (size_t)row0 * 1024; lda = 1024; Bp = W + W_1 + (size_t)CB * 256 * 1024; Kd = 1024; ssq = SSQX; nparts = 8; invK = 1.f / 1024; }
          else               { Ap = U + (size_t)row0 * 4096; lda = 4096; Bp = W + W_2 + (size_t)CB * 256 * 4096; Kd = 4096; }
          f32x4v acc[2][2][4][2];
          gemm8p(Ap, Bp, Kd, acc, smem);
          float* Cs = (float*)smem;
          if (k == 5 || k == 3) {
            float* rsL = (float*)(smem + RS_OFF);
            fill_rs(rsL, ssq, nparts, pstride, row0, invK);
            __syncthreads();
            const int tq = ltid(); const int lane = tq & 63, wave = tq >> 6, wr = wave >> 2, wc = wave & 3, fr = lane & 15, fq = lane >> 4;
            const int st = it % 6, br = st >> 1;
            bf16_t* YS = VDT + (size_t)blockIdx.x * 65536;
#pragma unroll
            for (int ai = 0; ai < 2; ++ai)
#pragma unroll
              for (int m = 0; m < 4; ++m) {
                const int row = ai * 128 + wr * 64 + m * 16 + fr;
                const float rsv = rsL[row];
#pragma unroll
                for (int bj = 0; bj < 2; ++bj)
#pragma unroll
                  for (int n = 0; n < 2; ++n) {
                    const int col = bj * 128 + wc * 32 + n * 16 + fq * 4;
                    const f32x4v a4 = acc[ai][bj][m][n];
                    float o4[4];
                    if (k == 5) {
#pragma unroll
                      for (int j = 0; j < 4; ++j) { const float u = fmaxf(a4[j] * rsv, 0.f); o4[j] = u * u; }
                      u2 w; w.x = pack2(o4[0], o4[1]); w.y = pack2(o4[2], o4[3]);
                      *(u2*)(U + (size_t)(row0 + row) * 4096 + CB * 256 + col) = w;
                    } else if (!(st & 1)) {
                      u2 w; w.x = pack2(a4[0], a4[1]); w.y = pack2(a4[2], a4[3]);
                      *(u2*)(YS + (size_t)row * 256 + col) = w;
                    } else {
                      const f4 bs = *(const f4*)(p.in[5] + (size_t)l * 3072 + br * 1024 + CB * 256 + col);
                      const u2 yu = *(const u2*)(YS + (size_t)row * 256 + col);
                      bf16_t* mp_ = MERGED + (size_t)(row0 + row) * 1024 + CB * 256 + col;
                      u2 mu; mu.x = mu.y = 0u;
                      if (br > 0) mu = *(const u2*)mp_;
                      const float bsv[4] = {bs.x, bs.y, bs.z, bs.w};
                      const unsigned yw[2] = {yu.x, yu.y}, mw[2] = {mu.x, mu.y};
#pragma unroll
                      for (int j = 0; j < 4; ++j) {
                        const float g = 1.f / (1.f + __expf(-(a4[j] * rsv + bsv[j])));
                        const float y = __uint_as_float((j & 1) ? (yw[j >> 1] & 0xffff0000u) : (yw[j >> 1] << 16));
                        const float mv = __uint_as_float((j & 1) ? (mw[j >> 1] & 0xffff0000u) : (mw[j >> 1] << 16));
                        o4[j] = mv + g * y;
                      }
                      u2 w; w.x = pack2(o4[0], o4[1]); w.y = pack2(o4[2], o4[3]);
                      *(u2*)mp_ = w;
                    }
                  }
              }
          } else
#pragma unroll 1
          for (int half = 0; half < 2; ++half) {
            if (half) __syncthreads();
            {
              const int tq = ltid(); const int lane = tq & 63, wave = tq >> 6, wr = wave >> 2, wc = wave & 3, fr = lane & 15, fq = lane >> 4;
#pragma unroll
              for (int ai = 0; ai < 2; ++ai)
#pragma unroll
                for (int m = 0; m < 4; ++m)
#pragma unroll
                  for (int n = 0; n < 2; ++n) {
                    f32x4v v4;
#pragma unroll
                    for (int j = 0; j < 4; ++j) v4[j] = half ? acc[ai][1][m][n][j] : acc[ai][0][m][n][j];
                    *(f32x4v*)(Cs + (ai * 128 + wr * 64 + m * 16 + fr) * CS_LD + wc * 32 + n * 16 + fq * 4) = v4;
                  }
            }
            if (half == 0) fill_rs((float*)(smem + RS_OFF), ssq, nparts, pstride, row0, invK);
            __syncthreads();
            const int cb = CB * 2 + half;
            Tile t;
            t.row0 = row0; t.cb = cb; t.epi = EP_PLAIN;
            t.dst = nullptr; t.ldd = 0; t.gain = nullptr; t.ssq_out = nullptr; t.xsrc = nullptr; t.oscale = 1.f; t.ysrc = nullptr; t.accum = 0;
            if (k == 0) {
              if (list == 0) {
                if (cb < 8)       { t.epi = EP_HEADROT; t.cb = cb; t.dst = QD; t.ldd = 1024; t.gain = p.in[6] + l * 64; t.oscale = 0.125f * 1.4426950408889634f; }
                else if (cb < 16) { t.epi = EP_HEADROT; t.cb = cb - 8; t.dst = KD; t.ldd = 1024; t.gain = p.in[7] + l * 64; }
                else if (cb < 24) { t.epi = EP_VT; t.cb = cb - 16; const int b = row0 >> 11, s0 = row0 & 2047; t.dst = VDT + ((size_t)(b * 1024 + (cb - 16) * 128)) * SEQ + s0; t.ldd = SEQ; }
                else if (cb < 27) { t.epi = EP_PLAIN; t.cb = cb - 24; t.dst = CQ; t.ldd = 384; t.ssq_out = SSQCQ + (size_t)(cb - 24) * T; }
                else if (cb < 29) { t.epi = EP_PLAIN; t.cb = cb - 27; t.dst = CKV; t.ldd = 256; t.ssq_out = SSQCKV + (size_t)(cb - 27) * T; }
                else if (cb == 29) { t.epi = EP_KROPE; t.cb = 0; }
                else              { t.epi = EP_NORM128; t.cb = cb - 30; t.dst = XQ; t.ldd = 512; t.gain = p.in[20] + l * 128; t.oscale = 0.08838834764831845f * 1.4426950408889634f; }
              } else {
                if (cb < 4) { t.epi = EP_NORM128; t.cb = cb; t.dst = KC; t.ldd = 512; t.gain = p.in[21] + l * 128; }
                else        { t.epi = EP_VT; t.cb = cb - 4; t.dst = VCT + ((size_t)(rb * 512 + (cb - 4) * 128)) * MEML; t.ldd = MEML; }
              }
            } else if (k == 1) {
              if (list == 0) { t.epi = EP_QB; t.dst = QM; t.gain = p.in[15] + l * 96; t.oscale = 0.10206207261596575f * 1.4426950408889634f; }
              else           { t.epi = EP_KVB; t.dst = KM; t.gain = p.in[16] + l * 96; }
            } else if (k == 3) {
              const int st = it % 6, br = st >> 1;
              bf16_t* YS = VDT + (size_t)blockIdx.x * 65536;
              if (st & 1) { t.epi = EP_GATE; t.dst = MERGED; t.ysrc = YS + half * 128; t.gain = p.in[5] + (size_t)l * 3072 + br * 1024 + cb * 128; t.accum = (br > 0); }
              else        { t.epi = EP_YTMP; t.dst = YS; t.cb = half; }
            } else if (k == 4) { t.epi = EP_RES; t.dst = XB; t.xsrc = (l == 0) ? p.in[0] : p.out; t.ssq_out = SSQX + (size_t)cb * T; }
            else if (k == 5)   { t.epi = EP_MLP1; t.dst = U; t.ldd = 4096; }
            else               { t.epi = EP_RES; t.dst = XB; t.xsrc = p.out; t.ssq_out = SSQX + (size_t)cb * T; }
            run_epilogue(p, t, smem);
          }
        }
      } else
#endif
#ifndef NO_ATT
      if (k == 2) {
        float lam;
        const float lam_init = 0.8f - 0.6f * expf(-0.3f * (float)l);
        {
          const int lane = ltid() & 63;
          const float* lv = p.in[8] + l * 256;
          float sa = lv[lane] * lv[64 + lane], sb = lv[128 + lane] * lv[192 + lane];
#pragma unroll
          for (int m = 32; m >= 1; m >>= 1) { sa += __shfl_xor(sa, m); sb += __shfl_xor(sb, m); }
          lam = expf(sa) - expf(sb) + lam_init;
        }
        const float L2E = 1.4426950408889634f;
#pragma unroll 1
        for (int it = 0; it < ((G == 256) ? 16 : (4096 + G - 1) / G); ++it) {
          int w;
          if (G == 256) {
            const int xcd = bid & 7, slot = bid >> 3;
            if (it < 8)       w = ((it * 32 + (slot >> 3) * 8 + xcd) << 3) + (slot & 7);
            else if (it < 12) w = 2048 + ((((it - 8) * 64 + (slot >> 2) * 8 + xcd) << 2) + (slot & 3));
            else              w = 3072 + ((((it - 12) * 32 + (slot >> 3) * 8 + xcd) << 3) + (slot & 7));
          } else { w = it * G + bid; if (w >= 4096) continue; }
#ifndef NO_A1
          if (w < 2048) {
            const int bh = w >> 3, j = w & 7, b = bh >> 3, hh = bh & 7;
#pragma unroll 1
            for (int half = 0; half < 2; ++half) {
              const int qb = half ? j : 15 - j;
              const int q0 = qb * 128;
              bf16_t* Qp = QD + ((size_t)(b * SEQ + q0)) * 1024 + hh * 128;
              attn_block<64, 128, 2, true>(Qp, 1024, KD + (size_t)b * SEQ * 1024 + hh * 128, 1024, VDT + ((size_t)(b * 1024 + hh * 128)) * SEQ, SEQ,
                                            (q0 + 128) >> 6, q0, Qp, 1024, 0.125f * L2E, lam, p.in[9] + l * 128, 1.f - lam_init, smem);
            }
          } else
#endif
#ifndef NO_A2
          if (w < 3072) {
            const int wj = w - 2048; const int bh = wj >> 2, j = wj & 3, b = bh >> 3, hh = bh & 7;
#pragma unroll 1
            for (int half = 0; half < 2; ++half) {
              const int qb = half ? j : 7 - j;
              const int q0 = qb * 256;
              bf16_t* Qp = QM + ((size_t)(b * SEQ + q0)) * 768 + hh * 96;
              attn_block<96, 64, 1, true>(Qp, 768, KM + (size_t)b * SEQ * 768 + hh * 96, 768, VMT + ((size_t)(b * 512 + hh * 64)) * SEQ, SEQ,
                                           (q0 + 256) >> 6, q0, Qp, 768, 0.10206207261596575f * L2E, 0.f, nullptr, 1.f, smem);
            }
          } else
#endif
#ifndef NO_A3
          {
            const int wj = w - 3072; const int bh = wj >> 3, qb = wj & 7, b = bh >> 2, hh = bh & 3;
            const int q0 = qb * 256;
            bf16_t* Qp = XQ + ((size_t)(b * SEQ + q0)) * 512 + hh * 128;
            attn_block<128, 128, 1, false>(Qp, 512, KC + (size_t)b * MEML * 512 + hh * 128, 512, VCT + ((size_t)(b * 512 + hh * 128)) * MEML, MEML,
                                            4, q0, Qp, 512, 0.08838834764831845f * L2E, 0.f, nullptr, 1.f, smem);
          }
#endif
          {}
        }
      } else
#endif
#ifndef NO_D
      if (k == 3) {
        float* Cs = (float*)smem;
        float* rs = (float*)(smem + RS_OFF);
#pragma unroll 1
        for (int it = 0; it < ((G == 256) ? 8 : (2048 + G - 1) / G); ++it) {
          int rb, cb;
          if (G == 256) map_regular(it, bid, 8, rb, cb);
          else { const int li = it * G + bid; if (li >= 2048) continue; rb = li >> 3; cb = li & 7; }
          const int tidd = ltid(); const int lane = tidd & 63, wave = tidd >> 6, wm = wave >> 1, wn = wave & 1, h = lane >> 5;
          const int row0 = rb * 256, col0 = cb * 128;
          __syncthreads();
          fill_rs(rs, SSQX, 8, T, row0, 1.f / 1024);
          f32x16 acc[2][2];
          unsigned gp[2][2][8], mp[2][2][8];
#pragma unroll
          for (int mi = 0; mi < 2; ++mi)
#pragma unroll
            for (int ni = 0; ni < 2; ++ni)
#pragma unroll
              for (int i = 0; i < 8; ++i) mp[mi][ni][i] = 0u;
#pragma unroll 1
          for (int st = 0; st < 6; ++st) {
            const int br = st >> 1, half = st & 1;
            const bf16_t* Ab; const bf16_t* Bb; int Kb;
            if (half == 0)    { Ab = XB + (size_t)row0 * 1024; Bb = W + W_IN + (size_t)(WIN_GATE0 + br * 1024 + col0) * 1024; Kb = 1024; }
            else if (br == 0) { Ab = QD + (size_t)row0 * 1024; Bb = W + W_DO + (size_t)col0 * 1024; Kb = 1024; }
            else if (br == 1) { Ab = QM + (size_t)row0 * 768;  Bb = W + W_MO + (size_t)col0 * 768;  Kb = 768; }
            else              { Ab = XQ + (size_t)row0 * 512;  Bb = W + W_CO + (size_t)col0 * 512;  Kb = 512; }
            gemm_mainloop<2, 2, 2, false>(Ab, Kb, Bb, Kb, Kb, acc, smem);
            if (half == 0) {
              const float* bg = p.in[5] + (size_t)l * 3072 + br * 1024 + col0 + wn * 64 + (lane & 31);
              const float bgv0 = bg[0], bgv1 = bg[32];
#pragma unroll
              for (int mi = 0; mi < 2; ++mi) {
                float rsv[16];
#pragma unroll
                for (int i = 0; i < 16; ++i) rsv[i] = rs[wm * 64 + mi * 32 + crow(i, h)];
#pragma unroll
                for (int ni = 0; ni < 2; ++ni) {
                  const float bgv = ni ? bgv1 : bgv0;
#pragma unroll
                  for (int i = 0; i < 16; i += 2) {
                    const float z0 = acc[mi][ni][i] * rsv[i] + bgv;
                    const float z1 = acc[mi][ni][i + 1] * rsv[i + 1] + bgv;
                    gp[mi][ni][i >> 1] = pack2(1.f / (1.f + __expf(-z0)), 1.f / (1.f + __expf(-z1)));
                  }
                }
                __builtin_amdgcn_sched_barrier(0);
              }
            } else {
#pragma unroll
              for (int mi = 0; mi < 2; ++mi)
#pragma unroll
                for (int ni = 0; ni < 2; ++ni)
#pragma unroll
                  for (int i = 0; i < 16; i += 2) {
                    const unsigned g2 = gp[mi][ni][i >> 1], m2 = mp[mi][ni][i >> 1];
                    const float m0 = __uint_as_float(m2 << 16) + __uint_as_float(g2 << 16) * acc[mi][ni][i];
                    const float m1 = __uint_as_float(m2 & 0xffff0000u) + __uint_as_float(g2 & 0xffff0000u) * acc[mi][ni][i + 1];
                    mp[mi][ni][i >> 1] = pack2(m0, m1);
                  }
            }
          }
#pragma unroll
          for (int mi = 0; mi < 2; ++mi)
#pragma unroll
            for (int ni = 0; ni < 2; ++ni)
#pragma unroll
              for (int i = 0; i < 16; ++i) {
                const unsigned m2 = mp[mi][ni][i >> 1];
                Cs[(wm * 64 + mi * 32 + crow(i, h)) * CS_LD + wn * 64 + ni * 32 + (lane & 31)] = __uint_as_float((i & 1) ? (m2 & 0xffff0000u) : (m2 << 16));
              }
          __syncthreads();
          const int q = tidd & 15, rsub = tidd >> 4;
#pragma unroll 1
          for (int pass = 0; pass < 8; ++pass) {
            const int r = rsub + 32 * pass;
            float v[8];
            load8(Cs, r, q, v);
            *(u4*)(MERGED + (size_t)(row0 + r) * 1024 + col0 + q * 8) = pack8(v);
          }
        }
      }
#endif
      {}
    }
    if (ph + 1 < p.ph_hi) grid.sync();
  }
}

extern "C" void kernel_launch(void* const* d_in, const int* in_sizes, int n_in, void* d_out, int out_size, void* d_ws, size_t ws_size, hipStream_t stream) {
  static int grid_blocks = 0;
  if (grid_blocks == 0) {
    if (n_in != 27 || ws_size < WS_NEED) { fprintf(stderr, "kernel_launch: unexpected inputs (n_in %d) or workspace (%zu < %zu)\n", n_in, ws_size, (size_t)WS_NEED); grid_blocks = -1; return; }
    int dev = 0, cus = 0, per_cu = 0;
    hipGetDevice(&dev);
    hipDeviceGetAttribute(&cus, hipDeviceAttributeMultiprocessorCount, dev);
    hipOccupancyMaxActiveBlocksPerMultiprocessor(&per_cu, mega_fwd, NTHR, 0);
    if (per_cu < 1) per_cu = 1;
    if (per_cu > 1) per_cu = 1;
    grid_blocks = cus * per_cu;
  }
  if (grid_blocks < 0) return;
  Params p{};
  for (int i = 0; i < 27; ++i) p.in[i] = (const float*)d_in[i];
  p.out = (float*)d_out;
  p.ws = (char*)d_ws;
  p.ph_lo = 0;
  p.dupk = (DUP_K >= 0) ? DUP_K : 100;
  p.per = (DUP_K >= 0) ? 8 : 7;
  p.ph_hi = 1 + NL * p.per;
  void* args[] = {&p};
  hipError_t e = hipLaunchCooperativeKernel((void*)mega_fwd, dim3(grid_blocks), dim3(NTHR), args, 0, stream);
  if (e != hipSuccess) fprintf(stderr, "cooperative launch failed: %s (grid %d)\n", hipGetErrorString(e), grid_blocks);
}
```

```cpp
#include <hip/hip_runtime.h>
#include <hip/hip_cooperative_groups.h>
#include <stdint.h>
#include <stdio.h>
#define NO_D 1
namespace cg = cooperative_groups;

typedef unsigned short bf16_t;
using bf16x8 = __attribute__((ext_vector_type(8))) short;
using f32x16 = __attribute__((ext_vector_type(16))) float;
typedef unsigned u4 __attribute__((ext_vector_type(4)));
typedef unsigned u2 __attribute__((ext_vector_type(2)));
typedef float f4 __attribute__((ext_vector_type(4)));
#define DI __device__ __forceinline__
#define MFMA(a, b, c) __builtin_amdgcn_mfma_f32_32x32x16_bf16((a), (b), (c), 0, 0, 0)

constexpr int T = 65536, DM = 1024, NB = 32, SEQ = 2048, NL = 4, MEML = 256, MEMR = NB * MEML;
constexpr int NTHR = 512;
constexpr int DUP_K = -1;
constexpr float EPSV = 1e-6f;
constexpr int WIN_N = 7424;
constexpr int WIN_GATE0 = 4352;

constexpr size_t MiB = 1024ull * 1024ull;
constexpr size_t OFF_XB = 0;
constexpr size_t OFF_QD = OFF_XB + 128 * MiB;
constexpr size_t OFF_KD = OFF_QD + 128 * MiB;
constexpr size_t OFF_VDT = OFF_KD + 128 * MiB;
constexpr size_t OFF_CQ = OFF_VDT + 128 * MiB;
constexpr size_t OFF_CKV = OFF_CQ + 48 * MiB;
constexpr size_t OFF_KR = OFF_CKV + 32 * MiB;
constexpr size_t OFF_XQ = OFF_KR + 8 * MiB;
constexpr size_t OFF_QM = OFF_XQ + 64 * MiB;
constexpr size_t OFF_KM = OFF_QM + 96 * MiB;
constexpr size_t OFF_VMT = OFF_KM + 96 * MiB;
constexpr size_t OFF_MEMB = OFF_VMT + 64 * MiB;
constexpr size_t OFF_KC = OFF_MEMB + 16 * MiB;
constexpr size_t OFF_VCT = OFF_KC + 8 * MiB;
constexpr size_t OFF_SSQX = OFF_VCT + 8 * MiB;
constexpr size_t OFF_SSQCQ = OFF_SSQX + 2 * MiB;
constexpr size_t OFF_SSQCKV = OFF_SSQCQ + 1 * MiB;
constexpr size_t OFF_SSQMEM = OFF_SSQCKV + 1 * MiB;
constexpr size_t OFF_W = OFF_SSQMEM + 1 * MiB;
constexpr size_t OFF_U = OFF_QD;
constexpr size_t W_IN = 0;
constexpr size_t W_MEM = W_IN + (size_t)WIN_N * 1024;
constexpr size_t W_QB = W_MEM + 1024 * 1024;
constexpr size_t W_KVB = W_QB + 1024 * 384;
constexpr size_t W_DO = W_KVB + 1024 * 256;
constexpr size_t W_MO = W_DO + 1024 * 1024;
constexpr size_t W_CO = W_MO + 1024 * 768;
constexpr size_t W_OUT = W_CO + 1024 * 512;
constexpr size_t W_1 = W_OUT + 1024 * 1024;
constexpr size_t W_2 = W_1 + 4096 * 1024;
constexpr size_t W_END = W_2 + 4096 * 1024;
constexpr size_t WS_NEED = OFF_W + W_END * 2;

constexpr int LDS_ROW = 144;
constexpr int CS_LD = 132;
constexpr int CS_BYTES = 256 * CS_LD * 4;
constexpr int RS_OFF = 2 * 512 * LDS_ROW;
constexpr int LDS_BYTES = RS_OFF + 1024;

__constant__ float INVF64[32] = {1.000000000e+00f,7.498942614e-01f,5.623413324e-01f,4.216965139e-01f,3.162277639e-01f,2.371373773e-01f,1.778279394e-01f,1.333521307e-01f,1.000000015e-01f,7.498941571e-02f,5.623413250e-02f,4.216965288e-02f,3.162277490e-02f,2.371373773e-02f,1.778279431e-02f,1.333521493e-02f,9.999999776e-03f,7.498941850e-03f,5.623413250e-03f,4.216964822e-03f,3.162277630e-03f,2.371373586e-03f,1.778279431e-03f,1.333521446e-03f,1.000000047e-03f,7.498942432e-04f,5.623413017e-04f,4.216965172e-04f,3.162277571e-04f,2.371373703e-04f,1.778279402e-04f,1.333521504e-04f};
__constant__ float INVF32[16] = {1.000000000e+00f,5.623413324e-01f,3.162277639e-01f,1.778279394e-01f,1.000000015e-01f,5.623413250e-02f,3.162277490e-02f,1.778279431e-02f,9.999999776e-03f,5.623413250e-03f,3.162277630e-03f,1.778279431e-03f,1.000000047e-03f,5.623413017e-04f,3.162277571e-04f,1.778279402e-04f};

struct Params {
  const float* in[27];
  float* out;
  char* ws;
  int ph_lo, ph_hi;
  int dupk, per;
};

typedef __bf16 bf2_t __attribute__((ext_vector_type(2)));
typedef float fl2_t __attribute__((ext_vector_type(2)));
DI unsigned pack2(float a, float b) { fl2_t f = {a, b}; bf2_t r = __builtin_convertvector(f, bf2_t); return __builtin_bit_cast(unsigned, r); }
DI u4 pack8(const float* v) { u4 u; u.x = pack2(v[0], v[1]); u.y = pack2(v[2], v[3]); u.z = pack2(v[4], v[5]); u.w = pack2(v[6], v[7]); return u; }
DI int ltid() { int t = threadIdx.x; asm volatile("" : "+v"(t)); return t; }
DI int crow(int i, int h) { return (i & 3) + 8 * (i >> 2) + 4 * h; }
DI void rot_cs(int pos, float invf, float& c, float& s) {
  const float ang = (float)pos * invf;
  double rev = (double)ang * 0.15915494309189535;
  rev -= floor(rev);
  const float rf = (float)rev;
  c = __builtin_amdgcn_cosf(rf);
  s = __builtin_amdgcn_sinf(rf);
}
DI void load8(const float* Cs, int r, int q, float* v) {
  const f4 a = *(const f4*)(Cs + r * CS_LD + q * 8);
  const f4 b = *(const f4*)(Cs + r * CS_LD + q * 8 + 4);
  v[0] = a.x; v[1] = a.y; v[2] = a.z; v[3] = a.w; v[4] = b.x; v[5] = b.y; v[6] = b.z; v[7] = b.w;
}

template <int MI, int NI, int WGN, bool FDB>
DI void gemm_mainloop(const bf16_t* __restrict__ A, int lda, const bf16_t* __restrict__ B, int ldb, int K, f32x16 (&acc)[MI][NI], char* smem) {
  constexpr int BM = (8 / WGN) * MI * 32, BN = WGN * NI * 32;
  constexpr int ASZ = BM * 64, STAGE = (BM + BN) * 64;
  constexpr int NGA = BM / 128, NGB = BN / 128, NLD = NGA + NGB;
  static_assert(4 * STAGE <= RS_OFF, "ring");
  const int tid = ltid(), lane = tid & 63, wave = tid >> 6, l31 = lane & 31, h = lane >> 5;
  const int wu = __builtin_amdgcn_readfirstlane(wave);
  const int wm = wave / WGN, wn = wave % WGN;
  const int lrow = lane >> 2, lchk = (lane & 3) ^ ((lane >> 4) & 3);
  const bf16_t* ga = A + (size_t)(wu * NGA * 16 + lrow) * lda + lchk * 8;
  const bf16_t* gb = B + (size_t)(wu * NGB * 16 + lrow) * ldb + lchk * 8;
#pragma unroll
  for (int mi = 0; mi < MI; ++mi)
#pragma unroll
    for (int ni = 0; ni < NI; ++ni)
#pragma unroll
      for (int i = 0; i < 16; ++i) acc[mi][ni][i] = 0.f;
  auto issue = [&](int j) {
    char* st = smem + (j & 3) * STAGE;
    const int k0 = j * 32;
#pragma unroll
    for (int i = 0; i < NGA; ++i)
      __builtin_amdgcn_global_load_lds((const unsigned*)(ga + (size_t)(i * 16) * lda + k0), (unsigned*)(st + (wu * NGA + i) * 1024), 16, 0, 0);
#pragma unroll
    for (int i = 0; i < NGB; ++i)
      __builtin_amdgcn_global_load_lds((const unsigned*)(gb + (size_t)(i * 16) * ldb + k0), (unsigned*)(st + ASZ + (wu * NGB + i) * 1024), 16, 0, 0);
  };
  asm volatile("s_waitcnt vmcnt(0)" ::: "memory");
  __syncthreads();
  const int nk = K >> 5;
  issue(0); issue(1); issue(2);
  const int sw = (l31 >> 2) & 3;
  const int oa = (wm * MI * 32 + l31) * 64, ob = ASZ + (wn * NI * 32 + l31) * 64;
  const int c0 = ((0 + h) ^ sw) * 16, c1 = ((2 + h) ^ sw) * 16;
#pragma unroll 1
  for (int j = 0; j < nk; ++j) {
    if (j + 2 < nk) asm volatile("s_waitcnt vmcnt(%0)" ::"n"(2 * NLD) : "memory");
    else if (j + 1 < nk) asm volatile("s_waitcnt vmcnt(%0)" ::"n"(NLD) : "memory");
    else asm volatile("s_waitcnt vmcnt(0)" ::: "memory");
    asm volatile("s_waitcnt lgkmcnt(0)" ::: "memory");
    __builtin_amdgcn_s_barrier();
    if (j + 3 < nk) issue(j + 3);
    const char* st = smem + (j & 3) * STAGE;
    const char* pa = st + oa;
    const char* pb = st + ob;
    bf16x8 fa0[MI], fb0[NI], fa1[MI], fb1[NI];
#pragma unroll
    for (int mi = 0; mi < MI; ++mi) fa0[mi] = *(const bf16x8*)(pa + mi * 2048 + c0);
#pragma unroll
    for (int ni = 0; ni < NI; ++ni) fb0[ni] = *(const bf16x8*)(pb + ni * 2048 + c0);
    if (FDB) {
#pragma unroll
      for (int mi = 0; mi < MI; ++mi) fa1[mi] = *(const bf16x8*)(pa + mi * 2048 + c1);
#pragma unroll
      for (int ni = 0; ni < NI; ++ni) fb1[ni] = *(const bf16x8*)(pb + ni * 2048 + c1);
    }
#pragma unroll
    for (int mi = 0; mi < MI; ++mi)
#pragma unroll
      for (int ni = 0; ni < NI; ++ni) acc[mi][ni] = MFMA(fa0[mi], fb0[ni], acc[mi][ni]);
    __builtin_amdgcn_sched_barrier(0);
    if (!FDB) {
#pragma unroll
      for (int mi = 0; mi < MI; ++mi) fa1[mi] = *(const bf16x8*)(pa + mi * 2048 + c1);
#pragma unroll
      for (int ni = 0; ni < NI; ++ni) fb1[ni] = *(const bf16x8*)(pb + ni * 2048 + c1);
    }
#pragma unroll
    for (int mi = 0; mi < MI; ++mi)
#pragma unroll
      for (int ni = 0; ni < NI; ++ni) acc[mi][ni] = MFMA(fa1[mi], fb1[ni], acc[mi][ni]);
    __builtin_amdgcn_sched_barrier(0);
  }
  asm volatile("s_waitcnt lgkmcnt(0)" ::: "memory");
  __builtin_amdgcn_s_barrier();
}

using f32x4v = __attribute__((ext_vector_type(4))) float;
DI int lds_byte8(int r, int c) {
  const int st = (r >> 4) * 2 + (c >> 5), rr = r & 15, cc = c & 31, ob = rr * 64 + cc * 2;
  return st * 1024 + (ob ^ (((ob >> 9) & 1) << 5));
}
DI void stage_rc8(int b, int& R, int& C) {
  const int st = b / 1024, sb = b % 1024, swz = sb ^ (((sb >> 9) & 1) << 5);
  R = (st >> 1) * 16 + swz / 64; C = (st & 1) * 32 + (swz % 64) / 2;
}
DI void gemm8p(const bf16_t* __restrict__ A, const bf16_t* __restrict__ Bt, int K, f32x4v (&acc)[2][2][4][2], char* smem) {
  constexpr int BK8 = 64, HALF8 = 128, HTB = HALF8 * BK8 * 2;
  const int tid = ltid(), wid = tid >> 6, lane = tid & 63, wr = wid >> 2, wc = wid & 3, fr = lane & 15, fq = lane >> 4;
  const int wu8 = __builtin_amdgcn_readfirstlane(wid);
  unsigned goff[2];
#pragma unroll
  for (int i_ = 0; i_ < 2; ++i_) { int r_, c_; stage_rc8(tid * 16 + i_ * 8192, r_, c_); goff[i_] = (unsigned)(r_ * K + c_); }
  const int lfrag = ((fr * 64 + fq * 16) ^ ((fr >> 3) << 5));
  const char* la = smem + wr * 8192 + lfrag;
  const char* lb = smem + 4 * HTB + wc * 4096 + lfrag;
#define SA8(b, h) ((b) * 2 + (h))
#define SB8(b, h) (4 + (b) * 2 + (h))
#define STAGE8(Q, BASE, br, kt) do { const bf16_t* sb_ = (BASE) + ((long)(br) * K + (long)(kt) * BK8); \
    _Pragma("unroll") for (int i_ = 0; i_ < 2; ++i_) \
      __builtin_amdgcn_global_load_lds((const unsigned*)(sb_ + goff[i_]), (unsigned*)(smem + (Q) * HTB + i_ * 8192 + wu8 * 1024), 16, 0, 0); } while (0)
#define LDA8(dst, b, h) _Pragma("unroll") for (int m = 0; m < 4; ++m) _Pragma("unroll") for (int k = 0; k < 2; ++k) \
    dst[m][k] = *(const bf16x8*)(la + ((b) * 2 + (h)) * HTB + (m * 2 + k) * 1024)
#define LDB8(dst, b, h) _Pragma("unroll") for (int n = 0; n < 2; ++n) _Pragma("unroll") for (int k = 0; k < 2; ++k) \
    dst[n][k] = *(const bf16x8*)(lb + ((b) * 2 + (h)) * HTB + (n * 2 + k) * 1024)
#define MMA8(ai, bj, At_, Bt_) do { __builtin_amdgcn_s_setprio(1); \
    _Pragma("unroll") for (int m = 0; m < 4; ++m) _Pragma("unroll") for (int n = 0; n < 2; ++n) _Pragma("unroll") for (int k = 0; k < 2; ++k) \
      acc[ai][bj][m][n] = __builtin_amdgcn_mfma_f32_16x16x32_bf16(Bt_[n][k], At_[m][k], acc[ai][bj][m][n], 0, 0, 0); \
    __builtin_amdgcn_s_setprio(0); } while (0)
#define WAIT_V8(n) asm volatile("s_waitcnt vmcnt(" #n ")" ::: "memory")
#define WAIT_L8(n) asm volatile("s_waitcnt lgkmcnt(" #n ")" ::: "memory")
#define BAR8 __builtin_amdgcn_s_barrier()
#define SCHED8 __builtin_amdgcn_sched_barrier(0)
#pragma unroll
  for (int a = 0; a < 2; ++a)
#pragma unroll
    for (int b = 0; b < 2; ++b)
#pragma unroll
      for (int m = 0; m < 4; ++m)
#pragma unroll
        for (int n = 0; n < 2; ++n) acc[a][b][m][n] = f32x4v{0.f, 0.f, 0.f, 0.f};
  bf16x8 At[4][2], B0[2][2], B1[2][2];
  const int nt = K / BK8;
  asm volatile("s_waitcnt vmcnt(0)" ::: "memory");
  __syncthreads();
  STAGE8(SB8(0, 0), Bt, 0, 0); STAGE8(SA8(0, 0), A, 0, 0);
  STAGE8(SB8(0, 1), Bt, HALF8, 0); STAGE8(SA8(0, 1), A, HALF8, 0);
  if (wr == 1) BAR8;
  WAIT_V8(4); BAR8;
  STAGE8(SB8(1, 0), Bt, 0, 1); STAGE8(SA8(1, 0), A, 0, 1); STAGE8(SB8(1, 1), Bt, HALF8, 1);
  WAIT_V8(6); BAR8;
#pragma unroll 1
  for (int t = 0; t < nt - 2; t += 2) {
    LDB8(B0, 0, 0); SCHED8; LDA8(At, 0, 0); STAGE8(SA8(1, 1), A, HALF8, t + 1);
    WAIT_L8(8); BAR8; WAIT_L8(0); MMA8(0, 0, At, B0); BAR8; SCHED8;
    LDB8(B1, 0, 1); STAGE8(SB8(0, 0), Bt, 0, t + 2);
    BAR8; WAIT_L8(0); MMA8(0, 1, At, B1); BAR8;
    LDA8(At, 0, 1); STAGE8(SA8(0, 0), A, 0, t + 2);
    BAR8; WAIT_L8(0); MMA8(1, 0, At, B0); BAR8; SCHED8;
    STAGE8(SB8(0, 1), Bt, HALF8, t + 2);
    WAIT_V8(6); BAR8; MMA8(1, 1, At, B1); BAR8;
    LDB8(B0, 1, 0); SCHED8; LDA8(At, 1, 0); STAGE8(SA8(0, 1), A, HALF8, t + 2);
    WAIT_L8(8); BAR8; WAIT_L8(0); MMA8(0, 0, At, B0); BAR8; SCHED8;
    LDB8(B1, 1, 1); STAGE8(SB8(1, 0), Bt, 0, t + 3);
    BAR8; WAIT_L8(0); MMA8(0, 1, At, B1); BAR8;
    LDA8(At, 1, 1); STAGE8(SA8(1, 0), A, 0, t + 3);
    BAR8; WAIT_L8(0); MMA8(1, 0, At, B0); BAR8; SCHED8;
    STAGE8(SB8(1, 1), Bt, HALF8, t + 3);
    WAIT_V8(6); BAR8; MMA8(1, 1, At, B1); BAR8;
  }
  { LDB8(B0, 0, 0); LDA8(At, 0, 0); STAGE8(SA8(1, 1), A, HALF8, nt - 1);
    BAR8; WAIT_L8(0); MMA8(0, 0, At, B0); BAR8;
    LDB8(B1, 0, 1); BAR8; WAIT_L8(0); MMA8(0, 1, At, B1); BAR8;
    LDA8(At, 0, 1); WAIT_V8(4); BAR8; WAIT_L8(0); MMA8(1, 0, At, B0); MMA8(1, 1, At, B1); BAR8; }
  { LDB8(B0, 1, 0); LDA8(At, 1, 0); WAIT_V8(2); BAR8; WAIT_L8(0); MMA8(0, 0, At, B0); BAR8;
    LDB8(B1, 1, 1); WAIT_V8(0); BAR8; WAIT_L8(0); MMA8(0, 1, At, B1); BAR8;
    LDA8(At, 1, 1); BAR8; WAIT_L8(0); MMA8(1, 0, At, B0); MMA8(1, 1, At, B1); BAR8; }
  if (wr == 0) BAR8;
  asm volatile("s_waitcnt lgkmcnt(0)" ::: "memory");
  BAR8;
#undef SA8
#undef SB8
#undef STAGE8
#undef LDA8
#undef LDB8
#undef MMA8
#undef WAIT_V8
#undef WAIT_L8
#undef BAR8
#undef SCHED8
}

DI void fill_rs(float* rs, const float* ssq, int nparts, int pstride, int row0, float invK) {
  const int t = ltid();
  if (t < 256) {
    float r = 1.f;
    if (ssq) {
      float s = 0.f;
      if (pstride == 1) {
        const f4 a = *(const f4*)(ssq + (size_t)(row0 + t) * 8), b = *(const f4*)(ssq + (size_t)(row0 + t) * 8 + 4);
        s = (a.x + a.y) + (a.z + a.w) + (b.x + b.y) + (b.z + b.w);
      } else {
        for (int p = 0; p < nparts; ++p) s += ssq[(size_t)p * pstride + row0 + t];
      }
      r = rsqrtf(s * invK + EPSV);
    }
    rs[t] = r;
  }
}

enum { EP_HEADROT = 0, EP_VT, EP_PLAIN, EP_KROPE, EP_NORM128, EP_QB, EP_KVB, EP_RES, EP_MLP1, EP_YTMP, EP_GATE };

struct Tile {
  int epi, row0, cb;
  bf16_t* dst; int ldd;
  const float* gain;
  float* ssq_out;
  const float* xsrc;
  float oscale;
  const bf16_t* ysrc;
  int accum;
};

DI void map_regular(int it, int bid, int NCB, int& rb, int& CB) {
  const int xcd = bid & 7, slot = bid >> 3;
  const int c = xcd * NCB + it;
  const int cgrp = c >> 5, rgrp = c & 31;
  rb = rgrp * 8 + (slot >> 2);
  CB = cgrp * 4 + (slot & 3);
}

template <int DK, int DV, int NM, bool CAUSAL>
DI void attn_block(const bf16_t* __restrict__ Q, int ldq, const bf16_t* __restrict__ Kg, int ldk, const bf16_t* __restrict__ Vt, int ldv,
                   int nkt, int q0, bf16_t* O, int ldo, float sc, float lam, const float* og, float omul, char* smem) {
  constexpr int KW = NM * DK, KCHV = KW / 8;
  constexpr int KBYTES = 64 * 256, VBYTES = DV * 128, STAGE = KBYTES + VBYTES;
  constexpr int NVI = DV / 64;
  constexpr int NLD = 2 + NVI;
  static_assert(KCHV <= 16 && 4 * STAGE <= RS_OFF, "lds");
  constexpr int NKC16 = DK / 16, NDVB = DV / 32;
  const int tid = ltid(), lane = tid & 63, wave = tid >> 6, h = lane >> 5, l31 = lane & 31;
  const int wq = (NM == 2) ? (wave & 3) : wave;
  const int mymap = (NM == 2) ? (wave >> 2) : 0;
  const int q0w = q0 + wq * 32;

  bf16x8 qf[NKC16];
  {
    const bf16_t* qp = Q + (size_t)(wq * 32 + l31) * ldq + mymap * DK + h * 8;
#pragma unroll
    for (int kc = 0; kc < NKC16; ++kc) qf[kc] = *(const bf16x8*)(qp + kc * 16);
#pragma unroll
    for (int kc = 0; kc < NKC16; ++kc) asm volatile("" : "+v"(qf[kc]));
  }
  f32x16 o[NDVB];
#pragma unroll
  for (int d = 0; d < NDVB; ++d)
#pragma unroll
    for (int i = 0; i < 16; ++i) o[d][i] = 0.f;
  f32x16 lacc;
#pragma unroll
  for (int i = 0; i < 16; ++i) lacc[i] = 0.f;
  u4 onesu; onesu.x = onesu.y = onesu.z = onesu.w = 0x3F803F80u;
  const bf16x8 ones = __builtin_bit_cast(bf16x8, onesu);

  const int wu = __builtin_amdgcn_readfirstlane(wave);
  const int krow = lane >> 4, kslot = lane & 15;
  const int vrow = lane >> 3, vslot = lane & 7;
  auto issue = [&](int kt) {
    char* st = smem + (kt & 3) * STAGE;
#pragma unroll
    for (int i = 0; i < 2; ++i) {
      const int r = (wu * 2 + i) * 4 + krow;
      const int c = kslot ^ (r & 15);
      if (KCHV == 16 || c < KCHV)
        __builtin_amdgcn_global_load_lds((const unsigned*)(Kg + (size_t)(kt * 64 + r) * ldk + c * 8), (unsigned*)(st + (wu * 2 + i) * 1024), 16, 0, 0);
    }
#pragma unroll
    for (int i = 0; i < NVI; ++i) {
      const int d = (wu * NVI + i) * 8 + vrow;
      const int c = vslot ^ ((d >> 1) & 7);
      __builtin_amdgcn_global_load_lds((const unsigned*)(Vt + (size_t)d * ldv + kt * 64 + c * 8), (unsigned*)(st + KBYTES + (wu * NVI + i) * 1024), 16, 0, 0);
    }
  };
  asm volatile("s_waitcnt vmcnt(0)" ::: "memory");
  __syncthreads();
  if (0 < nkt) issue(0);
  if (1 < nkt) issue(1);
  if (2 < nkt) issue(2);
  for (int kt = 0; kt < nkt; ++kt) {
    if (kt + 2 < nkt) asm volatile("s_waitcnt vmcnt(%0)" ::"n"(2 * NLD) : "memory");
    else if (kt + 1 < nkt) asm volatile("s_waitcnt vmcnt(%0)" ::"n"(NLD) : "memory");
    else asm volatile("s_waitcnt vmcnt(0)" ::: "memory");
    asm volatile("s_waitcnt lgkmcnt(0)" ::: "memory");
    __builtin_amdgcn_s_barrier();
    if (kt + 3 < nkt) issue(kt + 3);
    const bool skip = CAUSAL && (kt * 64 > q0w + 31);
    if (!skip) {
      const char* base = smem + (kt & 3) * STAGE;
      f32x16 s[2];
#pragma unroll
      for (int sb = 0; sb < 2; ++sb) {
#pragma unroll
        for (int i = 0; i < 16; ++i) s[sb][i] = 0.f;
        const char* pk = base + (sb * 32 + l31) * 256;
#pragma unroll
        for (int kc = 0; kc < NKC16; ++kc) {
          const bf16x8 a = *(const bf16x8*)(pk + (((mymap * (DK / 8) + kc * 2 + h) ^ (l31 & 15)) * 16));
          s[sb] = MFMA(a, qf[kc], s[sb]);
        }
        __builtin_amdgcn_sched_barrier(0);
      }
      const bool need_mask = CAUSAL && (kt * 64 + 63 > q0w);
      const char* pv = base + KBYTES + l31 * 128;
      const int vsw = (l31 >> 1) & 7;
      bf16x8 pf[4];
      auto expo = [&](int sb) {
#pragma unroll
        for (int i = 0; i < 16; ++i) {
          float pz = __builtin_amdgcn_exp2f(s[sb][i]);
          if (need_mask) {
            const int key = kt * 64 + sb * 32 + crow(i, h);
            if (key > q0w + l31) pz = 0.f;
          }
          s[sb][i] = pz;
        }
#pragma unroll
        for (int k2 = 0; k2 < 2; ++k2) {
          u4 pu;
          pu.x = pack2(s[sb][k2 * 8 + 0], s[sb][k2 * 8 + 1]);
          pu.y = pack2(s[sb][k2 * 8 + 2], s[sb][k2 * 8 + 3]);
          pu.z = pack2(s[sb][k2 * 8 + 4], s[sb][k2 * 8 + 5]);
          pu.w = pack2(s[sb][k2 * 8 + 6], s[sb][k2 * 8 + 7]);
          pf[sb * 2 + k2] = __builtin_bit_cast(bf16x8, pu);
        }
      };
      auto pvmm = [&](int ks) {
        lacc = MFMA(ones, pf[ks], lacc);
#pragma unroll
        for (int d = 0; d < NDVB; ++d) {
          const u4 au = *(const u4*)(pv + d * 32 * 128 + (((ks * 2 + h) ^ vsw) * 16));
          o[d] = MFMA(__builtin_bit_cast(bf16x8, au), pf[ks], o[d]);
        }
      };
      expo(0);
      pvmm(0); pvmm(1);
      expo(1);
      pvmm(2); pvmm(3);
      __builtin_amdgcn_sched_barrier(0);
    }
  }
  asm volatile("s_waitcnt lgkmcnt(0)" ::: "memory");
  __builtin_amdgcn_s_barrier();
  const float l_tot = lacc[0];
  const float inv = 1.f / l_tot;
#pragma unroll
  for (int d = 0; d < NDVB; ++d)
#pragma unroll
    for (int i = 0; i < 16; ++i) o[d][i] *= inv;

  float rn_out = 1.f;
  if (NM == 2) {
    float* buf = (float*)smem;
    if (wave >= 4) {
#pragma unroll
      for (int d = 0; d < NDVB; ++d)
#pragma unroll
        for (int i = 0; i < 16; ++i) buf[(d * 16 + i) * 256 + (wave & 3) * 64 + lane] = o[d][i];
    }
    __syncthreads();
    if (wave < 4) {
      float ss = 0.f;
#pragma unroll
      for (int d = 0; d < NDVB; ++d) {
#pragma unroll
        for (int i = 0; i < 16; ++i) {
          const float v = o[d][i] - lam * buf[(d * 16 + i) * 256 + wave * 64 + lane];
          o[d][i] = v;
          ss += v * v;
        }
        __builtin_amdgcn_sched_barrier(0);
      }
      ss += __shfl_xor(ss, 32);
      rn_out = rsqrtf(ss * (1.f / DV) + EPSV) * omul;
    }
  }
  if (NM == 1 || wave < 4) {
    bf16_t* op = O + (size_t)(wq * 32 + l31) * ldo + 4 * h;
#pragma unroll
    for (int d = 0; d < NDVB; ++d)
#pragma unroll
      for (int g = 0; g < 4; ++g) {
        f4 gg = {1.f, 1.f, 1.f, 1.f};
        if (NM == 2) gg = *(const f4*)(og + d * 32 + 8 * g + 4 * h);
        u2 u;
        u.x = pack2(o[d][4 * g + 0] * rn_out * gg.x, o[d][4 * g + 1] * rn_out * gg.y);
        u.y = pack2(o[d][4 * g + 2] * rn_out * gg.z, o[d][4 * g + 3] * rn_out * gg.w);
        *(u2*)(op + d * 32 + 8 * g) = u;
      }
  }
}

DI void prep_tile(const float* __restrict__ src, int N, const float* __restrict__ gain, bf16_t* __restrict__ dst, int Kp, int nmode, int kmode, int kt, int nt, char* smem) {
  float* tile = (float*)smem;
  const int tid = ltid();
  __syncthreads();
  {
    const int n = tid & 63;
    const int np = nt * 64 + n;
    int ns = np; bool nv = true;
    if (nmode == 1) {
      if (np < 3712) ns = np;
      else if (np < 3840) { ns = np; nv = (np < 3744); }
      else if (np < 4352) ns = np - 96;
      else ns = np - 96;
    } else if (nmode == 2) {
      const int hh = np >> 7, j = np & 127;
      nv = j < 96; ns = hh * 96 + j;
    }
#pragma unroll
    for (int j = 0; j < 8; ++j) {
      const int kk = (tid >> 6) + 8 * j;
      const int kp = kt * 64 + kk;
      int ks = kp; bool kv = true;
      if (kmode == 1) { const int hh = kp / 96, jj = kp % 96; kv = jj < 64; ks = hh * 64 + jj; }
      float v = 0.f;
      if (nv && kv) { v = src[(size_t)ks * N + ns]; if (gain) v *= gain[ks]; }
      tile[n * 65 + kk] = v;
    }
  }
  __syncthreads();
  {
    const int n = tid >> 3, kc = tid & 7;
    float v[8];
#pragma unroll
    for (int e = 0; e < 8; ++e) v[e] = tile[n * 65 + kc * 8 + e];
    *(u4*)(dst + (size_t)(nt * 64 + n) * Kp + kt * 64 + kc * 8) = pack8(v);
  }
}

DI void prep_item(const Params& p, int l, int it, char* smem) {
  bf16_t* W = (bf16_t*)(p.ws + OFF_W);
  const float* src; const float* gain = nullptr; bf16_t* dst; int N, Kp, nmode = 0, kmode = 0, nkt, loc;
  if (it < 1856)      { loc = it;        src = p.in[4] + (size_t)l * 1024 * 7328; N = 7328; gain = p.in[3] + l * 1024; dst = W + W_IN; Kp = 1024; nmode = 1; nkt = 16; }
  else if (it < 2112) { loc = it - 1856; src = p.in[19] + (size_t)l * 1024 * 1024; N = 1024; gain = p.in[18] + l * 1024; dst = W + W_MEM; Kp = 1024; nkt = 16; }
  else if (it < 2208) { loc = it - 2112; src = p.in[12] + (size_t)l * 384 * 768; N = 768; gain = p.in[11] + l * 384; dst = W + W_QB; Kp = 384; nmode = 2; nkt = 6; }
  else if (it < 2272) { loc = it - 2208; src = p.in[14] + (size_t)l * 256 * 1024; N = 1024; gain = p.in[13] + l * 256; dst = W + W_KVB; Kp = 256; nkt = 4; }
  else if (it < 2528) { loc = it - 2272; src = p.in[10] + (size_t)l * 1024 * 1024; N = 1024; dst = W + W_DO; Kp = 1024; nkt = 16; }
  else if (it < 2720) { loc = it - 2528; src = p.in[17] + (size_t)l * 512 * 1024; N = 1024; dst = W + W_MO; Kp = 768; kmode = 1; nkt = 12; }
  else if (it < 2848) { loc = it - 2720; src = p.in[22] + (size_t)l * 512 * 1024; N = 1024; dst = W + W_CO; Kp = 512; nkt = 8; }
  else if (it < 3104) { loc = it - 2848; src = p.in[23] + (size_t)l * 1024 * 1024; N = 1024; dst = W + W_OUT; Kp = 1024; nkt = 16; }
  else if (it < 4128) { loc = it - 3104; src = p.in[25] + (size_t)l * 1024 * 4096; N = 4096; gain = p.in[24] + l * 1024; dst = W + W_1; Kp = 1024; nkt = 16; }
  else                { loc = it - 4128; src = p.in[26] + (size_t)l * 4096 * 1024; N = 1024; dst = W + W_2; Kp = 4096; nkt = 64; }
  prep_tile(src, N, gain, dst, Kp, nmode, kmode, loc % nkt, loc / nkt, smem);
}
DI void prep_range(const Params& p, int l, int lo, int hi, char* smem) {
  for (int it = lo + blockIdx.x; it < hi; it += gridDim.x) prep_item(p, l, it, smem);
}

DI void phase_init(const Params& p) {
  const int tid_ = ltid(); const int lane = tid_ & 63, gw = blockIdx.x * 8 + (tid_ >> 6), GW = gridDim.x * 8;
  bf16_t* XB = (bf16_t*)(p.ws + OFF_XB); bf16_t* MB = (bf16_t*)(p.ws + OFF_MEMB);
  float* SX = (float*)(p.ws + OFF_SSQX); float* SM = (float*)(p.ws + OFF_SSQMEM);
  for (int r = gw; r < T + MEMR; r += GW) {
    const bool isx = r < T;
    const float* src = isx ? p.in[0] + (size_t)r * 1024 : p.in[1] + (size_t)(r - T) * 1024;
    bf16_t* dst = isx ? XB + (size_t)r * 1024 : MB + (size_t)(r - T) * 1024;
    float ss = 0.f;
#pragma unroll
    for (int j = 0; j < 4; ++j) {
      const f4 v = *(const f4*)(src + j * 256 + lane * 4);
      ss += v.x * v.x + v.y * v.y + v.z * v.z + v.w * v.w;
      u2 u; u.x = pack2(v.x, v.y); u.y = pack2(v.z, v.w);
      *(u2*)(dst + j * 256 + lane * 4) = u;
    }
#pragma unroll
    for (int m = 32; m >= 1; m >>= 1) ss += __shfl_xor(ss, m);
    if (isx) { if (lane < 8) SX[(size_t)r * 8 + lane] = (lane == 0) ? ss : 0.f; }
    else if (lane == 0) SM[r - T] = ss;
  }
}

DI void run_epilogue(const Params& p, const Tile& t, char* smem) {
  float* Cs = (float*)smem;
  float* rs = (float*)(smem + RS_OFF);
  const int tid = ltid();
  const int q = tid & 15, rsub = tid >> 4;
  const int* pos = (const int*)p.in[2];
  if (t.epi == EP_VT) {
    const int c = tid >> 2, rq = tid & 3;
#pragma unroll
    for (int j = 0; j < 8; ++j) {
      float v[8];
#pragma unroll
      for (int e = 0; e < 8; ++e) { const int r = rq * 64 + j * 8 + e; v[e] = Cs[r * CS_LD + c] * rs[r]; }
      bf16_t* d16 = t.dst + (size_t)c * t.ldd + rq * 64 + (j >> 1) * 16;
      u2 lo, hi; lo.x = pack2(v[0], v[1]); lo.y = pack2(v[2], v[3]); hi.x = pack2(v[4], v[5]); hi.y = pack2(v[6], v[7]);
      *(u2*)(d16 + ((j & 1) ? 4 : 0)) = lo;
      *(u2*)(d16 + ((j & 1) ? 12 : 8)) = hi;
    }
    return;
  }
#pragma unroll 1
  for (int pass = 0; pass < 8; ++pass) {
    const int r = rsub + 32 * pass;
    const int row = t.row0 + r;
    float v[8];
    load8(Cs, r, q, v);
    const float rsv = rs[r];
#pragma unroll
    for (int e = 0; e < 8; ++e) v[e] *= rsv;
    switch (t.epi) {
      case EP_HEADROT: {
        const float* cr = Cs + r * CS_LD + 2 * q;
        float x1[2][2], x2[2][2];
#pragma unroll
        for (int m = 0; m < 2; ++m) {
          const fl2_t a = *(const fl2_t*)(cr + m * 64), b = *(const fl2_t*)(cr + m * 64 + 32);
          x1[m][0] = a.x * rsv; x1[m][1] = a.y * rsv; x2[m][0] = b.x * rsv; x2[m][1] = b.y * rsv;
        }
        float ssm[2];
#pragma unroll
        for (int m = 0; m < 2; ++m) {
          float ss = x1[m][0] * x1[m][0] + x1[m][1] * x1[m][1] + x2[m][0] * x2[m][0] + x2[m][1] * x2[m][1];
          ss += __shfl_xor(ss, 1); ss += __shfl_xor(ss, 2); ss += __shfl_xor(ss, 4); ss += __shfl_xor(ss, 8);
          ssm[m] = rsqrtf(ss * (1.f / 64) + EPSV) * t.oscale;
        }
        const int ps = pos[row];
        const fl2_t g1 = *(const fl2_t*)(t.gain + 2 * q), g2 = *(const fl2_t*)(t.gain + 32 + 2 * q);
        const float g1v[2] = {g1.x, g1.y}, g2v[2] = {g2.x, g2.y};
        float cc[2], sn[2];
#pragma unroll
        for (int e = 0; e < 2; ++e) rot_cs(ps, INVF64[2 * q + e], cc[e], sn[e]);
#pragma unroll
        for (int m = 0; m < 2; ++m) {
          float o1[2], o2[2];
#pragma unroll
          for (int e = 0; e < 2; ++e) {
            const float y1 = x1[m][e] * ssm[m] * g1v[e], y2 = x2[m][e] * ssm[m] * g2v[e];
            o1[e] = y1 * cc[e] - y2 * sn[e];
            o2[e] = y2 * cc[e] + y1 * sn[e];
          }
          bf16_t* d = t.dst + (size_t)row * t.ldd + t.cb * 128 + m * 64 + 2 * q;
          *(unsigned*)d = pack2(o1[0], o1[1]);
          *(unsigned*)(d + 32) = pack2(o2[0], o2[1]);
        }
      } break;
      case EP_PLAIN: {
        float ss = 0.f;
#pragma unroll
        for (int e = 0; e < 8; ++e) ss += v[e] * v[e];
        ss += __shfl_xor(ss, 1); ss += __shfl_xor(ss, 2); ss += __shfl_xor(ss, 4); ss += __shfl_xor(ss, 8);
        *(u4*)(t.dst + (size_t)row * t.ldd + t.cb * 128 + q * 8) = pack8(v);
        if (q == 0) t.ssq_out[row] = ss;
      } break;
      case EP_KROPE: {
        const bool first = (q & 2) == 0; const int i0 = (q & 1) * 8;
        const int ps = pos[row];
        float ov[8];
#pragma unroll
        for (int e = 0; e < 8; ++e) {
          const float yp = __shfl_xor(v[e], 2);
          float c, s; rot_cs(ps, INVF32[i0 + e], c, s);
          ov[e] = first ? (v[e] * c - yp * s) : (v[e] * c + yp * s);
        }
        if (q < 4) {
          float* kr = (float*)(p.ws + OFF_KR) + (size_t)row * 32 + q * 8;
          *(f4*)kr = f4{ov[0], ov[1], ov[2], ov[3]};
          *(f4*)(kr + 4) = f4{ov[4], ov[5], ov[6], ov[7]};
        }
      } break;
      case EP_NORM128: {
        float ss = 0.f;
#pragma unroll
        for (int e = 0; e < 8; ++e) ss += v[e] * v[e];
        ss += __shfl_xor(ss, 1); ss += __shfl_xor(ss, 2); ss += __shfl_xor(ss, 4); ss += __shfl_xor(ss, 8);
        const float rn = rsqrtf(ss * (1.f / 128) + EPSV);
#pragma unroll
        for (int e = 0; e < 8; ++e) v[e] *= rn * t.oscale * t.gain[q * 8 + e];
        *(u4*)(t.dst + (size_t)row * t.ldd + t.cb * 128 + q * 8) = pack8(v);
      } break;
      case EP_QB: {
        const bool isr = (q >= 8 && q < 12);
        const bool first = (q & 2) == 0; const int i0 = (q & 1) * 8;
        const int ps = pos[row];
        float ss = 0.f;
#pragma unroll
        for (int e = 0; e < 8; ++e) {
          const float yp = __shfl_xor(v[e], 2);
          float c, s; rot_cs(ps, INVF32[i0 + e], c, s);
          const float rv = first ? (v[e] * c - yp * s) : (v[e] * c + yp * s);
          v[e] = isr ? rv : v[e];
          ss += v[e] * v[e];
        }
        ss += __shfl_xor(ss, 1); ss += __shfl_xor(ss, 2); ss += __shfl_xor(ss, 4); ss += __shfl_xor(ss, 8);
        const float rn = rsqrtf(ss * (1.f / 96) + EPSV);
        if (q < 12) {
#pragma unroll
          for (int e = 0; e < 8; ++e) v[e] *= rn * t.oscale * t.gain[q * 8 + e];
          *(u4*)(t.dst + (size_t)row * 768 + t.cb * 96 + q * 8) = pack8(v);
        }
      } break;
      case EP_KVB: {
        if (q >= 8) {
          if (q < 12) {
            const float* kr = (const float*)(p.ws + OFF_KR) + (size_t)row * 32 + (q - 8) * 8;
            const f4 a = *(const f4*)kr, b = *(const f4*)(kr + 4);
            v[0] = a.x; v[1] = a.y; v[2] = a.z; v[3] = a.w; v[4] = b.x; v[5] = b.y; v[6] = b.z; v[7] = b.w;
          } else {
#pragma unroll
            for (int e = 0; e < 8; ++e) v[e] = 0.f;
          }
        }
        float ss = 0.f;
#pragma unroll
        for (int e = 0; e < 8; ++e) ss += v[e] * v[e];
        ss += __shfl_xor(ss, 1); ss += __shfl_xor(ss, 2); ss += __shfl_xor(ss, 4); ss += __shfl_xor(ss, 8);
        const float rn = rsqrtf(ss * (1.f / 96) + EPSV);
        if (q < 12) {
#pragma unroll
          for (int e = 0; e < 8; ++e) v[e] *= rn * t.oscale * t.gain[q * 8 + e];
          *(u4*)(t.dst + (size_t)row * 768 + t.cb * 96 + q * 8) = pack8(v);
        }
      } break;
      case EP_RES: {
        const float* xs = t.xsrc + (size_t)row * 1024 + t.cb * 128 + q * 8;
        const f4 a = *(const f4*)xs, b = *(const f4*)(xs + 4);
        v[0] += a.x; v[1] += a.y; v[2] += a.z; v[3] += a.w; v[4] += b.x; v[5] += b.y; v[6] += b.z; v[7] += b.w;
        float ss = 0.f;
#pragma unroll
        for (int e = 0; e < 8; ++e) ss += v[e] * v[e];
        ss += __shfl_xor(ss, 1); ss += __shfl_xor(ss, 2); ss += __shfl_xor(ss, 4); ss += __shfl_xor(ss, 8);
        float* xo = p.out + (size_t)row * 1024 + t.cb * 128 + q * 8;
        *(f4*)xo = f4{v[0], v[1], v[2], v[3]};
        *(f4*)(xo + 4) = f4{v[4], v[5], v[6], v[7]};
        *(u4*)(t.dst + (size_t)row * 1024 + t.cb * 128 + q * 8) = pack8(v);
        if (q == 0) t.ssq_out[(size_t)row * 8] = ss;
      } break;
      case EP_YTMP: {
        *(u4*)(t.dst + (size_t)r * 256 + t.cb * 128 + q * 8) = pack8(v);
      } break;
      case EP_GATE: {
        const u4 yu = *(const u4*)(t.ysrc + (size_t)r * 256 + q * 8);
        const f4 ba = *(const f4*)(t.gain + q * 8), bb = *(const f4*)(t.gain + q * 8 + 4);
        bf16_t* mp_ = t.dst + (size_t)row * 1024 + t.cb * 128 + q * 8;
        u4 mu; mu.x = mu.y = mu.z = mu.w = 0u;
        if (t.accum) mu = *(const u4*)mp_;
        const float bs[8] = {ba.x, ba.y, ba.z, ba.w, bb.x, bb.y, bb.z, bb.w};
        const unsigned yw[4] = {yu.x, yu.y, yu.z, yu.w}, mw[4] = {mu.x, mu.y, mu.z, mu.w};
#pragma unroll
        for (int e = 0; e < 8; ++e) {
          const float g = 1.f / (1.f + __expf(-(v[e] + bs[e])));
          const float y = __uint_as_float((e & 1) ? (yw[e >> 1] & 0xffff0000u) : (yw[e >> 1] << 16));
          const float m = __uint_as_float((e & 1) ? (mw[e >> 1] & 0xffff0000u) : (mw[e >> 1] << 16));
          v[e] = m + g * y;
        }
        *(u4*)mp_ = pack8(v);
      } break;
      case EP_MLP1: {
#pragma unroll
        for (int e = 0; e < 8; ++e) { const float u = fmaxf(v[e], 0.f); v[e] = u * u; }
        *(u4*)(t.dst + (size_t)row * t.ldd + t.cb * 128 + q * 8) = pack8(v);
      } break;
      default: break;
    }
  }
  if (t.epi == EP_KVB) {
    bf16_t* VMT = (bf16_t*)(p.ws + OFF_VMT);
    const int c = tid >> 3, r8 = tid & 7;
    const int b = t.row0 >> 11, s0 = t.row0 & 2047;
    bf16_t* d = VMT + ((size_t)(b * 512 + t.cb * 64 + c)) * SEQ + s0 + r8 * 32;
#pragma unroll
    for (int j = 0; j < 4; ++j) {
      float v[8];
#pragma unroll
      for (int e = 0; e < 8; ++e) { const int r = r8 * 32 + j * 8 + e; v[e] = Cs[r * CS_LD + 64 + c] * rs[r]; }
      bf16_t* d16 = d + (j >> 1) * 16;
      u2 lo, hi; lo.x = pack2(v[0], v[1]); lo.y = pack2(v[2], v[3]); hi.x = pack2(v[4], v[5]); hi.y = pack2(v[6], v[7]);
      *(u2*)(d16 + ((j & 1) ? 4 : 0)) = lo;
      *(u2*)(d16 + ((j & 1) ? 12 : 8)) = hi;
    }
  }
}

__global__ void __launch_bounds__(NTHR) mega_fwd(Params p) {
  __shared__ __attribute__((aligned(16))) char smem[LDS_BYTES];
  cg::grid_group grid = cg::this_grid();
  const int G = gridDim.x, bid = blockIdx.x;
  for (int ph = p.ph_lo; ph < p.ph_hi; ++ph) {
      char* ws = p.ws; asm volatile("" : "+s"(ws));
    bf16_t* XB = (bf16_t*)(ws + OFF_XB);   bf16_t* QD = (bf16_t*)(ws + OFF_QD);   bf16_t* KD = (bf16_t*)(ws + OFF_KD);
    bf16_t* VDT = (bf16_t*)(ws + OFF_VDT); bf16_t* CQ = (bf16_t*)(ws + OFF_CQ);   bf16_t* CKV = (bf16_t*)(ws + OFF_CKV);
    bf16_t* XQ = (bf16_t*)(ws + OFF_XQ);   bf16_t* QM = (bf16_t*)(ws + OFF_QM);   bf16_t* KM = (bf16_t*)(ws + OFF_KM);
    bf16_t* VMT = (bf16_t*)(ws + OFF_VMT); bf16_t* MEMB = (bf16_t*)(ws + OFF_MEMB); bf16_t* KC = (bf16_t*)(ws + OFF_KC);
    bf16_t* VCT = (bf16_t*)(ws + OFF_VCT); bf16_t* W = (bf16_t*)(ws + OFF_W);     bf16_t* U = (bf16_t*)(ws + OFF_U);
    bf16_t* MERGED = KD;
    float* SSQX = (float*)(ws + OFF_SSQX); float* SSQCQ = (float*)(ws + OFF_SSQCQ); float* SSQCKV = (float*)(ws + OFF_SSQCKV);
    float* SSQMEM = (float*)(ws + OFF_SSQMEM);

    if (ph == 0) {
      phase_init(p);
      prep_range(p, 0, 0, 5152, smem);
    } else {
      const int l = (ph - 1) / p.per, kr = (ph - 1) % p.per;
      const int k = (kr > p.dupk) ? kr - (p.per - 7) : kr;
#ifndef NO_GEMM
      if (k == 0 || k == 1 || k == 3 || k == 4 || k == 5 || k == 6) {
        int nits = 0, total = 0;
        if (k == 0) { nits = 18; total = 4480; if (l > 0) prep_range(p, l, 4128, 5152, smem); }
        else if (k == 1) { nits = 8; total = 2048; }
        else if (k == 3) { nits = 24; total = 1024; }
        else if (k == 4) { nits = 4; total = 1024; }
        else if (k == 5) { nits = 16; total = 4096; if (l + 1 < NL) prep_range(p, l + 1, 0, 3104, smem); }
        else { nits = 4; total = 1024; if (l + 1 < NL) prep_range(p, l + 1, 3104, 4128, smem); }
        const bool xmap = (G == 256);
        if (!xmap) nits = ((total + G - 1) / G) * ((k == 3) ? 6 : 1);
#pragma unroll 1
        for (int it = 0; it < nits; ++it) {
          int list = 0, rb = -1, CB = 0;
          if (xmap) {
            if (k == 0) {
              if (it < 16) map_regular(it, bid, 16, rb, CB);
              else if (it == 16) { rb = bid; CB = 16; }
              else if (bid < 128) { list = 1; rb = bid >> 2; CB = bid & 3; }
            } else if (k == 1) { list = it >> 2; map_regular(it & 3, bid, 4, rb, CB); }
            else if (k == 3) map_regular(it / 6, bid, 4, rb, CB);
            else if (k == 5) map_regular(it, bid, 16, rb, CB);
            else map_regular(it, bid, 4, rb, CB);
          } else {
            const int li = ((k == 3) ? (it / 6) : it) * G + bid;
            if (li < total) {
              if (k == 0) { if (li < 4352) { rb = li / 17; CB = li % 17; } else { list = 1; rb = (li - 4352) >> 2; CB = (li - 4352) & 3; } }
              else if (k == 1) { list = li >> 10; rb = (li & 1023) >> 2; CB = li & 3; }
              else if (k == 5) { rb = li >> 4; CB = li & 15; }
              else { rb = li >> 2; CB = li & 3; }
            }
          }
          if (rb < 0) continue;
          const int row0 = rb * 256;
          const bf16_t* Ap; const bf16_t* Bp; int lda, Kd;
          const float* ssq = nullptr; int nparts = 0, pstride = T; float invK = 0.f;
          if (k == 0) {
            if (list == 0) { Ap = XB + (size_t)row0 * 1024; lda = 1024; Bp = W + W_IN + (size_t)CB * 256 * 1024; Kd = 1024; ssq = SSQX; nparts = 8; pstride = 1; invK = 1.f / 1024; }
            else           { Ap = MEMB + (size_t)row0 * 1024; lda = 1024; Bp = W + W_MEM + (size_t)CB * 256 * 1024; Kd = 1024; ssq = SSQMEM; nparts = 1; pstride = 0; invK = 1.f / 1024; }
          } else if (k == 1) {
            if (list == 0) { Ap = CQ + (size_t)row0 * 384; lda = 384; Bp = W + W_QB + (size_t)CB * 256 * 384; Kd = 384; ssq = SSQCQ; nparts = 3; invK = 1.f / 384; }
            else           { Ap = CKV + (size_t)row0 * 256; lda = 256; Bp = W + W_KVB + (size_t)CB * 256 * 256; Kd = 256; ssq = SSQCKV; nparts = 2; invK = 1.f / 256; }
          } else if (k == 3) {
            const int st = it % 6, br = st >> 1;
            if (st & 1)       { Ap = XB + (size_t)row0 * 1024; lda = 1024; Bp = W + W_IN + (size_t)(WIN_GATE0 + br * 1024 + CB * 256) * 1024; Kd = 1024; ssq = SSQX; nparts = 8; pstride = 1; invK = 1.f / 1024; }
            else if (br == 0) { Ap = QD + (size_t)row0 * 1024; lda = 1024; Bp = W + W_DO + (size_t)CB * 256 * 1024; Kd = 1024; }
            else if (br == 1) { Ap = QM + (size_t)row0 * 768;  lda = 768;  Bp = W + W_MO + (size_t)CB * 256 * 768;  Kd = 768; }
            else              { Ap = XQ + (size_t)row0 * 512;  lda = 512;  Bp = W + W_CO + (size_t)CB * 256 * 512;  Kd = 512; }
          } else if (k == 4) { Ap = MERGED + (size_t)row0 * 1024; lda = 1024; Bp = W + W_OUT + (size_t)CB * 256 * 1024; Kd = 1024; }
          else if (k == 5)   { Ap = XB + (size_t)row0 * 1024; lda = 1024; Bp = W + W_1 + (size_t)CB * 256 * 1024; Kd = 1024; ssq = SSQX; nparts = 8; pstride = 1; invK = 1.f / 1024; }
          else               { Ap = U + (size_t)row0 * 4096; lda = 4096; Bp = W + W_2 + (size_t)CB * 256 * 4096; Kd = 4096; }
          f32x4v acc[2][2][4][2];
          gemm8p(Ap, Bp, Kd, acc, smem);
          float* Cs = (float*)smem;
          if (k == 5 || k == 3) {
            float* rsL = (float*)(smem + RS_OFF);
            fill_rs(rsL, ssq, nparts, pstride, row0, invK);
            __syncthreads();
            const int tq = ltid(); const int lane = tq & 63, wave = tq >> 6, wr = wave >> 2, wc = wave & 3, fr = lane & 15, fq = lane >> 4;
            const int st = it % 6, br = st >> 1;
            bf16_t* YS = VDT + (size_t)blockIdx.x * 65536;
#pragma unroll
            for (int ai = 0; ai < 2; ++ai)
#pragma unroll
              for (int m = 0; m < 4; ++m) {
                const int row = ai * 128 + wr * 64 + m * 16 + fr;
                const float rsv = rsL[row];
#pragma unroll
                for (int bj = 0; bj < 2; ++bj)
#pragma unroll
                  for (int n = 0; n < 2; ++n) {
                    const int col = bj * 128 + wc * 32 + n * 16 + fq * 4;
                    const f32x4v a4 = acc[ai][bj][m][n];
                    float o4[4];
                    if (k == 5) {
#pragma unroll
                      for (int j = 0; j < 4; ++j) { const float u = fmaxf(a4[j] * rsv, 0.f); o4[j] = u * u; }
                      u2 w; w.x = pack2(o4[0], o4[1]); w.y = pack2(o4[2], o4[3]);
                      *(u2*)(U + (size_t)(row0 + row) * 4096 + CB * 256 + col) = w;
                    } else if (!(st & 1)) {
                      u2 w; w.x = pack2(a4[0], a4[1]); w.y = pack2(a4[2], a4[3]);
                      *(u2*)(YS + (size_t)row * 256 + col) = w;
                    } else {
                      const f4 bs = *(const f4*)(p.in[5] + (size_t)l * 3072 + br * 1024 + CB * 256 + col);
                      const u2 yu = *(const u2*)(YS + (size_t)row * 256 + col);
                      bf16_t* mp_ = MERGED + (size_t)(row0 + row) * 1024 + CB * 256 + col;
                      u2 mu; mu.x = mu.y = 0u;
                      if (br > 0) mu = *(const u2*)mp_;
                      const float bsv[4] = {bs.x, bs.y, bs.z, bs.w};
                      const unsigned yw[2] = {yu.x, yu.y}, mw[2] = {mu.x, mu.y};
#pragma unroll
                      for (int j = 0; j < 4; ++j) {
                        const float g = 1.f / (1.f + __expf(-(a4[j] * rsv + bsv[j])));
                        const float y = __uint_as_float((j & 1) ? (yw[j >> 1] & 0xffff0000u) : (yw[j >> 1] << 16));
                        const float mv = __uint_as_float((j & 1) ? (mw[j >> 1] & 0xffff0000u) : (mw[j >> 1] << 16));
                        o4[j] = mv + g * y;
                      }
                      u2 w; w.x = pack2(o4[0], o4[1]); w.y = pack2(o4[2], o4[3]);
                      *(u2*)mp_ = w;
                    }
                  }
              }
          } else
#pragma unroll 1
          for (int half = 0; half < 2; ++half) {
            if (half) __syncthreads();
            {
              const int tq = ltid(); const int lane = tq & 63, wave = tq >> 6, wr = wave >> 2, wc = wave & 3, fr = lane & 15, fq = lane >> 4;
#pragma unroll
              for (int ai = 0; ai < 2; ++ai)
#pragma unroll
                for (int m = 0; m < 4; ++m)
#pragma unroll
                  for (int n = 0; n < 2; ++n) {
                    f32x4v v4;
#pragma unroll
                    for (int j = 0; j < 4; ++j) v4[j] = half ? acc[ai][1][m][n][j] : acc[ai][0][m][n][j];
                    *(f32x4v*)(Cs + (ai * 128 + wr * 64 + m * 16 + fr) * CS_LD + wc * 32 + n * 16 + fq * 4) = v4;
                  }
            }
            if (half == 0) fill_rs((float*)(smem + RS_OFF), ssq, nparts, pstride, row0, invK);
            __syncthreads();
            const int cb = CB * 2 + half;
            Tile t;
            t.row0 = row0; t.cb = cb; t.epi = EP_PLAIN;
            t.dst = nullptr; t.ldd = 0; t.gain = nullptr; t.ssq_out = nullptr; t.xsrc = nullptr; t.oscale = 1.f; t.ysrc = nullptr; t.accum = 0;
            if (k == 0) {
              if (list == 0) {
                if (cb < 8)       { t.epi = EP_HEADROT; t.cb = cb; t.dst = QD; t.ldd = 1024; t.gain = p.in[6] + l * 64; t.oscale = 0.125f * 1.4426950408889634f; }
                else if (cb < 16) { t.epi = EP_HEADROT; t.cb = cb - 8; t.dst = KD; t.ldd = 1024; t.gain = p.in[7] + l * 64; }
                else if (cb < 24) { t.epi = EP_VT; t.cb = cb - 16; const int b = row0 >> 11, s0 = row0 & 2047; t.dst = VDT + ((size_t)(b * 1024 + (cb - 16) * 128)) * SEQ + s0; t.ldd = SEQ; }
                else if (cb < 27) { t.epi = EP_PLAIN; t.cb = cb - 24; t.dst = CQ; t.ldd = 384; t.ssq_out = SSQCQ + (size_t)(cb - 24) * T; }
                else if (cb < 29) { t.epi = EP_PLAIN; t.cb = cb - 27; t.dst = CKV; t.ldd = 256; t.ssq_out = SSQCKV + (size_t)(cb - 27) * T; }
                else if (cb == 29) { t.epi = EP_KROPE; t.cb = 0; }
                else              { t.epi = EP_NORM128; t.cb = cb - 30; t.dst = XQ; t.ldd = 512; t.gain = p.in[20] + l * 128; t.oscale = 0.08838834764831845f * 1.4426950408889634f; }
              } else {
                if (cb < 4) { t.epi = EP_NORM128; t.cb = cb; t.dst = KC; t.ldd = 512; t.gain = p.in[21] + l * 128; }
                else        { t.epi = EP_VT; t.cb = cb - 4; t.dst = VCT + ((size_t)(rb * 512 + (cb - 4) * 128)) * MEML; t.ldd = MEML; }
              }
            } else if (k == 1) {
              if (list == 0) { t.epi = EP_QB; t.dst = QM; t.gain = p.in[15] + l * 96; t.oscale = 0.10206207261596575f * 1.4426950408889634f; }
              else           { t.epi = EP_KVB; t.dst = KM; t.gain = p.in[16] + l * 96; }
            } else if (k == 3) {
              const int st = it % 6, br = st >> 1;
              bf16_t* YS = VDT + (size_t)blockIdx.x * 65536;
              if (st & 1) { t.epi = EP_GATE; t.dst = MERGED; t.ysrc = YS + half * 128; t.gain = p.in[5] + (size_t)l * 3072 + br * 1024 + cb * 128; t.accum = (br > 0); }
              else        { t.epi = EP_YTMP; t.dst = YS; t.cb = half; }
            } else if (k == 4) { t.epi = EP_RES; t.dst = XB; t.xsrc = (l == 0) ? p.in[0] : p.out; t.ssq_out = SSQX + cb; }
            else if (k == 5)   { t.epi = EP_MLP1; t.dst = U; t.ldd = 4096; }
            else               { t.epi = EP_RES; t.dst = XB; t.xsrc = p.out; t.ssq_out = SSQX + cb; }
            run_epilogue(p, t, smem);
          }
        }
      } else
#endif
#ifndef NO_ATT
      if (k == 2) {
        float lam;
        const float lam_init = 0.8f - 0.6f * expf(-0.3f * (float)l);
        {
          const int lane = ltid() & 63;
          const float* lv = p.in[8] + l * 256;
          float sa = lv[lane] * lv[64 + lane], sb = lv[128 + lane] * lv[192 + lane];
#pragma unroll
          for (int m = 32; m >= 1; m >>= 1) { sa += __shfl_xor(sa, m); sb += __shfl_xor(sb, m); }
          lam = expf(sa) - expf(sb) + lam_init;
        }
        const float L2E = 1.4426950408889634f;
#pragma unroll 1
        for (int it = 0; it < ((G == 256) ? 16 : (4096 + G - 1) / G); ++it) {
          int w;
          if (G == 256) {
            const int xcd = bid & 7, slot = bid >> 3;
            if (it < 8)       w = ((it * 32 + (slot >> 3) * 8 + xcd) << 3) + (slot & 7);
            else if (it < 12) w = 2048 + ((((it - 8) * 64 + (slot >> 2) * 8 + xcd) << 2) + (slot & 3));
            else              w = 3072 + ((((it - 12) * 32 + (slot >> 3) * 8 + xcd) << 3) + (slot & 7));
          } else { w = it * G + bid; if (w >= 4096) continue; }
#ifndef NO_A1
          if (w < 2048) {
            const int bh = w >> 3, j = w & 7, b = bh >> 3, hh = bh & 7;
#pragma unroll 1
            for (int half = 0; half < 2; ++half) {
              const int qb = half ? j : 15 - j;
              const int q0 = qb * 128;
              bf16_t* Qp = QD + ((size_t)(b * SEQ + q0)) * 1024 + hh * 128;
              attn_block<64, 128, 2, true>(Qp, 1024, KD + (size_t)b * SEQ * 1024 + hh * 128, 1024, VDT + ((size_t)(b * 1024 + hh * 128)) * SEQ, SEQ,
                                            (q0 + 128) >> 6, q0, Qp, 1024, 0.125f * L2E, lam, p.in[9] + l * 128, 1.f - lam_init, smem);
            }
          } else
#endif
#ifndef NO_A2
          if (w < 3072) {
            const int wj = w - 2048; const int bh = wj >> 2, j = wj & 3, b = bh >> 3, hh = bh & 7;
#pragma unroll 1
            for (int half = 0; half < 2; ++half) {
              const int qb = half ? j : 7 - j;
              const int q0 = qb * 256;
              bf16_t* Qp = QM + ((size_t)(b * SEQ + q0)) * 768 + hh * 96;
              attn_block<96, 64, 1, true>(Qp, 768, KM + (size_t)b * SEQ * 768 + hh * 96, 768, VMT + ((size_t)(b * 512 + hh * 64)) * SEQ, SEQ,
                                           (q0 + 256) >> 6, q0, Qp, 768, 0.10206207261596575f * L2E, 0.f, nullptr, 1.f, smem);
            }
          } else
#endif
#ifndef NO_A3
          {
            const int wj = w - 3072; const int bh = wj >> 3, qb = wj & 7, b = bh >> 2, hh = bh & 3;
            const int q0 = qb * 256;
            bf16_t* Qp = XQ + ((size_t)(b * SEQ + q0)) * 512 + hh * 128;
            attn_block<128, 128, 1, false>(Qp, 512, KC + (size_t)b * MEML * 512 + hh * 128, 512, VCT + ((size_t)(b * 512 + hh * 128)) * MEML, MEML,
                                            4, q0, Qp, 512, 0.08838834764831845f * L2E, 0.f, nullptr, 1.f, smem);
          }
#endif
          {}
        }
      } else
#endif
#ifndef NO_D
      if (k == 3) {
        float* Cs = (float*)smem;
        float* rs = (float*)(smem + RS_OFF);
#pragma unroll 1
        for (int it = 0; it < ((G == 256) ? 8 : (2048 + G - 1) / G); ++it) {
          int rb, cb;
          if (G == 256) map_regular(it, bid, 8, rb, cb);
          else { const int li = it * G + bid; if (li >= 2048) continue; rb = li >> 3; cb = li & 7; }
          const int tidd = ltid(); const int lane = tidd & 63, wave = tidd >> 6, wm = wave >> 1, wn = wave & 1, h = lane >> 5;
          const int row0 = rb * 256, col0 = cb * 128;
          __syncthreads();
          fill_rs(rs, SSQX, 8, T, row0, 1.f / 1024);
          f32x16 acc[2][2];
          unsigned gp[2][2][8], mp[2][2][8];
#pragma unroll
          for (int mi = 0; mi < 2; ++mi)
#pragma unroll
            for (int ni = 0; ni < 2; ++ni)
#pragma unroll
              for (int i = 0; i < 8; ++i) mp[mi][ni][i] = 0u;
#pragma unroll 1
          for (int st = 0; st < 6; ++st) {
            const int br = st >> 1, half = st & 1;
            const bf16_t* Ab; const bf16_t* Bb; int Kb;
            if (half == 0)    { Ab = XB + (size_t)row0 * 1024; Bb = W + W_IN + (size_t)(WIN_GATE0 + br * 1024 + col0) * 1024; Kb = 1024; }
            else if (br == 0) { Ab = QD + (size_t)row0 * 1024; Bb = W + W_DO + (size_t)col0 * 1024; Kb = 1024; }
            else if (br == 1) { Ab = QM + (size_t)row0 * 768;  Bb = W + W_MO + (size_t)col0 * 768;  Kb = 768; }
            else              { Ab = XQ + (size_t)row0 * 512;  Bb = W + W_CO + (size_t)col0 * 512;  Kb = 512; }
            gemm_mainloop<2, 2, 2, false>(Ab, Kb, Bb, Kb, Kb, acc, smem);
            if (half == 0) {
              const float* bg = p.in[5] + (size_t)l * 3072 + br * 1024 + col0 + wn * 64 + (lane & 31);
              const float bgv0 = bg[0], bgv1 = bg[32];
#pragma unroll
              for (int mi = 0; mi < 2; ++mi) {
                float rsv[16];
#pragma unroll
                for (int i = 0; i < 16; ++i) rsv[i] = rs[wm * 64 + mi * 32 + crow(i, h)];
#pragma unroll
                for (int ni = 0; ni < 2; ++ni) {
                  const float bgv = ni ? bgv1 : bgv0;
#pragma unroll
                  for (int i = 0; i < 16; i += 2) {
                    const float z0 = acc[mi][ni][i] * rsv[i] + bgv;
                    const float z1 = acc[mi][ni][i + 1] * rsv[i + 1] + bgv;
                    gp[mi][ni][i >> 1] = pack2(1.f / (1.f + __expf(-z0)), 1.f / (1.f + __expf(-z1)));
                  }
                }
                __builtin_amdgcn_sched_barrier(0);
              }
            } else {
#pragma unroll
              for (int mi = 0; mi < 2; ++mi)
#pragma unroll
                for (int ni = 0; ni < 2; ++ni)
#pragma unroll
                  for (int i = 0; i < 16; i += 2) {
                    const unsigned g2 = gp[mi][ni][i >> 1], m2 = mp[mi][ni][i >> 1];
                    const float m0 = __uint_as_float(m2 << 16) + __uint_as_float(g2 << 16) * acc[mi][ni][i];
                    const float m1 = __uint_as_float(m2 & 0xffff0000u) + __uint_as_float(g2 & 0xffff0000u) * acc[mi][ni][i + 1];
                    mp[mi][ni][i >> 1] = pack2(m0, m1);
                  }
            }
          }
#pragma unroll
          for (int mi = 0; mi < 2; ++mi)
#pragma unroll
            for (int ni = 0; ni < 2; ++ni)
#pragma unroll
              for (int i = 0; i < 16; ++i) {
                const unsigned m2 = mp[mi][ni][i >> 1];
                Cs[(wm * 64 + mi * 32 + crow(i, h)) * CS_LD + wn * 64 + ni * 32 + (lane & 31)] = __uint_as_float((i & 1) ? (m2 & 0xffff0000u) : (m2 << 16));
              }
          __syncthreads();
          const int q = tidd & 15, rsub = tidd >> 4;
#pragma unroll 1
          for (int pass = 0; pass < 8; ++pass) {
            const int r = rsub + 32 * pass;
            float v[8];
            load8(Cs, r, q, v);
            *(u4*)(MERGED + (size_t)(row0 + r) * 1024 + col0 + q * 8) = pack8(v);
          }
        }
      }
#endif
      {}
    }
    if (ph + 1 < p.ph_hi) grid.sync();
  }
}

extern "C" void kernel_launch(void* const* d_in, const int* in_sizes, int n_in, void* d_out, int out_size, void* d_ws, size_t ws_size, hipStream_t stream) {
  static int grid_blocks = 0;
  if (grid_blocks == 0) {
    if (n_in != 27 || ws_size < WS_NEED) { fprintf(stderr, "kernel_launch: unexpected inputs (n_in %d) or workspace (%zu < %zu)\n", n_in, ws_size, (size_t)WS_NEED); grid_blocks = -1; return; }
    int dev = 0, cus = 0, per_cu = 0;
    hipGetDevice(&dev);
    hipDeviceGetAttribute(&cus, hipDeviceAttributeMultiprocessorCount, dev);
    hipOccupancyMaxActiveBlocksPerMultiprocessor(&per_cu, mega_fwd, NTHR, 0);
    if (per_cu < 1) per_cu = 1;
    if (per_cu > 1) per_cu = 1;
    grid_blocks = cus * per_cu;
  }
  if (grid_blocks < 0) return;
  Params p{};
  for (int i = 0; i < 27; ++i) p.in[i] = (const float*)d_in[i];
  p.out = (float*)d_out;
  p.ws = (char*)d_ws;
  p.ph_lo = 0;
  p.dupk = (DUP_K >= 0) ? DUP_K : 100;
  p.per = (DUP_K >= 0) ? 8 : 7;
  p.ph_hi = 1 + NL * p.per;
  void* args[] = {&p};
  hipError_t e = hipLaunchCooperativeKernel((void*)mega_fwd, dim3(grid_blocks), dim3(NTHR), args, 0, stream);
  if (e != hipSuccess) fprintf(stderr, "cooperative launch failed: %s (grid %d)\n", hipGetErrorString(e), grid_blocks);
}
```

```cpp
#include <hip/hip_runtime.h>
#include <hip/hip_cooperative_groups.h>
#include <stdint.h>
#include <stdio.h>
#define NO_D 1
namespace cg = cooperative_groups;

typedef unsigned short bf16_t;
using bf16x8 = __attribute__((ext_vector_type(8))) short;
using f32x16 = __attribute__((ext_vector_type(16))) float;
typedef unsigned u4 __attribute__((ext_vector_type(4)));
typedef unsigned u2 __attribute__((ext_vector_type(2)));
typedef float f4 __attribute__((ext_vector_type(4)));
#define DI __device__ __forceinline__
#define MFMA(a, b, c) __builtin_amdgcn_mfma_f32_32x32x16_bf16((a), (b), (c), 0, 0, 0)

constexpr int T = 65536, DM = 1024, NB = 32, SEQ = 2048, NL = 4, MEML = 256, MEMR = NB * MEML;
constexpr int NTHR = 512;
constexpr int DUP_K = -1;
constexpr float EPSV = 1e-6f;
constexpr int WIN_N = 7424;
constexpr int WIN_GATE0 = 4352;

constexpr size_t MiB = 1024ull * 1024ull;
constexpr size_t OFF_XB = 0;
constexpr size_t OFF_QD = OFF_XB + 128 * MiB;
constexpr size_t OFF_KD = OFF_QD + 128 * MiB;
constexpr size_t OFF_VDT = OFF_KD + 128 * MiB;
constexpr size_t OFF_CQ = OFF_VDT + 128 * MiB;
constexpr size_t OFF_CKV = OFF_CQ + 48 * MiB;
constexpr size_t OFF_KR = OFF_CKV + 32 * MiB;
constexpr size_t OFF_XQ = OFF_KR + 8 * MiB;
constexpr size_t OFF_QM = OFF_XQ + 64 * MiB;
constexpr size_t OFF_KM = OFF_QM + 96 * MiB;
constexpr size_t OFF_VMT = OFF_KM + 96 * MiB;
constexpr size_t OFF_MEMB = OFF_VMT + 64 * MiB;
constexpr size_t OFF_KC = OFF_MEMB + 16 * MiB;
constexpr size_t OFF_VCT = OFF_KC + 8 * MiB;
constexpr size_t OFF_SSQX = OFF_VCT + 8 * MiB;
constexpr size_t OFF_SSQCQ = OFF_SSQX + 2 * MiB;
constexpr size_t OFF_SSQCKV = OFF_SSQCQ + 1 * MiB;
constexpr size_t OFF_SSQMEM = OFF_SSQCKV + 1 * MiB;
constexpr size_t OFF_W = OFF_SSQMEM + 1 * MiB;
constexpr size_t OFF_U = OFF_QD;
constexpr size_t W_IN = 0;
constexpr size_t W_MEM = W_IN + (size_t)WIN_N * 1024;
constexpr size_t W_QB = W_MEM + 1024 * 1024;
constexpr size_t W_KVB = W_QB + 1024 * 384;
constexpr size_t W_DO = W_KVB + 1024 * 256;
constexpr size_t W_MO = W_DO + 1024 * 1024;
constexpr size_t W_CO = W_MO + 1024 * 768;
constexpr size_t W_OUT = W_CO + 1024 * 512;
constexpr size_t W_1 = W_OUT + 1024 * 1024;
constexpr size_t W_2 = W_1 + 4096 * 1024;
constexpr size_t W_END = W_2 + 4096 * 1024;
constexpr size_t WS_NEED = OFF_W + W_END * 2;

constexpr int LDS_ROW = 144;
constexpr int CS_LD = 132;
constexpr int CS_BYTES = 256 * CS_LD * 4;
constexpr int RS_OFF = 2 * 512 * LDS_ROW;
constexpr int LDS_BYTES = RS_OFF + 1024;

__constant__ float INVF64[32] = {1.000000000e+00f,7.498942614e-01f,5.623413324e-01f,4.216965139e-01f,3.162277639e-01f,2.371373773e-01f,1.778279394e-01f,1.333521307e-01f,1.000000015e-01f,7.498941571e-02f,5.623413250e-02f,4.216965288e-02f,3.162277490e-02f,2.371373773e-02f,1.778279431e-02f,1.333521493e-02f,9.999999776e-03f,7.498941850e-03f,5.623413250e-03f,4.216964822e-03f,3.162277630e-03f,2.371373586e-03f,1.778279431e-03f,1.333521446e-03f,1.000000047e-03f,7.498942432e-04f,5.623413017e-04f,4.216965172e-04f,3.162277571e-04f,2.371373703e-04f,1.778279402e-04f,1.333521504e-04f};
__constant__ float INVF32[16] = {1.000000000e+00f,5.623413324e-01f,3.162277639e-01f,1.778279394e-01f,1.000000015e-01f,5.623413250e-02f,3.162277490e-02f,1.778279431e-02f,9.999999776e-03f,5.623413250e-03f,3.162277630e-03f,1.778279431e-03f,1.000000047e-03f,5.623413017e-04f,3.162277571e-04f,1.778279402e-04f};

struct Params {
  const float* in[27];
  float* out;
  char* ws;
  int ph_lo, ph_hi;
  int dupk, per;
};

typedef __bf16 bf2_t __attribute__((ext_vector_type(2)));
typedef float fl2_t __attribute__((ext_vector_type(2)));
DI unsigned pack2(float a, float b) { fl2_t f = {a, b}; bf2_t r = __builtin_convertvector(f, bf2_t); return __builtin_bit_cast(unsigned, r); }
DI u4 pack8(const float* v) { u4 u; u.x = pack2(v[0], v[1]); u.y = pack2(v[2], v[3]); u.z = pack2(v[4], v[5]); u.w = pack2(v[6], v[7]); return u; }
DI int ltid() { int t = threadIdx.x; asm volatile("" : "+v"(t)); return t; }
DI int crow(int i, int h) { return (i & 3) + 8 * (i >> 2) + 4 * h; }
DI void rot_cs(int pos, float invf, float& c, float& s) {
  const float ang = (float)pos * invf;
  double rev = (double)ang * 0.15915494309189535;
  rev -= floor(rev);
  const float rf = (float)rev;
  c = __builtin_amdgcn_cosf(rf);
  s = __builtin_amdgcn_sinf(rf);
}
DI void load8(const float* Cs, int r, int q, float* v) {
  const f4 a = *(const f4*)(Cs + r * CS_LD + q * 8);
  const f4 b = *(const f4*)(Cs + r * CS_LD + q * 8 + 4);
  v[0] = a.x; v[1] = a.y; v[2] = a.z; v[3] = a.w; v[4] = b.x; v[5] = b.y; v[6] = b.z; v[7] = b.w;
}

template <int MI, int NI, int WGN, bool FDB>
DI void gemm_mainloop(const bf16_t* __restrict__ A, int lda, const bf16_t* __restrict__ B, int ldb, int K, f32x16 (&acc)[MI][NI], char* smem) {
  constexpr int BM = (8 / WGN) * MI * 32, BN = WGN * NI * 32;
  constexpr int ASZ = BM * 64, STAGE = (BM + BN) * 64;
  constexpr int NGA = BM / 128, NGB = BN / 128, NLD = NGA + NGB;
  static_assert(4 * STAGE <= RS_OFF, "ring");
  const int tid = ltid(), lane = tid & 63, wave = tid >> 6, l31 = lane & 31, h = lane >> 5;
  const int wu = __builtin_amdgcn_readfirstlane(wave);
  const int wm = wave / WGN, wn = wave % WGN;
  const int lrow = lane >> 2, lchk = (lane & 3) ^ ((lane >> 4) & 3);
  const bf16_t* ga = A + (size_t)(wu * NGA * 16 + lrow) * lda + lchk * 8;
  const bf16_t* gb = B + (size_t)(wu * NGB * 16 + lrow) * ldb + lchk * 8;
#pragma unroll
  for (int mi = 0; mi < MI; ++mi)
#pragma unroll
    for (int ni = 0; ni < NI; ++ni)
#pragma unroll
      for (int i = 0; i < 16; ++i) acc[mi][ni][i] = 0.f;
  auto issue = [&](int j) {
    char* st = smem + (j & 3) * STAGE;
    const int k0 = j * 32;
#pragma unroll
    for (int i = 0; i < NGA; ++i)
      __builtin_amdgcn_global_load_lds((const unsigned*)(ga + (size_t)(i * 16) * lda + k0), (unsigned*)(st + (wu * NGA + i) * 1024), 16, 0, 0);
#pragma unroll
    for (int i = 0; i < NGB; ++i)
      __builtin_amdgcn_global_load_lds((const unsigned*)(gb + (size_t)(i * 16) * ldb + k0), (unsigned*)(st + ASZ + (wu * NGB + i) * 1024), 16, 0, 0);
  };
  asm volatile("s_waitcnt vmcnt(0)" ::: "memory");
  __syncthreads();
  const int nk = K >> 5;
  issue(0); issue(1); issue(2);
  const int sw = (l31 >> 2) & 3;
  const int oa = (wm * MI * 32 + l31) * 64, ob = ASZ + (wn * NI * 32 + l31) * 64;
  const int c0 = ((0 + h) ^ sw) * 16, c1 = ((2 + h) ^ sw) * 16;
#pragma unroll 1
  for (int j = 0; j < nk; ++j) {
    if (j + 2 < nk) asm volatile("s_waitcnt vmcnt(%0)" ::"n"(2 * NLD) : "memory");
    else if (j + 1 < nk) asm volatile("s_waitcnt vmcnt(%0)" ::"n"(NLD) : "memory");
    else asm volatile("s_waitcnt vmcnt(0)" ::: "memory");
    asm volatile("s_waitcnt lgkmcnt(0)" ::: "memory");
    __builtin_amdgcn_s_barrier();
    if (j + 3 < nk) issue(j + 3);
    const char* st = smem + (j & 3) * STAGE;
    const char* pa = st + oa;
    const char* pb = st + ob;
    bf16x8 fa0[MI], fb0[NI], fa1[MI], fb1[NI];
#pragma unroll
    for (int mi = 0; mi < MI; ++mi) fa0[mi] = *(const bf16x8*)(pa + mi * 2048 + c0);
#pragma unroll
    for (int ni = 0; ni < NI; ++ni) fb0[ni] = *(const bf16x8*)(pb + ni * 2048 + c0);
    if (FDB) {
#pragma unroll
      for (int mi = 0; mi < MI; ++mi) fa1[mi] = *(const bf16x8*)(pa + mi * 2048 + c1);
#pragma unroll
      for (int ni = 0; ni < NI; ++ni) fb1[ni] = *(const bf16x8*)(pb + ni * 2048 + c1);
    }
#pragma unroll
    for (int mi = 0; mi < MI; ++mi)
#pragma unroll
      for (int ni = 0; ni < NI; ++ni) acc[mi][ni] = MFMA(fa0[mi], fb0[ni], acc[mi][ni]);
    __builtin_amdgcn_sched_barrier(0);
    if (!FDB) {
#pragma unroll
      for (int mi = 0; mi < MI; ++mi) fa1[mi] = *(const bf16x8*)(pa + mi * 2048 + c1);
#pragma unroll
      for (int ni = 0; ni < NI; ++ni) fb1[ni] = *(const bf16x8*)(pb + ni * 2048 + c1);
    }
#pragma unroll
    for (int mi = 0; mi < MI; ++mi)
#pragma unroll
      for (int ni = 0; ni < NI; ++ni) acc[mi][ni] = MFMA(fa1[mi], fb1[ni], acc[mi][ni]);
    __builtin_amdgcn_sched_barrier(0);
  }
  asm volatile("s_waitcnt lgkmcnt(0)" ::: "memory");
  __builtin_amdgcn_s_barrier();
}

using f32x4v = __attribute__((ext_vector_type(4))) float;
DI int lds_byte8(int r, int c) {
  const int st = (r >> 4) * 2 + (c >> 5), rr = r & 15, cc = c & 31, ob = rr * 64 + cc * 2;
  return st * 1024 + (ob ^ (((ob >> 9) & 1) << 5));
}
DI void stage_rc8(int b, int& R, int& C) {
  const int st = b / 1024, sb = b % 1024, swz = sb ^ (((sb >> 9) & 1) << 5);
  R = (st >> 1) * 16 + swz / 64; C = (st & 1) * 32 + (swz % 64) / 2;
}
DI void gemm8p(const bf16_t* __restrict__ A, const bf16_t* __restrict__ Bt, int K, f32x4v (&acc)[2][2][4][2], char* smem) {
  constexpr int BK8 = 64, HALF8 = 128, HTB = HALF8 * BK8 * 2;
  const int tid = ltid(), wid = tid >> 6, lane = tid & 63, wr = wid >> 2, wc = wid & 3, fr = lane & 15, fq = lane >> 4;
  const int wu8 = __builtin_amdgcn_readfirstlane(wid);
  unsigned goff[2];
#pragma unroll
  for (int i_ = 0; i_ < 2; ++i_) { int r_, c_; stage_rc8(tid * 16 + i_ * 8192, r_, c_); goff[i_] = (unsigned)(r_ * K + c_); }
  const int lfrag = ((fr * 64 + fq * 16) ^ ((fr >> 3) << 5));
  const char* la = smem + wr * 8192 + lfrag;
  const char* lb = smem + 4 * HTB + wc * 4096 + lfrag;
#define SA8(b, h) ((b) * 2 + (h))
#define SB8(b, h) (4 + (b) * 2 + (h))
#define STAGE8(Q, BASE, br, kt) do { const bf16_t* sb_ = (BASE) + ((long)(br) * K + (long)(kt) * BK8); \
    _Pragma("unroll") for (int i_ = 0; i_ < 2; ++i_) \
      __builtin_amdgcn_global_load_lds((const unsigned*)(sb_ + goff[i_]), (unsigned*)(smem + (Q) * HTB + i_ * 8192 + wu8 * 1024), 16, 0, 0); } while (0)
#define LDA8(dst, b, h) _Pragma("unroll") for (int m = 0; m < 4; ++m) _Pragma("unroll") for (int k = 0; k < 2; ++k) \
    dst[m][k] = *(const bf16x8*)(la + ((b) * 2 + (h)) * HTB + (m * 2 + k) * 1024)
#define LDB8(dst, b, h) _Pragma("unroll") for (int n = 0; n < 2; ++n) _Pragma("unroll") for (int k = 0; k < 2; ++k) \
    dst[n][k] = *(const bf16x8*)(lb + ((b) * 2 + (h)) * HTB + (n * 2 + k) * 1024)
#define MMA8(ai, bj, At_, Bt_) do { __builtin_amdgcn_s_setprio(1); \
    _Pragma("unroll") for (int m = 0; m < 4; ++m) _Pragma("unroll") for (int n = 0; n < 2; ++n) _Pragma("unroll") for (int k = 0; k < 2; ++k) \
      acc[ai][bj][m][n] = __builtin_amdgcn_mfma_f32_16x16x32_bf16(Bt_[n][k], At_[m][k], acc[ai][bj][m][n], 0, 0, 0); \
    __builtin_amdgcn_s_setprio(0); } while (0)
#define WAIT_V8(n) asm volatile("s_waitcnt vmcnt(" #n ")" ::: "memory")
#define WAIT_L8(n) asm volatile("s_waitcnt lgkmcnt(" #n ")" ::: "memory")
#define BAR8 __builtin_amdgcn_s_barrier()
#define SCHED8 __builtin_amdgcn_sched_barrier(0)
#pragma unroll
  for (int a = 0; a < 2; ++a)
#pragma unroll
    for (int b = 0; b < 2; ++b)
#pragma unroll
      for (int m = 0; m < 4; ++m)
#pragma unroll
        for (int n = 0; n < 2; ++n) acc[a][b][m][n] = f32x4v{0.f, 0.f, 0.f, 0.f};
  bf16x8 At[4][2], B0[2][2], B1[2][2];
  const int nt = K / BK8;
  asm volatile("s_waitcnt vmcnt(0)" ::: "memory");
  __syncthreads();
  STAGE8(SB8(0, 0), Bt, 0, 0); STAGE8(SA8(0, 0), A, 0, 0);
  STAGE8(SB8(0, 1), Bt, HALF8, 0); STAGE8(SA8(0, 1), A, HALF8, 0);
  if (wr == 1) BAR8;
  WAIT_V8(4); BAR8;
  STAGE8(SB8(1, 0), Bt, 0, 1); STAGE8(SA8(1, 0), A, 0, 1); STAGE8(SB8(1, 1), Bt, HALF8, 1);
  WAIT_V8(6); BAR8;
#pragma unroll 1
  for (int t = 0; t < nt - 2; t += 2) {
    LDB8(B0, 0, 0); SCHED8; LDA8(At, 0, 0); STAGE8(SA8(1, 1), A, HALF8, t + 1);
    WAIT_L8(8); BAR8; WAIT_L8(0); MMA8(0, 0, At, B0); BAR8; SCHED8;
    LDB8(B1, 0, 1); STAGE8(SB8(0, 0), Bt, 0, t + 2);
    BAR8; WAIT_L8(0); MMA8(0, 1, At, B1); BAR8;
    LDA8(At, 0, 1); STAGE8(SA8(0, 0), A, 0, t + 2);
    BAR8; WAIT_L8(0); MMA8(1, 0, At, B0); BAR8; SCHED8;
    STAGE8(SB8(0, 1), Bt, HALF8, t + 2);
    WAIT_V8(6); BAR8; MMA8(1, 1, At, B1); BAR8;
    LDB8(B0, 1, 0); SCHED8; LDA8(At, 1, 0); STAGE8(SA8(0, 1), A, HALF8, t + 2);
    WAIT_L8(8); BAR8; WAIT_L8(0); MMA8(0, 0, At, B0); BAR8; SCHED8;
    LDB8(B1, 1, 1); STAGE8(SB8(1, 0), Bt, 0, t + 3);
    BAR8; WAIT_L8(0); MMA8(0, 1, At, B1); BAR8;
    LDA8(At, 1, 1); STAGE8(SA8(1, 0), A, 0, t + 3);
    BAR8; WAIT_L8(0); MMA8(1, 0, At, B0); BAR8; SCHED8;
    STAGE8(SB8(1, 1), Bt, HALF8, t + 3);
    WAIT_V8(6); BAR8; MMA8(1, 1, At, B1); BAR8;
  }
  { LDB8(B0, 0, 0); LDA8(At, 0, 0); STAGE8(SA8(1, 1), A, HALF8, nt - 1);
    BAR8; WAIT_L8(0); MMA8(0, 0, At, B0); BAR8;
    LDB8(B1, 0, 1); BAR8; WAIT_L8(0); MMA8(0, 1, At, B1); BAR8;
    LDA8(At, 0, 1); WAIT_V8(4); BAR8; WAIT_L8(0); MMA8(1, 0, At, B0); MMA8(1, 1, At, B1); BAR8; }
  { LDB8(B0, 1, 0); LDA8(At, 1, 0); WAIT_V8(2); BAR8; WAIT_L8(0); MMA8(0, 0, At, B0); BAR8;
    LDB8(B1, 1, 1); WAIT_V8(0); BAR8; WAIT_L8(0); MMA8(0, 1, At, B1); BAR8;
    LDA8(At, 1, 1); BAR8; WAIT_L8(0); MMA8(1, 0, At, B0); MMA8(1, 1, At, B1); BAR8; }
  if (wr == 0) BAR8;
  asm volatile("s_waitcnt lgkmcnt(0)" ::: "memory");
  BAR8;
#undef SA8
#undef SB8
#undef STAGE8
#undef LDA8
#undef LDB8
#undef MMA8
#undef WAIT_V8
#undef WAIT_L8
#undef BAR8
#undef SCHED8
}

DI void fill_rs(float* rs, const float* ssq, int nparts, int pstride, int row0, float invK) {
  const int t = ltid();
  if (t < 256) {
    float r = 1.f;
    if (ssq) {
      float s = 0.f;
      if (pstride == 1) {
        const f4 a = *(const f4*)(ssq + (size_t)(row0 + t) * 8), b = *(const f4*)(ssq + (size_t)(row0 + t) * 8 + 4);
        s = (a.x + a.y) + (a.z + a.w) + (b.x + b.y) + (b.z + b.w);
      } else {
        for (int p = 0; p < nparts; ++p) s += ssq[(size_t)p * pstride + row0 + t];
      }
      r = rsqrtf(s * invK + EPSV);
    }
    rs[t] = r;
  }
}

enum { EP_HEADROT = 0, EP_VT, EP_PLAIN, EP_KROPE, EP_NORM128, EP_QB, EP_KVB, EP_RES, EP_MLP1, EP_YTMP, EP_GATE };

struct Tile {
  int epi, row0, cb;
  bf16_t* dst; int ldd;
  const float* gain;
  float* ssq_out;
  const float* xsrc;
  float oscale;
  const bf16_t* ysrc;
  int accum;
};

DI void map_regular(int it, int bid, int NCB, int& rb, int& CB) {
  const int xcd = bid & 7, slot = bid >> 3;
  const int c = xcd * NCB + it;
  const int ncg = NCB >> 2;
  const int cgrp = c % ncg, rgrp = c / ncg;
  rb = rgrp * 8 + (slot >> 2);
  CB = cgrp * 4 + (slot & 3);
}

template <int DK, int DV, int NM, bool CAUSAL>
DI void attn_block(const bf16_t* __restrict__ Q, int ldq, const bf16_t* __restrict__ Kg, int ldk, const bf16_t* __restrict__ Vt, int ldv,
                   int nkt, int q0, bf16_t* O, int ldo, float sc, float lam, const float* og, float omul, char* smem) {
  constexpr int KW = NM * DK, KCHV = KW / 8;
  constexpr int KBYTES = 64 * 256, VBYTES = DV * 128, STAGE = KBYTES + VBYTES;
  constexpr int NVI = DV / 64;
  constexpr int NLD = 2 + NVI;
  static_assert(KCHV <= 16 && 4 * STAGE <= RS_OFF, "lds");
  constexpr int NKC16 = DK / 16, NDVB = DV / 32;
  const int tid = ltid(), lane = tid & 63, wave = tid >> 6, h = lane >> 5, l31 = lane & 31;
  const int wq = (NM == 2) ? (wave & 3) : wave;
  const int mymap = (NM == 2) ? (wave >> 2) : 0;
  const int q0w = q0 + wq * 32;

  bf16x8 qf[NKC16];
  {
    const bf16_t* qp = Q + (size_t)(wq * 32 + l31) * ldq + mymap * DK + h * 8;
#pragma unroll
    for (int kc = 0; kc < NKC16; ++kc) qf[kc] = *(const bf16x8*)(qp + kc * 16);
#pragma unroll
    for (int kc = 0; kc < NKC16; ++kc) asm volatile("" : "+v"(qf[kc]));
  }
  f32x16 o[NDVB];
#pragma unroll
  for (int d = 0; d < NDVB; ++d)
#pragma unroll
    for (int i = 0; i < 16; ++i) o[d][i] = 0.f;
  f32x16 lacc;
#pragma unroll
  for (int i = 0; i < 16; ++i) lacc[i] = 0.f;
  u4 onesu; onesu.x = onesu.y = onesu.z = onesu.w = 0x3F803F80u;
  const bf16x8 ones = __builtin_bit_cast(bf16x8, onesu);

  const int wu = __builtin_amdgcn_readfirstlane(wave);
  const int krow = lane >> 4, kslot = lane & 15;
  const int vrow = lane >> 3, vslot = lane & 7;
  auto issue = [&](int kt) {
    char* st = smem + (kt & 3) * STAGE;
#pragma unroll
    for (int i = 0; i < 2; ++i) {
      const int r = (wu * 2 + i) * 4 + krow;
      const int c = kslot ^ (r & 15);
      if (KCHV == 16 || c < KCHV)
        __builtin_amdgcn_global_load_lds((const unsigned*)(Kg + (size_t)(kt * 64 + r) * ldk + c * 8), (unsigned*)(st + (wu * 2 + i) * 1024), 16, 0, 0);
    }
#pragma unroll
    for (int i = 0; i < NVI; ++i) {
      const int d = (wu * NVI + i) * 8 + vrow;
      const int c = vslot ^ ((d >> 1) & 7);
      __builtin_amdgcn_global_load_lds((const unsigned*)(Vt + (size_t)d * ldv + kt * 64 + c * 8), (unsigned*)(st + KBYTES + (wu * NVI + i) * 1024), 16, 0, 0);
    }
  };
  asm volatile("s_waitcnt vmcnt(0)" ::: "memory");
  __syncthreads();
  if (0 < nkt) issue(0);
  if (1 < nkt) issue(1);
  if (2 < nkt) issue(2);
  for (int kt = 0; kt < nkt; ++kt) {
    if (kt + 2 < nkt) asm volatile("s_waitcnt vmcnt(%0)" ::"n"(2 * NLD) : "memory");
    else if (kt + 1 < nkt) asm volatile("s_waitcnt vmcnt(%0)" ::"n"(NLD) : "memory");
    else asm volatile("s_waitcnt vmcnt(0)" ::: "memory");
    asm volatile("s_waitcnt lgkmcnt(0)" ::: "memory");
    __builtin_amdgcn_s_barrier();
    if (kt + 3 < nkt) issue(kt + 3);
    const bool skip = CAUSAL && (kt * 64 > q0w + 31);
    if (!skip) {
      const char* base = smem + (kt & 3) * STAGE;
      f32x16 s[2];
#pragma unroll
      for (int sb = 0; sb < 2; ++sb) {
#pragma unroll
        for (int i = 0; i < 16; ++i) s[sb][i] = 0.f;
        const char* pk = base + (sb * 32 + l31) * 256;
#pragma unroll
        for (int kc = 0; kc < NKC16; ++kc) {
          const bf16x8 a = *(const bf16x8*)(pk + (((mymap * (DK / 8) + kc * 2 + h) ^ (l31 & 15)) * 16));
          s[sb] = MFMA(a, qf[kc], s[sb]);
        }
        __builtin_amdgcn_sched_barrier(0);
      }
      const bool need_mask = CAUSAL && (kt * 64 + 63 > q0w);
      const char* pv = base + KBYTES + l31 * 128;
      const int vsw = (l31 >> 1) & 7;
      bf16x8 pf[4];
      auto expo = [&](int sb) {
#pragma unroll
        for (int i = 0; i < 16; ++i) {
          float pz = __builtin_amdgcn_exp2f(s[sb][i]);
          if (need_mask) {
            const int key = kt * 64 + sb * 32 + crow(i, h);
            if (key > q0w + l31) pz = 0.f;
          }
          s[sb][i] = pz;
        }
#pragma unroll
        for (int k2 = 0; k2 < 2; ++k2) {
          u4 pu;
          pu.x = pack2(s[sb][k2 * 8 + 0], s[sb][k2 * 8 + 1]);
          pu.y = pack2(s[sb][k2 * 8 + 2], s[sb][k2 * 8 + 3]);
          pu.z = pack2(s[sb][k2 * 8 + 4], s[sb][k2 * 8 + 5]);
          pu.w = pack2(s[sb][k2 * 8 + 6], s[sb][k2 * 8 + 7]);
          pf[sb * 2 + k2] = __builtin_bit_cast(bf16x8, pu);
        }
      };
      auto pvmm = [&](int ks) {
        lacc = MFMA(ones, pf[ks], lacc);
#pragma unroll
        for (int d = 0; d < NDVB; ++d) {
          const u4 au = *(const u4*)(pv + d * 32 * 128 + (((ks * 2 + h) ^ vsw) * 16));
          o[d] = MFMA(__builtin_bit_cast(bf16x8, au), pf[ks], o[d]);
        }
      };
      expo(0);
      pvmm(0); pvmm(1);
      expo(1);
      pvmm(2); pvmm(3);
      __builtin_amdgcn_sched_barrier(0);
    }
  }
  asm volatile("s_waitcnt lgkmcnt(0)" ::: "memory");
  __builtin_amdgcn_s_barrier();
  const float l_tot = lacc[0];
  const float inv = 1.f / l_tot;
#pragma unroll
  for (int d = 0; d < NDVB; ++d)
#pragma unroll
    for (int i = 0; i < 16; ++i) o[d][i] *= inv;

  float rn_out = 1.f;
  if (NM == 2) {
    float* buf = (float*)smem;
    if (wave >= 4) {
#pragma unroll
      for (int d = 0; d < NDVB; ++d)
#pragma unroll
        for (int i = 0; i < 16; ++i) buf[(d * 16 + i) * 256 + (wave & 3) * 64 + lane] = o[d][i];
    }
    __syncthreads();
    if (wave < 4) {
      float ss = 0.f;
#pragma unroll
      for (int d = 0; d < NDVB; ++d) {
#pragma unroll
        for (int i = 0; i < 16; ++i) {
          const float v = o[d][i] - lam * buf[(d * 16 + i) * 256 + wave * 64 + lane];
          o[d][i] = v;
          ss += v * v;
        }
        __builtin_amdgcn_sched_barrier(0);
      }
      ss += __shfl_xor(ss, 32);
      rn_out = rsqrtf(ss * (1.f / DV) + EPSV) * omul;
    }
  }
  if (NM == 1 || wave < 4) {
    bf16_t* op = O + (size_t)(wq * 32 + l31) * ldo + 4 * h;
#pragma unroll
    for (int d = 0; d < NDVB; ++d)
#pragma unroll
      for (int g = 0; g < 4; ++g) {
        f4 gg = {1.f, 1.f, 1.f, 1.f};
        if (NM == 2) gg = *(const f4*)(og + d * 32 + 8 * g + 4 * h);
        u2 u;
        u.x = pack2(o[d][4 * g + 0] * rn_out * gg.x, o[d][4 * g + 1] * rn_out * gg.y);
        u.y = pack2(o[d][4 * g + 2] * rn_out * gg.z, o[d][4 * g + 3] * rn_out * gg.w);
        *(u2*)(op + d * 32 + 8 * g) = u;
      }
  }
}

DI void prep_tile(const float* __restrict__ src, int N, const float* __restrict__ gain, bf16_t* __restrict__ dst, int Kp, int nmode, int kmode, int kt, int nt, char* smem) {
  float* tile = (float*)smem;
  const int tid = ltid();
  __syncthreads();
  {
    const int n = tid & 63;
    const int np = nt * 64 + n;
    int ns = np; bool nv = true;
    if (nmode == 1) {
      if (np < 3712) ns = np;
      else if (np < 3840) { ns = np; nv = (np < 3744); }
      else if (np < 4352) ns = np - 96;
      else ns = np - 96;
    } else if (nmode == 2) {
      const int hh = np >> 7, j = np & 127;
      nv = j < 96; ns = hh * 96 + j;
    }
#pragma unroll
    for (int j = 0; j < 8; ++j) {
      const int kk = (tid >> 6) + 8 * j;
      const int kp = kt * 64 + kk;
      int ks = kp; bool kv = true;
      if (kmode == 1) { const int hh = kp / 96, jj = kp % 96; kv = jj < 64; ks = hh * 64 + jj; }
      float v = 0.f;
      if (nv && kv) { v = src[(size_t)ks * N + ns]; if (gain) v *= gain[ks]; }
      tile[n * 65 + kk] = v;
    }
  }
  __syncthreads();
  {
    const int n = tid >> 3, kc = tid & 7;
    float v[8];
#pragma unroll
    for (int e = 0; e < 8; ++e) v[e] = tile[n * 65 + kc * 8 + e];
    *(u4*)(dst + (size_t)(nt * 64 + n) * Kp + kt * 64 + kc * 8) = pack8(v);
  }
}

DI void prep_item(const Params& p, int l, int it, char* smem) {
  bf16_t* W = (bf16_t*)(p.ws + OFF_W);
  const float* src; const float* gain = nullptr; bf16_t* dst; int N, Kp, nmode = 0, kmode = 0, nkt, loc;
  if (it < 1856)      { loc = it;        src = p.in[4] + (size_t)l * 1024 * 7328; N = 7328; gain = p.in[3] + l * 1024; dst = W + W_IN; Kp = 1024; nmode = 1; nkt = 16; }
  else if (it < 2112) { loc = it - 1856; src = p.in[19] + (size_t)l * 1024 * 1024; N = 1024; gain = p.in[18] + l * 1024; dst = W + W_MEM; Kp = 1024; nkt = 16; }
  else if (it < 2208) { loc = it - 2112; src = p.in[12] + (size_t)l * 384 * 768; N = 768; gain = p.in[11] + l * 384; dst = W + W_QB; Kp = 384; nmode = 2; nkt = 6; }
  else if (it < 2272) { loc = it - 2208; src = p.in[14] + (size_t)l * 256 * 1024; N = 1024; gain = p.in[13] + l * 256; dst = W + W_KVB; Kp = 256; nkt = 4; }
  else if (it < 2528) { loc = it - 2272; src = p.in[10] + (size_t)l * 1024 * 1024; N = 1024; dst = W + W_DO; Kp = 1024; nkt = 16; }
  else if (it < 2720) { loc = it - 2528; src = p.in[17] + (size_t)l * 512 * 1024; N = 1024; dst = W + W_MO; Kp = 768; kmode = 1; nkt = 12; }
  else if (it < 2848) { loc = it - 2720; src = p.in[22] + (size_t)l * 512 * 1024; N = 1024; dst = W + W_CO; Kp = 512; nkt = 8; }
  else if (it < 3104) { loc = it - 2848; src = p.in[23] + (size_t)l * 1024 * 1024; N = 1024; dst = W + W_OUT; Kp = 1024; nkt = 16; }
  else if (it < 4128) { loc = it - 3104; src = p.in[25] + (size_t)l * 1024 * 4096; N = 4096; gain = p.in[24] + l * 1024; dst = W + W_1; Kp = 1024; nkt = 16; }
  else                { loc = it - 4128; src = p.in[26] + (size_t)l * 4096 * 1024; N = 1024; dst = W + W_2; Kp = 4096; nkt = 64; }
  prep_tile(src, N, gain, dst, Kp, nmode, kmode, loc % nkt, loc / nkt, smem);
}
DI void prep_range(const Params& p, int l, int lo, int hi, char* smem) {
  for (int it = lo + blockIdx.x; it < hi; it += gridDim.x) prep_item(p, l, it, smem);
}

DI void phase_init(const Params& p) {
  const int tid_ = ltid(); const int lane = tid_ & 63, gw = blockIdx.x * 8 + (tid_ >> 6), GW = gridDim.x * 8;
  bf16_t* XB = (bf16_t*)(p.ws + OFF_XB); bf16_t* MB = (bf16_t*)(p.ws + OFF_MEMB);
  float* SX = (float*)(p.ws + OFF_SSQX); float* SM = (float*)(p.ws + OFF_SSQMEM);
  for (int r = gw; r < T + MEMR; r += GW) {
    const bool isx = r < T;
    const float* src = isx ? p.in[0] + (size_t)r * 1024 : p.in[1] + (size_t)(r - T) * 1024;
    bf16_t* dst = isx ? XB + (size_t)r * 1024 : MB + (size_t)(r - T) * 1024;
    float ss = 0.f;
#pragma unroll
    for (int j = 0; j < 4; ++j) {
      const f4 v = *(const f4*)(src + j * 256 + lane * 4);
      ss += v.x * v.x + v.y * v.y + v.z * v.z + v.w * v.w;
      u2 u; u.x = pack2(v.x, v.y); u.y = pack2(v.z, v.w);
      *(u2*)(dst + j * 256 + lane * 4) = u;
    }
#pragma unroll
    for (int m = 32; m >= 1; m >>= 1) ss += __shfl_xor(ss, m);
    if (isx) { if (lane < 8) SX[(size_t)r * 8 + lane] = (lane == 0) ? ss : 0.f; }
    else if (lane == 0) SM[r - T] = ss;
  }
}

DI void run_epilogue(const Params& p, const Tile& t, char* smem) {
  float* Cs = (float*)smem;
  float* rs = (float*)(smem + RS_OFF);
  const int tid = ltid();
  const int q = tid & 15, rsub = tid >> 4;
  const int* pos = (const int*)p.in[2];
  if (t.epi == EP_VT) {
    const int c = tid >> 2, rq = tid & 3;
#pragma unroll
    for (int j = 0; j < 8; ++j) {
      float v[8];
#pragma unroll
      for (int e = 0; e < 8; ++e) { const int r = rq * 64 + j * 8 + e; v[e] = Cs[r * CS_LD + c] * rs[r]; }
      bf16_t* d16 = t.dst + (size_t)c * t.ldd + rq * 64 + (j >> 1) * 16;
      u2 lo, hi; lo.x = pack2(v[0], v[1]); lo.y = pack2(v[2], v[3]); hi.x = pack2(v[4], v[5]); hi.y = pack2(v[6], v[7]);
      *(u2*)(d16 + ((j & 1) ? 4 : 0)) = lo;
      *(u2*)(d16 + ((j & 1) ? 12 : 8)) = hi;
    }
    return;
  }
#pragma unroll 1
  for (int pass = 0; pass < 8; ++pass) {
    const int r = rsub + 32 * pass;
    const int row = t.row0 + r;
    float v[8];
    load8(Cs, r, q, v);
    const float rsv = rs[r];
#pragma unroll
    for (int e = 0; e < 8; ++e) v[e] *= rsv;
    switch (t.epi) {
      case EP_HEADROT: {
        const float* cr = Cs + r * CS_LD + 2 * q;
        float x1[2][2], x2[2][2];
#pragma unroll
        for (int m = 0; m < 2; ++m) {
          const fl2_t a = *(const fl2_t*)(cr + m * 64), b = *(const fl2_t*)(cr + m * 64 + 32);
          x1[m][0] = a.x * rsv; x1[m][1] = a.y * rsv; x2[m][0] = b.x * rsv; x2[m][1] = b.y * rsv;
        }
        float ssm[2];
#pragma unroll
        for (int m = 0; m < 2; ++m) {
          float ss = x1[m][0] * x1[m][0] + x1[m][1] * x1[m][1] + x2[m][0] * x2[m][0] + x2[m][1] * x2[m][1];
          ss += __shfl_xor(ss, 1); ss += __shfl_xor(ss, 2); ss += __shfl_xor(ss, 4); ss += __shfl_xor(ss, 8);
          ssm[m] = rsqrtf(ss * (1.f / 64) + EPSV) * t.oscale;
        }
        const int ps = pos[row];
        const fl2_t g1 = *(const fl2_t*)(t.gain + 2 * q), g2 = *(const fl2_t*)(t.gain + 32 + 2 * q);
        const float g1v[2] = {g1.x, g1.y}, g2v[2] = {g2.x, g2.y};
        float cc[2], sn[2];
#pragma unroll
        for (int e = 0; e < 2; ++e) rot_cs(ps, INVF64[2 * q + e], cc[e], sn[e]);
#pragma unroll
        for (int m = 0; m < 2; ++m) {
          float o1[2], o2[2];
#pragma unroll
          for (int e = 0; e < 2; ++e) {
            const float y1 = x1[m][e] * ssm[m] * g1v[e], y2 = x2[m][e] * ssm[m] * g2v[e];
            o1[e] = y1 * cc[e] - y2 * sn[e];
            o2[e] = y2 * cc[e] + y1 * sn[e];
          }
          bf16_t* d = t.dst + (size_t)row * t.ldd + t.cb * 128 + m * 64 + 2 * q;
          *(unsigned*)d = pack2(o1[0], o1[1]);
          *(unsigned*)(d + 32) = pack2(o2[0], o2[1]);
        }
      } break;
      case EP_PLAIN: {
        float ss = 0.f;
#pragma unroll
        for (int e = 0; e < 8; ++e) ss += v[e] * v[e];
        ss += __shfl_xor(ss, 1); ss += __shfl_xor(ss, 2); ss += __shfl_xor(ss, 4); ss += __shfl_xor(ss, 8);
        *(u4*)(t.dst + (size_t)row * t.ldd + t.cb * 128 + q * 8) = pack8(v);
        if (q == 0) t.ssq_out[row] = ss;
      } break;
      case EP_KROPE: {
        const bool first = (q & 2) == 0; const int i0 = (q & 1) * 8;
        const int ps = pos[row];
        float ov[8];
#pragma unroll
        for (int e = 0; e < 8; ++e) {
          const float yp = __shfl_xor(v[e], 2);
          float c, s; rot_cs(ps, INVF32[i0 + e], c, s);
          ov[e] = first ? (v[e] * c - yp * s) : (v[e] * c + yp * s);
        }
        if (q < 4) {
          float* kr = (float*)(p.ws + OFF_KR) + (size_t)row * 32 + q * 8;
          *(f4*)kr = f4{ov[0], ov[1], ov[2], ov[3]};
          *(f4*)(kr + 4) = f4{ov[4], ov[5], ov[6], ov[7]};
        }
      } break;
      case EP_NORM128: {
        float ss = 0.f;
#pragma unroll
        for (int e = 0; e < 8; ++e) ss += v[e] * v[e];
        ss += __shfl_xor(ss, 1); ss += __shfl_xor(ss, 2); ss += __shfl_xor(ss, 4); ss += __shfl_xor(ss, 8);
        const float rn = rsqrtf(ss * (1.f / 128) + EPSV);
#pragma unroll
        for (int e = 0; e < 8; ++e) v[e] *= rn * t.oscale * t.gain[q * 8 + e];
        *(u4*)(t.dst + (size_t)row * t.ldd + t.cb * 128 + q * 8) = pack8(v);
      } break;
      case EP_QB: {
        const bool isr = (q >= 8 && q < 12);
        const bool first = (q & 2) == 0; const int i0 = (q & 1) * 8;
        const int ps = pos[row];
        float ss = 0.f;
#pragma unroll
        for (int e = 0; e < 8; ++e) {
          const float yp = __shfl_xor(v[e], 2);
          float c, s; rot_cs(ps, INVF32[i0 + e], c, s);
          const float rv = first ? (v[e] * c - yp * s) : (v[e] * c + yp * s);
          v[e] = isr ? rv : v[e];
          ss += v[e] * v[e];
        }
        ss += __shfl_xor(ss, 1); ss += __shfl_xor(ss, 2); ss += __shfl_xor(ss, 4); ss += __shfl_xor(ss, 8);
        const float rn = rsqrtf(ss * (1.f / 96) + EPSV);
        if (q < 12) {
#pragma unroll
          for (int e = 0; e < 8; ++e) v[e] *= rn * t.oscale * t.gain[q * 8 + e];
          *(u4*)(t.dst + (size_t)row * 768 + t.cb * 96 + q * 8) = pack8(v);
        }
      } break;
      case EP_KVB: {
        if (q >= 8) {
          if (q < 12) {
            const float* kr = (const float*)(p.ws + OFF_KR) + (size_t)row * 32 + (q - 8) * 8;
            const f4 a = *(const f4*)kr, b = *(const f4*)(kr + 4);
            v[0] = a.x; v[1] = a.y; v[2] = a.z; v[3] = a.w; v[4] = b.x; v[5] = b.y; v[6] = b.z; v[7] = b.w;
          } else {
#pragma unroll
            for (int e = 0; e < 8; ++e) v[e] = 0.f;
          }
        }
        float ss = 0.f;
#pragma unroll
        for (int e = 0; e < 8; ++e) ss += v[e] * v[e];
        ss += __shfl_xor(ss, 1); ss += __shfl_xor(ss, 2); ss += __shfl_xor(ss, 4); ss += __shfl_xor(ss, 8);
        const float rn = rsqrtf(ss * (1.f / 96) + EPSV);
        if (q < 12) {
#pragma unroll
          for (int e = 0; e < 8; ++e) v[e] *= rn * t.oscale * t.gain[q * 8 + e];
          *(u4*)(t.dst + (size_t)row * 768 + t.cb * 96 + q * 8) = pack8(v);
        }
      } break;
      case EP_RES: {
        const float* xs = t.xsrc + (size_t)row * 1024 + t.cb * 128 + q * 8;
        const f4 a = *(const f4*)xs, b = *(const f4*)(xs + 4);
        v[0] += a.x; v[1] += a.y; v[2] += a.z; v[3] += a.w; v[4] += b.x; v[5] += b.y; v[6] += b.z; v[7] += b.w;
        float ss = 0.f;
#pragma unroll
        for (int e = 0; e < 8; ++e) ss += v[e] * v[e];
        ss += __shfl_xor(ss, 1); ss += __shfl_xor(ss, 2); ss += __shfl_xor(ss, 4); ss += __shfl_xor(ss, 8);
        float* xo = p.out + (size_t)row * 1024 + t.cb * 128 + q * 8;
        *(f4*)xo = f4{v[0], v[1], v[2], v[3]};
        *(f4*)(xo + 4) = f4{v[4], v[5], v[6], v[7]};
        *(u4*)(t.dst + (size_t)row * 1024 + t.cb * 128 + q * 8) = pack8(v);
        if (q == 0) t.ssq_out[(size_t)row * 8] = ss;
      } break;
      case EP_YTMP: {
        *(u4*)(t.dst + (size_t)r * 256 + t.cb * 128 + q * 8) = pack8(v);
      } break;
      case EP_GATE: {
        const u4 yu = *(const u4*)(t.ysrc + (size_t)r * 256 + q * 8);
        const f4 ba = *(const f4*)(t.gain + q * 8), bb = *(const f4*)(t.gain + q * 8 + 4);
        bf16_t* mp_ = t.dst + (size_t)row * 1024 + t.cb * 128 + q * 8;
        u4 mu; mu.x = mu.y = mu.z = mu.w = 0u;
        if (t.accum) mu = *(const u4*)mp_;
        const float bs[8] = {ba.x, ba.y, ba.z, ba.w, bb.x, bb.y, bb.z, bb.w};
        const unsigned yw[4] = {yu.x, yu.y, yu.z, yu.w}, mw[4] = {mu.x, mu.y, mu.z, mu.w};
#pragma unroll
        for (int e = 0; e < 8; ++e) {
          const float g = 1.f / (1.f + __expf(-(v[e] + bs[e])));
          const float y = __uint_as_float((e & 1) ? (yw[e >> 1] & 0xffff0000u) : (yw[e >> 1] << 16));
          const float m = __uint_as_float((e & 1) ? (mw[e >> 1] & 0xffff0000u) : (mw[e >> 1] << 16));
          v[e] = m + g * y;
        }
        *(u4*)mp_ = pack8(v);
      } break;
      case EP_MLP1: {
#pragma unroll
        for (int e = 0; e < 8; ++e) { const float u = fmaxf(v[e], 0.f); v[e] = u * u; }
        *(u4*)(t.dst + (size_t)row * t.ldd + t.cb * 128 + q * 8) = pack8(v);
      } break;
      default: break;
    }
  }
  if (t.epi == EP_KVB) {
    bf16_t* VMT = (bf16_t*)(p.ws + OFF_VMT);
    const int c = tid >> 3, r8 = tid & 7;
    const int b = t.row0 >> 11, s0 = t.row0 & 2047;
    bf16_t* d = VMT + ((size_t)(b * 512 + t.cb * 64 + c)) * SEQ + s0 + r8 * 32;
#pragma unroll
    for (int j = 0; j < 4; ++j) {
      float v[8];
#pragma unroll
      for (int e = 0; e < 8; ++e) { const int r = r8 * 32 + j * 8 + e; v[e] = Cs[r * CS_LD + 64 + c] * rs[r]; }
      bf16_t* d16 = d + (j >> 1) * 16;
      u2 lo, hi; lo.x = pack2(v[0], v[1]); lo.y = pack2(v[2], v[3]); hi.x = pack2(v[4], v[5]); hi.y = pack2(v[6], v[7]);
      *(u2*)(d16 + ((j & 1) ? 4 : 0)) = lo;
      *(u2*)(d16 + ((j & 1) ? 12 : 8)) = hi;
    }
  }
}

__global__ void __launch_bounds__(NTHR) mega_fwd(Params p) {
  __shared__ __attribute__((aligned(16))) char smem[LDS_BYTES];
  cg::grid_group grid = cg::this_grid();
  const int G = gridDim.x, bid = blockIdx.x;
  for (int ph = p.ph_lo; ph < p.ph_hi; ++ph) {
      char* ws = p.ws; asm volatile("" : "+s"(ws));
    bf16_t* XB = (bf16_t*)(ws + OFF_XB);   bf16_t* QD = (bf16_t*)(ws + OFF_QD);   bf16_t* KD = (bf16_t*)(ws + OFF_KD);
    bf16_t* VDT = (bf16_t*)(ws + OFF_VDT); bf16_t* CQ = (bf16_t*)(ws + OFF_CQ);   bf16_t* CKV = (bf16_t*)(ws + OFF_CKV);
    bf16_t* XQ = (bf16_t*)(ws + OFF_XQ);   bf16_t* QM = (bf16_t*)(ws + OFF_QM);   bf16_t* KM = (bf16_t*)(ws + OFF_KM);
    bf16_t* VMT = (bf16_t*)(ws + OFF_VMT); bf16_t* MEMB = (bf16_t*)(ws + OFF_MEMB); bf16_t* KC = (bf16_t*)(ws + OFF_KC);
    bf16_t* VCT = (bf16_t*)(ws + OFF_VCT); bf16_t* W = (bf16_t*)(ws + OFF_W);     bf16_t* U = (bf16_t*)(ws + OFF_U);
    bf16_t* MERGED = KD;
    float* SSQX = (float*)(ws + OFF_SSQX); float* SSQCQ = (float*)(ws + OFF_SSQCQ); float* SSQCKV = (float*)(ws + OFF_SSQCKV);
    float* SSQMEM = (float*)(ws + OFF_SSQMEM);

    if (ph == 0) {
      phase_init(p);
      prep_range(p, 0, 0, 5152, smem);
    } else {
      const int l = (ph - 1) / p.per, kr = (ph - 1) % p.per;
      const int k = (kr > p.dupk) ? kr - (p.per - 7) : kr;
#ifndef NO_GEMM
      if (k == 0 || k == 1 || k == 3 || k == 4 || k == 5 || k == 6) {
        int nits = 0, total = 0;
        if (k == 0) { nits = 18; total = 4480; if (l > 0) prep_range(p, l, 4128, 5152, smem); }
        else if (k == 1) { nits = 8; total = 2048; }
        else if (k == 3) { nits = 24; total = 1024; }
        else if (k == 4) { nits = 4; total = 1024; }
        else if (k == 5) { nits = 16; total = 4096; if (l + 1 < NL) prep_range(p, l + 1, 0, 3104, smem); }
        else { nits = 4; total = 1024; if (l + 1 < NL) prep_range(p, l + 1, 3104, 4128, smem); }
        const bool xmap = (G == 256);
        if (!xmap) nits = ((total + G - 1) / G) * ((k == 3) ? 6 : 1);
        int rs_row0 = -1;
#pragma unroll 1
        for (int it = 0; it < nits; ++it) {
          int list = 0, rb = -1, CB = 0;
          if (xmap) {
            if (k == 0) {
              if (it < 16) map_regular(it, bid, 16, rb, CB);
              else if (it == 16) { rb = bid; CB = 16; }
              else if (bid < 128) { list = 1; rb = bid >> 2; CB = bid & 3; }
            } else if (k == 1) { list = it >> 2; map_regular(it & 3, bid, 4, rb, CB); }
            else if (k == 3) map_regular(it / 6, bid, 4, rb, CB);
            else if (k == 5) map_regular(it, bid, 16, rb, CB);
            else map_regular(it, bid, 4, rb, CB);
          } else {
            const int li = ((k == 3) ? (it / 6) : it) * G + bid;
            if (li < total) {
              if (k == 0) { if (li < 4352) { rb = li / 17; CB = li % 17; } else { list = 1; rb = (li - 4352) >> 2; CB = (li - 4352) & 3; } }
              else if (k == 1) { list = li >> 10; rb = (li & 1023) >> 2; CB = li & 3; }
              else if (k == 5) { rb = li >> 4; CB = li & 15; }
              else { rb = li >> 2; CB = li & 3; }
            }
          }
          if (rb < 0) continue;
          const int row0 = rb * 256;
          const bf16_t* Ap; const bf16_t* Bp; int lda, Kd;
          const float* ssq = nullptr; int nparts = 0, pstride = T; float invK = 0.f;
          if (k == 0) {
            if (list == 0) { Ap = XB + (size_t)row0 * 1024; lda = 1024; Bp = W + W_IN + (size_t)CB * 256 * 1024; Kd = 1024; ssq = SSQX; nparts = 8; pstride = 1; invK = 1.f / 1024; }
            else           { Ap = MEMB + (size_t)row0 * 1024; lda = 1024; Bp = W + W_MEM + (size_t)CB * 256 * 1024; Kd = 1024; ssq = SSQMEM; nparts = 1; pstride = 0; invK = 1.f / 1024; }
          } else if (k == 1) {
            if (list == 0) { Ap = CQ + (size_t)row0 * 384; lda = 384; Bp = W + W_QB + (size_t)CB * 256 * 384; Kd = 384; ssq = SSQCQ; nparts = 3; invK = 1.f / 384; }
            else           { Ap = CKV + (size_t)row0 * 256; lda = 256; Bp = W + W_KVB + (size_t)CB * 256 * 256; Kd = 256; ssq = SSQCKV; nparts = 2; invK = 1.f / 256; }
          } else if (k == 3) {
            const int st = it % 6, br = st >> 1;
            if (st & 1)       { Ap = XB + (size_t)row0 * 1024; lda = 1024; Bp = W + W_IN + (size_t)(WIN_GATE0 + br * 1024 + CB * 256) * 1024; Kd = 1024; ssq = SSQX; nparts = 8; pstride = 1; invK = 1.f / 1024; }
            else if (br == 0) { Ap = QD + (size_t)row0 * 1024; lda = 1024; Bp = W + W_DO + (size_t)CB * 256 * 1024; Kd = 1024; }
            else if (br == 1) { Ap = QM + (size_t)row0 * 768;  lda = 768;  Bp = W + W_MO + (size_t)CB * 256 * 768;  Kd = 768; }
            else              { Ap = XQ + (size_t)row0 * 512;  lda = 512;  Bp = W + W_CO + (size_t)CB * 256 * 512;  Kd = 512; }
          } else if (k == 4) { Ap = MERGED + (size_t)row0 * 1024; lda = 1024; Bp = W + W_OUT + (size_t)CB * 256 * 1024; Kd = 1024; }
          else if (k == 5)   { Ap = XB + (size_t)row0 * 1024; lda = 1024; Bp = W + W_1 + (size_t)CB * 256 * 1024; Kd = 1024; ssq = SSQX; nparts = 8; pstride = 1; invK = 1.f / 1024; }
          else               { Ap = U + (size_t)row0 * 4096; lda = 4096; Bp = W + W_2 + (size_t)CB * 256 * 4096; Kd = 4096; }
          f32x4v acc[2][2][4][2];
          gemm8p(Ap, Bp, Kd, acc, smem);
          float* Cs = (float*)smem;
          if (k == 5 || k == 3) {
            float* rsL = (float*)(smem + RS_OFF);
            if (ssq != nullptr && !(ssq == SSQX && rs_row0 == row0)) {
              fill_rs(rsL, ssq, nparts, pstride, row0, invK);
              __syncthreads();
              rs_row0 = (ssq == SSQX) ? row0 : -1;
            }
            const int tq = ltid(); const int lane = tq & 63, wave = tq >> 6, wr = wave >> 2, wc = wave & 3, fr = lane & 15, fq = lane >> 4;
            const int st = it % 6, br = st >> 1;
            bf16_t* YS = VDT + (size_t)blockIdx.x * 65536;
#pragma unroll
            for (int ai = 0; ai < 2; ++ai)
#pragma unroll
              for (int m = 0; m < 4; ++m) {
                const int row = ai * 128 + wr * 64 + m * 16 + fr;
                const float rsv = rsL[row];
#pragma unroll
                for (int bj = 0; bj < 2; ++bj)
#pragma unroll
                  for (int n = 0; n < 2; ++n) {
                    const int col = bj * 128 + wc * 32 + n * 16 + fq * 4;
                    const f32x4v a4 = acc[ai][bj][m][n];
                    float o4[4];
                    if (k == 5) {
#pragma unroll
                      for (int j = 0; j < 4; ++j) { const float u = fmaxf(a4[j] * rsv, 0.f); o4[j] = u * u; }
                      u2 w; w.x = pack2(o4[0], o4[1]); w.y = pack2(o4[2], o4[3]);
                      *(u2*)(U + (size_t)(row0 + row) * 4096 + CB * 256 + col) = w;
                    } else if (!(st & 1)) {
                      u2 w; w.x = pack2(a4[0], a4[1]); w.y = pack2(a4[2], a4[3]);
                      *(u2*)(YS + (size_t)row * 256 + col) = w;
                    } else {
                      const f4 bs = *(const f4*)(p.in[5] + (size_t)l * 3072 + br * 1024 + CB * 256 + col);
                      const u2 yu = *(const u2*)(YS + (size_t)row * 256 + col);
                      bf16_t* mp_ = MERGED + (size_t)(row0 + row) * 1024 + CB * 256 + col;
                      u2 mu; mu.x = mu.y = 0u;
                      if (br > 0) mu = *(const u2*)mp_;
                      const float bsv[4] = {bs.x, bs.y, bs.z, bs.w};
                      const unsigned yw[2] = {yu.x, yu.y}, mw[2] = {mu.x, mu.y};
#pragma unroll
                      for (int j = 0; j < 4; ++j) {
                        const float g = 1.f / (1.f + __expf(-(a4[j] * rsv + bsv[j])));
                        const float y = __uint_as_float((j & 1) ? (yw[j >> 1] & 0xffff0000u) : (yw[j >> 1] << 16));
                        const float mv = __uint_as_float((j & 1) ? (mw[j >> 1] & 0xffff0000u) : (mw[j >> 1] << 16));
                        o4[j] = mv + g * y;
                      }
                      u2 w; w.x = pack2(o4[0], o4[1]); w.y = pack2(o4[2], o4[3]);
                      *(u2*)mp_ = w;
                    }
                  }
              }
          } else
#pragma unroll 1
          for (int half = 0; half < 2; ++half) {
            if (half) __syncthreads();
            {
              const int tq = ltid(); const int lane = tq & 63, wave = tq >> 6, wr = wave >> 2, wc = wave & 3, fr = lane & 15, fq = lane >> 4;
#pragma unroll
              for (int ai = 0; ai < 2; ++ai)
#pragma unroll
                for (int m = 0; m < 4; ++m)
#pragma unroll
                  for (int n = 0; n < 2; ++n) {
                    f32x4v v4;
#pragma unroll
                    for (int j = 0; j < 4; ++j) v4[j] = half ? acc[ai][1][m][n][j] : acc[ai][0][m][n][j];
                    *(f32x4v*)(Cs + (ai * 128 + wr * 64 + m * 16 + fr) * CS_LD + wc * 32 + n * 16 + fq * 4) = v4;
                  }
            }
            if (half == 0 && !(ssq == SSQX && rs_row0 == row0)) {
              fill_rs((float*)(smem + RS_OFF), ssq, nparts, pstride, row0, invK);
              rs_row0 = (ssq == SSQX) ? row0 : -1;
            }
            __syncthreads();
            const int cb = CB * 2 + half;
            Tile t;
            t.row0 = row0; t.cb = cb; t.epi = EP_PLAIN;
            t.dst = nullptr; t.ldd = 0; t.gain = nullptr; t.ssq_out = nullptr; t.xsrc = nullptr; t.oscale = 1.f; t.ysrc = nullptr; t.accum = 0;
            if (k == 0) {
              if (list == 0) {
                if (cb < 8)       { t.epi = EP_HEADROT; t.cb = cb; t.dst = QD; t.ldd = 1024; t.gain = p.in[6] + l * 64; t.oscale = 0.125f * 1.4426950408889634f; }
                else if (cb < 16) { t.epi = EP_HEADROT; t.cb = cb - 8; t.dst = KD; t.ldd = 1024; t.gain = p.in[7] + l * 64; }
                else if (cb < 24) { t.epi = EP_VT; t.cb = cb - 16; const int b = row0 >> 11, s0 = row0 & 2047; t.dst = VDT + ((size_t)(b * 1024 + (cb - 16) * 128)) * SEQ + s0; t.ldd = SEQ; }
                else if (cb < 27) { t.epi = EP_PLAIN; t.cb = cb - 24; t.dst = CQ; t.ldd = 384; t.ssq_out = SSQCQ + (size_t)(cb - 24) * T; }
                else if (cb < 29) { t.epi = EP_PLAIN; t.cb = cb - 27; t.dst = CKV; t.ldd = 256; t.ssq_out = SSQCKV + (size_t)(cb - 27) * T; }
                else if (cb == 29) { t.epi = EP_KROPE; t.cb = 0; }
                else              { t.epi = EP_NORM128; t.cb = cb - 30; t.dst = XQ; t.ldd = 512; t.gain = p.in[20] + l * 128; t.oscale = 0.08838834764831845f * 1.4426950408889634f; }
              } else {
                if (cb < 4) { t.epi = EP_NORM128; t.cb = cb; t.dst = KC; t.ldd = 512; t.gain = p.in[21] + l * 128; }
                else        { t.epi = EP_VT; t.cb = cb - 4; t.dst = VCT + ((size_t)(rb * 512 + (cb - 4) * 128)) * MEML; t.ldd = MEML; }
              }
            } else if (k == 1) {
              if (list == 0) { t.epi = EP_QB; t.dst = QM; t.gain = p.in[15] + l * 96; t.oscale = 0.10206207261596575f * 1.4426950408889634f; }
              else           { t.epi = EP_KVB; t.dst = KM; t.gain = p.in[16] + l * 96; }
            } else if (k == 3) {
              const int st = it % 6, br = st >> 1;
              bf16_t* YS = VDT + (size_t)blockIdx.x * 65536;
              if (st & 1) { t.epi = EP_GATE; t.dst = MERGED; t.ysrc = YS + half * 128; t.gain = p.in[5] + (size_t)l * 3072 + br * 1024 + cb * 128; t.accum = (br > 0); }
              else        { t.epi = EP_YTMP; t.dst = YS; t.cb = half; }
            } else if (k == 4) { t.epi = EP_RES; t.dst = XB; t.xsrc = (l == 0) ? p.in[0] : p.out; t.ssq_out = SSQX + cb; }
            else if (k == 5)   { t.epi = EP_MLP1; t.dst = U; t.ldd = 4096; }
            else               { t.epi = EP_RES; t.dst = XB; t.xsrc = p.out; t.ssq_out = SSQX + cb; }
            run_epilogue(p, t, smem);
          }
        }
      } else
#endif
#ifndef NO_ATT
      if (k == 2) {
        float lam;
        const float lam_init = 0.8f - 0.6f * expf(-0.3f * (float)l);
        {
          const int lane = ltid() & 63;
          const float* lv = p.in[8] + l * 256;
          float sa = lv[lane] * lv[64 + lane], sb = lv[128 + lane] * lv[192 + lane];
#pragma unroll
          for (int m = 32; m >= 1; m >>= 1) { sa += __shfl_xor(sa, m); sb += __shfl_xor(sb, m); }
          lam = expf(sa) - expf(sb) + lam_init;
        }
        const float L2E = 1.4426950408889634f;
#pragma unroll 1
        for (int it = 0; it < ((G == 256) ? 16 : (4096 + G - 1) / G); ++it) {
          int w;
          if (G == 256) {
            const int xcd = bid & 7, slot = bid >> 3;
            if (it < 8)       w = ((it * 32 + (slot >> 3) * 8 + xcd) << 3) + (slot & 7);
            else if (it < 12) w = 2048 + ((((it - 8) * 64 + (slot >> 2) * 8 + xcd) << 2) + (slot & 3));
            else              w = 3072 + ((((it - 12) * 32 + (slot >> 3) * 8 + xcd) << 3) + (slot & 7));
          } else { w = it * G + bid; if (w >= 4096) continue; }
#ifndef NO_A1
          if (w < 2048) {
            const int bh = w >> 3, j = w & 7, b = bh >> 3, hh = bh & 7;
#pragma unroll 1
            for (int half = 0; half < 2; ++half) {
              const int qb = half ? j : 15 - j;
              const int q0 = qb * 128;
              bf16_t* Qp = QD + ((size_t)(b * SEQ + q0)) * 1024 + hh * 128;
              attn_block<64, 128, 2, true>(Qp, 1024, KD + (size_t)b * SEQ * 1024 + hh * 128, 1024, VDT + ((size_t)(b * 1024 + hh * 128)) * SEQ, SEQ,
                                            (q0 + 128) >> 6, q0, Qp, 1024, 0.125f * L2E, lam, p.in[9] + l * 128, 1.f - lam_init, smem);
            }
          } else
#endif
#ifndef NO_A2
          if (w < 3072) {
            const int wj = w - 2048; const int bh = wj >> 2, j = wj & 3, b = bh >> 3, hh = bh & 7;
#pragma unroll 1
            for (int half = 0; half < 2; ++half) {
              const int qb = half ? j : 7 - j;
              const int q0 = qb * 256;
              bf16_t* Qp = QM + ((size_t)(b * SEQ + q0)) * 768 + hh * 96;
              attn_block<96, 64, 1, true>(Qp, 768, KM + (size_t)b * SEQ * 768 + hh * 96, 768, VMT + ((size_t)(b * 512 + hh * 64)) * SEQ, SEQ,
                                           (q0 + 256) >> 6, q0, Qp, 768, 0.10206207261596575f * L2E, 0.f, nullptr, 1.f, smem);
            }
          } else
#endif
#ifndef NO_A3
          {
            const int wj = w - 3072; const int bh = wj >> 3, qb = wj & 7, b = bh >> 2, hh = bh & 3;
            const int q0 = qb * 256;
            bf16_t* Qp = XQ + ((size_t)(b * SEQ + q0)) * 512 + hh * 128;
            attn_block<128, 128, 1, false>(Qp, 512, KC + (size_t)b * MEML * 512 + hh * 128, 512, VCT + ((size_t)(b * 512 + hh * 128)) * MEML, MEML,
                                            4, q0, Qp, 512, 0.08838834764831845f * L2E, 0.f, nullptr, 1.f, smem);
          }
#endif
          {}
        }
      } else
#endif
#ifndef NO_D
      if (k == 3) {
        float* Cs = (float*)smem;
        float* rs = (float*)(smem + RS_OFF);
#pragma unroll 1
        for (int it = 0; it < ((G == 256) ? 8 : (2048 + G - 1) / G); ++it) {
          int rb, cb;
          if (G == 256) map_regular(it, bid, 8, rb, cb);
          else { const int li = it * G + bid; if (li >= 2048) continue; rb = li >> 3; cb = li & 7; }
          const int tidd = ltid(); const int lane = tidd & 63, wave = tidd >> 6, wm = wave >> 1, wn = wave & 1, h = lane >> 5;
          const int row0 = rb * 256, col0 = cb * 128;
          __syncthreads();
          fill_rs(rs, SSQX, 8, T, row0, 1.f / 1024);
          f32x16 acc[2][2];
          unsigned gp[2][2][8], mp[2][2][8];
#pragma unroll
          for (int mi = 0; mi < 2; ++mi)
#pragma unroll
            for (int ni = 0; ni < 2; ++ni)
#pragma unroll
              for (int i = 0; i < 8; ++i) mp[mi][ni][i] = 0u;
#pragma unroll 1
          for (int st = 0; st < 6; ++st) {
            const int br = st >> 1, half = st & 1;
            const bf16_t* Ab; const bf16_t* Bb; int Kb;
            if (half == 0)    { Ab = XB + (size_t)row0 * 1024; Bb = W + W_IN + (size_t)(WIN_GATE0 + br * 1024 + col0) * 1024; Kb = 1024; }
            else if (br == 0) { Ab = QD + (size_t)row0 * 1024; Bb = W + W_DO + (size_t)col0 * 1024; Kb = 1024; }
            else if (br == 1) { Ab = QM + (size_t)row0 * 768;  Bb = W + W_MO + (size_t)col0 * 768;  Kb = 768; }
            else              { Ab = XQ + (size_t)row0 * 512;  Bb = W + W_CO + (size_t)col0 * 512;  Kb = 512; }
            gemm_mainloop<2, 2, 2, false>(Ab, Kb, Bb, Kb, Kb, acc, smem);
            if (half == 0) {
              const float* bg = p.in[5] + (size_t)l * 3072 + br * 1024 + col0 + wn * 64 + (lane & 31);
              const float bgv0 = bg[0], bgv1 = bg[32];
#pragma unroll
              for (int mi = 0; mi < 2; ++mi) {
                float rsv[16];
#pragma unroll
                for (int i = 0; i < 16; ++i) rsv[i] = rs[wm * 64 + mi * 32 + crow(i, h)];
#pragma unroll
                for (int ni = 0; ni < 2; ++ni) {
                  const float bgv = ni ? bgv1 : bgv0;
#pragma unroll
                  for (int i = 0; i < 16; i += 2) {
                    const float z0 = acc[mi][ni][i] * rsv[i] + bgv;
                    const float z1 = acc[mi][ni][i + 1] * rsv[i + 1] + bgv;
                    gp[mi][ni][i >> 1] = pack2(1.f / (1.f + __expf(-z0)), 1.f / (1.f + __expf(-z1)));
                  }
                }
                __builtin_amdgcn_sched_barrier(0);
              }
            } else {
#pragma unroll
              for (int mi = 0; mi < 2; ++mi)
#pragma unroll
                for (int ni = 0; ni < 2; ++ni)
#pragma unroll
                  for (int i = 0; i < 16; i += 2) {
                    const unsigned g2 = gp[mi][ni][i >> 1], m2 = mp[mi][ni][i >> 1];
                    const float m0 = __uint_as_float(m2 << 16) + __uint_as_float(g2 << 16) * acc[mi][ni][i];
                    const float m1 = __uint_as_float(m2 & 0xffff0000u) + __uint_as_float(g2 & 0xffff0000u) * acc[mi][ni][i + 1];
                    mp[mi][ni][i >> 1] = pack2(m0, m1);
                  }
            }
          }
#pragma unroll
          for (int mi = 0; mi < 2; ++mi)
#pragma unroll
            for (int ni = 0; ni < 2; ++ni)
#pragma unroll
              for (int i = 0; i < 16; ++i) {
                const unsigned m2 = mp[mi][ni][i >> 1];
                Cs[(wm * 64 + mi * 32 + crow(i, h)) * CS_LD + wn * 64 + ni * 32 + (lane & 31)] = __uint_as_float((i & 1) ? (m2 & 0xffff0000u) : (m2 << 16));
              }
          __syncthreads();
          const int q = tidd & 15, rsub = tidd >> 4;
#pragma unroll 1
          for (int pass = 0; pass < 8; ++pass) {
            const int r = rsub + 32 * pass;
            float v[8];
            load8(Cs, r, q, v);
            *(u4*)(MERGED + (size_t)(row0 + r) * 1024 + col0 + q * 8) = pack8(v);
          }
        }
      }
#endif
      {}
    }
    if (ph + 1 < p.ph_hi) grid.sync();
  }
}

extern "C" void kernel_launch(void* const* d_in, const int* in_sizes, int n_in, void* d_out, int out_size, void* d_ws, size_t ws_size, hipStream_t stream) {
  static int grid_blocks = 0;
  if (grid_blocks == 0) {
    if (n_in != 27 || ws_size < WS_NEED) { fprintf(stderr, "kernel_launch: unexpected inputs (n_in %d) or workspace (%zu < %zu)\n", n_in, ws_size, (size_t)WS_NEED); grid_blocks = -1; return; }
    int dev = 0, cus = 0, per_cu = 0;
    hipGetDevice(&dev);
    hipDeviceGetAttribute(&cus, hipDeviceAttributeMultiprocessorCount, dev);
    hipOccupancyMaxActiveBlocksPerMultiprocessor(&per_cu, mega_fwd, NTHR, 0);
    if (per_cu < 1) per_cu = 1;
    if (per_cu > 1) per_cu = 1;
    grid_blocks = cus * per_cu;
  }
  if (grid_blocks < 0) return;
  Params p{};
  for (int i = 0; i < 27; ++i) p.in[i] = (const float*)d_in[i];
  p.out = (float*)d_out;
  p.ws = (char*)d_ws;
  p.ph_lo = 0;
  p.dupk = (DUP_K >= 0) ? DUP_K : 100;
  p.per = (DUP_K >= 0) ? 8 : 7;
  p.ph_hi = 1 + NL * p.per;
  void* args[] = {&p};
  hipError_t e = hipLaunchCooperativeKernel((void*)mega_fwd, dim3(grid_blocks), dim3(NTHR), args, 0, stream);
  if (e != hipSuccess) fprintf(stderr, "cooperative launch failed: %s (grid %d)\n", hipGetErrorString(e), grid_blocks);
}
```

```cpp
#include <hip/hip_runtime.h>
#include <hip/hip_cooperative_groups.h>
#include <stdint.h>
#include <stdio.h>
#define NO_D 1
namespace cg = cooperative_groups;

typedef unsigned short bf16_t;
using bf16x8 = __attribute__((ext_vector_type(8))) short;
using f32x16 = __attribute__((ext_vector_type(16))) float;
typedef unsigned u4 __attribute__((ext_vector_type(4)));
typedef unsigned u2 __attribute__((ext_vector_type(2)));
typedef float f4 __attribute__((ext_vector_type(4)));
#define DI __device__ __forceinline__
#define MFMA(a, b, c) __builtin_amdgcn_mfma_f32_32x32x16_bf16((a), (b), (c), 0, 0, 0)

constexpr int T = 65536, DM = 1024, NB = 32, SEQ = 2048, NL = 4, MEML = 256, MEMR = NB * MEML;
constexpr int NTHR = 512;
constexpr int DUP_K = -1;
constexpr float EPSV = 1e-6f;
constexpr int WIN_N = 7424;
constexpr int WIN_GATE0 = 4352;

constexpr size_t MiB = 1024ull * 1024ull;
constexpr size_t OFF_XB = 0;
constexpr size_t OFF_QD = OFF_XB + 128 * MiB;
constexpr size_t OFF_KD = OFF_QD + 128 * MiB;
constexpr size_t OFF_VDT = OFF_KD + 128 * MiB;
constexpr size_t OFF_CQ = OFF_VDT + 128 * MiB;
constexpr size_t OFF_CKV = OFF_CQ + 48 * MiB;
constexpr size_t OFF_KR = OFF_CKV + 32 * MiB;
constexpr size_t OFF_XQ = OFF_KR + 8 * MiB;
constexpr size_t OFF_QM = OFF_XQ + 64 * MiB;
constexpr size_t OFF_KM = OFF_QM + 96 * MiB;
constexpr size_t OFF_VMT = OFF_KM + 96 * MiB;
constexpr size_t OFF_MEMB = OFF_VMT + 64 * MiB;
constexpr size_t OFF_KC = OFF_MEMB + 16 * MiB;
constexpr size_t OFF_VCT = OFF_KC + 8 * MiB;
constexpr size_t OFF_SSQX = OFF_VCT + 8 * MiB;
constexpr size_t OFF_SSQCQ = OFF_SSQX + 2 * MiB;
constexpr size_t OFF_SSQCKV = OFF_SSQCQ + 1 * MiB;
constexpr size_t OFF_SSQMEM = OFF_SSQCKV + 1 * MiB;
constexpr size_t OFF_W = OFF_SSQMEM + 1 * MiB;
constexpr size_t OFF_U = OFF_QD;
constexpr size_t W_IN = 0;
constexpr size_t W_MEM = W_IN + (size_t)WIN_N * 1024;
constexpr size_t W_QB = W_MEM + 1024 * 1024;
constexpr size_t W_KVB = W_QB + 1024 * 384;
constexpr size_t W_DO = W_KVB + 1024 * 256;
constexpr size_t W_MO = W_DO + 1024 * 1024;
constexpr size_t W_CO = W_MO + 1024 * 768;
constexpr size_t W_OUT = W_CO + 1024 * 512;
constexpr size_t W_1 = W_OUT + 1024 * 1024;
constexpr size_t W_2 = W_1 + 4096 * 1024;
constexpr size_t W_END = W_2 + 4096 * 1024;
constexpr size_t WS_NEED = OFF_W + W_END * 2;

constexpr int LDS_ROW = 144;
constexpr int CS_LD = 132;
constexpr int CS_BYTES = 256 * CS_LD * 4;
constexpr int RS_OFF = 2 * 512 * LDS_ROW;
constexpr int LDS_BYTES = RS_OFF + 1024;

__constant__ float INVF64[32] = {1.000000000e+00f,7.498942614e-01f,5.623413324e-01f,4.216965139e-01f,3.162277639e-01f,2.371373773e-01f,1.778279394e-01f,1.333521307e-01f,1.000000015e-01f,7.498941571e-02f,5.623413250e-02f,4.216965288e-02f,3.162277490e-02f,2.371373773e-02f,1.778279431e-02f,1.333521493e-02f,9.999999776e-03f,7.498941850e-03f,5.623413250e-03f,4.216964822e-03f,3.162277630e-03f,2.371373586e-03f,1.778279431e-03f,1.333521446e-03f,1.000000047e-03f,7.498942432e-04f,5.623413017e-04f,4.216965172e-04f,3.162277571e-04f,2.371373703e-04f,1.778279402e-04f,1.333521504e-04f};
__constant__ float INVF32[16] = {1.000000000e+00f,5.623413324e-01f,3.162277639e-01f,1.778279394e-01f,1.000000015e-01f,5.623413250e-02f,3.162277490e-02f,1.778279431e-02f,9.999999776e-03f,5.623413250e-03f,3.162277630e-03f,1.778279431e-03f,1.000000047e-03f,5.623413017e-04f,3.162277571e-04f,1.778279402e-04f};

struct Params {
  const float* in[27];
  float* out;
  char* ws;
  int ph_lo, ph_hi;
  int dupk, per;
};

typedef __bf16 bf2_t __attribute__((ext_vector_type(2)));
typedef float fl2_t __attribute__((ext_vector_type(2)));
DI unsigned pack2(float a, float b) { fl2_t f = {a, b}; bf2_t r = __builtin_convertvector(f, bf2_t); return __builtin_bit_cast(unsigned, r); }
DI u4 pack8(const float* v) { u4 u; u.x = pack2(v[0], v[1]); u.y = pack2(v[2], v[3]); u.z = pack2(v[4], v[5]); u.w = pack2(v[6], v[7]); return u; }
DI int ltid() { int t = threadIdx.x; asm volatile("" : "+v"(t)); return t; }
DI int crow(int i, int h) { return (i & 3) + 8 * (i >> 2) + 4 * h; }
DI void rot_cs(int pos, float invf, float& c, float& s) {
  const float ang = (float)pos * invf;
  double rev = (double)ang * 0.15915494309189535;
  rev -= floor(rev);
  const float rf = (float)rev;
  c = __builtin_amdgcn_cosf(rf);
  s = __builtin_amdgcn_sinf(rf);
}
DI void load8(const float* Cs, int r, int q, float* v) {
  const f4 a = *(const f4*)(Cs + r * CS_LD + q * 8);
  const f4 b = *(const f4*)(Cs + r * CS_LD + q * 8 + 4);
  v[0] = a.x; v[1] = a.y; v[2] = a.z; v[3] = a.w; v[4] = b.x; v[5] = b.y; v[6] = b.z; v[7] = b.w;
}

template <int MI, int NI, int WGN, bool FDB>
DI void gemm_mainloop(const bf16_t* __restrict__ A, int lda, const bf16_t* __restrict__ B, int ldb, int K, f32x16 (&acc)[MI][NI], char* smem) {
  constexpr int BM = (8 / WGN) * MI * 32, BN = WGN * NI * 32;
  constexpr int ASZ = BM * 64, STAGE = (BM + BN) * 64;
  constexpr int NGA = BM / 128, NGB = BN / 128, NLD = NGA + NGB;
  static_assert(4 * STAGE <= RS_OFF, "ring");
  const int tid = ltid(), lane = tid & 63, wave = tid >> 6, l31 = lane & 31, h = lane >> 5;
  const int wu = __builtin_amdgcn_readfirstlane(wave);
  const int wm = wave / WGN, wn = wave % WGN;
  const int lrow = lane >> 2, lchk = (lane & 3) ^ ((lane >> 4) & 3);
  const bf16_t* ga = A + (size_t)(wu * NGA * 16 + lrow) * lda + lchk * 8;
  const bf16_t* gb = B + (size_t)(wu * NGB * 16 + lrow) * ldb + lchk * 8;
#pragma unroll
  for (int mi = 0; mi < MI; ++mi)
#pragma unroll
    for (int ni = 0; ni < NI; ++ni)
#pragma unroll
      for (int i = 0; i < 16; ++i) acc[mi][ni][i] = 0.f;
  auto issue = [&](int j) {
    char* st = smem + (j & 3) * STAGE;
    const int k0 = j * 32;
#pragma unroll
    for (int i = 0; i < NGA; ++i)
      __builtin_amdgcn_global_load_lds((const unsigned*)(ga + (size_t)(i * 16) * lda + k0), (unsigned*)(st + (wu * NGA + i) * 1024), 16, 0, 0);
#pragma unroll
    for (int i = 0; i < NGB; ++i)
      __builtin_amdgcn_global_load_lds((const unsigned*)(gb + (size_t)(i * 16) * ldb + k0), (unsigned*)(st + ASZ + (wu * NGB + i) * 1024), 16, 0, 0);
  };
  asm volatile("s_waitcnt vmcnt(0)" ::: "memory");
  __syncthreads();
  const int nk = K >> 5;
  issue(0); issue(1); issue(2);
  const int sw = (l31 >> 2) & 3;
  const int oa = (wm * MI * 32 + l31) * 64, ob = ASZ + (wn * NI * 32 + l31) * 64;
  const int c0 = ((0 + h) ^ sw) * 16, c1 = ((2 + h) ^ sw) * 16;
#pragma unroll 1
  for (int j = 0; j < nk; ++j) {
    if (j + 2 < nk) asm volatile("s_waitcnt vmcnt(%0)" ::"n"(2 * NLD) : "memory");
    else if (j + 1 < nk) asm volatile("s_waitcnt vmcnt(%0)" ::"n"(NLD) : "memory");
    else asm volatile("s_waitcnt vmcnt(0)" ::: "memory");
    asm volatile("s_waitcnt lgkmcnt(0)" ::: "memory");
    __builtin_amdgcn_s_barrier();
    if (j + 3 < nk) issue(j + 3);
    const char* st = smem + (j & 3) * STAGE;
    const char* pa = st + oa;
    const char* pb = st + ob;
    bf16x8 fa0[MI], fb0[NI], fa1[MI], fb1[NI];
#pragma unroll
    for (int mi = 0; mi < MI; ++mi) fa0[mi] = *(const bf16x8*)(pa + mi * 2048 + c0);
#pragma unroll
    for (int ni = 0; ni < NI; ++ni) fb0[ni] = *(const bf16x8*)(pb + ni * 2048 + c0);
    if (FDB) {
#pragma unroll
      for (int mi = 0; mi < MI; ++mi) fa1[mi] = *(const bf16x8*)(pa + mi * 2048 + c1);
#pragma unroll
      for (int ni = 0; ni < NI; ++ni) fb1[ni] = *(const bf16x8*)(pb + ni * 2048 + c1);
    }
#pragma unroll
    for (int mi = 0; mi < MI; ++mi)
#pragma unroll
      for (int ni = 0; ni < NI; ++ni) acc[mi][ni] = MFMA(fa0[mi], fb0[ni], acc[mi][ni]);
    __builtin_amdgcn_sched_barrier(0);
    if (!FDB) {
#pragma unroll
      for (int mi = 0; mi < MI; ++mi) fa1[mi] = *(const bf16x8*)(pa + mi * 2048 + c1);
#pragma unroll
      for (int ni = 0; ni < NI; ++ni) fb1[ni] = *(const bf16x8*)(pb + ni * 2048 + c1);
    }
#pragma unroll
    for (int mi = 0; mi < MI; ++mi)
#pragma unroll
      for (int ni = 0; ni < NI; ++ni) acc[mi][ni] = MFMA(fa1[mi], fb1[ni], acc[mi][ni]);
    __builtin_amdgcn_sched_barrier(0);
  }
  asm volatile("s_waitcnt lgkmcnt(0)" ::: "memory");
  __builtin_amdgcn_s_barrier();
}

using f32x4v = __attribute__((ext_vector_type(4))) float;
DI int lds_byte8(int r, int c) {
  const int st = (r >> 4) * 2 + (c >> 5), rr = r & 15, cc = c & 31, ob = rr * 64 + cc * 2;
  return st * 1024 + (ob ^ (((ob >> 9) & 1) << 5));
}
DI void stage_rc8(int b, int& R, int& C) {
  const int st = b / 1024, sb = b % 1024, swz = sb ^ (((sb >> 9) & 1) << 5);
  R = (st >> 1) * 16 + swz / 64; C = (st & 1) * 32 + (swz % 64) / 2;
}
DI void gemm8p(const bf16_t* __restrict__ A, const bf16_t* __restrict__ Bt, int K, f32x4v (&acc)[2][2][4][2], char* smem) {
  constexpr int BK8 = 64, HALF8 = 128, HTB = HALF8 * BK8 * 2;
  const int tid = ltid(), wid = tid >> 6, lane = tid & 63, wr = wid >> 2, wc = wid & 3, fr = lane & 15, fq = lane >> 4;
  const int wu8 = __builtin_amdgcn_readfirstlane(wid);
  unsigned goff[2];
#pragma unroll
  for (int i_ = 0; i_ < 2; ++i_) { int r_, c_; stage_rc8(tid * 16 + i_ * 8192, r_, c_); goff[i_] = (unsigned)(r_ * K + c_); }
  const int lfrag = ((fr * 64 + fq * 16) ^ ((fr >> 3) << 5));
  const char* la = smem + wr * 8192 + lfrag;
  const char* lb = smem + 4 * HTB + wc * 4096 + lfrag;
#define SA8(b, h) ((b) * 2 + (h))
#define SB8(b, h) (4 + (b) * 2 + (h))
#define STAGE8(Q, BASE, br, kt) do { const bf16_t* sb_ = (BASE) + ((long)(br) * K + (long)(kt) * BK8); \
    _Pragma("unroll") for (int i_ = 0; i_ < 2; ++i_) \
      __builtin_amdgcn_global_load_lds((const unsigned*)(sb_ + goff[i_]), (unsigned*)(smem + (Q) * HTB + i_ * 8192 + wu8 * 1024), 16, 0, 0); } while (0)
#define LDA8(dst, b, h) _Pragma("unroll") for (int m = 0; m < 4; ++m) _Pragma("unroll") for (int k = 0; k < 2; ++k) \
    dst[m][k] = *(const bf16x8*)(la + ((b) * 2 + (h)) * HTB + (m * 2 + k) * 1024)
#define LDB8(dst, b, h) _Pragma("unroll") for (int n = 0; n < 2; ++n) _Pragma("unroll") for (int k = 0; k < 2; ++k) \
    dst[n][k] = *(const bf16x8*)(lb + ((b) * 2 + (h)) * HTB + (n * 2 + k) * 1024)
#define MMA8(ai, bj, At_, Bt_) do { __builtin_amdgcn_s_setprio(1); \
    _Pragma("unroll") for (int m = 0; m < 4; ++m) _Pragma("unroll") for (int n = 0; n < 2; ++n) _Pragma("unroll") for (int k = 0; k < 2; ++k) \
      acc[ai][bj][m][n] = __builtin_amdgcn_mfma_f32_16x16x32_bf16(Bt_[n][k], At_[m][k], acc[ai][bj][m][n], 0, 0, 0); \
    __builtin_amdgcn_s_setprio(0); } while (0)
#define WAIT_V8(n) asm volatile("s_waitcnt vmcnt(" #n ")" ::: "memory")
#define WAIT_L8(n) asm volatile("s_waitcnt lgkmcnt(" #n ")" ::: "memory")
#define BAR8 __builtin_amdgcn_s_barrier()
#define SCHED8 __builtin_amdgcn_sched_barrier(0)
#pragma unroll
  for (int a = 0; a < 2; ++a)
#pragma unroll
    for (int b = 0; b < 2; ++b)
#pragma unroll
      for (int m = 0; m < 4; ++m)
#pragma unroll
        for (int n = 0; n < 2; ++n) acc[a][b][m][n] = f32x4v{0.f, 0.f, 0.f, 0.f};
  bf16x8 At[4][2], B0[2][2], B1[2][2];
  const int nt = K / BK8;
  asm volatile("s_waitcnt vmcnt(0)" ::: "memory");
  __syncthreads();
  STAGE8(SB8(0, 0), Bt, 0, 0); STAGE8(SA8(0, 0), A, 0, 0);
  STAGE8(SB8(0, 1), Bt, HALF8, 0); STAGE8(SA8(0, 1), A, HALF8, 0);
  if (wr == 1) BAR8;
  WAIT_V8(4); BAR8;
  STAGE8(SB8(1, 0), Bt, 0, 1); STAGE8(SA8(1, 0), A, 0, 1); STAGE8(SB8(1, 1), Bt, HALF8, 1);
  WAIT_V8(6); BAR8;
#pragma unroll 1
  for (int t = 0; t < nt - 2; t += 2) {
    LDB8(B0, 0, 0); SCHED8; LDA8(At, 0, 0); STAGE8(SA8(1, 1), A, HALF8, t + 1);
    WAIT_L8(8); BAR8; WAIT_L8(0); MMA8(0, 0, At, B0); BAR8; SCHED8;
    LDB8(B1, 0, 1); STAGE8(SB8(0, 0), Bt, 0, t + 2);
    BAR8; WAIT_L8(0); MMA8(0, 1, At, B1); BAR8;
    LDA8(At, 0, 1); STAGE8(SA8(0, 0), A, 0, t + 2);
    BAR8; WAIT_L8(0); MMA8(1, 0, At, B0); BAR8; SCHED8;
    STAGE8(SB8(0, 1), Bt, HALF8, t + 2);
    WAIT_V8(6); BAR8; MMA8(1, 1, At, B1); BAR8;
    LDB8(B0, 1, 0); SCHED8; LDA8(At, 1, 0); STAGE8(SA8(0, 1), A, HALF8, t + 2);
    WAIT_L8(8); BAR8; WAIT_L8(0); MMA8(0, 0, At, B0); BAR8; SCHED8;
    LDB8(B1, 1, 1); STAGE8(SB8(1, 0), Bt, 0, t + 3);
    BAR8; WAIT_L8(0); MMA8(0, 1, At, B1); BAR8;
    LDA8(At, 1, 1); STAGE8(SA8(1, 0), A, 0, t + 3);
    BAR8; WAIT_L8(0); MMA8(1, 0, At, B0); BAR8; SCHED8;
    STAGE8(SB8(1, 1), Bt, HALF8, t + 3);
    WAIT_V8(6); BAR8; MMA8(1, 1, At, B1); BAR8;
  }
  { LDB8(B0, 0, 0); LDA8(At, 0, 0); STAGE8(SA8(1, 1), A, HALF8, nt - 1);
    BAR8; WAIT_L8(0); MMA8(0, 0, At, B0); BAR8;
    LDB8(B1, 0, 1); BAR8; WAIT_L8(0); MMA8(0, 1, At, B1); BAR8;
    LDA8(At, 0, 1); WAIT_V8(4); BAR8; WAIT_L8(0); MMA8(1, 0, At, B0); MMA8(1, 1, At, B1); BAR8; }
  { LDB8(B0, 1, 0); LDA8(At, 1, 0); WAIT_V8(2); BAR8; WAIT_L8(0); MMA8(0, 0, At, B0); BAR8;
    LDB8(B1, 1, 1); WAIT_V8(0); BAR8; WAIT_L8(0); MMA8(0, 1, At, B1); BAR8;
    LDA8(At, 1, 1); BAR8; WAIT_L8(0); MMA8(1, 0, At, B0); MMA8(1, 1, At, B1); BAR8; }
  if (wr == 0) BAR8;
  asm volatile("s_waitcnt lgkmcnt(0)" ::: "memory");
  BAR8;
#undef SA8
#undef SB8
#undef STAGE8
#undef LDA8
#undef LDB8
#undef MMA8
#undef WAIT_V8
#undef WAIT_L8
#undef BAR8
#undef SCHED8
}

DI void fill_rs(float* rs, const float* ssq, int nparts, int pstride, int row0, float invK) {
  const int t = ltid();
  if (t < 256) {
    float r = 1.f;
    if (ssq) {
      float s = 0.f;
      if (pstride == 1) {
        const f4 a = *(const f4*)(ssq + (size_t)(row0 + t) * 8), b = *(const f4*)(ssq + (size_t)(row0 + t) * 8 + 4);
        s = (a.x + a.y) + (a.z + a.w) + (b.x + b.y) + (b.z + b.w);
      } else {
        for (int p = 0; p < nparts; ++p) s += ssq[(size_t)p * pstride + row0 + t];
      }
      r = rsqrtf(s * invK + EPSV);
    }
    rs[t] = r;
  }
}

enum { EP_HEADROT = 0, EP_VT, EP_PLAIN, EP_KROPE, EP_NORM128, EP_QB, EP_KVB, EP_RES, EP_MLP1, EP_YTMP, EP_GATE };

struct Tile {
  int epi, row0, cb;
  bf16_t* dst; int ldd;
  const float* gain;
  float* ssq_out;
  const float* xsrc;
  float oscale;
  const bf16_t* ysrc;
  int accum;
};

DI void map_regular(int it, int bid, int NCB, int& rb, int& CB) {
  const int xcd = bid & 7, slot = bid >> 3;
  const int c = xcd * NCB + it;
  const int ncg = NCB >> 2;
  const int cgrp = c % ncg, rgrp = c / ncg;
  rb = rgrp * 8 + (slot >> 2);
  CB = cgrp * 4 + (slot & 3);
}

template <int DK, int DV, int NM, bool CAUSAL>
DI void attn_block(const bf16_t* __restrict__ Q, int ldq, const bf16_t* __restrict__ Kg, int ldk, const bf16_t* __restrict__ Vt, int ldv,
                   int nkt, int q0, bf16_t* O, int ldo, float sc, float lam, const float* og, float omul, char* smem) {
  constexpr int KW = NM * DK, KCHV = KW / 8;
  constexpr int KBYTES = 64 * 256, VBYTES = DV * 128, STAGE = KBYTES + VBYTES;
  constexpr int NVI = DV / 64;
  constexpr int NLD = 2 + NVI;
  static_assert(KCHV <= 16 && 4 * STAGE <= RS_OFF, "lds");
  constexpr int NKC16 = DK / 16, NDVB = DV / 32;
  const int tid = ltid(), lane = tid & 63, wave = tid >> 6, h = lane >> 5, l31 = lane & 31;
  const int wq = (NM == 2) ? (wave & 3) : wave;
  const int mymap = (NM == 2) ? (wave >> 2) : 0;
  const int q0w = q0 + wq * 32;

  bf16x8 qf[NKC16];
  f32x16 o[NDVB];
#pragma unroll
  for (int d = 0; d < NDVB; ++d)
#pragma unroll
    for (int i = 0; i < 16; ++i) o[d][i] = 0.f;
  f32x16 lacc;
#pragma unroll
  for (int i = 0; i < 16; ++i) lacc[i] = 0.f;
  u4 onesu; onesu.x = onesu.y = onesu.z = onesu.w = 0x3F803F80u;
  const bf16x8 ones = __builtin_bit_cast(bf16x8, onesu);

  const int wu = __builtin_amdgcn_readfirstlane(wave);
  const int krow = lane >> 4, kslot = lane & 15;
  const int vrow = lane >> 3, vslot = lane & 7;
  auto issue = [&](int kt) {
    char* st = smem + (kt & 3) * STAGE;
#pragma unroll
    for (int i = 0; i < 2; ++i) {
      const int r = (wu * 2 + i) * 4 + krow;
      const int c = kslot ^ (r & 15);
      if (KCHV == 16 || c < KCHV)
        __builtin_amdgcn_global_load_lds((const unsigned*)(Kg + (size_t)(kt * 64 + r) * ldk + c * 8), (unsigned*)(st + (wu * 2 + i) * 1024), 16, 0, 0);
    }
#pragma unroll
    for (int i = 0; i < NVI; ++i) {
      const int d = (wu * NVI + i) * 8 + vrow;
      const int c = vslot ^ ((d >> 1) & 7);
      __builtin_amdgcn_global_load_lds((const unsigned*)(Vt + (size_t)d * ldv + kt * 64 + c * 8), (unsigned*)(st + KBYTES + (wu * NVI + i) * 1024), 16, 0, 0);
    }
  };
  asm volatile("s_waitcnt vmcnt(0)" ::: "memory");
  __syncthreads();
  if (0 < nkt) issue(0);
  if (1 < nkt) issue(1);
  if (2 < nkt) issue(2);
  {
    const bf16_t* qp = Q + (size_t)(wq * 32 + l31) * ldq + mymap * DK + h * 8;
#pragma unroll
    for (int kc = 0; kc < NKC16; ++kc) qf[kc] = *(const bf16x8*)(qp + kc * 16);
#pragma unroll
    for (int kc = 0; kc < NKC16; ++kc) asm volatile("" : "+v"(qf[kc]));
  }
  for (int kt = 0; kt < nkt; ++kt) {
    if (kt + 2 < nkt) asm volatile("s_waitcnt vmcnt(%0)" ::"n"(2 * NLD) : "memory");
    else if (kt + 1 < nkt) asm volatile("s_waitcnt vmcnt(%0)" ::"n"(NLD) : "memory");
    else asm volatile("s_waitcnt vmcnt(0)" ::: "memory");
    asm volatile("s_waitcnt lgkmcnt(0)" ::: "memory");
    __builtin_amdgcn_s_barrier();
    if (kt + 3 < nkt) issue(kt + 3);
    const bool skip = CAUSAL && (kt * 64 > q0w + 31);
    if (!skip) {
      const char* base = smem + (kt & 3) * STAGE;
      f32x16 s[2];
#pragma unroll
      for (int sb = 0; sb < 2; ++sb) {
#pragma unroll
        for (int i = 0; i < 16; ++i) s[sb][i] = 0.f;
        const char* pk = base + (sb * 32 + l31) * 256;
#pragma unroll
        for (int kc = 0; kc < NKC16; ++kc) {
          const bf16x8 a = *(const bf16x8*)(pk + (((mymap * (DK / 8) + kc * 2 + h) ^ (l31 & 15)) * 16));
          s[sb] = MFMA(a, qf[kc], s[sb]);
        }
        __builtin_amdgcn_sched_barrier(0);
      }
      const bool need_mask = CAUSAL && (kt * 64 + 63 > q0w);
      const char* pv = base + KBYTES + l31 * 128;
      const int vsw = (l31 >> 1) & 7;
      bf16x8 pf[4];
      auto expo = [&](int sb) {
#pragma unroll
        for (int i = 0; i < 16; ++i) {
          float pz = __builtin_amdgcn_exp2f(s[sb][i]);
          if (need_mask) {
            const int key = kt * 64 + sb * 32 + crow(i, h);
            if (key > q0w + l31) pz = 0.f;
          }
          s[sb][i] = pz;
        }
#pragma unroll
        for (int k2 = 0; k2 < 2; ++k2) {
          u4 pu;
          pu.x = pack2(s[sb][k2 * 8 + 0], s[sb][k2 * 8 + 1]);
          pu.y = pack2(s[sb][k2 * 8 + 2], s[sb][k2 * 8 + 3]);
          pu.z = pack2(s[sb][k2 * 8 + 4], s[sb][k2 * 8 + 5]);
          pu.w = pack2(s[sb][k2 * 8 + 6], s[sb][k2 * 8 + 7]);
          pf[sb * 2 + k2] = __builtin_bit_cast(bf16x8, pu);
        }
      };
      auto pvmm = [&](int ks) {
        lacc = MFMA(ones, pf[ks], lacc);
#pragma unroll
        for (int d = 0; d < NDVB; ++d) {
          const u4 au = *(const u4*)(pv + d * 32 * 128 + (((ks * 2 + h) ^ vsw) * 16));
          o[d] = MFMA(__builtin_bit_cast(bf16x8, au), pf[ks], o[d]);
        }
      };
      expo(0);
      pvmm(0); pvmm(1);
      expo(1);
      pvmm(2); pvmm(3);
      __builtin_amdgcn_sched_barrier(0);
    }
  }
  asm volatile("s_waitcnt lgkmcnt(0)" ::: "memory");
  __builtin_amdgcn_s_barrier();
  const float l_tot = lacc[0];
  const float inv = 1.f / l_tot;
#pragma unroll
  for (int d = 0; d < NDVB; ++d)
#pragma unroll
    for (int i = 0; i < 16; ++i) o[d][i] *= inv;

  float rn_out = 1.f;
  if (NM == 2) {
    float* buf = (float*)smem;
    if (wave >= 4) {
#pragma unroll
      for (int d = 0; d < NDVB; ++d)
#pragma unroll
        for (int i = 0; i < 16; ++i) buf[(d * 16 + i) * 256 + (wave & 3) * 64 + lane] = o[d][i];
    }
    __syncthreads();
    if (wave < 4) {
      float ss = 0.f;
#pragma unroll
      for (int d = 0; d < NDVB; ++d) {
#pragma unroll
        for (int i = 0; i < 16; ++i) {
          const float v = o[d][i] - lam * buf[(d * 16 + i) * 256 + wave * 64 + lane];
          o[d][i] = v;
          ss += v * v;
        }
        __builtin_amdgcn_sched_barrier(0);
      }
      ss += __shfl_xor(ss, 32);
      rn_out = rsqrtf(ss * (1.f / DV) + EPSV) * omul;
    }
  }
  if (NM == 1 || wave < 4) {
    bf16_t* op = O + (size_t)(wq * 32 + l31) * ldo + 4 * h;
#pragma unroll
    for (int d = 0; d < NDVB; ++d)
#pragma unroll
      for (int g = 0; g < 4; ++g) {
        f4 gg = {1.f, 1.f, 1.f, 1.f};
        if (NM == 2) gg = *(const f4*)(og + d * 32 + 8 * g + 4 * h);
        u2 u;
        u.x = pack2(o[d][4 * g + 0] * rn_out * gg.x, o[d][4 * g + 1] * rn_out * gg.y);
        u.y = pack2(o[d][4 * g + 2] * rn_out * gg.z, o[d][4 * g + 3] * rn_out * gg.w);
        *(u2*)(op + d * 32 + 8 * g) = u;
      }
  }
}

DI void prep_tile(const float* __restrict__ src, int N, const float* __restrict__ gain, bf16_t* __restrict__ dst, int Kp, int nmode, int kmode, int kt, int nt, char* smem) {
  float* tile = (float*)smem;
  const int tid = ltid();
  __syncthreads();
  {
    const int n = tid & 63;
    const int np = nt * 64 + n;
    int ns = np; bool nv = true;
    if (nmode == 1) {
      if (np < 3712) ns = np;
      else if (np < 3840) { ns = np; nv = (np < 3744); }
      else if (np < 4352) ns = np - 96;
      else ns = np - 96;
    } else if (nmode == 2) {
      const int hh = np >> 7, j = np & 127;
      nv = j < 96; ns = hh * 96 + j;
    }
#pragma unroll
    for (int j = 0; j < 8; ++j) {
      const int kk = (tid >> 6) + 8 * j;
      const int kp = kt * 64 + kk;
      int ks = kp; bool kv = true;
      if (kmode == 1) { const int hh = kp / 96, jj = kp % 96; kv = jj < 64; ks = hh * 64 + jj; }
      float v = 0.f;
      if (nv && kv) { v = src[(size_t)ks * N + ns]; if (gain) v *= gain[ks]; }
      tile[n * 65 + kk] = v;
    }
  }
  __syncthreads();
  {
    const int n = tid >> 3, kc = tid & 7;
    float v[8];
#pragma unroll
    for (int e = 0; e < 8; ++e) v[e] = tile[n * 65 + kc * 8 + e];
    *(u4*)(dst + (size_t)(nt * 64 + n) * Kp + kt * 64 + kc * 8) = pack8(v);
  }
}

DI void prep_item(const Params& p, int l, int it, char* smem) {
  bf16_t* W = (bf16_t*)(p.ws + OFF_W);
  const float* src; const float* gain = nullptr; bf16_t* dst; int N, Kp, nmode = 0, kmode = 0, nkt, loc;
  if (it < 1856)      { loc = it;        src = p.in[4] + (size_t)l * 1024 * 7328; N = 7328; gain = p.in[3] + l * 1024; dst = W + W_IN; Kp = 1024; nmode = 1; nkt = 16; }
  else if (it < 2112) { loc = it - 1856; src = p.in[19] + (size_t)l * 1024 * 1024; N = 1024; gain = p.in[18] + l * 1024; dst = W + W_MEM; Kp = 1024; nkt = 16; }
  else if (it < 2208) { loc = it - 2112; src = p.in[12] + (size_t)l * 384 * 768; N = 768; gain = p.in[11] + l * 384; dst = W + W_QB; Kp = 384; nmode = 2; nkt = 6; }
  else if (it < 2272) { loc = it - 2208; src = p.in[14] + (size_t)l * 256 * 1024; N = 1024; gain = p.in[13] + l * 256; dst = W + W_KVB; Kp = 256; nkt = 4; }
  else if (it < 2528) { loc = it - 2272; src = p.in[10] + (size_t)l * 1024 * 1024; N = 1024; dst = W + W_DO; Kp = 1024; nkt = 16; }
  else if (it < 2720) { loc = it - 2528; src = p.in[17] + (size_t)l * 512 * 1024; N = 1024; dst = W + W_MO; Kp = 768; kmode = 1; nkt = 12; }
  else if (it < 2848) { loc = it - 2720; src = p.in[22] + (size_t)l * 512 * 1024; N = 1024; dst = W + W_CO; Kp = 512; nkt = 8; }
  else if (it < 3104) { loc = it - 2848; src = p.in[23] + (size_t)l * 1024 * 1024; N = 1024; dst = W + W_OUT; Kp = 1024; nkt = 16; }
  else if (it < 4128) { loc = it - 3104; src = p.in[25] + (size_t)l * 1024 * 4096; N = 4096; gain = p.in[24] + l * 1024; dst = W + W_1; Kp = 1024; nkt = 16; }
  else                { loc = it - 4128; src = p.in[26] + (size_t)l * 4096 * 1024; N = 1024; dst = W + W_2; Kp = 4096; nkt = 64; }
  prep_tile(src, N, gain, dst, Kp, nmode, kmode, loc % nkt, loc / nkt, smem);
}
DI void prep_range(const Params& p, int l, int lo, int hi, char* smem) {
  for (int it = lo + blockIdx.x; it < hi; it += gridDim.x) prep_item(p, l, it, smem);
}

DI void phase_init(const Params& p) {
  const int tid_ = ltid(); const int lane = tid_ & 63, gw = blockIdx.x * 8 + (tid_ >> 6), GW = gridDim.x * 8;
  bf16_t* XB = (bf16_t*)(p.ws + OFF_XB); bf16_t* MB = (bf16_t*)(p.ws + OFF_MEMB);
  float* SX = (float*)(p.ws + OFF_SSQX); float* SM = (float*)(p.ws + OFF_SSQMEM);
  for (int r = gw; r < T + MEMR; r += GW) {
    const bool isx = r < T;
    const float* src = isx ? p.in[0] + (size_t)r * 1024 : p.in[1] + (size_t)(r - T) * 1024;
    bf16_t* dst = isx ? XB + (size_t)r * 1024 : MB + (size_t)(r - T) * 1024;
    float ss = 0.f;
#pragma unroll
    for (int j = 0; j < 4; ++j) {
      const f4 v = *(const f4*)(src + j * 256 + lane * 4);
      ss += v.x * v.x + v.y * v.y + v.z * v.z + v.w * v.w;
      u2 u; u.x = pack2(v.x, v.y); u.y = pack2(v.z, v.w);
      *(u2*)(dst + j * 256 + lane * 4) = u;
    }
#pragma unroll
    for (int m = 32; m >= 1; m >>= 1) ss += __shfl_xor(ss, m);
    if (isx) { if (lane < 8) SX[(size_t)r * 8 + lane] = (lane == 0) ? ss : 0.f; }
    else if (lane == 0) SM[r - T] = ss;
  }
}

DI void run_epilogue(const Params& p, const Tile& t, char* smem) {
  float* Cs = (float*)smem;
  float* rs = (float*)(smem + RS_OFF);
  const int tid = ltid();
  const int q = tid & 15, rsub = tid >> 4;
  const int* pos = (const int*)p.in[2];
  if (t.epi == EP_VT) {
    const int c = tid >> 2, rq = tid & 3;
#pragma unroll
    for (int j = 0; j < 8; ++j) {
      float v[8];
#pragma unroll
      for (int e = 0; e < 8; ++e) { const int r = rq * 64 + j * 8 + e; v[e] = Cs[r * CS_LD + c] * rs[r]; }
      bf16_t* d16 = t.dst + (size_t)c * t.ldd + rq * 64 + (j >> 1) * 16;
      u2 lo, hi; lo.x = pack2(v[0], v[1]); lo.y = pack2(v[2], v[3]); hi.x = pack2(v[4], v[5]); hi.y = pack2(v[6], v[7]);
      *(u2*)(d16 + ((j & 1) ? 4 : 0)) = lo;
      *(u2*)(d16 + ((j & 1) ? 12 : 8)) = hi;
    }
    return;
  }
#pragma unroll 1
  for (int pass = 0; pass < 8; ++pass) {
    const int r = rsub + 32 * pass;
    const int row = t.row0 + r;
    float v[8];
    load8(Cs, r, q, v);
    const float rsv = rs[r];
#pragma unroll
    for (int e = 0; e < 8; ++e) v[e] *= rsv;
    switch (t.epi) {
      case EP_HEADROT: {
        const float* cr = Cs + r * CS_LD + 2 * q;
        float x1[2][2], x2[2][2];
#pragma unroll
        for (int m = 0; m < 2; ++m) {
          const fl2_t a = *(const fl2_t*)(cr + m * 64), b = *(const fl2_t*)(cr + m * 64 + 32);
          x1[m][0] = a.x * rsv; x1[m][1] = a.y * rsv; x2[m][0] = b.x * rsv; x2[m][1] = b.y * rsv;
        }
        float ssm[2];
#pragma unroll
        for (int m = 0; m < 2; ++m) {
          float ss = x1[m][0] * x1[m][0] + x1[m][1] * x1[m][1] + x2[m][0] * x2[m][0] + x2[m][1] * x2[m][1];
          ss += __shfl_xor(ss, 1); ss += __shfl_xor(ss, 2); ss += __shfl_xor(ss, 4); ss += __shfl_xor(ss, 8);
          ssm[m] = rsqrtf(ss * (1.f / 64) + EPSV) * t.oscale;
        }
        const int ps = pos[row];
        const fl2_t g1 = *(const fl2_t*)(t.gain + 2 * q), g2 = *(const fl2_t*)(t.gain + 32 + 2 * q);
        const float g1v[2] = {g1.x, g1.y}, g2v[2] = {g2.x, g2.y};
        float cc[2], sn[2];
#pragma unroll
        for (int e = 0; e < 2; ++e) rot_cs(ps, INVF64[2 * q + e], cc[e], sn[e]);
#pragma unroll
        for (int m = 0; m < 2; ++m) {
          float o1[2], o2[2];
#pragma unroll
          for (int e = 0; e < 2; ++e) {
            const float y1 = x1[m][e] * ssm[m] * g1v[e], y2 = x2[m][e] * ssm[m] * g2v[e];
            o1[e] = y1 * cc[e] - y2 * sn[e];
            o2[e] = y2 * cc[e] + y1 * sn[e];
          }
          bf16_t* d = t.dst + (size_t)row * t.ldd + t.cb * 128 + m * 64 + 2 * q;
          *(unsigned*)d = pack2(o1[0], o1[1]);
          *(unsigned*)(d + 32) = pack2(o2[0], o2[1]);
        }
      } break;
      case EP_PLAIN: {
        float ss = 0.f;
#pragma unroll
        for (int e = 0; e < 8; ++e) ss += v[e] * v[e];
        ss += __shfl_xor(ss, 1); ss += __shfl_xor(ss, 2); ss += __shfl_xor(ss, 4); ss += __shfl_xor(ss, 8);
        *(u4*)(t.dst + (size_t)row * t.ldd + t.cb * 128 + q * 8) = pack8(v);
        if (q == 0) t.ssq_out[row] = ss;
      } break;
      case EP_KROPE: {
        const bool first = (q & 2) == 0; const int i0 = (q & 1) * 8;
        const int ps = pos[row];
        float ov[8];
#pragma unroll
        for (int e = 0; e < 8; ++e) {
          const float yp = __shfl_xor(v[e], 2);
          float c, s; rot_cs(ps, INVF32[i0 + e], c, s);
          ov[e] = first ? (v[e] * c - yp * s) : (v[e] * c + yp * s);
        }
        if (q < 4) {
          float* kr = (float*)(p.ws + OFF_KR) + (size_t)row * 32 + q * 8;
          *(f4*)kr = f4{ov[0], ov[1], ov[2], ov[3]};
          *(f4*)(kr + 4) = f4{ov[4], ov[5], ov[6], ov[7]};
        }
      } break;
      case EP_NORM128: {
        float ss = 0.f;
#pragma unroll
        for (int e = 0; e < 8; ++e) ss += v[e] * v[e];
        ss += __shfl_xor(ss, 1); ss += __shfl_xor(ss, 2); ss += __shfl_xor(ss, 4); ss += __shfl_xor(ss, 8);
        const float rn = rsqrtf(ss * (1.f / 128) + EPSV);
#pragma unroll
        for (int e = 0; e < 8; ++e) v[e] *= rn * t.oscale * t.gain[q * 8 + e];
        *(u4*)(t.dst + (size_t)row * t.ldd + t.cb * 128 + q * 8) = pack8(v);
      } break;
      case EP_QB: {
        const bool isr = (q >= 8 && q < 12);
        const bool first = (q & 2) == 0; const int i0 = (q & 1) * 8;
        const int ps = pos[row];
        float ss = 0.f;
#pragma unroll
        for (int e = 0; e < 8; ++e) {
          const float yp = __shfl_xor(v[e], 2);
          float c, s; rot_cs(ps, INVF32[i0 + e], c, s);
          const float rv = first ? (v[e] * c - yp * s) : (v[e] * c + yp * s);
          v[e] = isr ? rv : v[e];
          ss += v[e] * v[e];
        }
        ss += __shfl_xor(ss, 1); ss += __shfl_xor(ss, 2); ss += __shfl_xor(ss, 4); ss += __shfl_xor(ss, 8);
        const float rn = rsqrtf(ss * (1.f / 96) + EPSV);
        if (q < 12) {
#pragma unroll
          for (int e = 0; e < 8; ++e) v[e] *= rn * t.oscale * t.gain[q * 8 + e];
          *(u4*)(t.dst + (size_t)row * 768 + t.cb * 96 + q * 8) = pack8(v);
        }
      } break;
      case EP_KVB: {
        if (q >= 8) {
          if (q < 12) {
            const float* kr = (const float*)(p.ws + OFF_KR) + (size_t)row * 32 + (q - 8) * 8;
            const f4 a = *(const f4*)kr, b = *(const f4*)(kr + 4);
            v[0] = a.x; v[1] = a.y; v[2] = a.z; v[3] = a.w; v[4] = b.x; v[5] = b.y; v[6] = b.z; v[7] = b.w;
          } else {
#pragma unroll
            for (int e = 0; e < 8; ++e) v[e] = 0.f;
          }
        }
        float ss = 0.f;
#pragma unroll
        for (int e = 0; e < 8; ++e) ss += v[e] * v[e];
        ss += __shfl_xor(ss, 1); ss += __shfl_xor(ss, 2); ss += __shfl_xor(ss, 4); ss += __shfl_xor(ss, 8);
        const float rn = rsqrtf(ss * (1.f / 96) + EPSV);
        if (q < 12) {
#pragma unroll
          for (int e = 0; e < 8; ++e) v[e] *= rn * t.oscale * t.gain[q * 8 + e];
          *(u4*)(t.dst + (size_t)row * 768 + t.cb * 96 + q * 8) = pack8(v);
        }
      } break;
      case EP_RES: {
        const float* xs = t.xsrc + (size_t)row * 1024 + t.cb * 128 + q * 8;
        const f4 a = *(const f4*)xs, b = *(const f4*)(xs + 4);
        v[0] += a.x; v[1] += a.y; v[2] += a.z; v[3] += a.w; v[4] += b.x; v[5] += b.y; v[6] += b.z; v[7] += b.w;
        float ss = 0.f;
#pragma unroll
        for (int e = 0; e < 8; ++e) ss += v[e] * v[e];
        ss += __shfl_xor(ss, 1); ss += __shfl_xor(ss, 2); ss += __shfl_xor(ss, 4); ss += __shfl_xor(ss, 8);
        float* xo = p.out + (size_t)row * 1024 + t.cb * 128 + q * 8;
        *(f4*)xo = f4{v[0], v[1], v[2], v[3]};
        *(f4*)(xo + 4) = f4{v[4], v[5], v[6], v[7]};
        *(u4*)(t.dst + (size_t)row * 1024 + t.cb * 128 + q * 8) = pack8(v);
        if (q == 0) t.ssq_out[(size_t)row * 8] = ss;
      } break;
      case EP_YTMP: {
        *(u4*)(t.dst + (size_t)r * 256 + t.cb * 128 + q * 8) = pack8(v);
      } break;
      case EP_GATE: {
        const u4 yu = *(const u4*)(t.ysrc + (size_t)r * 256 + q * 8);
        const f4 ba = *(const f4*)(t.gain + q * 8), bb = *(const f4*)(t.gain + q * 8 + 4);
        bf16_t* mp_ = t.dst + (size_t)row * 1024 + t.cb * 128 + q * 8;
        u4 mu; mu.x = mu.y = mu.z = mu.w = 0u;
        if (t.accum) mu = *(const u4*)mp_;
        const float bs[8] = {ba.x, ba.y, ba.z, ba.w, bb.x, bb.y, bb.z, bb.w};
        const unsigned yw[4] = {yu.x, yu.y, yu.z, yu.w}, mw[4] = {mu.x, mu.y, mu.z, mu.w};
#pragma unroll
        for (int e = 0; e < 8; ++e) {
          const float g = 1.f / (1.f + __expf(-(v[e] + bs[e])));
          const float y = __uint_as_float((e & 1) ? (yw[e >> 1] & 0xffff0000u) : (yw[e >> 1] << 16));
          const float m = __uint_as_float((e & 1) ? (mw[e >> 1] & 0xffff0000u) : (mw[e >> 1] << 16));
          v[e] = m + g * y;
        }
        *(u4*)mp_ = pack8(v);
      } break;
      case EP_MLP1: {
#pragma unroll
        for (int e = 0; e < 8; ++e) { const float u = fmaxf(v[e], 0.f); v[e] = u * u; }
        *(u4*)(t.dst + (size_t)row * t.ldd + t.cb * 128 + q * 8) = pack8(v);
      } break;
      default: break;
    }
  }
  if (t.epi == EP_KVB) {
    bf16_t* VMT = (bf16_t*)(p.ws + OFF_VMT);
    const int c = tid >> 3, r8 = tid & 7;
    const int b = t.row0 >> 11, s0 = t.row0 & 2047;
    bf16_t* d = VMT + ((size_t)(b * 512 + t.cb * 64 + c)) * SEQ + s0 + r8 * 32;
#pragma unroll
    for (int j = 0; j < 4; ++j) {
      float v[8];
#pragma unroll
      for (int e = 0; e < 8; ++e) { const int r = r8 * 32 + j * 8 + e; v[e] = Cs[r * CS_LD + 64 + c] * rs[r]; }
      bf16_t* d16 = d + (j >> 1) * 16;
      u2 lo, hi; lo.x = pack2(v[0], v[1]); lo.y = pack2(v[2], v[3]); hi.x = pack2(v[4], v[5]); hi.y = pack2(v[6], v[7]);
      *(u2*)(d16 + ((j & 1) ? 4 : 0)) = lo;
      *(u2*)(d16 + ((j & 1) ? 12 : 8)) = hi;
    }
  }
}

__global__ void __launch_bounds__(NTHR) mega_fwd(Params p) {
  __shared__ __attribute__((aligned(16))) char smem[LDS_BYTES];
  cg::grid_group grid = cg::this_grid();
  const int G = gridDim.x, bid = blockIdx.x;
  for (int ph = p.ph_lo; ph < p.ph_hi; ++ph) {
      char* ws = p.ws; asm volatile("" : "+s"(ws));
    bf16_t* XB = (bf16_t*)(ws + OFF_XB);   bf16_t* QD = (bf16_t*)(ws + OFF_QD);   bf16_t* KD = (bf16_t*)(ws + OFF_KD);
    bf16_t* VDT = (bf16_t*)(ws + OFF_VDT); bf16_t* CQ = (bf16_t*)(ws + OFF_CQ);   bf16_t* CKV = (bf16_t*)(ws + OFF_CKV);
    bf16_t* XQ = (bf16_t*)(ws + OFF_XQ);   bf16_t* QM = (bf16_t*)(ws + OFF_QM);   bf16_t* KM = (bf16_t*)(ws + OFF_KM);
    bf16_t* VMT = (bf16_t*)(ws + OFF_VMT); bf16_t* MEMB = (bf16_t*)(ws + OFF_MEMB); bf16_t* KC = (bf16_t*)(ws + OFF_KC);
    bf16_t* VCT = (bf16_t*)(ws + OFF_VCT); bf16_t* W = (bf16_t*)(ws + OFF_W);     bf16_t* U = (bf16_t*)(ws + OFF_U);
    bf16_t* MERGED = KD;
    float* SSQX = (float*)(ws + OFF_SSQX); float* SSQCQ = (float*)(ws + OFF_SSQCQ); float* SSQCKV = (float*)(ws + OFF_SSQCKV);
    float* SSQMEM = (float*)(ws + OFF_SSQMEM);

    if (ph == 0) {
      phase_init(p);
      prep_range(p, 0, 0, 5152, smem);
    } else {
      const int l = (ph - 1) / p.per, kr = (ph - 1) % p.per;
      const int k = (kr > p.dupk) ? kr - (p.per - 7) : kr;
#ifndef NO_GEMM
      if (k == 0 || k == 1 || k == 3 || k == 4 || k == 5 || k == 6) {
        int nits = 0, total = 0;
        if (k == 0) { nits = 18; total = 4480; if (l > 0) prep_range(p, l, 4128, 5152, smem); }
        else if (k == 1) { nits = 8; total = 2048; }
        else if (k == 3) { nits = 24; total = 1024; }
        else if (k == 4) { nits = 4; total = 1024; }
        else if (k == 5) { nits = 16; total = 4096; if (l + 1 < NL) prep_range(p, l + 1, 0, 3104, smem); }
        else { nits = 4; total = 1024; if (l + 1 < NL) prep_range(p, l + 1, 3104, 4128, smem); }
        const bool xmap = (G == 256);
        if (!xmap) nits = ((total + G - 1) / G) * ((k == 3) ? 6 : 1);
        int rs_row0 = -1;
#pragma unroll 1
        for (int it = 0; it < nits; ++it) {
          int list = 0, rb = -1, CB = 0;
          if (xmap) {
            if (k == 0) {
              if (it < 16) map_regular(it, bid, 16, rb, CB);
              else if (it == 16) { rb = bid; CB = 16; }
              else if (bid < 128) { list = 1; rb = bid >> 2; CB = bid & 3; }
            } else if (k == 1) { list = it >> 2; map_regular(it & 3, bid, 4, rb, CB); }
            else if (k == 3) map_regular(it / 6, bid, 4, rb, CB);
            else if (k == 5) map_regular(it, bid, 16, rb, CB);
            else map_regular(it, bid, 4, rb, CB);
          } else {
            const int li = ((k == 3) ? (it / 6) : it) * G + bid;
            if (li < total) {
              if (k == 0) { if (li < 4352) { rb = li / 17; CB = li % 17; } else { list = 1; rb = (li - 4352) >> 2; CB = (li - 4352) & 3; } }
              else if (k == 1) { list = li >> 10; rb = (li & 1023) >> 2; CB = li & 3; }
              else if (k == 5) { rb = li >> 4; CB = li & 15; }
              else { rb = li >> 2; CB = li & 3; }
            }
          }
          if (rb < 0) continue;
          const int row0 = rb * 256;
          const bf16_t* Ap; const bf16_t* Bp; int lda, Kd;
          const float* ssq = nullptr; int nparts = 0, pstride = T; float invK = 0.f;
          if (k == 0) {
            if (list == 0) { Ap = XB + (size_t)row0 * 1024; lda = 1024; Bp = W + W_IN + (size_t)CB * 256 * 1024; Kd = 1024; ssq = SSQX; nparts = 8; pstride = 1; invK = 1.f / 1024; }
            else           { Ap = MEMB + (size_t)row0 * 1024; lda = 1024; Bp = W + W_MEM + (size_t)CB * 256 * 1024; Kd = 1024; ssq = SSQMEM; nparts = 1; pstride = 0; invK = 1.f / 1024; }
          } else if (k == 1) {
            if (list == 0) { Ap = CQ + (size_t)row0 * 384; lda = 384; Bp = W + W_QB + (size_t)CB * 256 * 384; Kd = 384; ssq = SSQCQ; nparts = 3; invK = 1.f / 384; }
            else           { Ap = CKV + (size_t)row0 * 256; lda = 256; Bp = W + W_KVB + (size_t)CB * 256 * 256; Kd = 256; ssq = SSQCKV; nparts = 2; invK = 1.f / 256; }
          } else if (k == 3) {
            const int st = it % 6, br = st >> 1;
            if (st & 1)       { Ap = XB + (size_t)row0 * 1024; lda = 1024; Bp = W + W_IN + (size_t)(WIN_GATE0 + br * 1024 + CB * 256) * 1024; Kd = 1024; ssq = SSQX; nparts = 8; pstride = 1; invK = 1.f / 1024; }
            else if (br == 0) { Ap = QD + (size_t)row0 * 1024; lda = 1024; Bp = W + W_DO + (size_t)CB * 256 * 1024; Kd = 1024; }
            else if (br == 1) { Ap = QM + (size_t)row0 * 768;  lda = 768;  Bp = W + W_MO + (size_t)CB * 256 * 768;  Kd = 768; }
            else              { Ap = XQ + (size_t)row0 * 512;  lda = 512;  Bp = W + W_CO + (size_t)CB * 256 * 512;  Kd = 512; }
          } else if (k == 4) { Ap = MERGED + (size_t)row0 * 1024; lda = 1024; Bp = W + W_OUT + (size_t)CB * 256 * 1024; Kd = 1024; }
          else if (k == 5)   { Ap = XB + (size_t)row0 * 1024; lda = 1024; Bp = W + W_1 + (size_t)CB * 256 * 1024; Kd = 1024; ssq = SSQX; nparts = 8; pstride = 1; invK = 1.f / 1024; }
          else               { Ap = U + (size_t)row0 * 4096; lda = 4096; Bp = W + W_2 + (size_t)CB * 256 * 4096; Kd = 4096; }
          f32x4v acc[2][2][4][2];
          gemm8p(Ap, Bp, Kd, acc, smem);
          float* Cs = (float*)smem;
          if (k == 5 || k == 3) {
            float* rsL = (float*)(smem + RS_OFF);
            if (ssq != nullptr && !(ssq == SSQX && rs_row0 == row0)) {
              fill_rs(rsL, ssq, nparts, pstride, row0, invK);
              __syncthreads();
              rs_row0 = (ssq == SSQX) ? row0 : -1;
            }
            const int tq = ltid(); const int lane = tq & 63, wave = tq >> 6, wr = wave >> 2, wc = wave & 3, fr = lane & 15, fq = lane >> 4;
            const int st = it % 6, br = st >> 1;
            bf16_t* YS = VDT + (size_t)blockIdx.x * 65536;
#pragma unroll
            for (int ai = 0; ai < 2; ++ai)
#pragma unroll
              for (int m = 0; m < 4; ++m) {
                const int row = ai * 128 + wr * 64 + m * 16 + fr;
                const float rsv = rsL[row];
#pragma unroll
                for (int bj = 0; bj < 2; ++bj)
#pragma unroll
                  for (int n = 0; n < 2; ++n) {
                    const int col = bj * 128 + wc * 32 + n * 16 + fq * 4;
                    const f32x4v a4 = acc[ai][bj][m][n];
                    float o4[4];
                    if (k == 5) {
#pragma unroll
                      for (int j = 0; j < 4; ++j) { const float u = fmaxf(a4[j] * rsv, 0.f); o4[j] = u * u; }
                      u2 w; w.x = pack2(o4[0], o4[1]); w.y = pack2(o4[2], o4[3]);
                      *(u2*)(U + (size_t)(row0 + row) * 4096 + CB * 256 + col) = w;
                    } else if (!(st & 1)) {
                      u2 w; w.x = pack2(a4[0], a4[1]); w.y = pack2(a4[2], a4[3]);
                      *(u2*)(YS + (size_t)row * 256 + col) = w;
                    } else {
                      const f4 bs = *(const f4*)(p.in[5] + (size_t)l * 3072 + br * 1024 + CB * 256 + col);
                      const u2 yu = *(const u2*)(YS + (size_t)row * 256 + col);
                      bf16_t* mp_ = MERGED + (size_t)(row0 + row) * 1024 + CB * 256 + col;
                      u2 mu; mu.x = mu.y = 0u;
                      if (br > 0) mu = *(const u2*)mp_;
                      const float bsv[4] = {bs.x, bs.y, bs.z, bs.w};
                      const unsigned yw[2] = {yu.x, yu.y}, mw[2] = {mu.x, mu.y};
#pragma unroll
                      for (int j = 0; j < 4; ++j) {
                        const float g = 1.f / (1.f + __expf(-(a4[j] * rsv + bsv[j])));
                        const float y = __uint_as_float((j & 1) ? (yw[j >> 1] & 0xffff0000u) : (yw[j >> 1] << 16));
                        const float mv = __uint_as_float((j & 1) ? (mw[j >> 1] & 0xffff0000u) : (mw[j >> 1] << 16));
                        o4[j] = mv + g * y;
                      }
                      u2 w; w.x = pack2(o4[0], o4[1]); w.y = pack2(o4[2], o4[3]);
                      *(u2*)mp_ = w;
                    }
                  }
              }
          } else
#pragma unroll 1
          for (int half = 0; half < 2; ++half) {
            if (half) __syncthreads();
            {
              const int tq = ltid(); const int lane = tq & 63, wave = tq >> 6, wr = wave >> 2, wc = wave & 3, fr = lane & 15, fq = lane >> 4;
#pragma unroll
              for (int ai = 0; ai < 2; ++ai)
#pragma unroll
                for (int m = 0; m < 4; ++m)
#pragma unroll
                  for (int n = 0; n < 2; ++n) {
                    f32x4v v4;
#pragma unroll
                    for (int j = 0; j < 4; ++j) v4[j] = half ? acc[ai][1][m][n][j] : acc[ai][0][m][n][j];
                    *(f32x4v*)(Cs + (ai * 128 + wr * 64 + m * 16 + fr) * CS_LD + wc * 32 + n * 16 + fq * 4) = v4;
                  }
            }
            if (half == 0 && !(ssq == SSQX && rs_row0 == row0)) {
              fill_rs((float*)(smem + RS_OFF), ssq, nparts, pstride, row0, invK);
              rs_row0 = (ssq == SSQX) ? row0 : -1;
            }
            __syncthreads();
            const int cb = CB * 2 + half;
            Tile t;
            t.row0 = row0; t.cb = cb; t.epi = EP_PLAIN;
            t.dst = nullptr; t.ldd = 0; t.gain = nullptr; t.ssq_out = nullptr; t.xsrc = nullptr; t.oscale = 1.f; t.ysrc = nullptr; t.accum = 0;
            if (k == 0) {
              if (list == 0) {
                if (cb < 8)       { t.epi = EP_HEADROT; t.cb = cb; t.dst = QD; t.ldd = 1024; t.gain = p.in[6] + l * 64; t.oscale = 0.125f * 1.4426950408889634f; }
                else if (cb < 16) { t.epi = EP_HEADROT; t.cb = cb - 8; t.dst = KD; t.ldd = 1024; t.gain = p.in[7] + l * 64; }
                else if (cb < 24) { t.epi = EP_VT; t.cb = cb - 16; const int b = row0 >> 11, s0 = row0 & 2047; t.dst = VDT + ((size_t)(b * 1024 + (cb - 16) * 128)) * SEQ + s0; t.ldd = SEQ; }
                else if (cb < 27) { t.epi = EP_PLAIN; t.cb = cb - 24; t.dst = CQ; t.ldd = 384; t.ssq_out = SSQCQ + (size_t)(cb - 24) * T; }
                else if (cb < 29) { t.epi = EP_PLAIN; t.cb = cb - 27; t.dst = CKV; t.ldd = 256; t.ssq_out = SSQCKV + (size_t)(cb - 27) * T; }
                else if (cb == 29) { t.epi = EP_KROPE; t.cb = 0; }
                else              { t.epi = EP_NORM128; t.cb = cb - 30; t.dst = XQ; t.ldd = 512; t.gain = p.in[20] + l * 128; t.oscale = 0.08838834764831845f * 1.4426950408889634f; }
              } else {
                if (cb < 4) { t.epi = EP_NORM128; t.cb = cb; t.dst = KC; t.ldd = 512; t.gain = p.in[21] + l * 128; }
                else        { t.epi = EP_VT; t.cb = cb - 4; t.dst = VCT + ((size_t)(rb * 512 + (cb - 4) * 128)) * MEML; t.ldd = MEML; }
              }
            } else if (k == 1) {
              if (list == 0) { t.epi = EP_QB; t.dst = QM; t.gain = p.in[15] + l * 96; t.oscale = 0.10206207261596575f * 1.4426950408889634f; }
              else           { t.epi = EP_KVB; t.dst = KM; t.gain = p.in[16] + l * 96; }
            } else if (k == 3) {
              const int st = it % 6, br = st >> 1;
              bf16_t* YS = VDT + (size_t)blockIdx.x * 65536;
              if (st & 1) { t.epi = EP_GATE; t.dst = MERGED; t.ysrc = YS + half * 128; t.gain = p.in[5] + (size_t)l * 3072 + br * 1024 + cb * 128; t.accum = (br > 0); }
              else        { t.epi = EP_YTMP; t.dst = YS; t.cb = half; }
            } else if (k == 4) { t.epi = EP_RES; t.dst = XB; t.xsrc = (l == 0) ? p.in[0] : p.out; t.ssq_out = SSQX + cb; }
            else if (k == 5)   { t.epi = EP_MLP1; t.dst = U; t.ldd = 4096; }
            else               { t.epi = EP_RES; t.dst = XB; t.xsrc = p.out; t.ssq_out = SSQX + cb; }
            run_epilogue(p, t, smem);
          }
        }
      } else
#endif
#ifndef NO_ATT
      if (k == 2) {
        float lam;
        const float lam_init = 0.8f - 0.6f * expf(-0.3f * (float)l);
        {
          const int lane = ltid() & 63;
          const float* lv = p.in[8] + l * 256;
          float sa = lv[lane] * lv[64 + lane], sb = lv[128 + lane] * lv[192 + lane];
#pragma unroll
          for (int m = 32; m >= 1; m >>= 1) { sa += __shfl_xor(sa, m); sb += __shfl_xor(sb, m); }
          lam = expf(sa) - expf(sb) + lam_init;
        }
        const float L2E = 1.4426950408889634f;
#pragma unroll 1
        for (int it = 0; it < ((G == 256) ? 16 : (4096 + G - 1) / G); ++it) {
          int w;
          if (G == 256) {
            const int xcd = bid & 7, slot = bid >> 3;
            if (it < 8)       w = ((it * 32 + (slot >> 3) * 8 + xcd) << 3) + (slot & 7);
            else if (it < 12) w = 2048 + ((((it - 8) * 64 + (slot >> 2) * 8 + xcd) << 2) + (slot & 3));
            else              w = 3072 + ((((it - 12) * 32 + (slot >> 3) * 8 + xcd) << 3) + (slot & 7));
          } else { w = it * G + bid; if (w >= 4096) continue; }
#ifndef NO_A1
          if (w < 2048) {
            const int bh = w >> 3, j = w & 7, b = bh >> 3, hh = bh & 7;
#pragma unroll 1
            for (int half = 0; half < 2; ++half) {
              const int qb = half ? j : 15 - j;
              const int q0 = qb * 128;
              bf16_t* Qp = QD + ((size_t)(b * SEQ + q0)) * 1024 + hh * 128;
              attn_block<64, 128, 2, true>(Qp, 1024, KD + (size_t)b * SEQ * 1024 + hh * 128, 1024, VDT + ((size_t)(b * 1024 + hh * 128)) * SEQ, SEQ,
                                            (q0 + 128) >> 6, q0, Qp, 1024, 0.125f * L2E, lam, p.in[9] + l * 128, 1.f - lam_init, smem);
            }
          } else
#endif
#ifndef NO_A2
          if (w < 3072) {
            const int wj = w - 2048; const int bh = wj >> 2, j = wj & 3, b = bh >> 3, hh = bh & 7;
#pragma unroll 1
            for (int half = 0; half < 2; ++half) {
              const int qb = half ? j : 7 - j;
              const int q0 = qb * 256;
              bf16_t* Qp = QM + ((size_t)(b * SEQ + q0)) * 768 + hh * 96;
              attn_block<96, 64, 1, true>(Qp, 768, KM + (size_t)b * SEQ * 768 + hh * 96, 768, VMT + ((size_t)(b * 512 + hh * 64)) * SEQ, SEQ,
                                           (q0 + 256) >> 6, q0, Qp, 768, 0.10206207261596575f * L2E, 0.f, nullptr, 1.f, smem);
            }
          } else
#endif
#ifndef NO_A3
          {
            const int wj = w - 3072; const int bh = wj >> 3, qb = wj & 7, b = bh >> 2, hh = bh & 3;
            const int q0 = qb * 256;
            bf16_t* Qp = XQ + ((size_t)(b * SEQ + q0)) * 512 + hh * 128;
            attn_block<128, 128, 1, false>(Qp, 512, KC + (size_t)b * MEML * 512 + hh * 128, 512, VCT + ((size_t)(b * 512 + hh * 128)) * MEML, MEML,
                                            4, q0, Qp, 512, 0.08838834764831845f * L2E, 0.f, nullptr, 1.f, smem);
          }
#endif
          {}
        }
      } else
#endif
#ifndef NO_D
      if (k == 3) {
        float* Cs = (float*)smem;
        float* rs = (float*)(smem + RS_OFF);
#pragma unroll 1
        for (int it = 0; it < ((G == 256) ? 8 : (2048 + G - 1) / G); ++it) {
          int rb, cb;
          if (G == 256) map_regular(it, bid, 8, rb, cb);
          else { const int li = it * G + bid; if (li >= 2048) continue; rb = li >> 3; cb = li & 7; }
          const int tidd = ltid(); const int lane = tidd & 63, wave = tidd >> 6, wm = wave >> 1, wn = wave & 1, h = lane >> 5;
          const int row0 = rb * 256, col0 = cb * 128;
          __syncthreads();
          fill_rs(rs, SSQX, 8, T, row0, 1.f / 1024);
          f32x16 acc[2][2];
          unsigned gp[2][2][8], mp[2][2][8];
#pragma unroll
          for (int mi = 0; mi < 2; ++mi)
#pragma unroll
            for (int ni = 0; ni < 2; ++ni)
#pragma unroll
              for (int i = 0; i < 8; ++i) mp[mi][ni][i] = 0u;
#pragma unroll 1
          for (int st = 0; st < 6; ++st) {
            const int br = st >> 1, half = st & 1;
            const bf16_t* Ab; const bf16_t* Bb; int Kb;
            if (half == 0)    { Ab = XB + (size_t)row0 * 1024; Bb = W + W_IN + (size_t)(WIN_GATE0 + br * 1024 + col0) * 1024; Kb = 1024; }
            else if (br == 0) { Ab = QD + (size_t)row0 * 1024; Bb = W + W_DO + (size_t)col0 * 1024; Kb = 1024; }
            else if (br == 1) { Ab = QM + (size_t)row0 * 768;  Bb = W + W_MO + (size_t)col0 * 768;  Kb = 768; }
            else              { Ab = XQ + (size_t)row0 * 512;  Bb = W + W_CO + (size_t)col0 * 512;  Kb = 512; }
            gemm_mainloop<2, 2, 2, false>(Ab, Kb, Bb, Kb, Kb, acc, smem);
            if (half == 0) {
              const float* bg = p.in[5] + (size_t)l * 3072 + br * 1024 + col0 + wn * 64 + (lane & 31);
              const float bgv0 = bg[0], bgv1 = bg[32];
#pragma unroll
              for (int mi = 0; mi < 2; ++mi) {
                float rsv[16];
#pragma unroll
                for (int i = 0; i < 16; ++i) rsv[i] = rs[wm * 64 + mi * 32 + crow(i, h)];
#pragma unroll
                for (int ni = 0; ni < 2; ++ni) {
                  const float bgv = ni ? bgv1 : bgv0;
#pragma unroll
                  for (int i = 0; i < 16; i += 2) {
                    const float z0 = acc[mi][ni][i] * rsv[i] + bgv;
                    const float z1 = acc[mi][ni][i + 1] * rsv[i + 1] + bgv;
                    gp[mi][ni][i >> 1] = pack2(1.f / (1.f + __expf(-z0)), 1.f / (1.f + __expf(-z1)));
                  }
                }
                __builtin_amdgcn_sched_barrier(0);
              }
            } else {
#pragma unroll
              for (int mi = 0; mi < 2; ++mi)
#pragma unroll
                for (int ni = 0; ni < 2; ++ni)
#pragma unroll
                  for (int i = 0; i < 16; i += 2) {
                    const unsigned g2 = gp[mi][ni][i >> 1], m2 = mp[mi][ni][i >> 1];
                    const float m0 = __uint_as_float(m2 << 16) + __uint_as_float(g2 << 16) * acc[mi][ni][i];
                    const float m1 = __uint_as_float(m2 & 0xffff0000u) + __uint_as_float(g2 & 0xffff0000u) * acc[mi][ni][i + 1];
                    mp[mi][ni][i >> 1] = pack2(m0, m1);
                  }
            }
          }
#pragma unroll
          for (int mi = 0; mi < 2; ++mi)
#pragma unroll
            for (int ni = 0; ni < 2; ++ni)
#pragma unroll
              for (int i = 0; i < 16; ++i) {
                const unsigned m2 = mp[mi][ni][i >> 1];
                Cs[(wm * 64 + mi * 32 + crow(i, h)) * CS_LD + wn * 64 + ni * 32 + (lane & 31)] = __uint_as_float((i & 1) ? (m2 & 0xffff0000u) : (m2 << 16));
              }
          __syncthreads();
          const int q = tidd & 15, rsub = tidd >> 4;
#pragma unroll 1
          for (int pass = 0; pass < 8; ++pass) {
            const int r = rsub + 32 * pass;
            float v[8];
            load8(Cs, r, q, v);
            *(u4*)(MERGED + (size_t)(row0 + r) * 1024 + col0 + q * 8) = pack8(v);
          }
        }
      }
#endif
      {}
    }
    if (ph + 1 < p.ph_hi) grid.sync();
  }
}

extern "C" void kernel_launch(void* const* d_in, const int* in_sizes, int n_in, void* d_out, int out_size, void* d_ws, size_t ws_size, hipStream_t stream) {
  static int grid_blocks = 0;
  if (grid_blocks == 0) {
    if (n_in != 27 || ws_size < WS_NEED) { fprintf(stderr, "kernel_launch: unexpected inputs (n_in %d) or workspace (%zu < %zu)\n", n_in, ws_size, (size_t)WS_NEED); grid_blocks = -1; return; }
    int dev = 0, cus = 0, per_cu = 0;
    hipGetDevice(&dev);
    hipDeviceGetAttribute(&cus, hipDeviceAttributeMultiprocessorCount, dev);
    hipOccupancyMaxActiveBlocksPerMultiprocessor(&per_cu, mega_fwd, NTHR, 0);
    if (per_cu < 1) per_cu = 1;
    if (per_cu > 1) per_cu = 1;
    grid_blocks = cus * per_cu;
  }
  if (grid_blocks < 0) return;
  Params p{};
  for (int i = 0; i < 27; ++i) p.in[i] = (const float*)d_in[i];
  p.out = (float*)d_out;
  p.ws = (char*)d_ws;
  p.ph_lo = 0;
  p.dupk = (DUP_K >= 0) ? DUP_K : 100;
  p.per = (DUP_K >= 0) ? 8 : 7;
  p.ph_hi = 1 + NL * p.per;
  void* args[] = {&p};
  hipError_t e = hipLaunchCooperativeKernel((void*)mega_fwd, dim3(grid_blocks), dim3(NTHR), args, 0, stream);
  if (e != hipSuccess) fprintf(stderr, "cooperative launch failed: %s (grid %d)\n", hipGetErrorString(e), grid_blocks);
}
```
